# Optimizing an MI355X kernel written in HIP

```python
import math, functools
import jax, jax.numpy as jnp
from jax import lax
import numpy as np

D_MODEL = 1024
BATCH = 4
SEQ = 4096
DEPTH = 2
DEC_BATCH = 128
DEC_SEQ = 4
PAST_LEN = 8192
PAGE_SIZE = 128

D_MIX = D_MODEL
D_CONV = D_MIX // 4
CONV_WIDTH = 31
H_HGRN = 4
DK_HGRN = 128
D_HGRN = D_MIX // 2
DV_HGRN = D_HGRN // H_HGRN
HGRN_CHUNK = 64
HEAD_DIM = 64
D_ATTN = D_MIX - D_CONV - D_HGRN
H_ATTN = D_ATTN // HEAD_DIM
KV_HEADS = 2
GROUP = H_ATTN // KV_HEADS
WINDOW = 128
ATTN_BLOCK = 128
NUM_BUCKETS = 32
MAX_DISTANCE = 128
D_FF = 4 * D_MODEL
N_MOD = 6
EPS = 1e-6
IN_SIZES = (D_CONV, D_CONV, H_HGRN * DK_HGRN, H_HGRN * DK_HGRN, D_HGRN, D_HGRN,
            D_ATTN, KV_HEADS * HEAD_DIM, KV_HEADS * HEAD_DIM)
IN_WIDTH = sum(IN_SIZES)

kernel_name = "hymba_conv_hgrn2_swa_adaln_step"


def rmsnorm(x, g):
    xf = x.astype(jnp.float32)
    y = xf * lax.rsqrt(jnp.mean(xf * xf, axis=-1, keepdims=True) + EPS)
    return (y * g.astype(jnp.float32)).astype(x.dtype)


def layernorm(x, g, b):
    xf = x.astype(jnp.float32)
    mu = jnp.mean(xf, axis=-1, keepdims=True)
    xc = xf - mu
    y = xc * lax.rsqrt(jnp.mean(xc * xc, axis=-1, keepdims=True) + EPS)
    return (y * g.astype(jnp.float32) + b.astype(jnp.float32)).astype(x.dtype)


def causal_dwconv(a_prev, a, w, b):
    full = jnp.concatenate([a_prev, a], axis=1)
    out = lax.conv_general_dilated(full, w[:, None, :].astype(full.dtype), window_strides=(1,), padding='VALID',
                                   dimension_numbers=('NWC', 'WIO', 'NWC'), feature_group_count=a.shape[-1])
    return out + b, full[:, -(CONV_WIDTH - 1):]


def hgrn2_chunked(q, log_f, k, v, S0):
    B, T = q.shape[:2]
    L = min(HGRN_CHUNK, T)
    n = -(-T // L)
    pad = n * L - T

    def prep(t):
        t = jnp.pad(t, ((0, 0), (0, pad), (0, 0), (0, 0)))
        return t.reshape(B, n, L, t.shape[2], t.shape[3]).transpose(1, 0, 3, 2, 4)

    tri = jnp.tril(jnp.ones((L, L), dtype=bool))

    def step(S, inp):
        qc, lfc, kc, vc = inp
        bcum = jnp.cumsum(lfc, axis=2)
        diff = bcum[:, :, :, None, :] - bcum[:, :, None, :, :]
        decay = jnp.exp(jnp.where(tri[:, :, None], diff, -jnp.inf))
        A = jnp.einsum('bhtd,bhsd,bhtsd->bhts', qc, kc, decay)
        o = jnp.einsum('bhts,bhsv->bhtv', A, vc) + jnp.einsum('bhtd,bhdv->bhtv', qc * jnp.exp(bcum), S)
        bL = bcum[:, :, -1]
        S_new = jnp.exp(bL)[..., None] * S + jnp.einsum('bhsd,bhsv->bhdv', kc * jnp.exp(bL[:, :, None] - bcum), vc)
        return S_new, o

    S_fin, o = lax.scan(step, S0, (prep(q), prep(log_f), prep(k), prep(v)))
    o = o.transpose(1, 0, 3, 2, 4).reshape(B, n * L, q.shape[2], v.shape[3])[:, :T]
    return o, S_fin


def t5_bucket(rel):
    n = jnp.maximum(rel, 0)
    max_exact = NUM_BUCKETS // 2
    nf = jnp.maximum(n, max_exact).astype(jnp.float32)
    large = max_exact + (jnp.log(nf / max_exact) / math.log(MAX_DISTANCE / max_exact)
                         * (NUM_BUCKETS - max_exact)).astype(jnp.int32)
    large = jnp.minimum(large, NUM_BUCKETS - 1)
    return jnp.where(n < max_exact, n, large)


def band_bias(q_pos, k_pos, table):
    rel = q_pos[..., :, None] - k_pos[..., None, :]
    mask = (rel >= 0) & (rel <= WINDOW) & (k_pos[..., None, :] >= 0)
    bias = jnp.moveaxis(table.astype(jnp.float32)[t5_bucket(rel)], -1, -3)
    return jnp.where(mask[..., None, :, :], bias, -jnp.inf)


def sink_attention(q, k, v, bias, sinks):
    qg = q.reshape(q.shape[:-2] + (KV_HEADS, GROUP, HEAD_DIM))
    bias = bias.reshape(bias.shape[:-3] + (KV_HEADS, GROUP) + bias.shape[-2:])
    s = jnp.einsum('...qkgd,...skd->...kgqs', qg, k).astype(jnp.float32) * (HEAD_DIM ** -0.5) + bias
    sink = sinks.astype(jnp.float32).reshape(KV_HEADS, GROUP)[:, :, None, None]
    m = jnp.maximum(jnp.max(s, axis=-1, keepdims=True), sink)
    p = jnp.exp(s - m)
    p = p / (jnp.sum(p, axis=-1, keepdims=True) + jnp.exp(sink - m))
    o = jnp.einsum('...kgqs,...skd->...qkgd', p.astype(v.dtype), v)
    return o.reshape(q.shape[:-2] + (H_ATTN * HEAD_DIM,))


def swa_prompt(q, k, v, sinks, bias):
    B, T = q.shape[:2]
    nb = T // ATTN_BLOCK
    qb = q.reshape(B, nb, ATTN_BLOCK, H_ATTN, HEAD_DIM)
    kb = k.reshape(B, nb, ATTN_BLOCK, KV_HEADS, HEAD_DIM)
    vb = v.reshape(B, nb, ATTN_BLOCK, KV_HEADS, HEAD_DIM)
    kk = jnp.concatenate([jnp.concatenate([jnp.zeros_like(kb[:, :1]), kb[:, :-1]], axis=1), kb], axis=2)
    vv = jnp.concatenate([jnp.concatenate([jnp.zeros_like(vb[:, :1]), vb[:, :-1]], axis=1), vb], axis=2)
    o = sink_attention(qb, kk, vv, bias, sinks).reshape(B, T, D_ATTN)
    keep = min(WINDOW, T)
    return o, k[:, -keep:], v[:, -keep:]


def swa_sample(q, k, v, sinks, bias, k_buf, v_buf):
    kk = jnp.concatenate([k_buf, k], axis=1)
    vv = jnp.concatenate([v_buf, v], axis=1)
    o = sink_attention(q, kk, vv, bias, sinks)
    keep = k_buf.shape[1]
    return o, kk[:, -keep:], vv[:, -keep:]


def layer(x, c, conv_prev, S0, attn_fn, lb, w_ada, b_ada, norm_mix_g, w_in, conv_w, conv_b, conv_ln_g, conv_ln_b,
          hgrn_norm_g, sinks, w_out, norm_mlp_g, w_up, w_down):
    B, T = x.shape[:2]
    mod = jax.nn.silu(c) @ w_ada + b_ada
    sh1, sc1, g1, sh2, sc2, g2 = jnp.split(mod[:, None, :], N_MOD, axis=-1)
    h = rmsnorm(x, norm_mix_g) * (1 + sc1) + sh1
    proj = h @ w_in
    a_val, a_gate, q_h, f_h, i_h, g_h, q_a, k_a, v_a = jnp.split(proj, np.cumsum(IN_SIZES)[:-1].tolist(), axis=-1)
    a = a_val * jax.nn.sigmoid(a_gate)
    a_conv, conv_new = causal_dwconv(conv_prev, a, conv_w, conv_b)
    out_a = jax.nn.silu(layernorm(a_conv, conv_ln_g, conv_ln_b))
    lbh = lb.reshape(H_HGRN, DK_HGRN)
    f = lbh + (1 - lbh) * jax.nn.sigmoid(f_h.reshape(B, T, H_HGRN, DK_HGRN).astype(jnp.float32))
    o_b, S_new = hgrn2_chunked(q_h.reshape(B, T, H_HGRN, DK_HGRN).astype(jnp.float32), jnp.log(f), 1 - f,
                               i_h.reshape(B, T, H_HGRN, DV_HGRN).astype(jnp.float32), S0.astype(jnp.float32))
    out_b = (rmsnorm(o_b, hgrn_norm_g) * jax.nn.silu(g_h.reshape(B, T, H_HGRN, DV_HGRN).astype(jnp.float32)))
    out_b = out_b.reshape(B, T, D_HGRN).astype(x.dtype)
    out_c, k_new, v_new = attn_fn(q_a.reshape(B, T, H_ATTN, HEAD_DIM), k_a.reshape(B, T, KV_HEADS, HEAD_DIM),
                                  v_a.reshape(B, T, KV_HEADS, HEAD_DIM), sinks)
    mix = jnp.concatenate([out_a, out_b, out_c.astype(x.dtype)], axis=-1) @ w_out
    x = x + g1 * mix
    h2 = rmsnorm(x, norm_mlp_g) * (1 + sc2) + sh2
    x = x + g2 * (jnp.square(jax.nn.relu(h2 @ w_up)) @ w_down)
    return x, conv_new, S_new.astype(S0.dtype), k_new, v_new


def setup_inputs(seed: int = 0) -> dict:
    key = jax.random.key(seed)
    ks = jax.random.split(key, 26)
    f32 = jnp.float32

    def nrm(k, shape, scale=1.0):
        return scale * jax.random.normal(k, shape, f32)

    w_buf = min(WINDOW, PAST_LEN)
    return {
        "x_prompt": nrm(ks[0], (BATCH, SEQ, D_MODEL)),
        "x_sample": nrm(ks[1], (DEC_BATCH, DEC_SEQ, D_MODEL)),
        "cache_conv": nrm(ks[2], (DEPTH, DEC_BATCH, CONV_WIDTH - 1, D_CONV), 0.5),
        "state_hgrn": nrm(ks[3], (DEPTH, DEC_BATCH, H_HGRN, DK_HGRN, DV_HGRN), 0.5),
        "cache_swa_k": nrm(ks[4], (DEPTH, DEC_BATCH, w_buf, KV_HEADS, HEAD_DIM)),
        "cache_swa_v": nrm(ks[5], (DEPTH, DEC_BATCH, w_buf, KV_HEADS, HEAD_DIM)),
        "c_prompt": nrm(ks[6], (BATCH, D_MODEL)),
        "c_sample": nrm(ks[7], (DEC_BATCH, D_MODEL)),
        "rel_bias": nrm(ks[8], (NUM_BUCKETS, H_ATTN), 0.5),
        "w_ada": nrm(ks[9], (DEPTH, D_MODEL, N_MOD * D_MODEL), 0.5 * D_MODEL ** -0.5),
        "b_ada": nrm(ks[10], (DEPTH, N_MOD * D_MODEL), 0.02),
        "norm_mix_g": 1 + nrm(ks[11], (DEPTH, D_MODEL), 0.05),
        "w_in": nrm(ks[12], (DEPTH, D_MODEL, IN_WIDTH), D_MODEL ** -0.5),
        "conv_w": nrm(ks[13], (DEPTH, CONV_WIDTH, D_CONV), CONV_WIDTH ** -0.5),
        "conv_b": nrm(ks[14], (DEPTH, D_CONV), 0.02),
        "conv_ln_g": 1 + nrm(ks[15], (DEPTH, D_CONV), 0.05),
        "conv_ln_b": nrm(ks[16], (DEPTH, D_CONV), 0.02),
        "hgrn_lb": nrm(ks[17], (DEPTH, H_HGRN * DK_HGRN), 0.5),
        "hgrn_norm_g": 1 + nrm(ks[18], (DEPTH, DV_HGRN), 0.05),
        "attn_sinks": nrm(ks[19], (DEPTH, H_ATTN), 0.5),
        "w_out": nrm(ks[20], (DEPTH, D_MIX, D_MODEL), D_MIX ** -0.5),
        "norm_mlp_g": 1 + nrm(ks[21], (DEPTH, D_MODEL), 0.05),
        "w_up": nrm(ks[22], (DEPTH, D_MODEL, D_FF), D_MODEL ** -0.5),
        "w_down": nrm(ks[23], (DEPTH, D_FF, D_MODEL), D_FF ** -0.5),
        "final_g": 1 + nrm(ks[24], (D_MODEL,), 0.05),
    }


def reference(x_prompt, x_sample, cache_conv, state_hgrn, cache_swa_k, cache_swa_v, c_prompt, c_sample, rel_bias,
              w_ada, b_ada, norm_mix_g, w_in, conv_w, conv_b, conv_ln_g, conv_ln_b, hgrn_lb, hgrn_norm_g,
              attn_sinks, w_out, norm_mlp_g, w_up, w_down, final_g):
    Bp, Tp = x_prompt.shape[:2]
    Bs, Ts = x_sample.shape[:2]
    w_buf = cache_swa_k.shape[2]
    lbs = jnp.cumsum(jax.nn.softmax(hgrn_lb.astype(jnp.float32), axis=0), axis=0)
    lbs = lbs - lbs[0]
    nb = Tp // ATTN_BLOCK
    qpos_p = jnp.arange(Tp, dtype=jnp.int32).reshape(nb, ATTN_BLOCK)
    kpos_p = (jnp.arange(nb, dtype=jnp.int32) * ATTN_BLOCK)[:, None] - ATTN_BLOCK + jnp.arange(2 * ATTN_BLOCK, dtype=jnp.int32)[None]
    bias_p = band_bias(qpos_p, kpos_p, rel_bias)
    qpos_s = PAST_LEN + jnp.arange(Ts, dtype=jnp.int32)
    kpos_s = PAST_LEN - w_buf + jnp.arange(w_buf + Ts, dtype=jnp.int32)
    bias_s = band_bias(qpos_s, kpos_s, rel_bias)

    xp, xs = x_prompt, x_sample
    conv_p, conv_s, hg_p, hg_s, kp_l, ks_l, vp_l, vs_l = [], [], [], [], [], [], [], []
    for l in range(DEPTH):
        params = (w_ada[l], b_ada[l], norm_mix_g[l], w_in[l], conv_w[l], conv_b[l], conv_ln_g[l], conv_ln_b[l],
                  hgrn_norm_g[l], attn_sinks[l], w_out[l], norm_mlp_g[l], w_up[l], w_down[l])
        xp, cp, sp, kp, vp = layer(xp, c_prompt, jnp.zeros((Bp, CONV_WIDTH - 1, D_CONV), xp.dtype),
                                   jnp.zeros((Bp, H_HGRN, DK_HGRN, DV_HGRN), state_hgrn.dtype),
                                   functools.partial(swa_prompt, bias=bias_p), lbs[l], *params)
        xs, cs, ss, ksn, vsn = layer(xs, c_sample, cache_conv[l], state_hgrn[l],
                                     functools.partial(swa_sample, bias=bias_s, k_buf=cache_swa_k[l], v_buf=cache_swa_v[l]),
                                     lbs[l], *params)
        conv_p.append(cp); conv_s.append(cs); hg_p.append(sp); hg_s.append(ss)
        kp_l.append(kp); ks_l.append(ksn); vp_l.append(vp); vs_l.append(vsn)
    y_prompt = rmsnorm(xp, final_g)
    y_sample = rmsnorm(xs, final_g)
    return (y_prompt, y_sample, jnp.stack(conv_p), jnp.stack(conv_s), jnp.stack(hg_p), jnp.stack(hg_s),
            jnp.stack(kp_l), jnp.stack(ks_l), jnp.stack(vp_l), jnp.stack(vs_l))
```

```cpp
#define MK_PER_PHASE 1
#include <hip/hip_runtime.h>
#include <cstdio>
#include <cstdint>
namespace pg8 {
#define PG8_LAS __attribute__((address_space(3)))
typedef unsigned short bf16_t;
typedef short bf16x8 __attribute__((ext_vector_type(8)));
typedef float f32x4 __attribute__((ext_vector_type(4)));
typedef unsigned u32x4 __attribute__((ext_vector_type(4)));
constexpr int BM = 256, BK = 64, HALF = 128, HTB = HALF * BK * 2  , STAGE_BYTES = 8 * HTB, NXCD = 8, WGM = 8;

__host__ __device__ __forceinline__ int lds_byte(int r, int c) { const int st = (r >> 4) * 2 + (c >> 5), rr = r & 15, cc = c & 31, ob = rr * 64 + cc * 2; return st * 1024 + (ob ^ (((ob >> 9) & 1) << 5)); }
__host__ __device__ __forceinline__ void stage_rc(int b, int& R, int& C) { const int st = b / 1024, sb = b % 1024, swz = sb ^ (((sb >> 9) & 1) << 5); R = (st >> 1) * 16 + swz / 64; C = (st & 1) * 32 + (swz % 64) / 2; }
__host__ __device__ __forceinline__ int perm32(int rho) { const int n = rho >> 4, i = rho & 15; return 8 * (i >> 2) + 4 * n + (i & 3); }

struct Unit { int pm, pn; };
struct Gemm { const bf16_t* A; const bf16_t* Bt; int M, N, K; };

struct StaticOrder {
    int nM, nN, nwg, G, c;
    __host__ __device__ void init(int M, int N, int G_, int c_) { nM = M / BM; nN = N / BM; nwg = nM * nN; G = G_; c = c_; }
    __host__ __device__ bool next(int i, Unit& u) const {
        const long L = (long)i * G + c; if (L >= nwg) return false;
        int wgid = (int)L; { const int q = nwg / NXCD, r = nwg % NXCD, xcd = wgid % NXCD, off = wgid / NXCD; wgid = (xcd < r ? xcd * (q + 1) : r * (q + 1) + (xcd - r) * q) + off; }
        const int nig = WGM * nN, gid = wgid / nig, fm = gid * WGM, gsz = (nM - fm) < WGM ? (nM - fm) : WGM;
        u.pm = fm + ((wgid % nig) % gsz); u.pn = (wgid % nig) / gsz; return true;
    }
    __device__ __forceinline__ void a_ready(const Unit&) const {}
    __device__ __forceinline__ void done(const Unit&) const {}
};

__device__ __forceinline__ unsigned cvt_pk_bf16(float lo, float hi) { unsigned r; asm volatile("v_cvt_pk_bf16_f32 %0, %1, %2" : "=v"(r) : "v"(lo), "v"(hi)); return r; }
typedef float f32x2 __attribute__((ext_vector_type(2)));
constexpr int EP_NP = 16384, EP_D = 1024, EP_MODLD = 6144;
__device__ __forceinline__ int ep_modrow(int r) { return r < EP_NP ? (r >> 12) : 4 + ((r - EP_NP) >> 2); }
template <int ACT> struct EpiStore {
    static constexpr bool PERM = true, AFTER_DRAIN = false;
    bf16_t* O; int ldc;
    __device__ __forceinline__ void operator()(const f32x4 (&acc)[2][2][4][2], const Unit& u, int wr, int wc, int fr, int fq) const {
        const int row0 = u.pm * BM + wr * 64 + fr, col0 = u.pn * BM + wc * 32 + 8 * fq;
#pragma unroll
        for (int ai = 0; ai < 2; ++ai)
#pragma unroll
            for (int m = 0; m < 4; ++m) { bf16_t* rowp = O + (size_t)(row0 + ai * HALF + m * 16) * ldc + col0;
#pragma unroll
                for (int bj = 0; bj < 2; ++bj) { f32x4 v0 = acc[ai][bj][m][0], v1 = acc[ai][bj][m][1];
                    if (ACT == 1) {
#pragma unroll
                        for (int e = 0; e < 4; ++e) { const float a = v0[e] > 0.f ? v0[e] : 0.f, b = v1[e] > 0.f ? v1[e] : 0.f; v0[e] = a * a; v1[e] = b * b; } }
                    u32x4 w; w.x = cvt_pk_bf16(v0[0], v0[1]); w.y = cvt_pk_bf16(v0[2], v0[3]); w.z = cvt_pk_bf16(v1[0], v1[1]); w.w = cvt_pk_bf16(v1[2], v1[3]);
                    *(u32x4*)(rowp + bj * HALF) = w; } }
    }
};
struct EpiGateRes {
    static constexpr bool PERM = false, AFTER_DRAIN = false;
    const float* baseP; const float* baseS; float* out; const float* gate;
    __device__ __forceinline__ void operator()(const f32x4 (&acc)[2][2][4][2], const Unit& u, int wr, int wc, int fr, int fq) const {
        const int col0 = u.pn * BM + wc * 32 + 4 * fq;
#pragma unroll
        for (int ai = 0; ai < 2; ++ai)
#pragma unroll
            for (int m = 0; m < 4; ++m) { const int r = u.pm * BM + ai * HALF + wr * 64 + m * 16 + fr;
                const float* gp = gate + (size_t)ep_modrow(r) * EP_MODLD + col0;
                const float* bp = (r < EP_NP ? baseP + (size_t)r * EP_D : baseS + (size_t)(r - EP_NP) * EP_D) + col0;
                float* op = out + (size_t)r * EP_D + col0;
#pragma unroll
                for (int bj = 0; bj < 2; ++bj)
#pragma unroll
                    for (int n = 0; n < 2; ++n) { const f32x4 g4 = *(const f32x4*)(gp + bj * HALF + n * 16), b4 = *(const f32x4*)(bp + bj * HALF + n * 16);
                        *(f32x4*)(op + bj * HALF + n * 16) = b4 + g4 * acc[ai][bj][m][n]; }
                asm volatile("" ::: "memory"); }
    }
};
template <class Epi, class Sched, bool ALIGN_EPI = false, bool SP2 = false>
__device__ __forceinline__ void gemm_phase(PG8_LAS unsigned char* lds, const Gemm g, const Sched& S, const Epi& E, const int tid) {
    const int wid = __builtin_amdgcn_readfirstlane(tid >> 6), lane = tid & 63, wr = wid >> 2, wc = wid & 3, fr = lane & 15, fq = lane >> 4;
    const int K = g.K, nt = K / BK;
    unsigned voffA[2], voffB[2];
#pragma unroll
    for (int i = 0; i < 2; ++i) { int R, C; stage_rc(tid * 16 + i * 8192, R, C); const int Rb = Epi::PERM ? ((R & ~31) + perm32(R & 31)) : R;
        voffA[i] = (unsigned)(R * K + C) * 2u; voffB[i] = (unsigned)(Rb * K + C) * 2u; }
    const size_t kstep = (size_t)(BK * 2);
    const size_t hstep = (size_t)HALF * K * 2;
    const size_t tstep = 2 * hstep;
    const unsigned ldsw = (unsigned)wid * 1024u;
    const int aoff = lds_byte(wr * 64 + fr, fq * 8), boff = lds_byte(wc * 32 + fr, fq * 8);
#define PG8_SA(b, h) (((b) * 2 + (h)) * HTB)
#define PG8_SB(b, h) ((4 + (b) * 2 + (h)) * HTB)
#define PG8_STAGE(bufoff, gbase, voff) do { _Pragma("unroll") for (int _i = 0; _i < 2; ++_i) \
        __builtin_amdgcn_global_load_lds((const unsigned*)((const char*)(gbase) + (voff)[_i]), (PG8_LAS unsigned*)(lds + (bufoff) + ldsw + _i * 8192), 16, 0, 0); } while (0)
#define PG8_LDA(dst, b, h) do { _Pragma("unroll") for (int m = 0; m < 4; ++m) _Pragma("unroll") for (int k = 0; k < 2; ++k) dst[m][k] = *(const PG8_LAS bf16x8*)(lds + PG8_SA(b, h) + aoff + m * 2048 + k * 1024); } while (0)
#define PG8_LDB(dst, b, h) do { _Pragma("unroll") for (int n = 0; n < 2; ++n) _Pragma("unroll") for (int k = 0; k < 2; ++k) dst[n][k] = *(const PG8_LAS bf16x8*)(lds + PG8_SB(b, h) + boff + n * 2048 + k * 1024); } while (0)
#define PG8_MMA(ai, bj, At, Bt) do { __builtin_amdgcn_s_setprio(1); _Pragma("unroll") for (int m = 0; m < 4; ++m) _Pragma("unroll") for (int n = 0; n < 2; ++n) _Pragma("unroll") for (int k = 0; k < 2; ++k) \
        acc[ai][bj][m][n] = __builtin_amdgcn_mfma_f32_16x16x32_bf16(Bt[n][k], At[m][k], acc[ai][bj][m][n], 0, 0, 0); __builtin_amdgcn_s_setprio(0); } while (0)
#define PG8_WAIT_V(n) asm volatile("s_waitcnt vmcnt(" #n ")" ::: "memory")
#define PG8_WAIT_L(n) asm volatile("s_waitcnt lgkmcnt(" #n ")" ::: "memory")
#define PG8_BAR __builtin_amdgcn_s_barrier()
#define PG8_SCHED __builtin_amdgcn_sched_barrier(0)
    Unit cur, nxt; int ui = 0;
    if (!S.next(0, cur)) return;
    f32x4 acc[2][2][4][2];
#pragma unroll
    for (int a = 0; a < 2; ++a)
#pragma unroll
        for (int b = 0; b < 2; ++b)
#pragma unroll
            for (int m = 0; m < 4; ++m)
#pragma unroll
                for (int n = 0; n < 2; ++n) acc[a][b][m][n] = (f32x4){0.f, 0.f, 0.f, 0.f};
    bf16x8 At[4][2], B0[2][2], B1[2][2];
    const char* cA = (const char*)g.A + (size_t)cur.pm * tstep; const char* cB = (const char*)g.Bt + (size_t)cur.pn * tstep;
    S.a_ready(cur);
    if constexpr (SP2) {
        PG8_STAGE(PG8_SB(0, 0), cB, voffB); PG8_STAGE(PG8_SB(0, 1), cB + hstep, voffB); PG8_STAGE(PG8_SA(0, 0), cA, voffA); PG8_STAGE(PG8_SA(0, 1), cA + hstep, voffA);
        if (wr == 1) PG8_BAR;
        PG8_WAIT_V(2); PG8_BAR;
        PG8_STAGE(PG8_SB(1, 0), cB + kstep, voffB); PG8_STAGE(PG8_SA(1, 0), cA + kstep, voffA); PG8_STAGE(PG8_SB(1, 1), cB + hstep + kstep, voffB);
        PG8_WAIT_V(6); PG8_BAR;
    } else {
        PG8_STAGE(PG8_SB(0, 0), cB, voffB); PG8_STAGE(PG8_SA(0, 0), cA, voffA); PG8_STAGE(PG8_SB(0, 1), cB + hstep, voffB); PG8_STAGE(PG8_SA(0, 1), cA + hstep, voffA);
        if (wr == 1) PG8_BAR;
        PG8_WAIT_V(4); PG8_BAR;
        PG8_STAGE(PG8_SB(1, 0), cB + kstep, voffB); PG8_STAGE(PG8_SA(1, 0), cA + kstep, voffA); PG8_STAGE(PG8_SB(1, 1), cB + hstep + kstep, voffB);
        PG8_WAIT_V(6); PG8_BAR;
    }
    for (;;) {
        const bool has_next = S.next(ui + 1, nxt);
        const char* nA = has_next ? (const char*)g.A + (size_t)nxt.pm * tstep : cA; const char* nB = has_next ? (const char*)g.Bt + (size_t)nxt.pn * tstep : cB;
        for (int t = 0; t < nt; t += 2) {
            const bool last = (t == nt - 2);
            const char* a1 = cA + (size_t)(t + 1) * kstep;
            const char* a2 = last ? nA : cA + (size_t)(t + 2) * kstep; const char* b2 = last ? nB : cB + (size_t)(t + 2) * kstep;
            const char* a3 = a2 + kstep; const char* b3 = b2 + kstep;
            if (last && has_next) S.a_ready(nxt);
            if constexpr (SP2) {
            PG8_LDB(B0, 0, 0); PG8_LDB(B1, 0, 1); PG8_SCHED; PG8_LDA(At, 0, 0); PG8_STAGE(PG8_SA(1, 1), a1 + hstep, voffA);
            PG8_WAIT_V(8); PG8_WAIT_L(0); PG8_BAR; PG8_MMA(0, 0, At, B0); PG8_MMA(0, 1, At, B1); PG8_BAR; PG8_SCHED;
            PG8_LDA(At, 0, 1); PG8_STAGE(PG8_SB(0, 0), b2, voffB); PG8_STAGE(PG8_SB(0, 1), b2 + hstep, voffB); PG8_STAGE(PG8_SA(0, 0), a2, voffA);
            PG8_WAIT_V(8); PG8_WAIT_L(0); PG8_BAR; PG8_MMA(1, 0, At, B0); PG8_MMA(1, 1, At, B1); PG8_BAR; PG8_SCHED;
            PG8_LDB(B0, 1, 0); PG8_LDB(B1, 1, 1); PG8_SCHED; PG8_LDA(At, 1, 0); PG8_STAGE(PG8_SA(0, 1), a2 + hstep, voffA);
            PG8_WAIT_V(8); PG8_WAIT_L(0); PG8_BAR; PG8_MMA(0, 0, At, B0); PG8_MMA(0, 1, At, B1); PG8_BAR; PG8_SCHED;
            PG8_LDA(At, 1, 1); PG8_STAGE(PG8_SB(1, 0), b3, voffB); PG8_STAGE(PG8_SB(1, 1), b3 + hstep, voffB); PG8_STAGE(PG8_SA(1, 0), a3, voffA);
            PG8_WAIT_V(8); PG8_WAIT_L(0); PG8_BAR; PG8_MMA(1, 0, At, B0); PG8_MMA(1, 1, At, B1); PG8_BAR; PG8_SCHED;
            } else {
            PG8_LDB(B0, 0, 0); PG8_SCHED; PG8_LDA(At, 0, 0); PG8_STAGE(PG8_SA(1, 1), a1 + hstep, voffA);
            PG8_WAIT_L(8); PG8_BAR; PG8_WAIT_L(0); PG8_MMA(0, 0, At, B0); PG8_BAR; PG8_SCHED;
            PG8_LDB(B1, 0, 1); PG8_STAGE(PG8_SB(0, 0), b2, voffB);
            PG8_BAR; PG8_WAIT_L(0); PG8_MMA(0, 1, At, B1); PG8_BAR;
            PG8_LDA(At, 0, 1); PG8_STAGE(PG8_SA(0, 0), a2, voffA);
            PG8_BAR; PG8_WAIT_L(0); PG8_MMA(1, 0, At, B0); PG8_BAR; PG8_SCHED;
            PG8_STAGE(PG8_SB(0, 1), b2 + hstep, voffB);
            PG8_WAIT_V(6); PG8_BAR; PG8_MMA(1, 1, At, B1); PG8_BAR;
            PG8_LDB(B0, 1, 0); PG8_SCHED; PG8_LDA(At, 1, 0); PG8_STAGE(PG8_SA(0, 1), a2 + hstep, voffA);
            PG8_WAIT_L(8); PG8_BAR; PG8_WAIT_L(0); PG8_MMA(0, 0, At, B0); PG8_BAR; PG8_SCHED;
            PG8_LDB(B1, 1, 1); PG8_STAGE(PG8_SB(1, 0), b3, voffB);
            PG8_BAR; PG8_WAIT_L(0); PG8_MMA(0, 1, At, B1); PG8_BAR;
            PG8_LDA(At, 1, 1); PG8_STAGE(PG8_SA(1, 0), a3, voffA);
            PG8_BAR; PG8_WAIT_L(0); PG8_MMA(1, 0, At, B0); PG8_BAR; PG8_SCHED;
            PG8_STAGE(PG8_SB(1, 1), b3 + hstep, voffB);
            PG8_WAIT_V(6); PG8_BAR; PG8_MMA(1, 1, At, B1); PG8_BAR;
            }
        }
        if constexpr (ALIGN_EPI) { if (wr == 0) PG8_BAR; }
        if constexpr (!Epi::AFTER_DRAIN) { E(acc, cur, wr, wc, fr, fq); S.done(cur); }
        if (!has_next) break;
#pragma unroll
        for (int a = 0; a < 2; ++a)
#pragma unroll
            for (int b = 0; b < 2; ++b)
#pragma unroll
                for (int m = 0; m < 4; ++m)
#pragma unroll
                    for (int n = 0; n < 2; ++n) acc[a][b][m][n] = (f32x4){0.f, 0.f, 0.f, 0.f};
        cur = nxt; cA = nA; cB = nB; ++ui;
        if constexpr (ALIGN_EPI) { if (wr == 1) PG8_BAR; }
    }
    PG8_WAIT_V(0);
    if constexpr (!ALIGN_EPI) { if (wr == 0) PG8_BAR; }
    PG8_BAR;
    if constexpr (Epi::AFTER_DRAIN) { E.fused(acc, cur, wr, wc, fr, fq, lds, wid, lane); S.done(cur); }
#undef PG8_SA
#undef PG8_SB
#undef PG8_STAGE
#undef PG8_LDA
#undef PG8_LDB
#undef PG8_MMA
#undef PG8_WAIT_V
#undef PG8_WAIT_L
#undef PG8_BAR
#undef PG8_SCHED
}
}
#define GAS __attribute__((address_space(1)))
#define LAS __attribute__((address_space(3)))
typedef unsigned short bf16;
typedef unsigned v4u __attribute__((ext_vector_type(4)));
typedef float f32x4 __attribute__((ext_vector_type(4)));
typedef short bf16x8 __attribute__((ext_vector_type(8)));
typedef GAS unsigned gu32;
typedef GAS unsigned long long gu64;
#define RLX_AGENT __ATOMIC_RELAXED, __HIP_MEMORY_SCOPE_AGENT
#define LDS_WAIT() asm volatile("s_waitcnt lgkmcnt(0)" ::: "memory")
#define VM_WAIT() asm volatile("s_waitcnt vmcnt(0)" ::: "memory")
__device__ __forceinline__ unsigned long long rt() { return __builtin_amdgcn_s_memrealtime(); }
__device__ __forceinline__ unsigned f2bf(float f) { unsigned u = __builtin_bit_cast(unsigned, f); return (u + 0x7fffu + ((u >> 16) & 1u)) >> 16; }
__device__ __forceinline__ unsigned pk2(float lo, float hi) { return f2bf(lo) | (f2bf(hi) << 16); }

#define XB_TMO      128
#define XB_XCNT(j)  (256  + 64 * (j))
#define XB_XSUB(j)  (1280 + 64 * (j))
#define XB_XGEN(j)  (2304 + 64 * (j))
#define XB_TOP      3328
#define XB_TOPGEN   3392
#define XCD_BAR_WORDS 3456
#define XB_SPIN_CAP (1u << 18)

__device__ __forceinline__ unsigned xb_ld(unsigned* p)              { return __hip_atomic_load(p, __ATOMIC_RELAXED, __HIP_MEMORY_SCOPE_AGENT); }
__device__ __forceinline__ unsigned xb_add(unsigned* p, unsigned v) { return __hip_atomic_fetch_add(p, v, __ATOMIC_RELAXED, __HIP_MEMORY_SCOPE_AGENT); }
__device__ __forceinline__ unsigned xb_xcc_id() { return (unsigned)__builtin_amdgcn_s_getreg((3 << 11) | 20) & 0xFu; }
#define XB_SPIN(cond, bar) do { unsigned _sp = 0; while (cond) { __builtin_amdgcn_s_sleep(1); \
    if ((++_sp & 255u) == 0u) { if (xb_ld(&(bar)[XB_TMO])) break; if (_sp > XB_SPIN_CAP) { atomicAdd(&(bar)[XB_TMO], 1u); break; } } } } while (0)

struct XcdBarrier {
    unsigned* bar; unsigned x;
    volatile LAS unsigned* st;
};

__device__ __forceinline__ XcdBarrier xcd_barrier_post(unsigned* bar, volatile LAS unsigned* st) {
    XcdBarrier b; b.bar = bar; b.x = xb_xcc_id(); b.st = st;
    if (threadIdx.x == 0) (void)xb_add(&bar[XB_XCNT(b.x)], 1u);
    return b;
}
__device__ __forceinline__ void xcd_barrier_complete(unsigned* bar, unsigned x, unsigned& nloc, unsigned& nx) {
    const unsigned G = gridDim.x * gridDim.y * gridDim.z;
    unsigned sum, cnt, mine, sp = 0u;
    for (;;) {
        sum = 0u; cnt = 0u; mine = 0u;
#pragma unroll
        for (unsigned j = 0; j < 16; ++j) { const unsigned c = xb_ld(&bar[XB_XCNT(j)]); sum += c; cnt += (c > 0u) ? 1u : 0u; mine = (j == x) ? c : mine; }
        if (sum == G) break;
        __builtin_amdgcn_s_sleep(1);
        if ((++sp & 255u) == 0u) { if (xb_ld(&bar[XB_TMO])) break; if (sp > XB_SPIN_CAP) { atomicAdd(&bar[XB_TMO], 1u); break; } }
    }
    nloc = mine > 0u ? mine : 1u; nx = cnt > 0u ? cnt : 1u;
}

__device__ __forceinline__ void xcd_barrier(const XcdBarrier& b) {
    asm volatile("s_waitcnt vmcnt(0)" ::: "memory");
    __syncthreads();
    if (threadIdx.x == 0) {
        unsigned* bar = b.bar;
        __builtin_amdgcn_s_waitcnt(0);
        unsigned nloc = b.st[0], nx = b.st[1];
        if (nloc == 0u) { xcd_barrier_complete(bar, b.x, nloc, nx); b.st[0] = nloc; b.st[1] = nx; }
        const unsigned old = xb_add(&bar[XB_XSUB(b.x)], 1u);
        const unsigned gen = old / nloc;
        if (old + 1u == (gen + 1u) * nloc) {
            __builtin_amdgcn_fence(__ATOMIC_RELEASE, "agent");
            asm volatile("s_waitcnt vmcnt(0)" ::: "memory");
            const unsigned og = xb_add(&bar[XB_TOP], 1u);
            const unsigned tg = og / nx;
            if (og + 1u == (tg + 1u) * nx) xb_add(&bar[XB_TOPGEN], 1u);
            else XB_SPIN(xb_ld(&bar[XB_TOPGEN]) == tg, bar);
            __builtin_amdgcn_fence(__ATOMIC_ACQUIRE, "agent");
            xb_add(&bar[XB_XGEN(b.x)], 1u);
            asm volatile("s_waitcnt vmcnt(0)" ::: "memory");
        } else {
            XB_SPIN(xb_ld(&bar[XB_XGEN(b.x)]) == gen, bar);
            __builtin_amdgcn_fence(__ATOMIC_ACQUIRE, "agent");
            asm volatile("s_waitcnt vmcnt(0)" ::: "memory");
        }
    }
    __syncthreads();
}

constexpr int D = 1024, NP = 16384, NS = 512, M = NP + NS, INW = 3072, FF = 4096, TP = 4096;
constexpr int C_AV = 0, C_AG = 256, C_Q = 512, C_F = 1024, C_I = 1536, C_G = 2048, C_QA = 2560, C_KA = 2816, C_VA = 2944;
constexpr int MODR = 132, MODLD = 6144;
constexpr float EPS = 1e-6f;
constexpr size_t O_CONVP = (size_t)M * D, O_CONVS = O_CONVP + 2 * 4 * 30 * 256, O_HGP = O_CONVS + 2 * 128 * 30 * 256, O_HGS = O_HGP + 2 * 4 * 4 * 16384,
                 O_KP = O_HGS + (size_t)2 * 128 * 4 * 16384, O_KS = O_KP + 2 * 4 * 128 * 128, O_VP = O_KS + (size_t)2 * 128 * 128 * 128, O_VS = O_VP + 2 * 4 * 128 * 128,
                 O_END = O_VS + (size_t)2 * 128 * 128 * 128;
constexpr size_t MiB = 1u << 20;
constexpr size_t WS_CTL = 0, CTL_ZERO_BYTES = 1 * MiB, WS_TAB = 1 * MiB, WS_MOD = 2 * MiB, WS_DC = 9 * MiB, WS_WIN = 10 * MiB, WS_WOUT = 22 * MiB, WS_WUP = 26 * MiB, WS_WDN = 42 * MiB,
                 WS_XN = 58 * MiB, WS_HG = 58 * MiB, WS_PROJ = 91 * MiB, WS_MIX = 190 * MiB, WS_HB = 91 * MiB, WS_END = 223 * MiB;
constexpr int CW_BAR = 4096;
constexpr int RING_BYTES = 131072, LDSCTL_OFF = RING_BYTES, MISC_OFF = LDSCTL_OFF + 320, LDS_BYTES = 147456;
constexpr int NPH = 20;

typedef float f32x16 __attribute__((ext_vector_type(16)));
typedef unsigned v2u __attribute__((ext_vector_type(2)));
__device__ __forceinline__ float bf2f(unsigned h) { return __builtin_bit_cast(float, h << 16); }
__device__ __forceinline__ float wave_sum(float v) {
#pragma unroll
    for (int o = 1; o < 64; o <<= 1) v += __shfl_xor(v, o);
    return v;
}
__device__ __forceinline__ float wave_max(float v) {
#pragma unroll
    for (int o = 1; o < 64; o <<= 1) v = fmaxf(v, __shfl_xor(v, o));
    return v;
}
__device__ __forceinline__ int modrow(int r) { return r < NP ? (r >> 12) : 4 + ((r - NP) >> 2); }
__device__ __forceinline__ int crow(int r, int hi) { return (r & 3) + 8 * (r >> 2) + 4 * hi; }
__device__ __forceinline__ bf16x8 pk8(float a0, float a1, float a2, float a3, float a4, float a5, float a6, float a7) {
    v4u w; w.x = pk2(a0, a1); w.y = pk2(a2, a3); w.z = pk2(a4, a5); w.w = pk2(a6, a7); return __builtin_bit_cast(bf16x8, w);
}
__device__ __forceinline__ float sigm(float x) { return 1.f / (1.f + __expf(-x)); }
#define MFMA32(a, b, c) __builtin_amdgcn_mfma_f32_32x32x16_bf16((a), (b), (c), 0, 0, 0)
#define MFMA16(a, b, c) __builtin_amdgcn_mfma_f32_16x16x32_bf16((a), (b), (c), 0, 0, 0)

struct Args { const float* in[25]; float* out; unsigned char* ws; int ph_lo, ph_hi; };
struct Ctx {
    LAS unsigned char* lds;
    int tid, lane, wave, G, bid, z;
    float* out; unsigned char* ws;
};

__device__ __forceinline__ void p0_transpose_item(const float* W, int K, int N, bf16* WT, LAS float* scr, int item, int lane) {
    const int nblk = N / 32, kb = item / nblk, nb = item % nblk, k0 = 64 * kb, n0 = 32 * nb;
#pragma unroll 8
    for (int i = 0; i < 32; ++i) { const int kk = 2 * i + (lane >> 5); scr[kk * 33 + (lane & 31)] = W[(size_t)(k0 + kk) * N + n0 + (lane & 31)]; }
    LDS_WAIT(); asm volatile("" ::: "memory");
    const int c = lane & 7;
#pragma unroll
    for (int j = 0; j < 4; ++j) { const int n = (lane >> 3) + 8 * j; const LAS float* s = scr + (8 * c) * 33 + n;
        v4u o; o.x = pk2(s[0 * 33], s[1 * 33]); o.y = pk2(s[2 * 33], s[3 * 33]); o.z = pk2(s[4 * 33], s[5 * 33]); o.w = pk2(s[6 * 33], s[7 * 33]);
        *(GAS v4u*)(WT + (size_t)(n0 + n) * K + k0 + 8 * c) = o; }
    LDS_WAIT(); asm volatile("" ::: "memory");
}
__device__ __forceinline__ void mod_unit(const Args& A, Ctx& F, int u) {
    const int l = u / 192, n0 = 32 * (u % 192), k0 = 128 * F.wave, c = F.lane & 31, h2 = F.lane >> 5;
    const float* W = A.in[9 + F.z] + (size_t)l * 1024 * 6144;
    f32x16 acc[5];
#pragma unroll
    for (int i = 0; i < 5; ++i)
#pragma unroll
        for (int e = 0; e < 16; ++e) acc[i][e] = 0.f;
#pragma unroll 2
    for (int j = 0; j < 8; ++j) {
        const int kb = k0 + 16 * j + 8 * h2;
        float wv[8];
#pragma unroll
        for (int e = 0; e < 8; ++e) wv[e] = W[(size_t)(kb + e) * 6144 + n0 + c];
        const bf16x8 b = pk8(wv[0], wv[1], wv[2], wv[3], wv[4], wv[5], wv[6], wv[7]);
#pragma unroll
        for (int rt = 0; rt < 5; ++rt) {
            const int r = 32 * rt + c;
            f32x4 c0 = {0.f, 0.f, 0.f, 0.f}, c1 = {0.f, 0.f, 0.f, 0.f};
            if (r < MODR) { const float* cp = (r < 4 ? A.in[6 + F.z] + r * 1024 : A.in[7 + F.z] + (r - 4) * 1024) + kb; c0 = *(const f32x4*)cp; c1 = *(const f32x4*)(cp + 4); }
#pragma unroll
            for (int e = 0; e < 4; ++e) { c0[e] = c0[e] * sigm(c0[e]); c1[e] = c1[e] * sigm(c1[e]); }
            const bf16x8 a = pk8(c0[0], c0[1], c0[2], c0[3], c1[0], c1[1], c1[2], c1[3]);
            acc[rt] = MFMA32(a, b, acc[rt]);
        }
    }
    LAS float* RED = (LAS float*)F.lds;
#define RED_WR(slot) do { _Pragma("unroll") for (int rt = 0; rt < 5; ++rt) _Pragma("unroll") for (int e = 0; e < 16; ++e) RED[(slot) * 5120 + (rt * 16 + e) * 64 + F.lane] = acc[rt][e]; } while (0)
#define RED_ADD(slot) do { _Pragma("unroll") for (int rt = 0; rt < 5; ++rt) _Pragma("unroll") for (int e = 0; e < 16; ++e) acc[rt][e] += RED[(slot) * 5120 + (rt * 16 + e) * 64 + F.lane]; } while (0)
    __syncthreads();
    if (F.wave >= 4) RED_WR(F.wave - 4);
    __syncthreads();
    if (F.wave < 4) RED_ADD(F.wave);
    __syncthreads();
    if (F.wave == 2 || F.wave == 3) RED_WR(F.wave - 2);
    __syncthreads();
    if (F.wave < 2) RED_ADD(F.wave);
    __syncthreads();
    if (F.wave == 1) RED_WR(0);
    __syncthreads();
    if (F.wave == 0) {
        RED_ADD(0);
        float* mo = (float*)(F.ws + WS_MOD) + (size_t)l * MODR * MODLD;
        const float bias = A.in[10 + F.z][l * MODLD + n0 + c];
#pragma unroll
        for (int rt = 0; rt < 5; ++rt)
#pragma unroll
            for (int e = 0; e < 16; ++e) { const int r = 32 * rt + crow(e, h2); if (r < MODR) mo[(size_t)r * MODLD + n0 + c] = acc[rt][e] + bias; }
    }
#undef RED_WR
#undef RED_ADD
}
__device__ __forceinline__ void p0_prologue(const Args& A, Ctx& F) {
    LAS float* scr = (LAS float*)(F.lds + F.wave * 16384);
    const int gw = F.bid * 8 + F.wave, NGW = F.G * 8;
    for (int it = gw; it < 12288; it += NGW) {
        const int l = it / 6144; int r = it % 6144;
        if (r < 1536) { p0_transpose_item(A.in[12 + F.z] + (size_t)l * 1024 * 3072, 1024, 3072, (bf16*)(F.ws + WS_WIN) + (size_t)l * 3072 * 1024, scr, r, F.lane); continue; } r -= 1536;
        if (r < 512) { p0_transpose_item(A.in[20 + F.z] + (size_t)l * 1024 * 1024, 1024, 1024, (bf16*)(F.ws + WS_WOUT) + (size_t)l * 1024 * 1024, scr, r, F.lane); continue; } r -= 512;
        if (r < 2048) { p0_transpose_item(A.in[22 + F.z] + (size_t)l * 1024 * 4096, 1024, 4096, (bf16*)(F.ws + WS_WUP) + (size_t)l * 4096 * 1024, scr, r, F.lane); continue; } r -= 2048;
        p0_transpose_item(A.in[23 + F.z] + (size_t)l * 4096 * 1024, 4096, 1024, (bf16*)(F.ws + WS_WDN) + (size_t)l * 1024 * 4096, scr, r, F.lane);
    }
    if (F.bid == 0) {
        float* BT = (float*)(F.ws + WS_TAB); float* LB1 = BT + 1024;
        for (int i = F.tid; i < 129 * 4; i += 512) { const int rel = i >> 2, h = i & 3; int bk = rel;
            if (rel >= 16) { bk = 16 + (int)(logf((float)rel / 16.f) / logf(8.f) * 16.f); bk = bk > 31 ? 31 : bk; }
            BT[i] = A.in[8 + F.z][bk * 4 + h]; }
        { const int i = F.tid; const float a = A.in[17 + F.z][i], b = A.in[17 + F.z][512 + i], mx = fmaxf(a, b), ea = expf(a - mx), eb = expf(b - mx); LB1[i] = eb / (ea + eb); }
    }
    for (int u = F.bid; u < 384; u += F.G) mod_unit(A, F, u);
}
__device__ __forceinline__ void norm_phase(const Args& A, Ctx& F, int l, int which) {
    const int gw = F.bid * 8 + F.wave, NGW = F.G * 8;
    const float* gamma = which == 0 ? A.in[11 + F.z] + l * D : (which == 1 ? A.in[21 + F.z] + l * D : A.in[24 + F.z]);
    const float* mod = (const float*)(F.ws + WS_MOD) + (size_t)l * MODR * MODLD;
    const int shc = which == 0 ? 0 : 3 * D, scc = shc + D;
    const bool from_in = (which == 0 && l == 0);
    bf16* XN = (bf16*)(F.ws + WS_XN);
    f32x4 gm[4];
#pragma unroll
    for (int j = 0; j < 4; ++j) gm[j] = *(const f32x4*)(gamma + 4 * F.lane + 256 * j);
    for (int m = gw; m < M; m += NGW) {
        const float* xr = from_in ? (m < NP ? A.in[0 + F.z] + (size_t)m * D : A.in[1 + F.z] + (size_t)(m - NP) * D) : F.out + (size_t)m * D;
        f32x4 v[4]; float s = 0.f;
#pragma unroll
        for (int j = 0; j < 4; ++j) { v[j] = *(const f32x4*)(xr + 4 * F.lane + 256 * j); s += (v[j].x * v[j].x + v[j].y * v[j].y) + (v[j].z * v[j].z + v[j].w * v[j].w); }
        const float rstd = 1.f / sqrtf(wave_sum(s) * (1.f / D) + EPS);
        if (which == 2) {
#pragma unroll
            for (int j = 0; j < 4; ++j) *(f32x4*)(F.out + (size_t)m * D + 4 * F.lane + 256 * j) = v[j] * rstd * gm[j];
        } else {
            const float* mr = mod + (size_t)modrow(m) * MODLD;
#pragma unroll
            for (int j = 0; j < 4; ++j) { const f32x4 sc = *(const f32x4*)(mr + scc + 4 * F.lane + 256 * j), sh = *(const f32x4*)(mr + shc + 4 * F.lane + 256 * j);
                const f32x4 y = v[j] * rstd * gm[j] * (sc + 1.f) + sh; v2u w; w.x = pk2(y.x, y.y); w.y = pk2(y.z, y.w);
                *(v2u*)(XN + (size_t)m * D + 4 * F.lane + 256 * j) = w; }
        }
    }
}

constexpr int RS = 272;
constexpr int RS64 = 144;
struct HgGate { float cl[16], kf[16]; };
__device__ __forceinline__ void hg_gates(const Args& A, Ctx& F, int l, int h, const bf16* prow  , int d, HgGate& g) {
    const float lb = l == 0 ? 0.f : ((const float*)(F.ws + WS_TAB))[1024 + h * 128 + d];
    float run = 0.f;
#pragma unroll
    for (int j = 0; j < 16; ++j) {
        const float x = bf2f(prow[(size_t)j * INW + C_F + h * 128 + d]);
        const float e = __expf(-x), sg = 1.f / (1.f + e);
        const float f = lb + (1.f - lb) * sg;
        g.kf[j] = (1.f - lb) * e * sg;
        run += __logf(f); g.cl[j] = run;
    }
}
__device__ __forceinline__ void h1_unit(const Args& A, Ctx& F, int l, int u) {
    const int bh = u >> 6, b = bh >> 2, h = bh & 3, ch = u & 63, m0 = b * TP + ch * 64;
    const int d = F.tid & 127, sc = F.tid >> 7, c = F.lane & 31, h2 = F.lane >> 5;
    const bf16* PROJ = (const bf16*)(F.ws + WS_PROJ);
    LAS unsigned char* L = F.lds;
    LAS unsigned short* KDT = (LAS unsigned short*)L;
    LAS unsigned short* VT = (LAS unsigned short*)(L + 128 * RS64);
    LAS float* TOT = (LAS float*)(L + 2 * 128 * RS64);
    const bf16* prow = PROJ + (size_t)(m0 + sc * 16) * INW;
    HgGate g; hg_gates(A, F, l, h, prow, d, g);
    __syncthreads();
    TOT[sc * 128 + d] = g.cl[15];
#pragma unroll
    for (int j = 0; j < 16; ++j) VT[d * (RS64 / 2) + sc * 16 + j] = prow[(size_t)j * INW + C_I + h * 128 + d];
    __syncthreads();
    float after = 0.f;
#pragma unroll
    for (int i = 1; i < 4; ++i) if (i > sc) after += TOT[i * 128 + d];
    const float tot = g.cl[15];
#pragma unroll
    for (int j = 0; j < 16; ++j) KDT[d * (RS64 / 2) + sc * 16 + j] = (unsigned short)f2bf(g.kf[j] * __expf(after + tot - g.cl[j]));
    if (sc == 0) ((float*)(F.ws + WS_DC))[u * 128 + d] = __expf(after + tot);
    __syncthreads();
    const int vt = F.wave >> 1, dt0 = 2 * (F.wave & 1);
    f32x16 acc0, acc1;
#pragma unroll
    for (int e = 0; e < 16; ++e) { acc0[e] = 0.f; acc1[e] = 0.f; }
#pragma unroll
    for (int ks = 0; ks < 4; ++ks) {
        const bf16x8 a = *(const LAS bf16x8*)(L + 128 * RS64 + (32 * vt + c) * RS64 + (16 * ks + 8 * h2) * 2);
        const bf16x8 b0 = *(const LAS bf16x8*)(L + (32 * dt0 + c) * RS64 + (16 * ks + 8 * h2) * 2);
        const bf16x8 b1 = *(const LAS bf16x8*)(L + (32 * dt0 + 32 + c) * RS64 + (16 * ks + 8 * h2) * 2);
        acc0 = MFMA32(a, b0, acc0); acc1 = MFMA32(a, b1, acc1);
    }
    bf16* HG = (bf16*)(F.ws + WS_HG) + (size_t)u * 16384;
#pragma unroll
    for (int e = 0; e < 16; ++e) { const int v = 32 * vt + crow(e, h2);
        HG[v * 128 + 32 * dt0 + c] = (bf16)f2bf(acc0[e]); HG[v * 128 + 32 * dt0 + 32 + c] = (bf16)f2bf(acc1[e]); }
}
__device__ __forceinline__ void h2_scan(const Args& A, Ctx& F, int l) {
    unsigned* HG32 = (unsigned*)(F.ws + WS_HG); const float* DC = (const float*)(F.ws + WS_DC);
    for (int gid = F.bid * 512 + F.tid; gid < 16 * 8192; gid += F.G * 512) {
        const int bh = gid >> 13, e2 = gid & 8191, v = e2 >> 6, d = 2 * (e2 & 63);
        float s0 = 0.f, s1 = 0.f;
#pragma unroll 8
        for (int ch = 0; ch < 64; ++ch) {
            const int u = bh * 64 + ch;
            const unsigned kc = HG32[(size_t)u * 8192 + e2];
            const float d0 = DC[u * 128 + d], d1 = DC[u * 128 + d + 1];
            HG32[(size_t)u * 8192 + e2] = pk2(s0, s1);
            s0 = d0 * s0 + bf2f(kc & 0xffffu); s1 = d1 * s1 + bf2f(kc >> 16);
        }
        float* o = F.out + O_HGP + ((size_t)l * 16 + bh) * 16384;
        o[d * 128 + v] = s0; o[(d + 1) * 128 + v] = s1;
    }
}
__device__ __forceinline__ void h3_unit(const Args& A, Ctx& F, int l, int u) {
    const int bh = u >> 6, b = bh >> 2, h = bh & 3, ch = u & 63, m0 = b * TP + ch * 64;
    const int d = F.tid & 127, sc = F.tid >> 7, c = F.lane & 31, h2 = F.lane >> 5;
    const bf16* PROJ = (const bf16*)(F.ws + WS_PROJ);
    LAS unsigned char* L = F.lds;
    constexpr int OQH = 0, OKH = 64 * RS, OKC = 2 * 64 * RS, OQG = 3 * 64 * RS, OQT = OQG + 48 * RS, OAM = OQT + 64 * RS, OVT = OAM + 64 * RS64, OTOT = OVT + 128 * RS64, OEND = OTOT + 2048;
    static_assert(OEND <= RING_BYTES, "h3 LDS map");
    LAS unsigned short* QH = (LAS unsigned short*)(L + OQH); LAS unsigned short* KH = (LAS unsigned short*)(L + OKH); LAS unsigned short* KC = (LAS unsigned short*)(L + OKC);
    LAS unsigned short* QG = (LAS unsigned short*)(L + OQG); LAS unsigned short* QT = (LAS unsigned short*)(L + OQT); LAS unsigned short* AM = (LAS unsigned short*)(L + OAM);
    LAS unsigned short* VT = (LAS unsigned short*)(L + OVT); LAS float* TOT = (LAS float*)(L + OTOT); LAS float* O32 = (LAS float*)(L + OQH);
    const bf16* prow = PROJ + (size_t)(m0 + sc * 16) * INW;
    HgGate g; hg_gates(A, F, l, h, prow, d, g);
    float q[16];
#pragma unroll
    for (int j = 0; j < 16; ++j) q[j] = bf2f(prow[(size_t)j * INW + C_Q + h * 128 + d]);
    __syncthreads();
    TOT[sc * 128 + d] = g.cl[15];
#pragma unroll
    for (int j = 0; j < 16; ++j) VT[d * (RS64 / 2) + sc * 16 + j] = prow[(size_t)j * INW + C_I + h * 128 + d];
    for (int i = F.tid; i < 64 * RS64 / 4; i += 512) ((LAS unsigned*)AM)[i] = 0u;
    __syncthreads();
    const float t0 = TOT[d], t1 = TOT[128 + d], t2 = TOT[256 + d];
    const float rsc = sc == 0 ? 0.f : (sc == 1 ? t0 : (sc == 2 ? t0 + t1 : t0 + t1 + t2));
    const float ers = __expf(rsc), tot = g.cl[15];
    const float ga = sc == 2 ? __expf(t1) : __expf(t1 + t2), gb = __expf(t2);
#pragma unroll
    for (int j = 0; j < 16; ++j) {
        const int row = sc * 16 + j;
        const float qh = q[j] * __expf(g.cl[j]);
        QH[row * (RS / 2) + d] = (unsigned short)f2bf(qh);
        QT[row * (RS / 2) + d] = (unsigned short)f2bf(qh * ers);
        if (sc == 2) QG[j * (RS / 2) + d] = (unsigned short)f2bf(qh * ga);
        if (sc == 3) { QG[(16 + j) * (RS / 2) + d] = (unsigned short)f2bf(qh * ga); QG[(32 + j) * (RS / 2) + d] = (unsigned short)f2bf(qh * gb); }
        KH[row * (RS / 2) + d] = (unsigned short)f2bf(g.kf[j] * __expf(tot - g.cl[j]));
        KC[row * (RS / 2) + d] = (unsigned short)f2bf(g.kf[j] * __expf(-g.cl[j]));
    }
    __syncthreads();
    {
        const int r16 = F.lane & 15, kq = F.lane >> 4;
        for (int blk = F.wave; blk < 10; blk += 8) {
            int bi, bj, qoff, koff;
            if (blk < 4) { bi = blk; bj = blk; qoff = OQH + 16 * bi * RS; koff = OKC + 16 * bj * RS; }
            else if (blk < 7) { bi = blk - 3; bj = bi - 1; qoff = OQH + 16 * bi * RS; koff = OKH + 16 * bj * RS; }
            else if (blk == 7) { bi = 2; bj = 0; qoff = OQG; koff = OKH; }
            else if (blk == 8) { bi = 3; bj = 0; qoff = OQG + 16 * RS; koff = OKH; }
            else { bi = 3; bj = 1; qoff = OQG + 32 * RS; koff = OKH + 16 * RS; }
            f32x4 a4 = {0.f, 0.f, 0.f, 0.f};
#pragma unroll
            for (int ks = 0; ks < 4; ++ks) {
                const bf16x8 qa = *(const LAS bf16x8*)(L + qoff + r16 * RS + (32 * ks + 8 * kq) * 2);
                const bf16x8 kb = *(const LAS bf16x8*)(L + koff + r16 * RS + (32 * ks + 8 * kq) * 2);
                a4 = MFMA16(qa, kb, a4);
            }
#pragma unroll
            for (int e = 0; e < 4; ++e) { const int t = 4 * kq + e; float val = a4[e]; if (bi == bj && r16 > t) val = 0.f;
                AM[(16 * bi + t) * (RS64 / 2) + 16 * bj + r16] = (unsigned short)f2bf(val); }
        }
    }
    __syncthreads();
    const int tt = F.wave >> 2, vt = F.wave & 3;
    f32x16 acc;
#pragma unroll
    for (int e = 0; e < 16; ++e) acc[e] = 0.f;
    const bf16* Srow = (const bf16*)(F.ws + WS_HG) + (size_t)u * 16384 + (size_t)(32 * vt + c) * 128 + 8 * h2;
    bf16x8 sb[8];
#pragma unroll
    for (int ks = 0; ks < 8; ++ks) sb[ks] = *(const bf16x8*)(Srow + 16 * ks);
#pragma unroll
    for (int ks = 0; ks < 4; ++ks) {
        const bf16x8 a = *(const LAS bf16x8*)(L + OAM + (32 * tt + c) * RS64 + (16 * ks + 8 * h2) * 2);
        const bf16x8 bv = *(const LAS bf16x8*)(L + OVT + (32 * vt + c) * RS64 + (16 * ks + 8 * h2) * 2);
        acc = MFMA32(a, bv, acc);
    }
#pragma unroll
    for (int ks = 0; ks < 8; ++ks) {
        const bf16x8 a = *(const LAS bf16x8*)(L + OQT + (32 * tt + c) * RS + (16 * ks + 8 * h2) * 2);
        acc = MFMA32(a, sb[ks], acc);
    }
#pragma unroll
    for (int e = 0; e < 16; ++e) O32[(32 * tt + crow(e, h2)) * 132 + 32 * vt + c] = acc[e];
    __syncthreads();
    {
        const int t = F.tid >> 3, vq = F.tid & 7;
        float o[16]; float ss = 0.f;
#pragma unroll
        for (int i = 0; i < 4; ++i) { const f32x4 x = *(const LAS f32x4*)(O32 + t * 132 + vq * 16 + 4 * i); o[4 * i] = x.x; o[4 * i + 1] = x.y; o[4 * i + 2] = x.z; o[4 * i + 3] = x.w;
            ss += (x.x * x.x + x.y * x.y) + (x.z * x.z + x.w * x.w); }
        ss += __shfl_xor(ss, 1); ss += __shfl_xor(ss, 2); ss += __shfl_xor(ss, 4);
        const float rstd = 1.f / sqrtf(ss * (1.f / 128.f) + EPS);
        const bf16* gp = PROJ + (size_t)(m0 + t) * INW + C_G + h * 128 + vq * 16;
        const v4u g0 = *(const v4u*)gp, g1 = *(const v4u*)(gp + 8);
        const float* gn = A.in[18 + F.z] + l * 128 + vq * 16;
        unsigned gw_[8] = {g0.x, g0.y, g0.z, g0.w, g1.x, g1.y, g1.z, g1.w};
        unsigned ow[8];
#pragma unroll
        for (int i = 0; i < 8; ++i) {
            const float ga0 = bf2f(gw_[i] & 0xffffu), ga1 = bf2f(gw_[i] >> 16);
            const float y0 = o[2 * i] * rstd * gn[2 * i] * (ga0 * sigm(ga0)), y1 = o[2 * i + 1] * rstd * gn[2 * i + 1] * (ga1 * sigm(ga1));
            ow[i] = pk2(y0, y1);
        }
        bf16* op = (bf16*)(F.ws + WS_MIX) + (size_t)(m0 + t) * D + 256 + h * 128 + vq * 16;
        v4u w0 = {ow[0], ow[1], ow[2], ow[3]}, w1 = {ow[4], ow[5], ow[6], ow[7]};
        *(v4u*)op = w0; *(v4u*)(op + 8) = w1;
    }
}

__device__ __forceinline__ void conv_tail(const Args& A, Ctx& F, int l, f32x4 acc, bf16* orow) {
    const float mean = wave_sum((acc.x + acc.y) + (acc.z + acc.w)) * (1.f / 256.f);
    const f32x4 dv = acc - mean;
    const float rstd = 1.f / sqrtf(wave_sum((dv.x * dv.x + dv.y * dv.y) + (dv.z * dv.z + dv.w * dv.w)) * (1.f / 256.f) + EPS);
    const f32x4 lg = *(const f32x4*)(A.in[15 + F.z] + l * 256 + 4 * F.lane), lb = *(const f32x4*)(A.in[16 + F.z] + l * 256 + 4 * F.lane);
    const f32x4 y = dv * rstd * lg + lb;
    v2u w; w.x = pk2(y.x * sigm(y.x), y.y * sigm(y.y)); w.y = pk2(y.z * sigm(y.z), y.w * sigm(y.w));
    *(v2u*)(orow + 4 * F.lane) = w;
}
__device__ __forceinline__ void conv_unit(const Args& A, Ctx& F, int l, int u) {
    const int b = u >> 6, tile = u & 63, t0 = tile * 64;
    const bf16* PROJ = (const bf16*)(F.ws + WS_PROJ);
    LAS float* AL = (LAS float*)F.lds;
    __syncthreads();
    for (int it = F.tid; it < 94 * 32; it += 512) {
        const int row = it >> 5, cg = it & 31, t = t0 - 30 + row;
        f32x4 a0 = {0.f, 0.f, 0.f, 0.f}, a1 = {0.f, 0.f, 0.f, 0.f};
        if (t >= 0) {
            const bf16* p = PROJ + (size_t)(b * TP + t) * INW + 8 * cg;
            const v4u vv = *(const v4u*)(p + C_AV), gg = *(const v4u*)(p + C_AG);
            a0.x = bf2f(vv.x & 0xffffu) * sigm(bf2f(gg.x & 0xffffu)); a0.y = bf2f(vv.x >> 16) * sigm(bf2f(gg.x >> 16));
            a0.z = bf2f(vv.y & 0xffffu) * sigm(bf2f(gg.y & 0xffffu)); a0.w = bf2f(vv.y >> 16) * sigm(bf2f(gg.y >> 16));
            a1.x = bf2f(vv.z & 0xffffu) * sigm(bf2f(gg.z & 0xffffu)); a1.y = bf2f(vv.z >> 16) * sigm(bf2f(gg.z >> 16));
            a1.z = bf2f(vv.w & 0xffffu) * sigm(bf2f(gg.w & 0xffffu)); a1.w = bf2f(vv.w >> 16) * sigm(bf2f(gg.w >> 16));
        }
        *(LAS f32x4*)(AL + row * 256 + 8 * cg) = a0; *(LAS f32x4*)(AL + row * 256 + 8 * cg + 4) = a1;
    }
    __syncthreads();
    f32x4 cw[31];
#pragma unroll
    for (int j = 0; j < 31; ++j) cw[j] = *(const f32x4*)(A.in[13 + F.z] + (size_t)(l * 31 + j) * 256 + 4 * F.lane);
    const f32x4 cb = *(const f32x4*)(A.in[14 + F.z] + l * 256 + 4 * F.lane);
    for (int i = 0; i < 8; ++i) {
        const int tl = 8 * F.wave + i;
        f32x4 acc = cb;
#pragma unroll
        for (int j = 0; j < 31; ++j) acc += cw[j] * *(const LAS f32x4*)(AL + (tl + j) * 256 + 4 * F.lane);
        conv_tail(A, F, l, acc, (bf16*)(F.ws + WS_MIX) + (size_t)(b * TP + t0 + tl) * D);
    }
    if (tile == 63) {
        float* o = F.out + O_CONVP + (size_t)(l * 4 + b) * 30 * 256;
        for (int i = F.tid; i < 30 * 256; i += 512) o[i] = AL[64 * 256 + i];
    }
}
constexpr int VS = 528;
__device__ __forceinline__ void attn_unit(const Args& A, Ctx& F, int l, int u) {
    const int b = u >> 6, blk = (u >> 1) & 31, kvh = u & 1;
    const int c = F.lane & 31, h2 = F.lane >> 5;
    const bf16* PROJ = (const bf16*)(F.ws + WS_PROJ);
    LAS unsigned char* L = F.lds;
    LAS unsigned short* VTt = (LAS unsigned short*)L;
    LAS float* BTl = (LAS float*)(L + 64 * VS);
    const int tok0 = b * TP + (blk - 1) * 128;
    __syncthreads();
    for (int it = F.tid; it < 256 * 8; it += 512) {
        const int kidx = it >> 3, chn = it & 7;
        v4u vv = {0u, 0u, 0u, 0u};
        if (blk > 0 || kidx >= 128) vv = *(const v4u*)(PROJ + (size_t)(tok0 + kidx) * INW + C_VA + kvh * 64 + 8 * chn);
        const int kl = kidx & 31, pos = (kidx & ~31) | (kl & 0x13) | ((kl & 4) << 1) | ((kl & 8) >> 1);
        const unsigned w[4] = {vv.x, vv.y, vv.z, vv.w};
#pragma unroll
        for (int e = 0; e < 4; ++e) { VTt[(8 * chn + 2 * e) * (VS / 2) + pos] = (unsigned short)(w[e] & 0xffffu); VTt[(8 * chn + 2 * e + 1) * (VS / 2) + pos] = (unsigned short)(w[e] >> 16); }
    }
    for (int i = F.tid; i < 129 * 4; i += 512) BTl[i] = ((const float*)(F.ws + WS_TAB))[i];
    __syncthreads();
    const int g = F.wave >> 2, qs = F.wave & 3, hq = 2 * kvh + g;
    const int mq = b * TP + blk * 128 + 32 * qs + c;
    bf16x8 bq[4];
#pragma unroll
    for (int ks = 0; ks < 4; ++ks) bq[ks] = *(const bf16x8*)(PROJ + (size_t)mq * INW + C_QA + hq * 64 + 16 * ks + 8 * h2);
    f32x16 S[5];
#pragma unroll
    for (int j = 0; j < 5; ++j) {
#pragma unroll
        for (int e = 0; e < 16; ++e) S[j][e] = 0.f;
        const int kidx = 32 * (qs + j) + c;
        const bool ex = (blk > 0 || kidx >= 128);
#pragma unroll
        for (int ks = 0; ks < 4; ++ks) {
            bf16x8 ak = {0, 0, 0, 0, 0, 0, 0, 0};
            if (ex) ak = *(const bf16x8*)(PROJ + (size_t)(tok0 + kidx) * INW + C_KA + kvh * 64 + 16 * ks + 8 * h2);
            S[j] = MFMA32(ak, bq[ks], S[j]);
        }
    }
    const float sink = A.in[19 + F.z][l * 4 + hq];
    float mx = -INFINITY;
#pragma unroll
    for (int j = 0; j < 5; ++j)
#pragma unroll
        for (int e = 0; e < 16; ++e) {
            const int cr = crow(e, h2), rel = 128 + c - 32 * j - cr, kidx = 32 * (qs + j) + cr;
            const bool ok = rel >= 0 && rel <= 128 && (blk > 0 || kidx >= 128);
            const float s = ok ? S[j][e] * 0.125f + BTl[(rel < 0 ? 0 : (rel > 128 ? 128 : rel)) * 4 + hq] : -INFINITY;
            S[j][e] = s; mx = fmaxf(mx, s);
        }
    mx = fmaxf(mx, __shfl_xor(mx, 32)); mx = fmaxf(mx, sink);
    float sum = 0.f;
#pragma unroll
    for (int j = 0; j < 5; ++j)
#pragma unroll
        for (int e = 0; e < 16; ++e) { const float p = __expf(S[j][e] - mx); S[j][e] = p; sum += p; }
    sum += __shfl_xor(sum, 32);
    const float inv = 1.f / (sum + __expf(sink - mx));
    f32x16 O0, O1;
#pragma unroll
    for (int e = 0; e < 16; ++e) { O0[e] = 0.f; O1[e] = 0.f; }
#pragma unroll
    for (int j = 0; j < 5; ++j)
#pragma unroll
        for (int s2 = 0; s2 < 2; ++s2) {
            const bf16x8 pb = pk8(S[j][8 * s2], S[j][8 * s2 + 1], S[j][8 * s2 + 2], S[j][8 * s2 + 3], S[j][8 * s2 + 4], S[j][8 * s2 + 5], S[j][8 * s2 + 6], S[j][8 * s2 + 7]);
            const int slot = 32 * (qs + j) + 16 * s2 + 8 * h2;
            const bf16x8 av0 = *(const LAS bf16x8*)(L + c * VS + slot * 2), av1 = *(const LAS bf16x8*)(L + (32 + c) * VS + slot * 2);
            O0 = MFMA32(av0, pb, O0); O1 = MFMA32(av1, pb, O1);
        }
    bf16* op = (bf16*)(F.ws + WS_MIX) + (size_t)mq * D + 768 + hq * 64;
#pragma unroll
    for (int gq = 0; gq < 4; ++gq) {
        v2u w0, w1;
        w0.x = pk2(O0[4 * gq] * inv, O0[4 * gq + 1] * inv); w0.y = pk2(O0[4 * gq + 2] * inv, O0[4 * gq + 3] * inv);
        w1.x = pk2(O1[4 * gq] * inv, O1[4 * gq + 1] * inv); w1.y = pk2(O1[4 * gq + 2] * inv, O1[4 * gq + 3] * inv);
        *(v2u*)(op + 8 * gq + 4 * h2) = w0; *(v2u*)(op + 32 + 8 * gq + 4 * h2) = w1;
    }
    if (blk == 31) {
        for (int i = F.tid; i < 128 * 64; i += 512) { const int j = i >> 6, dd = i & 63;
            const bf16* p = PROJ + (size_t)(b * TP + 3968 + j) * INW + kvh * 64 + dd;
            const size_t oi = (((size_t)(l * 4 + b) * 128 + j) * 2 + kvh) * 64 + dd;
            F.out[O_KP + oi] = bf2f(p[C_KA]); F.out[O_VP + oi] = bf2f(p[C_VA]); }
    }
}

__device__ __forceinline__ void samp_b_unit(const Args& A, Ctx& F, int l, int bs) {
    const bf16* PROJ = (const bf16*)(F.ws + WS_PROJ);
    const int m0 = NP + 4 * bs;
    LAS float* FL = (LAS float*)F.lds;
    LAS float* CV = FL + 34 * 256;
    LAS float* QS = CV + 4 * 256;
    LAS float* KN = QS + 1024;
    LAS float* VN = KN + 512;
    LAS float* PW = VN + 512;
    __syncthreads();
    const float* cc = A.in[2 + F.z] + ((size_t)l * 128 + bs) * 30 * 256;
    for (int i = F.tid; i < 30 * 256; i += 512) FL[i] = cc[i];
    for (int i = F.tid; i < 4 * 256; i += 512) { const int t = i >> 8, ch = i & 255; const bf16* p = PROJ + (size_t)(m0 + t) * INW + ch;
        FL[30 * 256 + i] = bf2f(p[C_AV]) * sigm(bf2f(p[C_AG])); }
    for (int i = F.tid; i < 1024; i += 512) { const int t = i >> 8, r = i & 255; QS[i] = bf2f(PROJ[(size_t)(m0 + t) * INW + C_QA + r]); }
    { const int t = F.tid >> 7, r = F.tid & 127; const bf16* p = PROJ + (size_t)(m0 + t) * INW + r; KN[F.tid] = bf2f(p[C_KA]); VN[F.tid] = bf2f(p[C_VA]); }
    __syncthreads();
    {
        const int ch = F.tid & 255, hf = F.tid >> 8;
        float a0 = A.in[14 + F.z][l * 256 + ch], a1 = a0;
#pragma unroll
        for (int j = 0; j < 31; ++j) { const float w = A.in[13 + F.z][(size_t)(l * 31 + j) * 256 + ch]; a0 += w * FL[(2 * hf + j) * 256 + ch]; a1 += w * FL[(2 * hf + 1 + j) * 256 + ch]; }
        CV[(2 * hf) * 256 + ch] = a0; CV[(2 * hf + 1) * 256 + ch] = a1;
    }
    { float* o = F.out + O_CONVS + ((size_t)l * 128 + bs) * 30 * 256; for (int i = F.tid; i < 30 * 256; i += 512) o[i] = FL[4 * 256 + i]; }
    __syncthreads();
    if (F.wave < 4) { const f32x4 acc = *(const LAS f32x4*)(CV + F.wave * 256 + 4 * F.lane); conv_tail(A, F, l, acc, (bf16*)(F.ws + WS_MIX) + (size_t)(m0 + F.wave) * D); }
    const float* ck = A.in[4 + F.z] + ((size_t)l * 128 + bs) * 128 * 128;
    const float* cv = A.in[5 + F.z] + ((size_t)l * 128 + bs) * 128 * 128;
    const float* BT = (const float*)(F.ws + WS_TAB);
#pragma unroll 1
    for (int rr = 0; rr < 2; ++rr) {
        const int row = 2 * F.wave + rr, t = row >> 2, hq = row & 3, kvh = hq >> 1;
        const LAS float* qv = QS + t * 256 + hq * 64;
        float sc[3];
#pragma unroll
        for (int i = 0; i < 3; ++i) {
            const int j = F.lane + 64 * i; float s = -INFINITY;
            if (j < 132 && j >= t && j <= 128 + t) {
                float acc = 0.f;
                if (j < 128) { const float* kp = ck + (size_t)j * 128 + kvh * 64;
#pragma unroll 16
                    for (int dd = 0; dd < 64; dd += 4) { const f32x4 kv = *(const f32x4*)(kp + dd); acc += kv.x * qv[dd] + kv.y * qv[dd + 1] + kv.z * qv[dd + 2] + kv.w * qv[dd + 3]; } }
                else { const LAS float* kp = KN + (j - 128) * 128 + kvh * 64;
#pragma unroll 16
                    for (int dd = 0; dd < 64; ++dd) acc += kp[dd] * qv[dd]; }
                s = acc * 0.125f + BT[(128 + t - j) * 4 + hq];
            }
            sc[i] = s;
        }
        const float sink = A.in[19 + F.z][l * 4 + hq];
        const float mx = fmaxf(wave_max(fmaxf(fmaxf(sc[0], sc[1]), sc[2])), sink);
        float ps = 0.f;
#pragma unroll
        for (int i = 0; i < 3; ++i) { const float p = __expf(sc[i] - mx); ps += p; const int j = F.lane + 64 * i; if (j < 132) PW[(F.wave * 2 + rr) * 136 + j] = p; }
        const float inv = 1.f / (wave_sum(ps) + __expf(sink - mx));
        LDS_WAIT(); asm volatile("" ::: "memory");
        float o = 0.f;
        const LAS float* pw = PW + (F.wave * 2 + rr) * 136;
        for (int j = t; j <= 128 + t; ++j) { const float vv = j < 128 ? cv[(size_t)j * 128 + kvh * 64 + F.lane] : VN[(j - 128) * 128 + kvh * 64 + F.lane]; o += pw[j] * vv; }
        ((bf16*)(F.ws + WS_MIX))[(size_t)(m0 + t) * D + 768 + hq * 64 + F.lane] = (bf16)f2bf(o * inv);
    }
    {
        float* ok = F.out + O_KS + ((size_t)l * 128 + bs) * 128 * 128; float* ov = F.out + O_VS + ((size_t)l * 128 + bs) * 128 * 128;
        for (int i = F.tid; i < 124 * 128; i += 512) { ok[i] = ck[4 * 128 + i]; ov[i] = cv[4 * 128 + i]; }
        ok[124 * 128 + F.tid] = KN[F.tid]; ov[124 * 128 + F.tid] = VN[F.tid];
    }
}
__device__ __forceinline__ void samp_hg_unit(const Args& A, Ctx& F, int l, int u) {
    const int bs = u >> 2, h = u & 3, m0 = NP + 4 * bs;
    const bf16* PROJ = (const bf16*)(F.ws + WS_PROJ);
    LAS float* FT = (LAS float*)F.lds;
    LAS float* KT = FT + 512;
    LAS float* QT = KT + 512;
    LAS float* VV = QT + 512;
    LAS float* OP = VV + 512;
    LAS float* SS = OP + 2048;
    __syncthreads();
    {
        const int t = F.tid >> 7, d = F.tid & 127; const bf16* p = PROJ + (size_t)(m0 + t) * INW + h * 128 + d;
        const float lb = l == 0 ? 0.f : ((const float*)(F.ws + WS_TAB))[1024 + h * 128 + d];
        const float x = bf2f(p[C_F]), e = __expf(-x), sg = 1.f / (1.f + e);
        FT[F.tid] = lb + (1.f - lb) * sg; KT[F.tid] = (1.f - lb) * e * sg; QT[F.tid] = bf2f(p[C_Q]); VV[F.tid] = bf2f(p[C_I]);
    }
    __syncthreads();
    const int v = F.tid & 127, dq = F.tid >> 7;
    const float* S0 = A.in[3 + F.z] + (((size_t)l * 128 + bs) * 4 + h) * 16384 + (size_t)(dq * 32) * 128 + v;
    float S[32];
#pragma unroll
    for (int i = 0; i < 32; ++i) S[i] = S0[i * 128];
#pragma unroll
    for (int t = 0; t < 4; ++t) {
        const float vt = VV[t * 128 + v]; float part = 0.f;
#pragma unroll
        for (int i = 0; i < 32; ++i) { const int d = dq * 32 + i; S[i] = FT[t * 128 + d] * S[i] + KT[t * 128 + d] * vt; part += QT[t * 128 + d] * S[i]; }
        OP[(dq * 4 + t) * 128 + v] = part;
    }
    float* So = F.out + O_HGS + (((size_t)l * 128 + bs) * 4 + h) * 16384 + (size_t)(dq * 32) * 128 + v;
#pragma unroll
    for (int i = 0; i < 32; ++i) So[i * 128] = S[i];
    __syncthreads();
    {
        const int t = F.tid >> 7, vv = F.tid & 127;
        const float o = (OP[(0 * 4 + t) * 128 + vv] + OP[(1 * 4 + t) * 128 + vv]) + (OP[(2 * 4 + t) * 128 + vv] + OP[(3 * 4 + t) * 128 + vv]);
        const float ss = wave_sum(o * o);
        if (F.lane == 0) SS[t * 2 + (F.wave & 1)] = ss;
        __syncthreads();
        const float rstd = 1.f / sqrtf((SS[t * 2] + SS[t * 2 + 1]) * (1.f / 128.f) + EPS);
        const float gg = bf2f(PROJ[(size_t)(m0 + t) * INW + C_G + h * 128 + vv]);
        ((bf16*)(F.ws + WS_MIX))[(size_t)(m0 + t) * D + 256 + h * 128 + vv] = (bf16)f2bf(o * rstd * A.in[18 + F.z][l * 128 + vv] * (gg * sigm(gg)));
    }
}

#ifndef MK_PER_PHASE
#define MK_PER_PHASE 0
#endif
#ifndef PH_MASK
#define PH_MASK 0xFFFF
#endif
#define PHON(k) ((PH_MASK >> (k)) & 1)
__global__ void __launch_bounds__(512, 2) mk_fwd(Args args) {
    extern __shared__ __attribute__((aligned(16))) unsigned char lds[];
    Ctx F;
    F.lds = (LAS unsigned char*)lds;
    F.tid = threadIdx.x; F.lane = F.tid & 63; F.wave = __builtin_amdgcn_readfirstlane(F.tid >> 6);
    F.G = gridDim.x; F.bid = blockIdx.x; F.z = 0;
    F.out = args.out; F.ws = args.ws;
    volatile LAS unsigned* MISC = (volatile LAS unsigned*)(F.lds + MISC_OFF);
    for (int u = F.tid; u < (LDS_BYTES - LDSCTL_OFF) / 4; u += 512) ((LAS unsigned*)(F.lds + LDSCTL_OFF))[u] = 0u;
    __syncthreads();
    const int lo = args.ph_lo, hi = args.ph_hi;
    XcdBarrier bar; bar.bar = (unsigned*)(F.ws + WS_CTL) + CW_BAR; bar.x = 0; bar.st = nullptr;
    if (hi - lo > 1) bar = xcd_barrier_post((unsigned*)(F.ws + WS_CTL) + CW_BAR, MISC + 8);
    for (int p = lo; p < hi; ++p) {
        { unsigned char* ws_ = args.ws; float* out_ = args.out; int z_ = 0, tid_ = threadIdx.x, bid_ = blockIdx.x, g_ = gridDim.x;
          asm volatile("" : "+s"(ws_), "+s"(out_), "+s"(z_), "+s"(bid_), "+s"(g_)); asm volatile("" : "+v"(tid_));
          F.ws = ws_; F.out = out_; F.z = z_; F.tid = tid_; F.lane = tid_ & 63; F.wave = __builtin_amdgcn_readfirstlane(tid_ >> 6); F.bid = bid_; F.G = g_; }
        const int l = p == 0 ? 0 : (p - 1) / 9, s = (p == 0 || p == NPH - 1) ? -1 : (p - 1) % 9;
        const int which = p == NPH - 1 ? 2 : (s == 0 ? 0 : (s == 6 ? 1 : -1));
        if (p == 0) { if (PHON(0)) p0_prologue(args, F); }
        else if (which >= 0) { if (PHON(1)) norm_phase(args, F, p == NPH - 1 ? 0 : l, which); }
        else if (s == 1 && PHON(2)) {
            pg8::Gemm g{(const pg8::bf16_t*)(F.ws + WS_XN), (const pg8::bf16_t*)(F.ws + WS_WIN) + (size_t)l * INW * D, M, INW, D};
            pg8::StaticOrder S; S.init(M, INW, F.G, F.bid);
            pg8::EpiStore<0> E{(pg8::bf16_t*)(F.ws + WS_PROJ), INW};
            pg8::gemm_phase<pg8::EpiStore<0>, pg8::StaticOrder, true, true>(F.lds, g, S, E, F.tid);
        } else if (s == 2) {
#if PHON(3)
            for (int u = F.bid; u < 256; u += F.G) attn_unit(args, F, l, u);
#endif
#if PHON(4)
            for (int u = F.bid; u < 256; u += F.G) conv_unit(args, F, l, u);
#endif
#if PHON(5)
            for (int u = F.bid; u < 1024; u += F.G) h1_unit(args, F, l, u);
#endif
#if PHON(6)
            for (int u = F.bid; u < 512; u += F.G) samp_hg_unit(args, F, l, u);
#endif
#if PHON(7)
            for (int u = F.bid; u < 128; u += F.G) samp_b_unit(args, F, l, u);
#endif
        } else if (s == 3) { if (PHON(8)) h2_scan(args, F, l); }
        else if (s == 4 && PHON(9)) { for (int u = F.bid; u < 1024; u += F.G) h3_unit(args, F, l, u); }
        else if ((s == 5 || s == 8) && PHON(10)) {
            const bool dn = s == 8;
            pg8::Gemm g{(const pg8::bf16_t*)(F.ws + (dn ? WS_HB : WS_MIX)), (const pg8::bf16_t*)(F.ws + (dn ? WS_WDN : WS_WOUT)) + (size_t)l * (dn ? D * FF : D * D), M, D, dn ? FF : D};
            pg8::StaticOrder S; S.init(M, D, F.G, F.bid);
            const bool from_in = (!dn && l == 0);
            pg8::EpiGateRes E{from_in ? args.in[0 + F.z] : F.out, from_in ? args.in[1 + F.z] : F.out + (size_t)NP * D, F.out, (const float*)(F.ws + WS_MOD) + (size_t)l * MODR * MODLD + (dn ? 5 * D : 2 * D)};
            pg8::gemm_phase<pg8::EpiGateRes, pg8::StaticOrder, true, true>(F.lds, g, S, E, F.tid);
        } else if (s == 7 && PHON(11)) {
            pg8::Gemm g{(const pg8::bf16_t*)(F.ws + WS_XN), (const pg8::bf16_t*)(F.ws + WS_WUP) + (size_t)l * FF * D, M, FF, D};
            pg8::StaticOrder S; S.init(M, FF, F.G, F.bid);
            pg8::EpiStore<1> E{(pg8::bf16_t*)(F.ws + WS_HB), FF};
            pg8::gemm_phase<pg8::EpiStore<1>, pg8::StaticOrder, true, true>(F.lds, g, S, E, F.tid);
        }
        if (p + 1 < hi) xcd_barrier(bar);
    }
}

extern "C" void kernel_launch(void* const* d_in, const int* in_sizes, int n_in, void* d_out, int out_size, void* d_ws, size_t ws_size, hipStream_t stream) {
    static int grid = 0;
    if (grid == 0) {
        if (n_in != 25 || in_sizes[0] != NP * D || (size_t)out_size != O_END || ws_size < WS_END) {
            fprintf(stderr, "kernel_launch: unexpected shapes (n_in %d, in0 %d, out %d, ws %zu)\n", n_in, n_in > 0 ? in_sizes[0] : -1, out_size, ws_size); grid = -1; return; }
        int dev = 0, cus = 0, per_cu = 0;
        if (hipGetDevice(&dev) != hipSuccess || hipDeviceGetAttribute(&cus, hipDeviceAttributeMultiprocessorCount, dev) != hipSuccess) { grid = -1; return; }
        if (hipFuncSetAttribute((const void*)mk_fwd, hipFuncAttributeMaxDynamicSharedMemorySize, LDS_BYTES) != hipSuccess) { fprintf(stderr, "kernel_launch: hipFuncSetAttribute failed\n"); grid = -1; return; }
        if (hipOccupancyMaxActiveBlocksPerMultiprocessor(&per_cu, (const void*)mk_fwd, 512, LDS_BYTES) != hipSuccess || per_cu < 1) {
            fprintf(stderr, "kernel_launch: occupancy query reports %d blocks per CU; nothing launched\n", per_cu); (void)hipGetLastError(); grid = -1; return; }
        grid = cus;
    }
    if (grid < 0) return;
    (void)hipMemsetAsync((char*)d_ws + WS_CTL, 0, CTL_ZERO_BYTES, stream);
    Args a{};
    for (int i = 0; i < 25; ++i) a.in[i] = (const float*)d_in[i];
    a.out = (float*)d_out; a.ws = (unsigned char*)d_ws;
#if MK_PER_PHASE
    for (int p = 0; p < NPH; ++p) { a.ph_lo = p; a.ph_hi = p + 1; hipLaunchKernelGGL(mk_fwd, dim3(grid), dim3(512), LDS_BYTES, stream, a); }
#else
    a.ph_lo = 0; a.ph_hi = NPH; hipLaunchKernelGGL(mk_fwd, dim3(grid), dim3(512), LDS_BYTES, stream, a);
#endif
}
```

```cpp
#define MK_PER_PHASE 0
#include <hip/hip_runtime.h>
#include <cstdio>
#include <cstdint>
namespace pg8 {
#define PG8_LAS __attribute__((address_space(3)))
typedef unsigned short bf16_t;
typedef short bf16x8 __attribute__((ext_vector_type(8)));
typedef float f32x4 __attribute__((ext_vector_type(4)));
typedef unsigned u32x4 __attribute__((ext_vector_type(4)));
constexpr int BM = 256, BK = 64, HALF = 128, HTB = HALF * BK * 2  , STAGE_BYTES = 8 * HTB, NXCD = 8, WGM = 8;

__host__ __device__ __forceinline__ int lds_byte(int r, int c) { const int st = (r >> 4) * 2 + (c >> 5), rr = r & 15, cc = c & 31, ob = rr * 64 + cc * 2; return st * 1024 + (ob ^ (((ob >> 9) & 1) << 5)); }
__host__ __device__ __forceinline__ void stage_rc(int b, int& R, int& C) { const int st = b / 1024, sb = b % 1024, swz = sb ^ (((sb >> 9) & 1) << 5); R = (st >> 1) * 16 + swz / 64; C = (st & 1) * 32 + (swz % 64) / 2; }
__host__ __device__ __forceinline__ int perm32(int rho) { const int n = rho >> 4, i = rho & 15; return 8 * (i >> 2) + 4 * n + (i & 3); }

struct Unit { int pm, pn; };
struct Gemm { const bf16_t* A; const bf16_t* Bt; int M, N, K; };

struct StaticOrder {
    int nM, nN, nwg, G, c;
    __host__ __device__ void init(int M, int N, int G_, int c_) { nM = M / BM; nN = N / BM; nwg = nM * nN; G = G_; c = c_; }
    __host__ __device__ bool next(int i, Unit& u) const {
        const long L = (long)i * G + c; if (L >= nwg) return false;
        int wgid = (int)L; { const int q = nwg / NXCD, r = nwg % NXCD, xcd = wgid % NXCD, off = wgid / NXCD; wgid = (xcd < r ? xcd * (q + 1) : r * (q + 1) + (xcd - r) * q) + off; }
        const int nig = WGM * nN, gid = wgid / nig, fm = gid * WGM, gsz = (nM - fm) < WGM ? (nM - fm) : WGM;
        u.pm = fm + ((wgid % nig) % gsz); u.pn = (wgid % nig) / gsz; return true;
    }
    __device__ __forceinline__ void a_ready(const Unit&) const {}
    __device__ __forceinline__ void done(const Unit&) const {}
};

__device__ __forceinline__ unsigned cvt_pk_bf16(float lo, float hi) { unsigned r; asm volatile("v_cvt_pk_bf16_f32 %0, %1, %2" : "=v"(r) : "v"(lo), "v"(hi)); return r; }
typedef float f32x2 __attribute__((ext_vector_type(2)));
constexpr int EP_NP = 16384, EP_D = 1024, EP_MODLD = 6144;
__device__ __forceinline__ int ep_modrow(int r) { return r < EP_NP ? (r >> 12) : 4 + ((r - EP_NP) >> 2); }
template <int ACT> struct EpiStore {
    static constexpr bool PERM = true, AFTER_DRAIN = false;
    bf16_t* O; int ldc;
    __device__ __forceinline__ void operator()(const f32x4 (&acc)[2][2][4][2], const Unit& u, int wr, int wc, int fr, int fq) const {
        const int row0 = u.pm * BM + wr * 64 + fr, col0 = u.pn * BM + wc * 32 + 8 * fq;
#pragma unroll
        for (int ai = 0; ai < 2; ++ai)
#pragma unroll
            for (int m = 0; m < 4; ++m) { bf16_t* rowp = O + (size_t)(row0 + ai * HALF + m * 16) * ldc + col0;
#pragma unroll
                for (int bj = 0; bj < 2; ++bj) { f32x4 v0 = acc[ai][bj][m][0], v1 = acc[ai][bj][m][1];
                    if (ACT == 1) {
#pragma unroll
                        for (int e = 0; e < 4; ++e) { const float a = v0[e] > 0.f ? v0[e] : 0.f, b = v1[e] > 0.f ? v1[e] : 0.f; v0[e] = a * a; v1[e] = b * b; } }
                    u32x4 w; w.x = cvt_pk_bf16(v0[0], v0[1]); w.y = cvt_pk_bf16(v0[2], v0[3]); w.z = cvt_pk_bf16(v1[0], v1[1]); w.w = cvt_pk_bf16(v1[2], v1[3]);
                    *(u32x4*)(rowp + bj * HALF) = w; } }
    }
};
struct EpiGateRes {
    static constexpr bool PERM = false, AFTER_DRAIN = false;
    const float* baseP; const float* baseS; float* out; const float* gate;
    __device__ __forceinline__ void operator()(const f32x4 (&acc)[2][2][4][2], const Unit& u, int wr, int wc, int fr, int fq) const {
        const int col0 = u.pn * BM + wc * 32 + 4 * fq;
        const float* gp = gate + (size_t)ep_modrow(u.pm * BM) * EP_MODLD + col0;
        f32x4 g4[2][2];
#pragma unroll
        for (int bj = 0; bj < 2; ++bj)
#pragma unroll
            for (int n = 0; n < 2; ++n) g4[bj][n] = *(const f32x4*)(gp + bj * HALF + n * 16);
#pragma unroll
        for (int ai = 0; ai < 2; ++ai)
#pragma unroll
            for (int mp = 0; mp < 2; ++mp) {
                f32x4 b4[2][2][2];
#pragma unroll
                for (int mm = 0; mm < 2; ++mm) { const int r = u.pm * BM + ai * HALF + wr * 64 + (2 * mp + mm) * 16 + fr;
                    const float* bp = (r < EP_NP ? baseP + (size_t)r * EP_D : baseS + (size_t)(r - EP_NP) * EP_D) + col0;
#pragma unroll
                    for (int bj = 0; bj < 2; ++bj)
#pragma unroll
                        for (int n = 0; n < 2; ++n) b4[mm][bj][n] = *(const f32x4*)(bp + bj * HALF + n * 16); }
                __builtin_amdgcn_sched_barrier(0);
#pragma unroll
                for (int mm = 0; mm < 2; ++mm) { const int m = 2 * mp + mm, r = u.pm * BM + ai * HALF + wr * 64 + m * 16 + fr;
                    float* op = out + (size_t)r * EP_D + col0;
#pragma unroll
                    for (int bj = 0; bj < 2; ++bj)
#pragma unroll
                        for (int n = 0; n < 2; ++n) *(f32x4*)(op + bj * HALF + n * 16) = b4[mm][bj][n] + g4[bj][n] * acc[ai][bj][m][n]; }
                __builtin_amdgcn_sched_barrier(0);
            }
    }
};
template <class Epi, class Sched, bool ALIGN_EPI = false, bool SP2 = false>
__device__ __forceinline__ void gemm_phase(PG8_LAS unsigned char* lds, const Gemm g, const Sched& S, const Epi& E, const int tid) {
    const int wid = __builtin_amdgcn_readfirstlane(tid >> 6), lane = tid & 63, wr = wid >> 2, wc = wid & 3, fr = lane & 15, fq = lane >> 4;
    const int K = g.K, nt = K / BK;
    unsigned voffA[2], voffB[2];
#pragma unroll
    for (int i = 0; i < 2; ++i) { int R, C; stage_rc(tid * 16 + i * 8192, R, C); const int Rb = Epi::PERM ? ((R & ~31) + perm32(R & 31)) : R;
        voffA[i] = (unsigned)(R * K + C) * 2u; voffB[i] = (unsigned)(Rb * K + C) * 2u; }
    const size_t kstep = (size_t)(BK * 2);
    const size_t hstep = (size_t)HALF * K * 2;
    const size_t tstep = 2 * hstep;
    const unsigned ldsw = (unsigned)wid * 1024u;
    const int aoff = lds_byte(wr * 64 + fr, fq * 8), boff = lds_byte(wc * 32 + fr, fq * 8);
#define PG8_SA(b, h) (((b) * 2 + (h)) * HTB)
#define PG8_SB(b, h) ((4 + (b) * 2 + (h)) * HTB)
#define PG8_STAGE(bufoff, gbase, voff) do { _Pragma("unroll") for (int _i = 0; _i < 2; ++_i) \
        __builtin_amdgcn_global_load_lds((const unsigned*)((const char*)(gbase) + (voff)[_i]), (PG8_LAS unsigned*)(lds + (bufoff) + ldsw + _i * 8192), 16, 0, 0); } while (0)
#define PG8_LDA(dst, b, h) do { _Pragma("unroll") for (int m = 0; m < 4; ++m) _Pragma("unroll") for (int k = 0; k < 2; ++k) dst[m][k] = *(const PG8_LAS bf16x8*)(lds + PG8_SA(b, h) + aoff + m * 2048 + k * 1024); } while (0)
#define PG8_LDB(dst, b, h) do { _Pragma("unroll") for (int n = 0; n < 2; ++n) _Pragma("unroll") for (int k = 0; k < 2; ++k) dst[n][k] = *(const PG8_LAS bf16x8*)(lds + PG8_SB(b, h) + boff + n * 2048 + k * 1024); } while (0)
#define PG8_MMA(ai, bj, At, Bt) do { __builtin_amdgcn_s_setprio(1); _Pragma("unroll") for (int m = 0; m < 4; ++m) _Pragma("unroll") for (int n = 0; n < 2; ++n) _Pragma("unroll") for (int k = 0; k < 2; ++k) \
        acc[ai][bj][m][n] = __builtin_amdgcn_mfma_f32_16x16x32_bf16(Bt[n][k], At[m][k], acc[ai][bj][m][n], 0, 0, 0); __builtin_amdgcn_s_setprio(0); } while (0)
#define PG8_WAIT_V(n) asm volatile("s_waitcnt vmcnt(" #n ")" ::: "memory")
#define PG8_WAIT_L(n) asm volatile("s_waitcnt lgkmcnt(" #n ")" ::: "memory")
#define PG8_BAR __builtin_amdgcn_s_barrier()
#define PG8_SCHED __builtin_amdgcn_sched_barrier(0)
    Unit cur, nxt; int ui = 0;
    if (!S.next(0, cur)) return;
    f32x4 acc[2][2][4][2];
#pragma unroll
    for (int a = 0; a < 2; ++a)
#pragma unroll
        for (int b = 0; b < 2; ++b)
#pragma unroll
            for (int m = 0; m < 4; ++m)
#pragma unroll
                for (int n = 0; n < 2; ++n) acc[a][b][m][n] = (f32x4){0.f, 0.f, 0.f, 0.f};
    bf16x8 At[4][2], B0[2][2], B1[2][2];
    const char* cA = (const char*)g.A + (size_t)cur.pm * tstep; const char* cB = (const char*)g.Bt + (size_t)cur.pn * tstep;
    S.a_ready(cur);
    if constexpr (SP2) {
        PG8_STAGE(PG8_SB(0, 0), cB, voffB); PG8_STAGE(PG8_SB(0, 1), cB + hstep, voffB); PG8_STAGE(PG8_SA(0, 0), cA, voffA); PG8_STAGE(PG8_SA(0, 1), cA + hstep, voffA);
        if (wr == 1) PG8_BAR;
        PG8_WAIT_V(2); PG8_BAR;
        PG8_STAGE(PG8_SB(1, 0), cB + kstep, voffB); PG8_STAGE(PG8_SA(1, 0), cA + kstep, voffA); PG8_STAGE(PG8_SB(1, 1), cB + hstep + kstep, voffB);
        PG8_WAIT_V(6); PG8_BAR;
    } else {
        PG8_STAGE(PG8_SB(0, 0), cB, voffB); PG8_STAGE(PG8_SA(0, 0), cA, voffA); PG8_STAGE(PG8_SB(0, 1), cB + hstep, voffB); PG8_STAGE(PG8_SA(0, 1), cA + hstep, voffA);
        if (wr == 1) PG8_BAR;
        PG8_WAIT_V(4); PG8_BAR;
        PG8_STAGE(PG8_SB(1, 0), cB + kstep, voffB); PG8_STAGE(PG8_SA(1, 0), cA + kstep, voffA); PG8_STAGE(PG8_SB(1, 1), cB + hstep + kstep, voffB);
        PG8_WAIT_V(6); PG8_BAR;
    }
    for (;;) {
        const bool has_next = S.next(ui + 1, nxt);
        const char* nA = has_next ? (const char*)g.A + (size_t)nxt.pm * tstep : cA; const char* nB = has_next ? (const char*)g.Bt + (size_t)nxt.pn * tstep : cB;
        for (int t = 0; t < nt; t += 2) {
            const bool last = (t == nt - 2);
            const char* a1 = cA + (size_t)(t + 1) * kstep;
            const char* a2 = last ? nA : cA + (size_t)(t + 2) * kstep; const char* b2 = last ? nB : cB + (size_t)(t + 2) * kstep;
            const char* a3 = a2 + kstep; const char* b3 = b2 + kstep;
            if (last && has_next) S.a_ready(nxt);
            if constexpr (SP2) {
            PG8_LDB(B0, 0, 0); PG8_LDB(B1, 0, 1); PG8_SCHED; PG8_LDA(At, 0, 0); PG8_STAGE(PG8_SA(1, 1), a1 + hstep, voffA);
            PG8_WAIT_V(8); PG8_WAIT_L(0); PG8_BAR; PG8_MMA(0, 0, At, B0); PG8_MMA(0, 1, At, B1); PG8_BAR; PG8_SCHED;
            PG8_LDA(At, 0, 1); PG8_STAGE(PG8_SB(0, 0), b2, voffB); PG8_STAGE(PG8_SB(0, 1), b2 + hstep, voffB); PG8_STAGE(PG8_SA(0, 0), a2, voffA);
            PG8_WAIT_V(8); PG8_WAIT_L(0); PG8_BAR; PG8_MMA(1, 0, At, B0); PG8_MMA(1, 1, At, B1); PG8_BAR; PG8_SCHED;
            PG8_LDB(B0, 1, 0); PG8_LDB(B1, 1, 1); PG8_SCHED; PG8_LDA(At, 1, 0); PG8_STAGE(PG8_SA(0, 1), a2 + hstep, voffA);
            PG8_WAIT_V(8); PG8_WAIT_L(0); PG8_BAR; PG8_MMA(0, 0, At, B0); PG8_MMA(0, 1, At, B1); PG8_BAR; PG8_SCHED;
            PG8_LDA(At, 1, 1); PG8_STAGE(PG8_SB(1, 0), b3, voffB); PG8_STAGE(PG8_SB(1, 1), b3 + hstep, voffB); PG8_STAGE(PG8_SA(1, 0), a3, voffA);
            PG8_WAIT_V(8); PG8_WAIT_L(0); PG8_BAR; PG8_MMA(1, 0, At, B0); PG8_MMA(1, 1, At, B1); PG8_BAR; PG8_SCHED;
            } else {
            PG8_LDB(B0, 0, 0); PG8_SCHED; PG8_LDA(At, 0, 0); PG8_STAGE(PG8_SA(1, 1), a1 + hstep, voffA);
            PG8_WAIT_L(8); PG8_BAR; PG8_WAIT_L(0); PG8_MMA(0, 0, At, B0); PG8_BAR; PG8_SCHED;
            PG8_LDB(B1, 0, 1); PG8_STAGE(PG8_SB(0, 0), b2, voffB);
            PG8_BAR; PG8_WAIT_L(0); PG8_MMA(0, 1, At, B1); PG8_BAR;
            PG8_LDA(At, 0, 1); PG8_STAGE(PG8_SA(0, 0), a2, voffA);
            PG8_BAR; PG8_WAIT_L(0); PG8_MMA(1, 0, At, B0); PG8_BAR; PG8_SCHED;
            PG8_STAGE(PG8_SB(0, 1), b2 + hstep, voffB);
            PG8_WAIT_V(6); PG8_BAR; PG8_MMA(1, 1, At, B1); PG8_BAR;
            PG8_LDB(B0, 1, 0); PG8_SCHED; PG8_LDA(At, 1, 0); PG8_STAGE(PG8_SA(0, 1), a2 + hstep, voffA);
            PG8_WAIT_L(8); PG8_BAR; PG8_WAIT_L(0); PG8_MMA(0, 0, At, B0); PG8_BAR; PG8_SCHED;
            PG8_LDB(B1, 1, 1); PG8_STAGE(PG8_SB(1, 0), b3, voffB);
            PG8_BAR; PG8_WAIT_L(0); PG8_MMA(0, 1, At, B1); PG8_BAR;
            PG8_LDA(At, 1, 1); PG8_STAGE(PG8_SA(1, 0), a3, voffA);
            PG8_BAR; PG8_WAIT_L(0); PG8_MMA(1, 0, At, B0); PG8_BAR; PG8_SCHED;
            PG8_STAGE(PG8_SB(1, 1), b3 + hstep, voffB);
            PG8_WAIT_V(6); PG8_BAR; PG8_MMA(1, 1, At, B1); PG8_BAR;
            }
        }
        if constexpr (ALIGN_EPI) { if (wr == 0) PG8_BAR; }
        if constexpr (!Epi::AFTER_DRAIN) { E(acc, cur, wr, wc, fr, fq); S.done(cur); }
        if (!has_next) break;
#pragma unroll
        for (int a = 0; a < 2; ++a)
#pragma unroll
            for (int b = 0; b < 2; ++b)
#pragma unroll
                for (int m = 0; m < 4; ++m)
#pragma unroll
                    for (int n = 0; n < 2; ++n) acc[a][b][m][n] = (f32x4){0.f, 0.f, 0.f, 0.f};
        cur = nxt; cA = nA; cB = nB; ++ui;
        if constexpr (ALIGN_EPI) { if (wr == 1) PG8_BAR; }
    }
    PG8_WAIT_V(0);
    if constexpr (!ALIGN_EPI) { if (wr == 0) PG8_BAR; }
    PG8_BAR;
    if constexpr (Epi::AFTER_DRAIN) { E.fused(acc, cur, wr, wc, fr, fq, lds, wid, lane); S.done(cur); }
#undef PG8_SA
#undef PG8_SB
#undef PG8_STAGE
#undef PG8_LDA
#undef PG8_LDB
#undef PG8_MMA
#undef PG8_WAIT_V
#undef PG8_WAIT_L
#undef PG8_BAR
#undef PG8_SCHED
}
}
#define GAS __attribute__((address_space(1)))
#define LAS __attribute__((address_space(3)))
typedef unsigned short bf16;
typedef unsigned v4u __attribute__((ext_vector_type(4)));
typedef float f32x4 __attribute__((ext_vector_type(4)));
typedef short bf16x8 __attribute__((ext_vector_type(8)));
typedef GAS unsigned gu32;
typedef GAS unsigned long long gu64;
#define RLX_AGENT __ATOMIC_RELAXED, __HIP_MEMORY_SCOPE_AGENT
#define LDS_WAIT() asm volatile("s_waitcnt lgkmcnt(0)" ::: "memory")
#define VM_WAIT() asm volatile("s_waitcnt vmcnt(0)" ::: "memory")
__device__ __forceinline__ unsigned long long rt() { return __builtin_amdgcn_s_memrealtime(); }
typedef float f32x2_ __attribute__((ext_vector_type(2)));
typedef __bf16 bf16x2_ __attribute__((ext_vector_type(2)));
__device__ __forceinline__ unsigned pk2(float lo, float hi) { const f32x2_ v = {lo, hi}; const bf16x2_ b = __builtin_convertvector(v, bf16x2_); return __builtin_bit_cast(unsigned, b); }
__device__ __forceinline__ unsigned f2bf(float f) { return (unsigned)__builtin_bit_cast(unsigned short, (__bf16)f); }

#define XB_TMO      128
#define XB_XCNT(j)  (256  + 64 * (j))
#define XB_XSUB(j)  (1280 + 64 * (j))
#define XB_XGEN(j)  (2304 + 64 * (j))
#define XB_TOP      3328
#define XB_TOPGEN   3392
#define XCD_BAR_WORDS 3456
#define XB_SPIN_CAP (1u << 18)

__device__ __forceinline__ unsigned xb_ld(unsigned* p)              { return __hip_atomic_load(p, __ATOMIC_RELAXED, __HIP_MEMORY_SCOPE_AGENT); }
__device__ __forceinline__ unsigned xb_add(unsigned* p, unsigned v) { return __hip_atomic_fetch_add(p, v, __ATOMIC_RELAXED, __HIP_MEMORY_SCOPE_AGENT); }
__device__ __forceinline__ unsigned xb_xcc_id() { return (unsigned)__builtin_amdgcn_s_getreg((3 << 11) | 20) & 0xFu; }
#define XB_SPIN(cond, bar) do { unsigned _sp = 0; while (cond) { __builtin_amdgcn_s_sleep(1); \
    if ((++_sp & 255u) == 0u) { if (xb_ld(&(bar)[XB_TMO])) break; if (_sp > XB_SPIN_CAP) { atomicAdd(&(bar)[XB_TMO], 1u); break; } } } } while (0)

struct XcdBarrier {
    unsigned* bar; unsigned x;
    volatile LAS unsigned* st;
};

__device__ __forceinline__ XcdBarrier xcd_barrier_post(unsigned* bar, volatile LAS unsigned* st, const int tid_) {
    XcdBarrier b; b.bar = bar; b.x = xb_xcc_id(); b.st = st;
    if (tid_ == 0) (void)xb_add(&bar[XB_XCNT(b.x)], 1u);
    return b;
}
__device__ __forceinline__ void xcd_barrier_complete(unsigned* bar, unsigned x, unsigned& nloc, unsigned& nx) {
    const unsigned G = gridDim.x * gridDim.y * gridDim.z;
    unsigned sum, cnt, mine, sp = 0u;
    for (;;) {
        sum = 0u; cnt = 0u; mine = 0u;
#pragma unroll
        for (unsigned j = 0; j < 16; ++j) { const unsigned c = xb_ld(&bar[XB_XCNT(j)]); sum += c; cnt += (c > 0u) ? 1u : 0u; mine = (j == x) ? c : mine; }
        if (sum == G) break;
        __builtin_amdgcn_s_sleep(1);
        if ((++sp & 255u) == 0u) { if (xb_ld(&bar[XB_TMO])) break; if (sp > XB_SPIN_CAP) { atomicAdd(&bar[XB_TMO], 1u); break; } }
    }
    nloc = mine > 0u ? mine : 1u; nx = cnt > 0u ? cnt : 1u;
}

__device__ __forceinline__ void xcd_barrier(const XcdBarrier& b, const int tid_) {
    asm volatile("s_waitcnt vmcnt(0)" ::: "memory");
    __syncthreads();
    if (tid_ == 0) {
        unsigned* bar = b.bar;
        __builtin_amdgcn_s_waitcnt(0);
        unsigned nloc = b.st[0], nx = b.st[1];
        if (nloc == 0u) { xcd_barrier_complete(bar, b.x, nloc, nx); b.st[0] = nloc; b.st[1] = nx; }
        const unsigned old = xb_add(&bar[XB_XSUB(b.x)], 1u);
        const unsigned gen = old / nloc;
        if (old + 1u == (gen + 1u) * nloc) {
            __builtin_amdgcn_fence(__ATOMIC_RELEASE, "agent");
            asm volatile("s_waitcnt vmcnt(0)" ::: "memory");
            const unsigned og = xb_add(&bar[XB_TOP], 1u);
            const unsigned tg = og / nx;
            if (og + 1u == (tg + 1u) * nx) xb_add(&bar[XB_TOPGEN], 1u);
            else XB_SPIN(xb_ld(&bar[XB_TOPGEN]) == tg, bar);
            __builtin_amdgcn_fence(__ATOMIC_ACQUIRE, "agent");
            xb_add(&bar[XB_XGEN(b.x)], 1u);
            asm volatile("s_waitcnt vmcnt(0)" ::: "memory");
        } else {
            XB_SPIN(xb_ld(&bar[XB_XGEN(b.x)]) == gen, bar);
            __builtin_amdgcn_fence(__ATOMIC_ACQUIRE, "agent");
            asm volatile("s_waitcnt vmcnt(0)" ::: "memory");
        }
    }
    __syncthreads();
}

constexpr int D = 1024, NP = 16384, NS = 512, M = NP + NS, INW = 3072, FF = 4096, TP = 4096;
constexpr int C_AV = 0, C_AG = 256, C_Q = 512, C_F = 1024, C_I = 1536, C_G = 2048, C_QA = 2560, C_KA = 2816, C_VA = 2944;
constexpr int MODR = 132, MODLD = 6144;
constexpr float EPS = 1e-6f;
constexpr size_t O_CONVP = (size_t)M * D, O_CONVS = O_CONVP + 2 * 4 * 30 * 256, O_HGP = O_CONVS + 2 * 128 * 30 * 256, O_HGS = O_HGP + 2 * 4 * 4 * 16384,
                 O_KP = O_HGS + (size_t)2 * 128 * 4 * 16384, O_KS = O_KP + 2 * 4 * 128 * 128, O_VP = O_KS + (size_t)2 * 128 * 128 * 128, O_VS = O_VP + 2 * 4 * 128 * 128,
                 O_END = O_VS + (size_t)2 * 128 * 128 * 128;
constexpr size_t MiB = 1u << 20;
constexpr size_t WS_CTL = 0, CTL_ZERO_BYTES = 1 * MiB, WS_TAB = 1 * MiB, WS_MOD = 2 * MiB, WS_DC = 9 * MiB, WS_WIN = 10 * MiB, WS_WOUT = 22 * MiB, WS_WUP = 26 * MiB, WS_WDN = 42 * MiB,
                 WS_XN = 58 * MiB, WS_HG = 58 * MiB, WS_PROJ = 91 * MiB, WS_MIX = 190 * MiB, WS_HB = 91 * MiB, WS_END = 223 * MiB;
constexpr size_t WS_SC = WS_TAB + 65536;
constexpr int CW_BAR = 4096;
constexpr int RING_BYTES = 131072, LDSCTL_OFF = RING_BYTES, MISC_OFF = LDSCTL_OFF + 320, LDS_BYTES = 147456;
constexpr int NPH = 21;

typedef float f32x16 __attribute__((ext_vector_type(16)));
typedef unsigned v2u __attribute__((ext_vector_type(2)));
__device__ __forceinline__ float bf2f(unsigned h) { return __builtin_bit_cast(float, h << 16); }
__device__ __forceinline__ float wave_sum(float v) {
#pragma unroll
    for (int o = 1; o < 64; o <<= 1) v += __shfl_xor(v, o);
    return v;
}
__device__ __forceinline__ float wave_max(float v) {
#pragma unroll
    for (int o = 1; o < 64; o <<= 1) v = fmaxf(v, __shfl_xor(v, o));
    return v;
}
__device__ __forceinline__ int modrow(int r) { return r < NP ? (r >> 12) : 4 + ((r - NP) >> 2); }
__device__ __forceinline__ int crow(int r, int hi) { return (r & 3) + 8 * (r >> 2) + 4 * hi; }
__device__ __forceinline__ bf16x8 pk8(float a0, float a1, float a2, float a3, float a4, float a5, float a6, float a7) {
    v4u w; w.x = pk2(a0, a1); w.y = pk2(a2, a3); w.z = pk2(a4, a5); w.w = pk2(a6, a7); return __builtin_bit_cast(bf16x8, w);
}
__device__ __forceinline__ float sigm(float x) { return __builtin_amdgcn_rcpf(1.f + __expf(-x)); }
#define MFMA32(a, b, c) __builtin_amdgcn_mfma_f32_32x32x16_bf16((a), (b), (c), 0, 0, 0)
#define MFMA16(a, b, c) __builtin_amdgcn_mfma_f32_16x16x32_bf16((a), (b), (c), 0, 0, 0)

#ifndef PROBE_SPIN
#define PROBE_SPIN -1
#endif
#ifndef PROBE_N
#define PROBE_N 0
#endif
#define TSEC_BEGIN(k) const unsigned long long ts0_##k = PROBE_SPIN == (k) ? __builtin_amdgcn_s_memrealtime() : 0ull
#define TSEC_END(k) do { if (PROBE_SPIN == (k)) { const unsigned long long ts1_ = __builtin_amdgcn_s_memrealtime(), du_ = (ts1_ - ts0_##k) * PROBE_N; while (__builtin_amdgcn_s_memrealtime() - ts1_ < du_) __builtin_amdgcn_s_sleep(4); } } while (0)
struct Args { const float* in[25]; float* out; unsigned char* ws; int ph_lo, ph_hi; };
struct Ctx {
    LAS unsigned char* lds;
    int tid, lane, wave, G, bid, z;
    float* out; unsigned char* ws;
};

__device__ __forceinline__ void p0_transpose_item(const float* W, int K, int N, bf16* WT, LAS float* scr, int item, int lane) {
    const int nblk = N / 32, kb = item / nblk, nb = item % nblk, k0 = 64 * kb, n0 = 32 * nb;
    float tv[32];
#pragma unroll
    for (int i = 0; i < 32; ++i) { const int kk = 2 * i + (lane >> 5); tv[i] = W[(size_t)(k0 + kk) * N + n0 + (lane & 31)]; }
    __builtin_amdgcn_sched_barrier(0);
#pragma unroll
    for (int i = 0; i < 32; ++i) { const int kk = 2 * i + (lane >> 5); scr[kk * 33 + (lane & 31)] = tv[i]; }
    LDS_WAIT(); asm volatile("" ::: "memory");
    const int c = lane & 7;
#pragma unroll
    for (int j = 0; j < 4; ++j) { const int n = (lane >> 3) + 8 * j; const LAS float* s = scr + (8 * c) * 33 + n;
        v4u o; o.x = pk2(s[0 * 33], s[1 * 33]); o.y = pk2(s[2 * 33], s[3 * 33]); o.z = pk2(s[4 * 33], s[5 * 33]); o.w = pk2(s[6 * 33], s[7 * 33]);
        *(GAS v4u*)(WT + (size_t)(n0 + n) * K + k0 + 8 * c) = o; }
    LDS_WAIT(); asm volatile("" ::: "memory");
}
__device__ __forceinline__ void mod_unit(const Args& A, Ctx& F, int u) {
    const int l = u / 192, n0 = 32 * (u % 192), k0 = 128 * F.wave, c = F.lane & 31, h2 = F.lane >> 5;
    const float* W = A.in[9 + F.z] + (size_t)l * 1024 * 6144;
    f32x16 acc[5];
#pragma unroll
    for (int i = 0; i < 5; ++i)
#pragma unroll
        for (int e = 0; e < 16; ++e) acc[i][e] = 0.f;
    const bf16* SC = (const bf16*)(F.ws + WS_SC);
    LAS unsigned char* WL = F.lds + F.wave * 16384;
    const int lr = F.lane >> 3, lp = F.lane & 7;
    TSEC_BEGIN(42);
    __syncthreads();
#pragma unroll 1
    for (int jh = 0; jh < 2; ++jh) {
        const int kh = k0 + 64 * jh;
        float wv[4][8];
#pragma unroll
        for (int j = 0; j < 4; ++j)
#pragma unroll
            for (int e = 0; e < 8; ++e) wv[j][e] = W[(size_t)(kh + 16 * j + 8 * h2 + e) * 6144 + n0 + c];
        v4u rs[16];
#pragma unroll
        for (int t = 0; t < 16; ++t) rs[t] = *(const v4u*)(SC + (size_t)(4 + 8 * t + lr) * 1024 + kh + 8 * lp);
        bf16x8 ap4[4];
#pragma unroll
        for (int j = 0; j < 4; ++j) { ap4[j] = (bf16x8){0, 0, 0, 0, 0, 0, 0, 0}; if (c < 4) ap4[j] = *(const bf16x8*)(SC + (size_t)c * 1024 + kh + 16 * j + 8 * h2); }
        __builtin_amdgcn_sched_barrier(0);
#pragma unroll
        for (int t = 0; t < 16; ++t) { const int r = 8 * t + lr; *(LAS v4u*)(WL + r * 128 + ((lp ^ (r & 7)) << 4)) = rs[t]; }
        __builtin_amdgcn_sched_barrier(0);
#pragma unroll
        for (int j = 0; j < 4; ++j) {
            const bf16x8 b = pk8(wv[j][0], wv[j][1], wv[j][2], wv[j][3], wv[j][4], wv[j][5], wv[j][6], wv[j][7]);
            acc[0] = MFMA32(ap4[j], b, acc[0]);
#pragma unroll
            for (int rt = 1; rt < 5; ++rt) { const int r = 32 * (rt - 1) + c; const bf16x8 af = *(const LAS bf16x8*)(WL + r * 128 + (((2 * j + h2) ^ (r & 7)) << 4)); acc[rt] = MFMA32(af, b, acc[rt]); }
        }
        __builtin_amdgcn_sched_barrier(0);
    }
    TSEC_END(42);
    TSEC_BEGIN(43);
    LAS float* RED = (LAS float*)F.lds;
#define RED_WR(slot) do { _Pragma("unroll") for (int rt = 0; rt < 5; ++rt) _Pragma("unroll") for (int e = 0; e < 16; ++e) RED[(slot) * 5120 + (rt * 16 + e) * 64 + F.lane] = acc[rt][e]; } while (0)
#define RED_ADD(slot) do { _Pragma("unroll") for (int rt = 0; rt < 5; ++rt) _Pragma("unroll") for (int e = 0; e < 16; ++e) acc[rt][e] += RED[(slot) * 5120 + (rt * 16 + e) * 64 + F.lane]; } while (0)
    __syncthreads();
    if (F.wave >= 4) RED_WR(F.wave - 4);
    __syncthreads();
    if (F.wave < 4) RED_ADD(F.wave);
    __syncthreads();
    if (F.wave == 2 || F.wave == 3) RED_WR(F.wave - 2);
    __syncthreads();
    if (F.wave < 2) RED_ADD(F.wave);
    __syncthreads();
    if (F.wave == 1) RED_WR(0);
    __syncthreads();
    if (F.wave == 0) {
        RED_ADD(0);
        float* mo = (float*)(F.ws + WS_MOD) + (size_t)l * MODR * MODLD;
        const float bias = A.in[10 + F.z][l * MODLD + n0 + c];
#pragma unroll
        for (int rt = 0; rt < 5; ++rt)
#pragma unroll
            for (int e = 0; e < 16; ++e) { const int cr = crow(e, h2), r = rt == 0 ? cr : 4 + 32 * (rt - 1) + cr; if (rt > 0 || cr < 4) mo[(size_t)r * MODLD + n0 + c] = acc[rt][e] + bias; }
    }
#undef RED_WR
#undef RED_ADD
    TSEC_END(43);
}
__device__ __forceinline__ void p0_prologue(const Args& A, Ctx& F) {
    LAS float* scr = (LAS float*)(F.lds + F.wave * 16384);
    const int gw = F.bid * 8 + F.wave, NGW = F.G * 8;
    TSEC_BEGIN(40);
    for (int it = gw; it < 12288; it += NGW) {
        const int l = it / 6144; int r = it % 6144;
        if (r < 1536) { p0_transpose_item(A.in[12 + F.z] + (size_t)l * 1024 * 3072, 1024, 3072, (bf16*)(F.ws + WS_WIN) + (size_t)l * 3072 * 1024, scr, r, F.lane); continue; } r -= 1536;
        if (r < 512) { p0_transpose_item(A.in[20 + F.z] + (size_t)l * 1024 * 1024, 1024, 1024, (bf16*)(F.ws + WS_WOUT) + (size_t)l * 1024 * 1024, scr, r, F.lane); continue; } r -= 512;
        if (r < 2048) { p0_transpose_item(A.in[22 + F.z] + (size_t)l * 1024 * 4096, 1024, 4096, (bf16*)(F.ws + WS_WUP) + (size_t)l * 4096 * 1024, scr, r, F.lane); continue; } r -= 2048;
        p0_transpose_item(A.in[23 + F.z] + (size_t)l * 4096 * 1024, 4096, 1024, (bf16*)(F.ws + WS_WDN) + (size_t)l * 1024 * 4096, scr, r, F.lane);
    }
    TSEC_END(40);
    if (F.bid == 0) {
        float* BT = (float*)(F.ws + WS_TAB); float* LB1 = BT + 1024;
        for (int i = F.tid; i < 129 * 4; i += 512) { const int rel = i >> 2, h = i & 3; int bk = rel;
            if (rel >= 16) { bk = 16 + (int)(logf((float)rel / 16.f) / logf(8.f) * 16.f); bk = bk > 31 ? 31 : bk; }
            BT[i] = A.in[8 + F.z][bk * 4 + h]; }
        { const int i = F.tid; const float a = A.in[17 + F.z][i], b = A.in[17 + F.z][512 + i], mx = fmaxf(a, b), ea = expf(a - mx), eb = expf(b - mx); LB1[i] = eb / (ea + eb); }
    }
    for (int i = F.bid * 512 + F.tid; i < 160 * 128; i += F.G * 512) {
        const int r = i >> 7, k8 = 8 * (i & 127);
        v4u o = {0u, 0u, 0u, 0u};
        if (r < MODR) { const float* cp = (r < 4 ? A.in[6 + F.z] + r * 1024 : A.in[7 + F.z] + (r - 4) * 1024) + k8; const f32x4 c0 = *(const f32x4*)cp, c1 = *(const f32x4*)(cp + 4);
            o.x = pk2(c0.x * sigm(c0.x), c0.y * sigm(c0.y)); o.y = pk2(c0.z * sigm(c0.z), c0.w * sigm(c0.w)); o.z = pk2(c1.x * sigm(c1.x), c1.y * sigm(c1.y)); o.w = pk2(c1.z * sigm(c1.z), c1.w * sigm(c1.w)); }
        *(v4u*)((bf16*)(F.ws + WS_SC) + (size_t)r * 1024 + k8) = o;
    }
}
__device__ __forceinline__ void mod_phase(const Args& A, Ctx& F) {
    TSEC_BEGIN(41);
    if ((F.G & 7) == 0) { const int xg = F.bid & 7, wpx = F.G >> 3; for (int w = F.bid >> 3; w < 48; w += wpx) mod_unit(A, F, xg * 48 + w); }
    else for (int u = F.bid; u < 384; u += F.G) mod_unit(A, F, u);
    TSEC_END(41);
}
__device__ __forceinline__ void norm_phase(const Args& A, Ctx& F, int l, int which) {
    const int gw = F.bid * 8 + F.wave, NGW = F.G * 8;
    const float* gamma = which == 0 ? A.in[11 + F.z] + l * D : (which == 1 ? A.in[21 + F.z] + l * D : A.in[24 + F.z]);
    const float* mod = (const float*)(F.ws + WS_MOD) + (size_t)l * MODR * MODLD;
    const int shc = which == 0 ? 0 : 3 * D, scc = shc + D;
    const bool from_in = (which == 0 && l == 0);
    bf16* XN = (bf16*)(F.ws + WS_XN);
    f32x4 gm[4];
#pragma unroll
    for (int j = 0; j < 4; ++j) gm[j] = *(const f32x4*)(gamma + 4 * F.lane + 256 * j);
    constexpr int NR = 4;
    for (int m0 = gw; m0 < M; m0 += NR * NGW) {
        f32x4 v[NR][4], msc[NR][4], msh[NR][4];
#pragma unroll
        for (int r = 0; r < NR; ++r) { const int mr_ = m0 + r * NGW, m = mr_ < M ? mr_ : m0;
            const float* xr = from_in ? (m < NP ? A.in[0 + F.z] + (size_t)m * D : A.in[1 + F.z] + (size_t)(m - NP) * D) : F.out + (size_t)m * D;
#pragma unroll
            for (int j = 0; j < 4; ++j) v[r][j] = *(const f32x4*)(xr + 4 * F.lane + 256 * j);
            if (which != 2) { const float* mr = mod + (size_t)modrow(m) * MODLD;
#pragma unroll
                for (int j = 0; j < 4; ++j) { msc[r][j] = *(const f32x4*)(mr + scc + 4 * F.lane + 256 * j); msh[r][j] = *(const f32x4*)(mr + shc + 4 * F.lane + 256 * j); } } }
        __builtin_amdgcn_sched_barrier(0);
        float ssq[NR];
#pragma unroll
        for (int r = 0; r < NR; ++r) { ssq[r] = 0.f;
#pragma unroll
            for (int j = 0; j < 4; ++j) ssq[r] += (v[r][j].x * v[r][j].x + v[r][j].y * v[r][j].y) + (v[r][j].z * v[r][j].z + v[r][j].w * v[r][j].w); }
#pragma unroll
        for (int o = 1; o < 64; o <<= 1) {
            float t_[NR];
#pragma unroll
            for (int r = 0; r < NR; ++r) t_[r] = __shfl_xor(ssq[r], o);
#pragma unroll
            for (int r = 0; r < NR; ++r) ssq[r] += t_[r];
        }
#pragma unroll
        for (int r = 0; r < NR; ++r) {
            const int m = m0 + r * NGW;
            if (m < M) {
                const float rstd = __builtin_amdgcn_rsqf(ssq[r] * (1.f / D) + EPS);
                if (which == 2) {
#pragma unroll
                    for (int j = 0; j < 4; ++j) *(f32x4*)(F.out + (size_t)m * D + 4 * F.lane + 256 * j) = v[r][j] * rstd * gm[j];
                } else {
#pragma unroll
                    for (int j = 0; j < 4; ++j) { const f32x4 y = v[r][j] * rstd * gm[j] * (msc[r][j] + 1.f) + msh[r][j]; v2u w; w.x = pk2(y.x, y.y); w.y = pk2(y.z, y.w);
                        *(v2u*)(XN + (size_t)m * D + 4 * F.lane + 256 * j) = w; }
                }
            }
        }
    }
}

constexpr int RS = 272;
constexpr int RS64 = 144;
struct HgGate { float cl[16], kf[16]; };
__device__ __forceinline__ void hg_gates(const float lb, const LAS unsigned short* rawf  , int d, HgGate& g) {
    float run = 0.f;
#pragma unroll
    for (int j = 0; j < 16; ++j) {
        const float x = bf2f(rawf[j * (RS / 2) + d]);
        const float e = __expf(-x), sg = __builtin_amdgcn_rcpf(1.f + e);
        const float f = lb + (1.f - lb) * sg;
        g.kf[j] = (1.f - lb) * e * sg;
        run += __logf(f); g.cl[j] = run;
    }
}
__device__ __forceinline__ void tile_load(const bf16* g0  , int tid, v4u (&r)[2]) {
#pragma unroll
    for (int i = 0; i < 2; ++i) { const int it = tid + 512 * i; r[i] = *(const v4u*)(g0 + (size_t)(it >> 4) * INW + 8 * (it & 15)); }
    __builtin_amdgcn_sched_barrier(0);
}
__device__ __forceinline__ void tile_store(LAS unsigned char* dst, int tid, const v4u (&r)[2]) {
#pragma unroll
    for (int i = 0; i < 2; ++i) { const int it = tid + 512 * i; *(LAS v4u*)(dst + (it >> 4) * RS + 16 * (it & 15)) = r[i]; }
}
__device__ __forceinline__ void h1_load(Ctx& F, int u, v4u (&rf)[2], v4u (&rv)[2]) {
    const int bh = u >> 6, b = bh >> 2, h = bh & 3, ch = u & 63, m0 = b * TP + ch * 64;
    const bf16* PROJ = (const bf16*)(F.ws + WS_PROJ);
    tile_load(PROJ + (size_t)m0 * INW + C_F + h * 128, F.tid, rf); tile_load(PROJ + (size_t)m0 * INW + C_I + h * 128, F.tid, rv);
}
__device__ __forceinline__ void h1_unit(const Args& A, Ctx& F, int l, int u, const v4u (&rf)[2], const v4u (&rv)[2]) {
    const int bh = u >> 6, b = bh >> 2, h = bh & 3, ch = u & 63, m0 = b * TP + ch * 64;
    const int d = F.tid & 127, sc = F.tid >> 7, c = F.lane & 31, h2 = F.lane >> 5;
    const bf16* PROJ = (const bf16*)(F.ws + WS_PROJ);
    LAS unsigned char* L = F.lds;
    constexpr int OKDT = 0, OVT = 128 * RS64, OTOT = 2 * 128 * RS64, ORF = OTOT + 2048, ORV = ORF + 64 * RS;
    LAS unsigned short* KDT = (LAS unsigned short*)(L + OKDT);
    LAS unsigned short* VT = (LAS unsigned short*)(L + OVT);
    LAS float* TOT = (LAS float*)(L + OTOT);
    const float lb = l == 0 ? 0.f : ((const float*)(F.ws + WS_TAB))[1024 + h * 128 + d];
    __syncthreads();
    tile_store(L + ORF, F.tid, rf); tile_store(L + ORV, F.tid, rv);
    __syncthreads();
    HgGate g; hg_gates(lb, (const LAS unsigned short*)(L + ORF + sc * 16 * RS), d, g);
    TOT[sc * 128 + d] = g.cl[15];
#pragma unroll
    for (int j = 0; j < 16; ++j) VT[d * (RS64 / 2) + sc * 16 + j] = ((const LAS unsigned short*)(L + ORV))[(sc * 16 + j) * (RS / 2) + d];
    __syncthreads();
    float after = 0.f;
#pragma unroll
    for (int i = 1; i < 4; ++i) if (i > sc) after += TOT[i * 128 + d];
    const float tot = g.cl[15];
#pragma unroll
    for (int j = 0; j < 16; ++j) KDT[d * (RS64 / 2) + sc * 16 + j] = (unsigned short)f2bf(g.kf[j] * __expf(after + tot - g.cl[j]));
    if (sc == 0) ((float*)(F.ws + WS_DC))[u * 128 + d] = __expf(after + tot);
    __syncthreads();
    const int vt = F.wave >> 1, dt0 = 2 * (F.wave & 1);
    f32x16 acc0, acc1;
#pragma unroll
    for (int e = 0; e < 16; ++e) { acc0[e] = 0.f; acc1[e] = 0.f; }
#pragma unroll
    for (int ks = 0; ks < 4; ++ks) {
        const bf16x8 a = *(const LAS bf16x8*)(L + OVT + (32 * vt + c) * RS64 + (16 * ks + 8 * h2) * 2);
        const bf16x8 b0 = *(const LAS bf16x8*)(L + OKDT + (32 * dt0 + c) * RS64 + (16 * ks + 8 * h2) * 2);
        const bf16x8 b1 = *(const LAS bf16x8*)(L + OKDT + (32 * dt0 + 32 + c) * RS64 + (16 * ks + 8 * h2) * 2);
        acc0 = MFMA32(a, b0, acc0); acc1 = MFMA32(a, b1, acc1);
    }
    LAS unsigned short* OT = (LAS unsigned short*)(L + ORF);
#pragma unroll
    for (int e = 0; e < 16; ++e) { const int v = 32 * vt + crow(e, h2);
        OT[v * (RS / 2) + 32 * dt0 + c] = (unsigned short)f2bf(acc0[e]); OT[v * (RS / 2) + 32 * dt0 + 32 + c] = (unsigned short)f2bf(acc1[e]); }
    __syncthreads();
    bf16* HG = (bf16*)(F.ws + WS_HG) + (size_t)u * 16384;
#pragma unroll
    for (int i = 0; i < 4; ++i) { const int it = F.tid + 512 * i, v = it >> 4, ch16 = it & 15;
        *(v4u*)(HG + v * 128 + 8 * ch16) = *(const LAS v4u*)(L + ORF + v * RS + 16 * ch16); }
}
__device__ __forceinline__ void h2_scan(const Args& A, Ctx& F, int l) {
    unsigned* HG32 = (unsigned*)(F.ws + WS_HG); const float* DC = (const float*)(F.ws + WS_DC);
    for (int gid = F.bid * 512 + F.tid; gid < 16 * 8192; gid += F.G * 512) {
        const int bh = gid >> 13, e2 = gid & 8191, v = e2 >> 6, d = 2 * (e2 & 63);
        float s0 = 0.f, s1 = 0.f;
        for (int c0 = 0; c0 < 64; c0 += 16) {
            unsigned kc[16]; float d0[16], d1[16];
#pragma unroll
            for (int i = 0; i < 16; ++i) { const int u = bh * 64 + c0 + i; kc[i] = HG32[(size_t)u * 8192 + e2]; d0[i] = DC[u * 128 + d]; d1[i] = DC[u * 128 + d + 1]; }
            __builtin_amdgcn_sched_barrier(0);
#pragma unroll
            for (int i = 0; i < 16; ++i) { const int u = bh * 64 + c0 + i;
                HG32[(size_t)u * 8192 + e2] = pk2(s0, s1);
                s0 = d0[i] * s0 + bf2f(kc[i] & 0xffffu); s1 = d1[i] * s1 + bf2f(kc[i] >> 16); }
        }
        float* o = F.out + O_HGP + ((size_t)l * 16 + bh) * 16384;
        o[d * 128 + v] = s0; o[(d + 1) * 128 + v] = s1;
    }
}
__device__ __forceinline__ void h3_load(Ctx& F, int u, v4u (&rf)[2], v4u (&rq)[2], v4u (&rv)[2]) {
    const int bh = u >> 6, b = bh >> 2, h = bh & 3, ch = u & 63, m0 = b * TP + ch * 64;
    const bf16* PROJ = (const bf16*)(F.ws + WS_PROJ);
    tile_load(PROJ + (size_t)m0 * INW + C_F + h * 128, F.tid, rf); tile_load(PROJ + (size_t)m0 * INW + C_Q + h * 128, F.tid, rq); tile_load(PROJ + (size_t)m0 * INW + C_I + h * 128, F.tid, rv);
}
__device__ __forceinline__ void h3_unit(const Args& A, Ctx& F, int l, int u, const v4u (&rf)[2], const v4u (&rq)[2], const v4u (&rv)[2], int un, v4u (&nf)[2], v4u (&nq)[2], v4u (&nv)[2]) {
    const int bh = u >> 6, b = bh >> 2, h = bh & 3, ch = u & 63, m0 = b * TP + ch * 64;
    const int d = F.tid & 127, sc = F.tid >> 7, c = F.lane & 31, h2 = F.lane >> 5;
    const bf16* PROJ = (const bf16*)(F.ws + WS_PROJ);
    LAS unsigned char* L = F.lds;
    constexpr int OQH = 0, OKH = 64 * RS, OKC = 2 * 64 * RS, OQG = 3 * 64 * RS, OQT = OQG + 48 * RS, OAM = OQT + 64 * RS, OVT = OAM + 64 * RS64, OTOT = OVT + 128 * RS64, OEND = OTOT + 2048;
    static_assert(OEND <= RING_BYTES, "h3 LDS map");
    LAS unsigned short* QH = (LAS unsigned short*)(L + OQH); LAS unsigned short* KH = (LAS unsigned short*)(L + OKH); LAS unsigned short* KC = (LAS unsigned short*)(L + OKC);
    LAS unsigned short* QG = (LAS unsigned short*)(L + OQG); LAS unsigned short* QT = (LAS unsigned short*)(L + OQT); LAS unsigned short* AM = (LAS unsigned short*)(L + OAM);
    LAS unsigned short* VT = (LAS unsigned short*)(L + OVT); LAS float* TOT = (LAS float*)(L + OTOT); LAS float* O32 = (LAS float*)(L + OQH);
    TSEC_BEGIN(30);
    const float lb = l == 0 ? 0.f : ((const float*)(F.ws + WS_TAB))[1024 + h * 128 + d];
    f32x4 gnv[4];
#pragma unroll
    for (int i = 0; i < 4; ++i) gnv[i] = *(const f32x4*)(A.in[18 + F.z] + l * 128 + (F.tid & 7) * 16 + 4 * i);
    __syncthreads();
    tile_store(L + OQH, F.tid, rf); tile_store(L + OKH, F.tid, rq); tile_store(L + OKC, F.tid, rv);
    const bf16* gp = PROJ + (size_t)(m0 + (F.tid >> 3)) * INW + C_G + h * 128 + (F.tid & 7) * 16;
    const v4u g0 = *(const v4u*)gp, g1 = *(const v4u*)(gp + 8);
    const bf16* Srow = (const bf16*)(F.ws + WS_HG) + (size_t)u * 16384 + (size_t)(32 * (F.wave & 3) + c) * 128 + 8 * h2;
    bf16x8 sb[8];
#pragma unroll
    for (int ks = 0; ks < 8; ++ks) sb[ks] = *(const bf16x8*)(Srow + 16 * ks);
    __builtin_amdgcn_sched_barrier(0);
    for (int i = F.tid; i < 64 * RS64 / 4; i += 512) ((LAS unsigned*)AM)[i] = 0u;
    __syncthreads();
    TSEC_END(30);
    TSEC_BEGIN(31);
    HgGate g; hg_gates(lb, (const LAS unsigned short*)(L + OQH + sc * 16 * RS), d, g);
    float q[16];
#pragma unroll
    for (int j = 0; j < 16; ++j) q[j] = bf2f(((const LAS unsigned short*)(L + OKH))[(sc * 16 + j) * (RS / 2) + d]);
    TOT[sc * 128 + d] = g.cl[15];
#pragma unroll
    for (int j = 0; j < 16; ++j) VT[d * (RS64 / 2) + sc * 16 + j] = ((const LAS unsigned short*)(L + OKC))[(sc * 16 + j) * (RS / 2) + d];
    __syncthreads();
    TSEC_END(31);
    TSEC_BEGIN(32);
    const float t0 = TOT[d], t1 = TOT[128 + d], t2 = TOT[256 + d];
    const float rsc = sc == 0 ? 0.f : (sc == 1 ? t0 : (sc == 2 ? t0 + t1 : t0 + t1 + t2));
    const float ers = __expf(rsc), tot = g.cl[15];
    const float ga = sc == 2 ? __expf(t1) : __expf(t1 + t2), gb = __expf(t2);
#pragma unroll
    for (int j = 0; j < 16; ++j) {
        const int row = sc * 16 + j;
        const float qh = q[j] * __expf(g.cl[j]);
        QH[row * (RS / 2) + d] = (unsigned short)f2bf(qh);
        QT[row * (RS / 2) + d] = (unsigned short)f2bf(qh * ers);
        if (sc == 2) QG[j * (RS / 2) + d] = (unsigned short)f2bf(qh * ga);
        if (sc == 3) { QG[(16 + j) * (RS / 2) + d] = (unsigned short)f2bf(qh * ga); QG[(32 + j) * (RS / 2) + d] = (unsigned short)f2bf(qh * gb); }
        KH[row * (RS / 2) + d] = (unsigned short)f2bf(g.kf[j] * __expf(tot - g.cl[j]));
        KC[row * (RS / 2) + d] = (unsigned short)f2bf(g.kf[j] * __expf(-g.cl[j]));
    }
    h3_load(F, un, nf, nq, nv);
    __syncthreads();
    TSEC_END(32);
    TSEC_BEGIN(33);
    {
        const int r16 = F.lane & 15, kq = F.lane >> 4;
        for (int blk = F.wave; blk < 10; blk += 8) {
            int bi, bj, qoff, koff;
            if (blk < 4) { bi = blk; bj = blk; qoff = OQH + 16 * bi * RS; koff = OKC + 16 * bj * RS; }
            else if (blk < 7) { bi = blk - 3; bj = bi - 1; qoff = OQH + 16 * bi * RS; koff = OKH + 16 * bj * RS; }
            else if (blk == 7) { bi = 2; bj = 0; qoff = OQG; koff = OKH; }
            else if (blk == 8) { bi = 3; bj = 0; qoff = OQG + 16 * RS; koff = OKH; }
            else { bi = 3; bj = 1; qoff = OQG + 32 * RS; koff = OKH + 16 * RS; }
            f32x4 a4 = {0.f, 0.f, 0.f, 0.f};
#pragma unroll
            for (int ks = 0; ks < 4; ++ks) {
                const bf16x8 qa = *(const LAS bf16x8*)(L + qoff + r16 * RS + (32 * ks + 8 * kq) * 2);
                const bf16x8 kb = *(const LAS bf16x8*)(L + koff + r16 * RS + (32 * ks + 8 * kq) * 2);
                a4 = MFMA16(qa, kb, a4);
            }
#pragma unroll
            for (int e = 0; e < 4; ++e) { const int t = 4 * kq + e; float val = a4[e]; if (bi == bj && r16 > t) val = 0.f;
                AM[(16 * bi + t) * (RS64 / 2) + 16 * bj + r16] = (unsigned short)f2bf(val); }
        }
    }
    __syncthreads();
    TSEC_END(33);
    TSEC_BEGIN(34);
    const int tt = F.wave >> 2, vt = F.wave & 3;
    f32x16 acc;
#pragma unroll
    for (int e = 0; e < 16; ++e) acc[e] = 0.f;
#pragma unroll
    for (int ks = 0; ks < 4; ++ks) {
        const bf16x8 a = *(const LAS bf16x8*)(L + OAM + (32 * tt + c) * RS64 + (16 * ks + 8 * h2) * 2);
        const bf16x8 bv = *(const LAS bf16x8*)(L + OVT + (32 * vt + c) * RS64 + (16 * ks + 8 * h2) * 2);
        acc = MFMA32(a, bv, acc);
    }
#pragma unroll
    for (int ks = 0; ks < 8; ++ks) {
        const bf16x8 a = *(const LAS bf16x8*)(L + OQT + (32 * tt + c) * RS + (16 * ks + 8 * h2) * 2);
        acc = MFMA32(a, sb[ks], acc);
    }
#pragma unroll
    for (int e = 0; e < 16; ++e) O32[(32 * tt + crow(e, h2)) * 132 + 32 * vt + c] = acc[e];
    __syncthreads();
    TSEC_END(34);
    TSEC_BEGIN(35);
    {
        const int t = F.tid >> 3, vq = F.tid & 7;
        float o[16]; float ss = 0.f;
#pragma unroll
        for (int i = 0; i < 4; ++i) { const f32x4 x = *(const LAS f32x4*)(O32 + t * 132 + vq * 16 + 4 * i); o[4 * i] = x.x; o[4 * i + 1] = x.y; o[4 * i + 2] = x.z; o[4 * i + 3] = x.w;
            ss += (x.x * x.x + x.y * x.y) + (x.z * x.z + x.w * x.w); }
        ss += __shfl_xor(ss, 1); ss += __shfl_xor(ss, 2); ss += __shfl_xor(ss, 4);
        const float rstd = __builtin_amdgcn_rsqf(ss * (1.f / 128.f) + EPS);
        const float gn[16] = {gnv[0].x, gnv[0].y, gnv[0].z, gnv[0].w, gnv[1].x, gnv[1].y, gnv[1].z, gnv[1].w, gnv[2].x, gnv[2].y, gnv[2].z, gnv[2].w, gnv[3].x, gnv[3].y, gnv[3].z, gnv[3].w};
        unsigned gw_[8] = {g0.x, g0.y, g0.z, g0.w, g1.x, g1.y, g1.z, g1.w};
        unsigned ow[8];
#pragma unroll
        for (int i = 0; i < 8; ++i) {
            const float ga0 = bf2f(gw_[i] & 0xffffu), ga1 = bf2f(gw_[i] >> 16);
            const float y0 = o[2 * i] * rstd * gn[2 * i] * (ga0 * sigm(ga0)), y1 = o[2 * i + 1] * rstd * gn[2 * i + 1] * (ga1 * sigm(ga1));
            ow[i] = pk2(y0, y1);
        }
        bf16* op = (bf16*)(F.ws + WS_MIX) + (size_t)(m0 + t) * D + 256 + h * 128 + vq * 16;
        v4u w0 = {ow[0], ow[1], ow[2], ow[3]}, w1 = {ow[4], ow[5], ow[6], ow[7]};
        *(v4u*)op = w0; *(v4u*)(op + 8) = w1;
    }
    TSEC_END(35);
}

__device__ __forceinline__ void conv_tail(const Args& A, Ctx& F, int l, f32x4 acc, bf16* orow) {
    const float mean = wave_sum((acc.x + acc.y) + (acc.z + acc.w)) * (1.f / 256.f);
    const f32x4 dv = acc - mean;
    const float rstd = __builtin_amdgcn_rsqf(wave_sum((dv.x * dv.x + dv.y * dv.y) + (dv.z * dv.z + dv.w * dv.w)) * (1.f / 256.f) + EPS);
    const f32x4 lg = *(const f32x4*)(A.in[15 + F.z] + l * 256 + 4 * F.lane), lb = *(const f32x4*)(A.in[16 + F.z] + l * 256 + 4 * F.lane);
    const f32x4 y = dv * rstd * lg + lb;
    v2u w; w.x = pk2(y.x * sigm(y.x), y.y * sigm(y.y)); w.y = pk2(y.z * sigm(y.z), y.w * sigm(y.w));
    *(v2u*)(orow + 4 * F.lane) = w;
}
__device__ __forceinline__ void conv_unit(const Args& A, Ctx& F, int l, int u) {
    const int b = u >> 6, tile = u & 63, t0 = tile * 64;
    const bf16* PROJ = (const bf16*)(F.ws + WS_PROJ);
    LAS float* AL = (LAS float*)F.lds;
    v4u sv[6], sg[6];
#pragma unroll
    for (int i = 0; i < 6; ++i) { const int it = F.tid + 512 * i, row = it >> 5, cg = it & 31, t = t0 - 30 + row;
        sv[i] = (v4u){0u, 0u, 0u, 0u}; sg[i] = sv[i];
        if (it < 94 * 32 && t >= 0) { const bf16* p = PROJ + (size_t)(b * TP + t) * INW + 8 * cg; sv[i] = *(const v4u*)(p + C_AV); sg[i] = *(const v4u*)(p + C_AG); } }
    __builtin_amdgcn_sched_barrier(0);
    __syncthreads();
#pragma unroll
    for (int i = 0; i < 6; ++i) { const int it = F.tid + 512 * i, row = it >> 5, cg = it & 31;
        if (it < 94 * 32) {
            const v4u vv = sv[i], gg = sg[i]; f32x4 a0, a1;
            a0.x = bf2f(vv.x & 0xffffu) * sigm(bf2f(gg.x & 0xffffu)); a0.y = bf2f(vv.x >> 16) * sigm(bf2f(gg.x >> 16));
            a0.z = bf2f(vv.y & 0xffffu) * sigm(bf2f(gg.y & 0xffffu)); a0.w = bf2f(vv.y >> 16) * sigm(bf2f(gg.y >> 16));
            a1.x = bf2f(vv.z & 0xffffu) * sigm(bf2f(gg.z & 0xffffu)); a1.y = bf2f(vv.z >> 16) * sigm(bf2f(gg.z >> 16));
            a1.z = bf2f(vv.w & 0xffffu) * sigm(bf2f(gg.w & 0xffffu)); a1.w = bf2f(vv.w >> 16) * sigm(bf2f(gg.w >> 16));
            *(LAS f32x4*)(AL + row * 256 + 8 * cg) = a0; *(LAS f32x4*)(AL + row * 256 + 8 * cg + 4) = a1; } }
    const f32x4 cb = *(const f32x4*)(A.in[14 + F.z] + l * 256 + 4 * F.lane);
    __syncthreads();
    f32x4 acc[8];
#pragma unroll
    for (int i = 0; i < 8; ++i) acc[i] = cb;
#pragma unroll
    for (int hf = 0; hf < 2; ++hf) {
        f32x4 cw[16];
#pragma unroll
        for (int j = 0; j < 16; ++j) if (16 * hf + j < 31) cw[j] = *(const f32x4*)(A.in[13 + F.z] + (size_t)(l * 31 + 16 * hf + j) * 256 + 4 * F.lane);
#pragma unroll
        for (int i = 0; i < 8; ++i) {
#pragma unroll
            for (int j = 0; j < 16; ++j) if (16 * hf + j < 31) acc[i] += cw[j] * *(const LAS f32x4*)(AL + (8 * F.wave + i + 16 * hf + j) * 256 + 4 * F.lane);
            asm volatile("" ::: "memory");
        }
    }
    {
        float s1[8], s2[8];
#pragma unroll
        for (int i = 0; i < 8; ++i) { s1[i] = (acc[i].x + acc[i].y) + (acc[i].z + acc[i].w); s2[i] = (acc[i].x * acc[i].x + acc[i].y * acc[i].y) + (acc[i].z * acc[i].z + acc[i].w * acc[i].w); }
#pragma unroll
        for (int o = 1; o < 64; o <<= 1) {
            float t1[8], t2[8];
#pragma unroll
            for (int i = 0; i < 8; ++i) { t1[i] = __shfl_xor(s1[i], o); t2[i] = __shfl_xor(s2[i], o); }
#pragma unroll
            for (int i = 0; i < 8; ++i) { s1[i] += t1[i]; s2[i] += t2[i]; }
        }
        const f32x4 lg = *(const f32x4*)(A.in[15 + F.z] + l * 256 + 4 * F.lane), lb = *(const f32x4*)(A.in[16 + F.z] + l * 256 + 4 * F.lane);
#pragma unroll
        for (int i = 0; i < 8; ++i) {
            const float mean = s1[i] * (1.f / 256.f), var = fmaxf(s2[i] * (1.f / 256.f) - mean * mean, 0.f);
            const float rstd = __builtin_amdgcn_rsqf(var + EPS);
            const f32x4 y = (acc[i] - mean) * rstd * lg + lb;
            v2u w; w.x = pk2(y.x * sigm(y.x), y.y * sigm(y.y)); w.y = pk2(y.z * sigm(y.z), y.w * sigm(y.w));
            *(v2u*)((bf16*)(F.ws + WS_MIX) + (size_t)(b * TP + t0 + 8 * F.wave + i) * D + 4 * F.lane) = w;
        }
    }
    if (tile == 63) {
        float* o = F.out + O_CONVP + (size_t)(l * 4 + b) * 30 * 256;
        for (int i = F.tid; i < 30 * 256; i += 512) o[i] = AL[64 * 256 + i];
    }
}
constexpr int VS = 528;
__device__ __forceinline__ void attn_unit(const Args& A, Ctx& F, int l, int u) {
    const int b = u >> 6, blk = (u >> 1) & 31, kvh = u & 1;
    const int c = F.lane & 31, h2 = F.lane >> 5;
    const bf16* PROJ = (const bf16*)(F.ws + WS_PROJ);
    LAS unsigned char* L = F.lds;
    LAS unsigned short* VTt = (LAS unsigned short*)L;
    LAS float* BTl = (LAS float*)(L + 64 * VS);
    const int tok0 = b * TP + (blk - 1) * 128;
    const int g = F.wave >> 2, qs = F.wave & 3, hq = 2 * kvh + g;
    const int mq = b * TP + blk * 128 + 32 * qs + c;
    bf16x8 bq[4];
#pragma unroll
    for (int ks = 0; ks < 4; ++ks) bq[ks] = *(const bf16x8*)(PROJ + (size_t)mq * INW + C_QA + hq * 64 + 16 * ks + 8 * h2);
#define ATTN_LOADK(dst, j) do { const int kidx_ = 32 * (qs + (j)) + c; const bool ex_ = (blk > 0 || kidx_ >= 128); \
        _Pragma("unroll") for (int ks = 0; ks < 4; ++ks) { dst[ks] = (bf16x8){0, 0, 0, 0, 0, 0, 0, 0}; \
            if (ex_) dst[ks] = *(const bf16x8*)(PROJ + (size_t)(tok0 + kidx_) * INW + C_KA + kvh * 64 + 16 * ks + 8 * h2); } } while (0)
    bf16x8 ak0[4], ak1[4];
    ATTN_LOADK(ak0, 0); ATTN_LOADK(ak1, 1);
    const float sink = A.in[19 + F.z][l * 4 + hq];
    float btv = 0.f; { const int gg = F.tid / 224, ix = F.tid % 224 - 32; if (F.tid < 448 && ix >= 0 && ix <= 128) btv = ((const float*)(F.ws + WS_TAB))[(128 - ix) * 4 + 2 * kvh + gg]; }
    __builtin_amdgcn_sched_barrier(0);
    __syncthreads();
    if (F.tid < 448) BTl[F.tid] = btv;
    f32x16 S[5];
#pragma unroll
    for (int j = 0; j < 5; ++j)
#pragma unroll
        for (int e = 0; e < 16; ++e) S[j][e] = 0.f;
    bf16x8 ak2[4], ak3[4];
    ATTN_LOADK(ak2, 2); ATTN_LOADK(ak3, 3);
    __builtin_amdgcn_sched_barrier(0);
#pragma unroll
    for (int ks = 0; ks < 4; ++ks) { S[0] = MFMA32(ak0[ks], bq[ks], S[0]); S[1] = MFMA32(ak1[ks], bq[ks], S[1]); }
    ATTN_LOADK(ak0, 4);
#pragma unroll
    for (int ks = 0; ks < 4; ++ks) { S[2] = MFMA32(ak2[ks], bq[ks], S[2]); S[3] = MFMA32(ak3[ks], bq[ks], S[3]); }
#pragma unroll
    for (int ks = 0; ks < 4; ++ks) S[4] = MFMA32(ak0[ks], bq[ks], S[4]);
#undef ATTN_LOADK
    v4u vst[4];
#pragma unroll
    for (int i = 0; i < 4; ++i) { const int it = F.tid + 512 * i, kidx = it >> 3, chn = it & 7; vst[i] = (v4u){0u, 0u, 0u, 0u};
        if (blk > 0 || kidx >= 128) vst[i] = *(const v4u*)(PROJ + (size_t)(tok0 + kidx) * INW + C_VA + kvh * 64 + 8 * chn); }
    __builtin_amdgcn_sched_barrier(0);
    __syncthreads();
    float mx = -INFINITY;
    const LAS float* trp = BTl + g * 224 + 32 + 4 * h2 - c;
#pragma unroll
    for (int j = 0; j < 5; ++j) {
        float bia[16];
#pragma unroll
        for (int e = 0; e < 16; ++e) bia[e] = trp[32 * j + 8 * (e >> 2) + (e & 3)];
#pragma unroll
        for (int e = 0; e < 16; e += 4) asm volatile("" : "+v"(bia[e]), "+v"(bia[e + 1]), "+v"(bia[e + 2]), "+v"(bia[e + 3]));
#pragma unroll
        for (int e = 0; e < 16; ++e) {
            const int cr = crow(e, h2), rel = 128 + c - 32 * j - cr, kidx = 32 * (qs + j) + cr;
            const bool ok = rel >= 0 && rel <= 128 && (blk > 0 || kidx >= 128);
            const float s = ok ? S[j][e] * 0.125f + bia[e] : -INFINITY;
            S[j][e] = s; mx = fmaxf(mx, s);
        }
        __builtin_amdgcn_sched_barrier(0);
    }
    mx = fmaxf(mx, __shfl_xor(mx, 32)); mx = fmaxf(mx, sink);
    float sum = 0.f;
#pragma unroll
    for (int j = 0; j < 5; ++j)
#pragma unroll
        for (int e = 0; e < 16; ++e) { const float p = __expf(S[j][e] - mx); S[j][e] = p; sum += p; if (e == 15) __builtin_amdgcn_sched_barrier(0); }
    sum += __shfl_xor(sum, 32);
    const float inv = 1.f / (sum + __expf(sink - mx));
#pragma unroll
    for (int i = 0; i < 4; ++i) { const int it = F.tid + 512 * i, kidx = it >> 3, chn = it & 7;
        const int kl = kidx & 31, pos = (kidx & ~31) | (kl & 0x13) | ((kl & 4) << 1) | ((kl & 8) >> 1);
        const unsigned w[4] = {vst[i].x, vst[i].y, vst[i].z, vst[i].w};
#pragma unroll
        for (int e = 0; e < 4; ++e) { VTt[(8 * chn + 2 * e) * (VS / 2) + pos] = (unsigned short)(w[e] & 0xffffu); VTt[(8 * chn + 2 * e + 1) * (VS / 2) + pos] = (unsigned short)(w[e] >> 16); } }
    __syncthreads();
    f32x16 O0, O1;
#pragma unroll
    for (int e = 0; e < 16; ++e) { O0[e] = 0.f; O1[e] = 0.f; }
#pragma unroll
    for (int j = 0; j < 5; ++j)
#pragma unroll
        for (int s2 = 0; s2 < 2; ++s2) {
            const bf16x8 pb = pk8(S[j][8 * s2], S[j][8 * s2 + 1], S[j][8 * s2 + 2], S[j][8 * s2 + 3], S[j][8 * s2 + 4], S[j][8 * s2 + 5], S[j][8 * s2 + 6], S[j][8 * s2 + 7]);
            const int slot = 32 * (qs + j) + 16 * s2 + 8 * h2;
            const bf16x8 av0 = *(const LAS bf16x8*)(L + c * VS + slot * 2), av1 = *(const LAS bf16x8*)(L + (32 + c) * VS + slot * 2);
            O0 = MFMA32(av0, pb, O0); O1 = MFMA32(av1, pb, O1);
            __builtin_amdgcn_sched_barrier(0);
        }
    bf16* op = (bf16*)(F.ws + WS_MIX) + (size_t)mq * D + 768 + hq * 64;
#pragma unroll
    for (int gq = 0; gq < 4; ++gq) {
        v2u w0, w1;
        w0.x = pk2(O0[4 * gq] * inv, O0[4 * gq + 1] * inv); w0.y = pk2(O0[4 * gq + 2] * inv, O0[4 * gq + 3] * inv);
        w1.x = pk2(O1[4 * gq] * inv, O1[4 * gq + 1] * inv); w1.y = pk2(O1[4 * gq + 2] * inv, O1[4 * gq + 3] * inv);
        *(v2u*)(op + 8 * gq + 4 * h2) = w0; *(v2u*)(op + 32 + 8 * gq + 4 * h2) = w1;
    }
    if (blk == 31) {
        v4u kk[2], vv[2];
#pragma unroll
        for (int i = 0; i < 2; ++i) { const int it = F.tid + 512 * i, j = it >> 3, c8 = 8 * (it & 7);
            const bf16* p = PROJ + (size_t)(b * TP + 3968 + j) * INW + kvh * 64 + c8; kk[i] = *(const v4u*)(p + C_KA); vv[i] = *(const v4u*)(p + C_VA); }
        __builtin_amdgcn_sched_barrier(0);
#pragma unroll
        for (int i = 0; i < 2; ++i) { const int it = F.tid + 512 * i, j = it >> 3, c8 = 8 * (it & 7);
            const size_t oi = (((size_t)(l * 4 + b) * 128 + j) * 2 + kvh) * 64 + c8;
            const unsigned kw[4] = {kk[i].x, kk[i].y, kk[i].z, kk[i].w}, vw[4] = {vv[i].x, vv[i].y, vv[i].z, vv[i].w};
#pragma unroll
            for (int h4 = 0; h4 < 2; ++h4) {
                f32x4 ko, vo;
                ko.x = bf2f(kw[2 * h4] & 0xffffu); ko.y = bf2f(kw[2 * h4] >> 16); ko.z = bf2f(kw[2 * h4 + 1] & 0xffffu); ko.w = bf2f(kw[2 * h4 + 1] >> 16);
                vo.x = bf2f(vw[2 * h4] & 0xffffu); vo.y = bf2f(vw[2 * h4] >> 16); vo.z = bf2f(vw[2 * h4 + 1] & 0xffffu); vo.w = bf2f(vw[2 * h4 + 1] >> 16);
                *(f32x4*)(F.out + O_KP + oi + 4 * h4) = ko; *(f32x4*)(F.out + O_VP + oi + 4 * h4) = vo; } }
    }
}

__device__ __forceinline__ void samp_b_unit(const Args& A, Ctx& F, int l, int u) {
    const bf16* PROJ = (const bf16*)(F.ws + WS_PROJ);
    const int bs = u >> 1, hf = u & 1, m0 = NP + 4 * bs;
    LAS unsigned char* L = F.lds;
    constexpr int OFL = 0, OCV = 34 * 1024, OKL = OCV + 4096, OVTL = OKL + 144 * RS64, OQL = OVTL + 64 * 336, OSL = 0, OPL = 16 * 592, OENDB = OQL + 16 * RS64;
    static_assert(OENDB <= RING_BYTES && OPL + 16 * 336 <= OCV, "samp_b LDS map");
    LAS float* FL = (LAS float*)(L + OFL); LAS float* CV = (LAS float*)(L + OCV);
    const float* ck = A.in[4 + F.z] + ((size_t)l * 128 + bs) * 128 * 128 + hf * 64;
    const float* cv = A.in[5 + F.z] + ((size_t)l * 128 + bs) * 128 * 128 + hf * 64;
    float* okp = F.out + O_KS + ((size_t)l * 128 + bs) * 128 * 128 + hf * 64; float* ovp = F.out + O_VS + ((size_t)l * 128 + bs) * 128 * 128 + hf * 64;
    const float* cc = A.in[2 + F.z] + ((size_t)l * 128 + bs) * 30 * 256;
    f32x4 fr4[4];
#pragma unroll
    for (int i = 0; i < 4; ++i) { const int it = F.tid + 512 * i; fr4[i] = it < 30 * 64 ? *(const f32x4*)(cc + 4 * it) : (f32x4){0.f, 0.f, 0.f, 0.f}; }
    f32x4 kr[2][2], vr[2][2];
#pragma unroll
    for (int i = 0; i < 2; ++i) { const int it = F.tid + 512 * i, j = it >> 3, c8 = 8 * (it & 7);
        kr[i][0] = *(const f32x4*)(ck + j * 128 + c8); kr[i][1] = *(const f32x4*)(ck + j * 128 + c8 + 4); vr[i][0] = *(const f32x4*)(cv + j * 128 + c8); vr[i][1] = *(const f32x4*)(cv + j * 128 + c8 + 4); }
    const int nt_ = F.tid >> 8, nch = F.tid & 255;
    const bf16* pa0 = PROJ + (size_t)(m0 + nt_) * INW + nch; const bf16* pa1 = PROJ + (size_t)(m0 + 2 + nt_) * INW + nch;
    const unsigned short av0 = pa0[C_AV], ag0 = pa0[C_AG], av1 = pa1[C_AV], ag1 = pa1[C_AG];
    unsigned short kb = 0, vb = 0;
    if (F.tid < 256) { const int t = F.tid >> 6, r = F.tid & 63; const bf16* p = PROJ + (size_t)(m0 + t) * INW + hf * 64 + r; kb = p[C_KA]; vb = p[C_VA]; }
    unsigned short qv[2];
#pragma unroll
    for (int i = 0; i < 2; ++i) { const int ix = F.tid + 512 * i, row = ix >> 6, dd = ix & 63; qv[i] = PROJ[(size_t)(m0 + (row >> 2)) * INW + C_QA + (row & 3) * 64 + dd]; }
    const float sinkv = A.in[19 + F.z][l * 4 + 2 * hf + (F.wave & 1)];
    const float cbias = A.in[14 + F.z][l * 256 + nch];
    __builtin_amdgcn_sched_barrier(0);
    __syncthreads();
#pragma unroll
    for (int i = 0; i < 4; ++i) { const int it = F.tid + 512 * i; if (it < 30 * 64) *(LAS f32x4*)(FL + 4 * it) = fr4[i]; }
    FL[(30 + nt_) * 256 + nch] = bf2f(av0) * sigm(bf2f(ag0)); FL[(32 + nt_) * 256 + nch] = bf2f(av1) * sigm(bf2f(ag1));
#pragma unroll
    for (int i = 0; i < 2; ++i) { const int it = F.tid + 512 * i, j = it >> 3, c8 = 8 * (it & 7);
        const f32x4 k0 = kr[i][0], k1 = kr[i][1], v0 = vr[i][0], v1 = vr[i][1];
        if (j >= 4) { *(f32x4*)(okp + (j - 4) * 128 + c8) = k0; *(f32x4*)(okp + (j - 4) * 128 + c8 + 4) = k1; *(f32x4*)(ovp + (j - 4) * 128 + c8) = v0; *(f32x4*)(ovp + (j - 4) * 128 + c8 + 4) = v1; }
        v4u kw; kw.x = pk2(k0.x, k0.y); kw.y = pk2(k0.z, k0.w); kw.z = pk2(k1.x, k1.y); kw.w = pk2(k1.z, k1.w);
        *(LAS v4u*)(L + OKL + j * RS64 + 2 * c8) = kw;
        const float vv[8] = {v0.x, v0.y, v0.z, v0.w, v1.x, v1.y, v1.z, v1.w};
#pragma unroll
        for (int e = 0; e < 8; ++e) *(LAS unsigned short*)(L + OVTL + (c8 + e) * 336 + 2 * j) = (unsigned short)f2bf(vv[e]); }
    if (F.tid < 256) { const int t = F.tid >> 6, r = F.tid & 63;
        *(LAS unsigned short*)(L + OKL + (128 + t) * RS64 + 2 * r) = kb; *(LAS unsigned short*)(L + OVTL + r * 336 + 2 * (128 + t)) = vb;
        okp[(124 + t) * 128 + r] = bf2f(kb); ovp[(124 + t) * 128 + r] = bf2f(vb); }
    for (int i = F.tid; i < 12 * 64; i += 512) *(LAS unsigned short*)(L + OKL + (132 + (i >> 6)) * RS64 + 2 * (i & 63)) = 0;
    for (int i = F.tid; i < 64 * 28; i += 512) *(LAS unsigned short*)(L + OVTL + (i / 28) * 336 + 2 * (132 + i % 28)) = 0;
#pragma unroll
    for (int i = 0; i < 2; ++i) { const int ix = F.tid + 512 * i, row = ix >> 6, dd = ix & 63; *(LAS unsigned short*)(L + OQL + row * RS64 + 2 * dd) = qv[i]; }
    __syncthreads();
    {
        const int ch = nch, tok = 2 * hf + nt_;
        float a0 = cbias;
#pragma unroll
        for (int j = 0; j < 31; ++j) a0 += A.in[13 + F.z][(size_t)(l * 31 + j) * 256 + ch] * FL[(tok + j) * 256 + ch];
        CV[tok * 256 + ch] = a0;
    }
    { float* o = F.out + O_CONVS + ((size_t)l * 128 + bs) * 30 * 256 + hf * 15 * 256; for (int i = F.tid; i < 15 * 64; i += 512) *(f32x4*)(o + 4 * i) = *(const LAS f32x4*)(FL + (4 + 15 * hf) * 256 + 4 * i); }
    __syncthreads();
    if (F.wave < 2) { const int tok = 2 * hf + F.wave; const f32x4 acc = *(const LAS f32x4*)(CV + tok * 256 + 4 * F.lane); conv_tail(A, F, l, acc, (bf16*)(F.ws + WS_MIX) + (size_t)(m0 + tok) * D); }
    const int r16 = F.lane & 15, q4 = F.lane >> 4;
    const float* BT = (const float*)(F.ws + WS_TAB);
    for (int kt = F.wave; kt < 9; kt += 8) {
        f32x4 s0 = {0.f, 0.f, 0.f, 0.f};
#pragma unroll
        for (int ks = 0; ks < 2; ++ks) {
            const bf16x8 qa = *(const LAS bf16x8*)(L + OQL + r16 * RS64 + (32 * ks + 8 * q4) * 2);
            const bf16x8 k0 = *(const LAS bf16x8*)(L + OKL + (16 * kt + r16) * RS64 + (32 * ks + 8 * q4) * 2);
            s0 = MFMA16(qa, k0, s0);
        }
        const int key = 16 * kt + r16, t = q4; const bool ok = key >= t && key <= 128 + t;
#pragma unroll
        for (int g = 0; g < 2; ++g) { const int e = 2 * hf + g; const float sv = (hf ? (g ? s0[3] : s0[2]) : (g ? s0[1] : s0[0])) * 0.125f;
            const int rel_ = 128 + t - key; float bia = BT[(rel_ < 0 ? 0 : (rel_ > 128 ? 128 : rel_)) * 4 + e]; asm volatile("" : "+v"(bia));
            ((LAS float*)(L + OSL))[(4 * t + e) * 148 + key] = ok ? sv + bia : -INFINITY; }
    }
    __syncthreads();
    {
        const int row = 4 * (F.wave >> 1) + 2 * hf + (F.wave & 1);
        const LAS float* sl = (const LAS float*)(L + OSL) + row * 148;
        float sc[3];
#pragma unroll
        for (int i = 0; i < 3; ++i) { const int j = F.lane + 64 * i; sc[i] = j < 144 ? sl[j] : -INFINITY; }
        const float mx = fmaxf(wave_max(fmaxf(fmaxf(sc[0], sc[1]), sc[2])), sinkv);
        float p[3], ps = 0.f;
#pragma unroll
        for (int i = 0; i < 3; ++i) { p[i] = __expf(sc[i] - mx); ps += p[i]; }
        const float inv = __builtin_amdgcn_rcpf(wave_sum(ps) + __expf(sinkv - mx));
#pragma unroll
        for (int i = 0; i < 3; ++i) { const int j = F.lane + 64 * i; if (j < 160) *(LAS unsigned short*)(L + OPL + row * 336 + 2 * j) = (unsigned short)f2bf(p[i] * inv); }
    }
    __syncthreads();
    if (F.wave < 4) {
        const int dt = F.wave;
        f32x4 o4 = {0.f, 0.f, 0.f, 0.f};
#pragma unroll
        for (int ks = 0; ks < 5; ++ks) {
            const bf16x8 pa = *(const LAS bf16x8*)(L + OPL + r16 * 336 + (32 * ks + 8 * q4) * 2);
            const bf16x8 vb8 = *(const LAS bf16x8*)(L + OVTL + (16 * dt + r16) * 336 + (32 * ks + 8 * q4) * 2);
            o4 = MFMA16(pa, vb8, o4);
        }
#pragma unroll
        for (int g = 0; g < 2; ++g) { const int e = 2 * hf + g; const float ov = hf ? (g ? o4[3] : o4[2]) : (g ? o4[1] : o4[0]);
            ((bf16*)(F.ws + WS_MIX))[(size_t)(m0 + q4) * D + 768 + e * 64 + 16 * dt + r16] = (bf16)f2bf(ov); }
    }
}
__device__ __forceinline__ void samp_hg_load(const Args& A, Ctx& F, int l, int u, float (&S)[32]) {
    const int bs = u >> 2, h = u & 3, v = F.tid & 127, dq = F.tid >> 7;
    const float* S0 = A.in[3 + F.z] + (((size_t)l * 128 + bs) * 4 + h) * 16384 + (size_t)(dq * 32) * 128 + v;
#pragma unroll
    for (int i = 0; i < 32; ++i) S[i] = S0[i * 128];
    __builtin_amdgcn_sched_barrier(0);
}
__device__ __forceinline__ void samp_hg_unit(const Args& A, Ctx& F, int l, int u, float (&S)[32]) {
    const int bs = u >> 2, h = u & 3, m0 = NP + 4 * bs;
    const bf16* PROJ = (const bf16*)(F.ws + WS_PROJ);
    LAS float* FT = (LAS float*)F.lds;
    LAS float* KT = FT + 512;
    LAS float* QT = KT + 512;
    LAS float* VV = QT + 512;
    LAS float* OP = VV + 512;
    LAS float* SS = OP + 2048;
    const int t_ = F.tid >> 7, d_ = F.tid & 127; const bf16* p_ = PROJ + (size_t)(m0 + t_) * INW + h * 128 + d_;
    const float lb_ = l == 0 ? 0.f : ((const float*)(F.ws + WS_TAB))[1024 + h * 128 + d_];
    const float xf_ = bf2f(p_[C_F]), xq_ = bf2f(p_[C_Q]), xi_ = bf2f(p_[C_I]), gg_ = bf2f(p_[C_G]), gn_ = A.in[18 + F.z][l * 128 + d_];
    __syncthreads();
    {
        const float e = __expf(-xf_), sg = __builtin_amdgcn_rcpf(1.f + e);
        FT[F.tid] = lb_ + (1.f - lb_) * sg; KT[F.tid] = (1.f - lb_) * e * sg; QT[F.tid] = xq_; VV[F.tid] = xi_;
    }
    __syncthreads();
    const int v = F.tid & 127, dq = F.tid >> 7;
#pragma unroll
    for (int t = 0; t < 4; ++t) {
        const float vt = VV[t * 128 + v]; float part = 0.f;
#pragma unroll
        for (int i = 0; i < 32; ++i) { const int d = dq * 32 + i; S[i] = FT[t * 128 + d] * S[i] + KT[t * 128 + d] * vt; part += QT[t * 128 + d] * S[i]; }
        OP[(dq * 4 + t) * 128 + v] = part;
    }
    float* So = F.out + O_HGS + (((size_t)l * 128 + bs) * 4 + h) * 16384 + (size_t)(dq * 32) * 128 + v;
#pragma unroll
    for (int i = 0; i < 32; ++i) So[i * 128] = S[i];
    __syncthreads();
    {
        const int t = F.tid >> 7, vv = F.tid & 127;
        const float o = (OP[(0 * 4 + t) * 128 + vv] + OP[(1 * 4 + t) * 128 + vv]) + (OP[(2 * 4 + t) * 128 + vv] + OP[(3 * 4 + t) * 128 + vv]);
        const float ss = wave_sum(o * o);
        if (F.lane == 0) SS[t * 2 + (F.wave & 1)] = ss;
        __syncthreads();
        const float rstd = __builtin_amdgcn_rsqf((SS[t * 2] + SS[t * 2 + 1]) * (1.f / 128.f) + EPS);
        ((bf16*)(F.ws + WS_MIX))[(size_t)(m0 + t) * D + 256 + h * 128 + vv] = (bf16)f2bf(o * rstd * gn_ * (gg_ * sigm(gg_)));
    }
}

template <int ACT> struct SEpiStore {
    bf16* O; int ldc;
    __device__ __forceinline__ void operator()(int row, int col, const f32x4 v) const {
        f32x4 w = v;
        if (ACT == 1) {
#pragma unroll
            for (int i = 0; i < 4; ++i) { const float r = v[i] > 0.f ? v[i] : 0.f; w[i] = r * r; } }
        v2u o; o.x = pk2(w[0], w[1]); o.y = pk2(w[2], w[3]);
        *(v2u*)(O + (size_t)row * ldc + col) = o;
    }
};
struct SEpiGateRes {
    const float* baseS; float* out; const float* gate;
    __device__ __forceinline__ void operator()(int row, int col, const f32x4 v) const {
        const f32x4 g4 = *(const f32x4*)(gate + (size_t)modrow(row) * MODLD + col), b4 = *(const f32x4*)(baseS + (size_t)(row - NP) * D + col);
        *(f32x4*)(out + (size_t)row * D + col) = b4 + g4 * v;
    }
};
template <int NJ, class Epi>
__device__ __forceinline__ void sgemm_phase(Ctx& F, const bf16* Arow  , const bf16* Bt, int N, int K, const Epi& E) {
    static_assert(NJ <= 4, "wave-private image: 8 KiB of A + 2 NJ KiB of B");
    const int r16 = F.lane & 15, q4 = F.lane >> 4, lr = F.lane >> 3, lp = F.lane & 7;
    const int ntn = N / (16 * NJ), ksl = K / 8, nss = ksl / 64;
    LAS unsigned char* WL = F.lds + F.wave * 16384;
    LAS f32x4* RED = (LAS f32x4*)F.lds;
    TSEC_BEGIN(50);
    constexpr int SLOT = 4 * NJ * 64;
    const bool grp = ((F.G & 7) == 0) && ((ntn & 7) == 0);
    const int xg = F.bid & 7, wpx = grp ? (F.G >> 3) : F.G, cpx = ntn >> 3;
    for (int w = grp ? (F.bid >> 3) : F.bid; w < (grp ? ntn : 8 * ntn); w += wpx) {
        const int tm = w & 7, tn = grp ? xg * cpx + (w >> 3) : (w >> 3);
        const bf16* ap = Arow + (size_t)(64 * tm + lr) * K + F.wave * ksl + 8 * lp;
        const bf16* bp = Bt + (size_t)(16 * NJ * tn + lr) * K + F.wave * ksl + 8 * lp;
        f32x4 acc[4][NJ];
#pragma unroll
        for (int i = 0; i < 4; ++i)
#pragma unroll
            for (int j = 0; j < NJ; ++j) acc[i][j] = (f32x4){0.f, 0.f, 0.f, 0.f};
        v4u ra[8], rb[2 * NJ];
#define SG_LOAD(ss) do { _Pragma("unroll") for (int t = 0; t < 8; ++t) ra[t] = *(const v4u*)(ap + (size_t)(8 * t) * K + 64 * (ss)); \
                          _Pragma("unroll") for (int t = 0; t < 2 * NJ; ++t) rb[t] = *(const v4u*)(bp + (size_t)(8 * t) * K + 64 * (ss)); } while (0)
        SG_LOAD(0);
        __builtin_amdgcn_sched_barrier(0);
        __syncthreads();
        for (int ss = 0; ss < nss; ++ss) {
#pragma unroll
            for (int t = 0; t < 8; ++t) { const int r = 8 * t + lr; *(LAS v4u*)(WL + r * 128 + ((lp ^ (r & 7)) << 4)) = ra[t]; }
#pragma unroll
            for (int t = 0; t < 2 * NJ; ++t) { const int r = 8 * t + lr; *(LAS v4u*)(WL + 8192 + r * 128 + ((lp ^ (r & 7)) << 4)) = rb[t]; }
            __builtin_amdgcn_sched_barrier(0);
            if (ss + 1 < nss) SG_LOAD(ss + 1);
            __builtin_amdgcn_sched_barrier(0);
#pragma unroll
            for (int s = 0; s < 2; ++s) {
                bf16x8 fa[4], fb[NJ];
#pragma unroll
                for (int i = 0; i < 4; ++i) { const int r = 16 * i + r16; fa[i] = *(const LAS bf16x8*)(WL + r * 128 + (((4 * s + q4) ^ (r & 7)) << 4)); }
#pragma unroll
                for (int j = 0; j < NJ; ++j) { const int r = 16 * j + r16; fb[j] = *(const LAS bf16x8*)(WL + 8192 + r * 128 + (((4 * s + q4) ^ (r & 7)) << 4)); }
#pragma unroll
                for (int i = 0; i < 4; ++i)
#pragma unroll
                    for (int j = 0; j < NJ; ++j) acc[i][j] = MFMA16(fb[j], fa[i], acc[i][j]);
            }
            __builtin_amdgcn_sched_barrier(0);
        }
#undef SG_LOAD
        __syncthreads();
#pragma unroll
        for (int i = 0; i < 4; ++i)
#pragma unroll
            for (int j = 0; j < NJ; ++j) RED[(F.wave * 4 + i) * NJ * 64 + j * 64 + F.lane] = acc[i][j];
        __syncthreads();
#pragma unroll
        for (int q = 0; q < (SLOT + 511) / 512; ++q) {
            const int p = F.tid + 512 * q, ln = p & 63, ij = p >> 6, j = ij % NJ, mi = ij / NJ;
            if (p >= SLOT) break;
            f32x4 v = RED[p];
#pragma unroll
            for (int k4 = 1; k4 < 8; ++k4) v += RED[k4 * SLOT + p];
            E(NP + 64 * tm + 16 * mi + (ln & 15), 16 * NJ * tn + 16 * j + 4 * (ln >> 4), v);
        }
    }
    TSEC_END(50);
}

#ifndef MK_PER_PHASE
#define MK_PER_PHASE 0
#endif
#ifndef PH_MASK
#define PH_MASK 0xFFFF
#endif
#define PHON(k) ((PH_MASK >> (k)) & 1)
#ifndef PROBE_REP
#define PROBE_REP -1
#endif
#ifndef PROBE_SPIN
#define PROBE_SPIN -1
#endif
#define RELAUNDER() do { int tid_ = F.tid, bid_ = __builtin_amdgcn_readfirstlane(F.bid), g_ = __builtin_amdgcn_readfirstlane(F.G), z_ = __builtin_amdgcn_readfirstlane(F.z); asm volatile("" : "+s"(z_), "+s"(bid_), "+s"(g_)); asm volatile("" : "+v"(tid_)); \
    F.ws = args.ws + z_; F.out = args.out + z_; F.z = z_; F.tid = tid_; F.lane = tid_ & 63; F.wave = __builtin_amdgcn_readfirstlane(tid_ >> 6); F.bid = bid_; F.G = g_; } while (0)
#define SUBPROBE(k, ...) do { RELAUNDER(); const unsigned long long st0_ = PROBE_SPIN == (k) ? __builtin_amdgcn_s_memrealtime() : 0ull; __VA_ARGS__; if (PROBE_SPIN == (k)) { __syncthreads(); const unsigned long long st1_ = __builtin_amdgcn_s_memrealtime(), du_ = (st1_ - st0_) * PROBE_N; while (__builtin_amdgcn_s_memrealtime() - st1_ < du_) __builtin_amdgcn_s_sleep(8); } } while (0)
__global__ void __launch_bounds__(512, 2) mk_fwd(Args args) {
    extern __shared__ __attribute__((aligned(16))) unsigned char lds[];
    Ctx F;
    F.lds = (LAS unsigned char*)lds;
    F.tid = threadIdx.x; F.lane = F.tid & 63; F.wave = __builtin_amdgcn_readfirstlane(F.tid >> 6);
    F.G = gridDim.x; F.bid = blockIdx.x; F.z = 0;
    F.out = args.out; F.ws = args.ws;
    volatile LAS unsigned* MISC = (volatile LAS unsigned*)(F.lds + MISC_OFF);
    for (int u = F.tid; u < (LDS_BYTES - LDSCTL_OFF) / 4; u += 512) ((LAS unsigned*)(F.lds + LDSCTL_OFF))[u] = 0u;
    __syncthreads();
    const int lo = args.ph_lo, hi = args.ph_hi;
    const int wave0 = F.wave;
    XcdBarrier bar; bar.bar = (unsigned*)(F.ws + WS_CTL) + CW_BAR; bar.x = 0; bar.st = nullptr;
    if (hi - lo > 1) bar = xcd_barrier_post((unsigned*)(F.ws + WS_CTL) + CW_BAR, MISC + 8, F.tid);
    for (int p = lo; p < hi; ++p) {
        const int l = p < 2 ? 0 : (p - 2) / 9, s = (p < 2 || p == NPH - 1) ? -1 : (p - 2) % 9;
        const int which = p == NPH - 1 ? 2 : (s == 0 ? 0 : (s == 6 ? 1 : -1));
        const int kind = p == 0 ? 0 : p == 1 ? 12 : (which == 2 ? 10 : (which >= 0 ? 1 : (s == 1 ? 2 : (s == 2 ? 3 : (s == 3 ? 4 : (s == 4 ? 5 : (s == 5 ? (l == 0 ? 6 : 11) : (s == 7 ? 7 : 8))))))));
        const int nrep = (kind == PROBE_REP) ? 1 + PROBE_N : 1;
        const unsigned long long pt0 = PROBE_SPIN >= 0 ? __builtin_amdgcn_s_memrealtime() : 0ull;
        for (int rep = 0; rep < nrep; ++rep) {
        { int z_ = 0, tid_ = wave0 * 64 + (int)__builtin_amdgcn_mbcnt_hi(~0u, __builtin_amdgcn_mbcnt_lo(~0u, 0u)), bid_ = blockIdx.x, g_ = gridDim.x;
          asm volatile("" : "+s"(z_), "+s"(bid_), "+s"(g_)); asm volatile("" : "+v"(tid_));
          F.ws = args.ws + z_; F.out = args.out + z_; F.z = z_; F.tid = tid_; F.lane = tid_ & 63; F.wave = __builtin_amdgcn_readfirstlane(tid_ >> 6); F.bid = bid_; F.G = g_; }
        if (PROBE_REP == 9 && hi - lo > 1) { for (int xb = 0; xb < PROBE_N; ++xb) xcd_barrier(bar, F.tid); }
        if (p == 0) { if (PHON(0)) p0_prologue(args, F); }
        else if (p == 1) { if (PHON(0)) mod_phase(args, F); }
        else if (which >= 0) { if (PHON(1)) norm_phase(args, F, p == NPH - 1 ? 0 : l, which); }
        else if (s == 1 && PHON(2)) {
            pg8::Gemm g{(const pg8::bf16_t*)(F.ws + WS_XN), (const pg8::bf16_t*)(F.ws + WS_WIN) + (size_t)l * INW * D, NP, INW, D};
            pg8::StaticOrder S; S.init(NP, INW, F.G, F.bid);
            pg8::EpiStore<0> E{(pg8::bf16_t*)(F.ws + WS_PROJ), INW};
            SEpiStore<0> SE{(bf16*)(F.ws + WS_PROJ), INW};
            sgemm_phase<3>(F, (const bf16*)(F.ws + WS_XN) + (size_t)NP * D, (const bf16*)(F.ws + WS_WIN) + (size_t)l * INW * D, INW, D, SE);
            __syncthreads();
            pg8::gemm_phase<pg8::EpiStore<0>, pg8::StaticOrder, true, true>(F.lds, g, S, E, F.tid);
        } else if (s == 2) {
            for (int slot = 0; slot < 5; ++slot) {
                const int ty = __builtin_amdgcn_readfirstlane((slot + F.bid) % 5);
#if PHON(7)
                if (ty == 0) {
            SUBPROBE(20, for (int u = F.bid; u < 256; u += F.G) samp_b_unit(args, F, l, u));
                }
#endif
#if PHON(6)
                if (ty == 1) {
            SUBPROBE(21, { float S[32]; samp_hg_load(args, F, l, F.bid & 511, S); for (int u = F.bid; u < 512; u += F.G) { float Sn[32]; samp_hg_load(args, F, l, (u + F.G) & 511, Sn); samp_hg_unit(args, F, l, u, S); _Pragma("unroll") for (int i = 0; i < 32; ++i) S[i] = Sn[i]; } });
                }
#endif
#if PHON(3)
                if (ty == 2) {
            SUBPROBE(22, for (int u = F.bid; u < 256; u += F.G) attn_unit(args, F, l, u));
                }
#endif
#if PHON(4)
                if (ty == 3) {
            SUBPROBE(23, for (int u = F.bid; u < 256; u += F.G) conv_unit(args, F, l, u));
                }
#endif
#if PHON(5)
                if (ty == 4) {
                        SUBPROBE(24, {   const int nh1 = -1; auto h1idx = [&](int k) -> int { if (nh1 < 0) return F.bid + F.G * k; return k < 4 ? F.bid + 256 * k : F.bid + 640; }; const int cnt = nh1 < 0 ? (1024 - F.bid + F.G - 1) / F.G : nh1; v4u rf[2], rv[2]; h1_load(F, h1idx(0) & 1023, rf, rv); for (int k = 0; k < cnt; ++k) { v4u nf[2], nv[2]; h1_load(F, h1idx(k + 1 < cnt ? k + 1 : k) & 1023, nf, nv); h1_unit(args, F, l, h1idx(k), rf, rv); rf[0] = nf[0]; rf[1] = nf[1]; rv[0] = nv[0]; rv[1] = nv[1]; } });
                }
#endif
            }
        } else if (s == 3) { if (PHON(8)) h2_scan(args, F, l); }
        else if (s == 4 && PHON(9)) { v4u rf[2], rq[2], rv[2]; h3_load(F, F.bid & 1023, rf, rq, rv); for (int u = F.bid; u < 1024; u += F.G) { v4u nf[2], nq[2], nv[2]; h3_unit(args, F, l, u, rf, rq, rv, (u + F.G) & 1023, nf, nq, nv); rf[0] = nf[0]; rf[1] = nf[1]; rq[0] = nq[0]; rq[1] = nq[1]; rv[0] = nv[0]; rv[1] = nv[1]; } }
        else if ((s == 5 || s == 8) && PHON(10)) {
            const bool dn = s == 8;
            pg8::Gemm g{(const pg8::bf16_t*)(F.ws + (dn ? WS_HB : WS_MIX)), (const pg8::bf16_t*)(F.ws + (dn ? WS_WDN : WS_WOUT)) + (size_t)l * (dn ? D * FF : D * D), NP, D, dn ? FF : D};
            pg8::StaticOrder S; S.init(NP, D, F.G, F.bid);
            const bool from_in = (!dn && l == 0);
            pg8::EpiGateRes E{from_in ? args.in[0 + F.z] : F.out, from_in ? args.in[1 + F.z] : F.out + (size_t)NP * D, F.out, (const float*)(F.ws + WS_MOD) + (size_t)l * MODR * MODLD + (dn ? 5 * D : 2 * D)};
            SEpiGateRes SE{from_in ? args.in[1 + F.z] : F.out + (size_t)NP * D, F.out, (const float*)(F.ws + WS_MOD) + (size_t)l * MODR * MODLD + (dn ? 5 * D : 2 * D)};
            sgemm_phase<2>(F, (const bf16*)(F.ws + (dn ? WS_HB : WS_MIX)) + (size_t)NP * (dn ? FF : D), (const bf16*)(F.ws + (dn ? WS_WDN : WS_WOUT)) + (size_t)l * (dn ? D * FF : D * D), D, dn ? FF : D, SE);
            __syncthreads();
            pg8::gemm_phase<pg8::EpiGateRes, pg8::StaticOrder, true, true>(F.lds, g, S, E, F.tid);
        } else if (s == 7 && PHON(11)) {
            pg8::Gemm g{(const pg8::bf16_t*)(F.ws + WS_XN), (const pg8::bf16_t*)(F.ws + WS_WUP) + (size_t)l * FF * D, NP, FF, D};
            pg8::StaticOrder S; S.init(NP, FF, F.G, F.bid);
            pg8::EpiStore<1> E{(pg8::bf16_t*)(F.ws + WS_HB), FF};
            SEpiStore<1> SE{(bf16*)(F.ws + WS_HB), FF};
            sgemm_phase<4>(F, (const bf16*)(F.ws + WS_XN) + (size_t)NP * D, (const bf16*)(F.ws + WS_WUP) + (size_t)l * FF * D, FF, D, SE);
            __syncthreads();
            pg8::gemm_phase<pg8::EpiStore<1>, pg8::StaticOrder, true, true>(F.lds, g, S, E, F.tid);
        }
        }
        if (PROBE_SPIN >= 0 && kind == PROBE_SPIN) { const unsigned long long pt1 = __builtin_amdgcn_s_memrealtime(), dur = (pt1 - pt0) * PROBE_N; while (__builtin_amdgcn_s_memrealtime() - pt1 < dur) __builtin_amdgcn_s_sleep(8); }
        if (p + 1 < hi) xcd_barrier(bar, F.tid);
    }
}

extern "C" void kernel_launch(void* const* d_in, const int* in_sizes, int n_in, void* d_out, int out_size, void* d_ws, size_t ws_size, hipStream_t stream) {
    static int grid = 0;
    if (grid == 0) {
        if (n_in != 25 || in_sizes[0] != NP * D || (size_t)out_size != O_END || ws_size < WS_END) {
            fprintf(stderr, "kernel_launch: unexpected shapes (n_in %d, in0 %d, out %d, ws %zu)\n", n_in, n_in > 0 ? in_sizes[0] : -1, out_size, ws_size); grid = -1; return; }
        int dev = 0, cus = 0, per_cu = 0;
        if (hipGetDevice(&dev) != hipSuccess || hipDeviceGetAttribute(&cus, hipDeviceAttributeMultiprocessorCount, dev) != hipSuccess) { grid = -1; return; }
        if (hipFuncSetAttribute((const void*)mk_fwd, hipFuncAttributeMaxDynamicSharedMemorySize, LDS_BYTES) != hipSuccess) { fprintf(stderr, "kernel_launch: hipFuncSetAttribute failed\n"); grid = -1; return; }
        if (hipOccupancyMaxActiveBlocksPerMultiprocessor(&per_cu, (const void*)mk_fwd, 512, LDS_BYTES) != hipSuccess || per_cu < 1) {
            fprintf(stderr, "kernel_launch: occupancy query reports %d blocks per CU; nothing launched\n", per_cu); (void)hipGetLastError(); grid = -1; return; }
        grid = cus;
    }
    if (grid < 0) return;
    (void)hipMemsetAsync((char*)d_ws + WS_CTL, 0, CTL_ZERO_BYTES, stream);
    Args a{};
    for (int i = 0; i < 25; ++i) a.in[i] = (const float*)d_in[i];
    a.out = (float*)d_out; a.ws = (unsigned char*)d_ws;
#if MK_PER_PHASE
    for (int p = 0; p < NPH; ++p) { a.ph_lo = p; a.ph_hi = p + 1; hipLaunchKernelGGL(mk_fwd, dim3(grid), dim3(512), LDS_BYTES, stream, a); }
#else
    a.ph_lo = 0; a.ph_hi = NPH; hipLaunchKernelGGL(mk_fwd, dim3(grid), dim3(512), LDS_BYTES, stream, a);
#endif
}
```

```cpp
#define MK_PER_PHASE 0
#include <hip/hip_runtime.h>
#include <cstdio>
#include <cstdint>
namespace pg8 {
#define PG8_LAS __attribute__((address_space(3)))
typedef unsigned short bf16_t;
typedef short bf16x8 __attribute__((ext_vector_type(8)));
typedef float f32x4 __attribute__((ext_vector_type(4)));
typedef unsigned u32x4 __attribute__((ext_vector_type(4)));
constexpr int BM = 256, BK = 64, HALF = 128, HTB = HALF * BK * 2  , STAGE_BYTES = 8 * HTB, NXCD = 8, WGM = 8;

__host__ __device__ __forceinline__ int lds_byte(int r, int c) { const int st = (r >> 4) * 2 + (c >> 5), rr = r & 15, cc = c & 31, ob = rr * 64 + cc * 2; return st * 1024 + (ob ^ (((ob >> 9) & 1) << 5)); }
__host__ __device__ __forceinline__ void stage_rc(int b, int& R, int& C) { const int st = b / 1024, sb = b % 1024, swz = sb ^ (((sb >> 9) & 1) << 5); R = (st >> 1) * 16 + swz / 64; C = (st & 1) * 32 + (swz % 64) / 2; }
__host__ __device__ __forceinline__ int perm32(int rho) { const int n = rho >> 4, i = rho & 15; return 8 * (i >> 2) + 4 * n + (i & 3); }

struct Unit { int pm, pn; };
struct Gemm { const bf16_t* A; const bf16_t* Bt; int M, N, K; };

struct StaticOrder {
    int nM, nN, nwg, G, c;
    __host__ __device__ void init(int M, int N, int G_, int c_) { nM = M / BM; nN = N / BM; nwg = nM * nN; G = G_; c = c_; }
    __host__ __device__ bool next(int i, Unit& u) const {
        const long L = (long)i * G + c; if (L >= nwg) return false;
        int wgid = (int)L; { const int q = nwg / NXCD, r = nwg % NXCD, xcd = wgid % NXCD, off = wgid / NXCD; wgid = (xcd < r ? xcd * (q + 1) : r * (q + 1) + (xcd - r) * q) + off; }
        const int nig = WGM * nN, gid = wgid / nig, fm = gid * WGM, gsz = (nM - fm) < WGM ? (nM - fm) : WGM;
        u.pm = fm + ((wgid % nig) % gsz); u.pn = (wgid % nig) / gsz; return true;
    }
    __device__ __forceinline__ void a_ready(const Unit&) const {}
    __device__ __forceinline__ void done(const Unit&) const {}
};

__device__ __forceinline__ unsigned cvt_pk_bf16(float lo, float hi) { unsigned r; asm volatile("v_cvt_pk_bf16_f32 %0, %1, %2" : "=v"(r) : "v"(lo), "v"(hi)); return r; }
typedef float f32x2 __attribute__((ext_vector_type(2)));
constexpr int EP_NP = 16384, EP_D = 1024, EP_MODLD = 6144, EP_SHWLD = 4096;
constexpr float EP_EPS = 1e-6f;
__device__ __forceinline__ int ep_modrow(int r) { return r < EP_NP ? (r >> 12) : 4 + ((r - EP_NP) >> 2); }
template <int ACT> struct EpiStore {
    static constexpr bool PERM = true, AFTER_DRAIN = false;
    bf16_t* O; int ldc; const float* rss; const float* shw;
    __device__ __forceinline__ void operator()(const f32x4 (&acc)[2][2][4][2], const Unit& u, int wr, int wc, int fr, int fq) const {
        const int row0 = u.pm * BM + wr * 64 + fr, col0 = u.pn * BM + wc * 32 + 8 * fq;
        f32x4 h4[2][2]; float rs[8];
#pragma unroll
        for (int bj = 0; bj < 2; ++bj)
#pragma unroll
            for (int n = 0; n < 2; ++n) h4[bj][n] = (f32x4){0.f, 0.f, 0.f, 0.f};
#pragma unroll
        for (int i = 0; i < 8; ++i) rs[i] = 1.f;
        if (rss) {
            const float* hp = shw + (size_t)ep_modrow(u.pm * BM) * EP_SHWLD + col0;
#pragma unroll
            for (int bj = 0; bj < 2; ++bj)
#pragma unroll
                for (int n = 0; n < 2; ++n) h4[bj][n] = *(const f32x4*)(hp + bj * HALF + 4 * n);
#pragma unroll
            for (int i = 0; i < 8; ++i) rs[i] = rss[row0 + (i >> 2) * HALF + (i & 3) * 16];
#pragma unroll
            for (int i = 0; i < 8; ++i) rs[i] = __builtin_amdgcn_rsqf(rs[i] * (1.f / EP_D) + EP_EPS);
        }
#pragma unroll
        for (int ai = 0; ai < 2; ++ai)
#pragma unroll
            for (int m = 0; m < 4; ++m) { bf16_t* rowp = O + (size_t)(row0 + ai * HALF + m * 16) * ldc + col0; const float rstd = rs[ai * 4 + m];
#pragma unroll
                for (int bj = 0; bj < 2; ++bj) { f32x4 v0 = acc[ai][bj][m][0] * rstd + h4[bj][0], v1 = acc[ai][bj][m][1] * rstd + h4[bj][1];
                    if (ACT == 1) {
#pragma unroll
                        for (int e = 0; e < 4; ++e) { const float a = v0[e] > 0.f ? v0[e] : 0.f, b = v1[e] > 0.f ? v1[e] : 0.f; v0[e] = a * a; v1[e] = b * b; } }
                    u32x4 w; w.x = cvt_pk_bf16(v0[0], v0[1]); w.y = cvt_pk_bf16(v0[2], v0[3]); w.z = cvt_pk_bf16(v1[0], v1[1]); w.w = cvt_pk_bf16(v1[2], v1[3]);
                    *(u32x4*)(rowp + bj * HALF) = w; } }
    }
};
struct EpiGateRes {
    static constexpr bool PERM = true, AFTER_DRAIN = false;
    const float* baseP; const float* baseS; float* out; const float* gate;
    bf16_t* xs; float* rss; const float* gam; const float* sc;
    __device__ __forceinline__ void operator()(const f32x4 (&acc)[2][2][4][2], const Unit& u, int wr, int wc, int fr, int fq) const {
        const int col0 = u.pn * BM + wc * 32 + 8 * fq;
        const int mr = ep_modrow(u.pm * BM);
        f32x4 g4[2][2], s4[2][2];
#pragma unroll
        for (int bj = 0; bj < 2; ++bj)
#pragma unroll
            for (int n = 0; n < 2; ++n) { g4[bj][n] = *(const f32x4*)(gate + (size_t)mr * EP_MODLD + col0 + bj * HALF + 4 * n); s4[bj][n] = (f32x4){0.f, 0.f, 0.f, 0.f}; }
        if (xs) {
#pragma unroll
            for (int bj = 0; bj < 2; ++bj)
#pragma unroll
                for (int n = 0; n < 2; ++n) s4[bj][n] = *(const f32x4*)(gam + col0 + bj * HALF + 4 * n) * (*(const f32x4*)(sc + (size_t)mr * EP_MODLD + col0 + bj * HALF + 4 * n) + 1.f);
        }
#pragma unroll
        for (int ai = 0; ai < 2; ++ai)
#pragma unroll
            for (int mp = 0; mp < 2; ++mp) {
                f32x4 b4[2][2][2];
#pragma unroll
                for (int mm = 0; mm < 2; ++mm) { const int r = u.pm * BM + ai * HALF + wr * 64 + (2 * mp + mm) * 16 + fr;
                    const float* bp = (r < EP_NP ? baseP + (size_t)r * EP_D : baseS + (size_t)(r - EP_NP) * EP_D) + col0;
#pragma unroll
                    for (int bj = 0; bj < 2; ++bj)
#pragma unroll
                        for (int n = 0; n < 2; ++n) b4[mm][bj][n] = *(const f32x4*)(bp + bj * HALF + 4 * n); }
                __builtin_amdgcn_sched_barrier(0);
#pragma unroll
                for (int mm = 0; mm < 2; ++mm) { const int m = 2 * mp + mm, r = u.pm * BM + ai * HALF + wr * 64 + m * 16 + fr;
                    float* op = out + (size_t)r * EP_D + col0; float ss = 0.f;
#pragma unroll
                    for (int bj = 0; bj < 2; ++bj) {
                        const f32x4 x0 = b4[mm][bj][0] + g4[bj][0] * acc[ai][bj][m][0], x1 = b4[mm][bj][1] + g4[bj][1] * acc[ai][bj][m][1];
                        *(f32x4*)(op + bj * HALF) = x0; *(f32x4*)(op + bj * HALF + 4) = x1;
                        if (xs) {
                            ss += ((x0[0] * x0[0] + x0[1] * x0[1]) + (x0[2] * x0[2] + x0[3] * x0[3])) + ((x1[0] * x1[0] + x1[1] * x1[1]) + (x1[2] * x1[2] + x1[3] * x1[3]));
                            const f32x4 y0 = x0 * s4[bj][0], y1 = x1 * s4[bj][1];
                            u32x4 w; w.x = cvt_pk_bf16(y0[0], y0[1]); w.y = cvt_pk_bf16(y0[2], y0[3]); w.z = cvt_pk_bf16(y1[0], y1[1]); w.w = cvt_pk_bf16(y1[2], y1[3]);
                            *(u32x4*)(xs + (size_t)r * EP_D + col0 + bj * HALF) = w; } }
                    if (xs) { ss += __shfl_xor(ss, 16); ss += __shfl_xor(ss, 32);
                        if (fq == 0) (void)__hip_atomic_fetch_add(rss + r, ss, __ATOMIC_RELAXED, __HIP_MEMORY_SCOPE_AGENT); } }
                __builtin_amdgcn_sched_barrier(0);
            }
    }
};
template <class Epi, class Sched, bool ALIGN_EPI = false, bool SP2 = false>
__device__ __forceinline__ void gemm_phase(PG8_LAS unsigned char* lds, const Gemm g, const Sched& S, const Epi& E, const int tid) {
    const int wid = __builtin_amdgcn_readfirstlane(tid >> 6), lane = tid & 63, wr = wid >> 2, wc = wid & 3, fr = lane & 15, fq = lane >> 4;
    const int K = g.K, nt = K / BK;
    unsigned voffA[2], voffB[2];
#pragma unroll
    for (int i = 0; i < 2; ++i) { int R, C; stage_rc(tid * 16 + i * 8192, R, C); const int Rb = Epi::PERM ? ((R & ~31) + perm32(R & 31)) : R;
        voffA[i] = (unsigned)(R * K + C) * 2u; voffB[i] = (unsigned)(Rb * K + C) * 2u; }
    const size_t kstep = (size_t)(BK * 2);
    const size_t hstep = (size_t)HALF * K * 2;
    const size_t tstep = 2 * hstep;
    const unsigned ldsw = (unsigned)wid * 1024u;
    const int aoff = lds_byte(wr * 64 + fr, fq * 8), boff = lds_byte(wc * 32 + fr, fq * 8);
#define PG8_SA(b, h) (((b) * 2 + (h)) * HTB)
#define PG8_SB(b, h) ((4 + (b) * 2 + (h)) * HTB)
#define PG8_STAGE(bufoff, gbase, voff) do { _Pragma("unroll") for (int _i = 0; _i < 2; ++_i) \
        __builtin_amdgcn_global_load_lds((const unsigned*)((const char*)(gbase) + (voff)[_i]), (PG8_LAS unsigned*)(lds + (bufoff) + ldsw + _i * 8192), 16, 0, 0); } while (0)
#define PG8_LDA(dst, b, h) do { _Pragma("unroll") for (int m = 0; m < 4; ++m) _Pragma("unroll") for (int k = 0; k < 2; ++k) dst[m][k] = *(const PG8_LAS bf16x8*)(lds + PG8_SA(b, h) + aoff + m * 2048 + k * 1024); } while (0)
#define PG8_LDB(dst, b, h) do { _Pragma("unroll") for (int n = 0; n < 2; ++n) _Pragma("unroll") for (int k = 0; k < 2; ++k) dst[n][k] = *(const PG8_LAS bf16x8*)(lds + PG8_SB(b, h) + boff + n * 2048 + k * 1024); } while (0)
#define PG8_MMA(ai, bj, At, Bt) do { __builtin_amdgcn_s_setprio(1); _Pragma("unroll") for (int m = 0; m < 4; ++m) _Pragma("unroll") for (int n = 0; n < 2; ++n) _Pragma("unroll") for (int k = 0; k < 2; ++k) \
        acc[ai][bj][m][n] = __builtin_amdgcn_mfma_f32_16x16x32_bf16(Bt[n][k], At[m][k], acc[ai][bj][m][n], 0, 0, 0); __builtin_amdgcn_s_setprio(0); } while (0)
#define PG8_WAIT_V(n) asm volatile("s_waitcnt vmcnt(" #n ")" ::: "memory")
#define PG8_WAIT_L(n) asm volatile("s_waitcnt lgkmcnt(" #n ")" ::: "memory")
#define PG8_BAR __builtin_amdgcn_s_barrier()
#define PG8_SCHED __builtin_amdgcn_sched_barrier(0)
    Unit cur, nxt; int ui = 0;
    if (!S.next(0, cur)) return;
    f32x4 acc[2][2][4][2];
#pragma unroll
    for (int a = 0; a < 2; ++a)
#pragma unroll
        for (int b = 0; b < 2; ++b)
#pragma unroll
            for (int m = 0; m < 4; ++m)
#pragma unroll
                for (int n = 0; n < 2; ++n) acc[a][b][m][n] = (f32x4){0.f, 0.f, 0.f, 0.f};
    bf16x8 At[4][2], B0[2][2], B1[2][2];
    const char* cA = (const char*)g.A + (size_t)cur.pm * tstep; const char* cB = (const char*)g.Bt + (size_t)cur.pn * tstep;
    S.a_ready(cur);
    if constexpr (SP2) {
        PG8_STAGE(PG8_SB(0, 0), cB, voffB); PG8_STAGE(PG8_SB(0, 1), cB + hstep, voffB); PG8_STAGE(PG8_SA(0, 0), cA, voffA); PG8_STAGE(PG8_SA(0, 1), cA + hstep, voffA);
        if (wr == 1) PG8_BAR;
        PG8_WAIT_V(2); PG8_BAR;
        PG8_STAGE(PG8_SB(1, 0), cB + kstep, voffB); PG8_STAGE(PG8_SA(1, 0), cA + kstep, voffA); PG8_STAGE(PG8_SB(1, 1), cB + hstep + kstep, voffB);
        PG8_WAIT_V(6); PG8_BAR;
    } else {
        PG8_STAGE(PG8_SB(0, 0), cB, voffB); PG8_STAGE(PG8_SA(0, 0), cA, voffA); PG8_STAGE(PG8_SB(0, 1), cB + hstep, voffB); PG8_STAGE(PG8_SA(0, 1), cA + hstep, voffA);
        if (wr == 1) PG8_BAR;
        PG8_WAIT_V(4); PG8_BAR;
        PG8_STAGE(PG8_SB(1, 0), cB + kstep, voffB); PG8_STAGE(PG8_SA(1, 0), cA + kstep, voffA); PG8_STAGE(PG8_SB(1, 1), cB + hstep + kstep, voffB);
        PG8_WAIT_V(6); PG8_BAR;
    }
    for (;;) {
        const bool has_next = S.next(ui + 1, nxt);
        const char* nA = has_next ? (const char*)g.A + (size_t)nxt.pm * tstep : cA; const char* nB = has_next ? (const char*)g.Bt + (size_t)nxt.pn * tstep : cB;
        for (int t = 0; t < nt; t += 2) {
            const bool last = (t == nt - 2);
            const char* a1 = cA + (size_t)(t + 1) * kstep;
            const char* a2 = last ? nA : cA + (size_t)(t + 2) * kstep; const char* b2 = last ? nB : cB + (size_t)(t + 2) * kstep;
            const char* a3 = a2 + kstep; const char* b3 = b2 + kstep;
            if (last && has_next) S.a_ready(nxt);
            if constexpr (SP2) {
            PG8_LDB(B0, 0, 0); PG8_LDB(B1, 0, 1); PG8_SCHED; PG8_LDA(At, 0, 0); PG8_STAGE(PG8_SA(1, 1), a1 + hstep, voffA);
            PG8_WAIT_V(8); PG8_WAIT_L(0); PG8_BAR; PG8_MMA(0, 0, At, B0); PG8_MMA(0, 1, At, B1); PG8_BAR; PG8_SCHED;
            PG8_LDA(At, 0, 1); PG8_STAGE(PG8_SB(0, 0), b2, voffB); PG8_STAGE(PG8_SB(0, 1), b2 + hstep, voffB); PG8_STAGE(PG8_SA(0, 0), a2, voffA);
            PG8_WAIT_V(8); PG8_WAIT_L(0); PG8_BAR; PG8_MMA(1, 0, At, B0); PG8_MMA(1, 1, At, B1); PG8_BAR; PG8_SCHED;
            PG8_LDB(B0, 1, 0); PG8_LDB(B1, 1, 1); PG8_SCHED; PG8_LDA(At, 1, 0); PG8_STAGE(PG8_SA(0, 1), a2 + hstep, voffA);
            PG8_WAIT_V(8); PG8_WAIT_L(0); PG8_BAR; PG8_MMA(0, 0, At, B0); PG8_MMA(0, 1, At, B1); PG8_BAR; PG8_SCHED;
            PG8_LDA(At, 1, 1); PG8_STAGE(PG8_SB(1, 0), b3, voffB); PG8_STAGE(PG8_SB(1, 1), b3 + hstep, voffB); PG8_STAGE(PG8_SA(1, 0), a3, voffA);
            PG8_WAIT_V(8); PG8_WAIT_L(0); PG8_BAR; PG8_MMA(1, 0, At, B0); PG8_MMA(1, 1, At, B1); PG8_BAR; PG8_SCHED;
            } else {
            PG8_LDB(B0, 0, 0); PG8_SCHED; PG8_LDA(At, 0, 0); PG8_STAGE(PG8_SA(1, 1), a1 + hstep, voffA);
            PG8_WAIT_L(8); PG8_BAR; PG8_WAIT_L(0); PG8_MMA(0, 0, At, B0); PG8_BAR; PG8_SCHED;
            PG8_LDB(B1, 0, 1); PG8_STAGE(PG8_SB(0, 0), b2, voffB);
            PG8_BAR; PG8_WAIT_L(0); PG8_MMA(0, 1, At, B1); PG8_BAR;
            PG8_LDA(At, 0, 1); PG8_STAGE(PG8_SA(0, 0), a2, voffA);
            PG8_BAR; PG8_WAIT_L(0); PG8_MMA(1, 0, At, B0); PG8_BAR; PG8_SCHED;
            PG8_STAGE(PG8_SB(0, 1), b2 + hstep, voffB);
            PG8_WAIT_V(6); PG8_BAR; PG8_MMA(1, 1, At, B1); PG8_BAR;
            PG8_LDB(B0, 1, 0); PG8_SCHED; PG8_LDA(At, 1, 0); PG8_STAGE(PG8_SA(0, 1), a2 + hstep, voffA);
            PG8_WAIT_L(8); PG8_BAR; PG8_WAIT_L(0); PG8_MMA(0, 0, At, B0); PG8_BAR; PG8_SCHED;
            PG8_LDB(B1, 1, 1); PG8_STAGE(PG8_SB(1, 0), b3, voffB);
            PG8_BAR; PG8_WAIT_L(0); PG8_MMA(0, 1, At, B1); PG8_BAR;
            PG8_LDA(At, 1, 1); PG8_STAGE(PG8_SA(1, 0), a3, voffA);
            PG8_BAR; PG8_WAIT_L(0); PG8_MMA(1, 0, At, B0); PG8_BAR; PG8_SCHED;
            PG8_STAGE(PG8_SB(1, 1), b3 + hstep, voffB);
            PG8_WAIT_V(6); PG8_BAR; PG8_MMA(1, 1, At, B1); PG8_BAR;
            }
        }
        if constexpr (ALIGN_EPI) { if (wr == 0) PG8_BAR; }
        if constexpr (!Epi::AFTER_DRAIN) { E(acc, cur, wr, wc, fr, fq); S.done(cur); }
        if (!has_next) break;
#pragma unroll
        for (int a = 0; a < 2; ++a)
#pragma unroll
            for (int b = 0; b < 2; ++b)
#pragma unroll
                for (int m = 0; m < 4; ++m)
#pragma unroll
                    for (int n = 0; n < 2; ++n) acc[a][b][m][n] = (f32x4){0.f, 0.f, 0.f, 0.f};
        cur = nxt; cA = nA; cB = nB; ++ui;
        if constexpr (ALIGN_EPI) { if (wr == 1) PG8_BAR; }
    }
    PG8_WAIT_V(0);
    if constexpr (!ALIGN_EPI) { if (wr == 0) PG8_BAR; }
    PG8_BAR;
    if constexpr (Epi::AFTER_DRAIN) { E.fused(acc, cur, wr, wc, fr, fq, lds, wid, lane); S.done(cur); }
#undef PG8_SA
#undef PG8_SB
#undef PG8_STAGE
#undef PG8_LDA
#undef PG8_LDB
#undef PG8_MMA
#undef PG8_WAIT_V
#undef PG8_WAIT_L
#undef PG8_BAR
#undef PG8_SCHED
}
}
#define GAS __attribute__((address_space(1)))
#define LAS __attribute__((address_space(3)))
typedef unsigned short bf16;
typedef unsigned v4u __attribute__((ext_vector_type(4)));
typedef float f32x4 __attribute__((ext_vector_type(4)));
typedef short bf16x8 __attribute__((ext_vector_type(8)));
typedef GAS unsigned gu32;
typedef GAS unsigned long long gu64;
#define RLX_AGENT __ATOMIC_RELAXED, __HIP_MEMORY_SCOPE_AGENT
#define LDS_WAIT() asm volatile("s_waitcnt lgkmcnt(0)" ::: "memory")
#define VM_WAIT() asm volatile("s_waitcnt vmcnt(0)" ::: "memory")
__device__ __forceinline__ unsigned long long rt() { return __builtin_amdgcn_s_memrealtime(); }
typedef float f32x2_ __attribute__((ext_vector_type(2)));
typedef __bf16 bf16x2_ __attribute__((ext_vector_type(2)));
__device__ __forceinline__ unsigned pk2(float lo, float hi) { const f32x2_ v = {lo, hi}; const bf16x2_ b = __builtin_convertvector(v, bf16x2_); return __builtin_bit_cast(unsigned, b); }
__device__ __forceinline__ unsigned f2bf(float f) { return (unsigned)__builtin_bit_cast(unsigned short, (__bf16)f); }

#define XB_TMO      128
#define XB_XCNT(j)  (256  + 64 * (j))
#define XB_XSUB(j)  (1280 + 64 * (j))
#define XB_XGEN(j)  (2304 + 64 * (j))
#define XB_TOP      3328
#define XB_TOPGEN   3392
#define XCD_BAR_WORDS 3456
#define XB_SPIN_CAP (1u << 18)

__device__ __forceinline__ unsigned xb_ld(unsigned* p)              { return __hip_atomic_load(p, __ATOMIC_RELAXED, __HIP_MEMORY_SCOPE_AGENT); }
__device__ __forceinline__ unsigned xb_add(unsigned* p, unsigned v) { return __hip_atomic_fetch_add(p, v, __ATOMIC_RELAXED, __HIP_MEMORY_SCOPE_AGENT); }
__device__ __forceinline__ unsigned xb_xcc_id() { return (unsigned)__builtin_amdgcn_s_getreg((3 << 11) | 20) & 0xFu; }
#define XB_SPIN(cond, bar) do { unsigned _sp = 0; while (cond) { __builtin_amdgcn_s_sleep(1); \
    if ((++_sp & 255u) == 0u) { if (xb_ld(&(bar)[XB_TMO])) break; if (_sp > XB_SPIN_CAP) { atomicAdd(&(bar)[XB_TMO], 1u); break; } } } } while (0)

struct XcdBarrier {
    unsigned* bar; unsigned x;
    volatile LAS unsigned* st;
};

__device__ __forceinline__ XcdBarrier xcd_barrier_post(unsigned* bar, volatile LAS unsigned* st, const int tid_) {
    XcdBarrier b; b.bar = bar; b.x = xb_xcc_id(); b.st = st;
    if (tid_ == 0) (void)xb_add(&bar[XB_XCNT(b.x)], 1u);
    return b;
}
__device__ __forceinline__ void xcd_barrier_complete(unsigned* bar, unsigned x, unsigned& nloc, unsigned& nx) {
    const unsigned G = gridDim.x * gridDim.y * gridDim.z;
    unsigned sum, cnt, mine, sp = 0u;
    for (;;) {
        sum = 0u; cnt = 0u; mine = 0u;
#pragma unroll
        for (unsigned j = 0; j < 16; ++j) { const unsigned c = xb_ld(&bar[XB_XCNT(j)]); sum += c; cnt += (c > 0u) ? 1u : 0u; mine = (j == x) ? c : mine; }
        if (sum == G) break;
        __builtin_amdgcn_s_sleep(1);
        if ((++sp & 255u) == 0u) { if (xb_ld(&bar[XB_TMO])) break; if (sp > XB_SPIN_CAP) { atomicAdd(&bar[XB_TMO], 1u); break; } }
    }
    nloc = mine > 0u ? mine : 1u; nx = cnt > 0u ? cnt : 1u;
}

__device__ __forceinline__ void xcd_barrier(const XcdBarrier& b, const int tid_) {
    asm volatile("s_waitcnt vmcnt(0)" ::: "memory");
    __syncthreads();
    if (tid_ == 0) {
        unsigned* bar = b.bar;
        __builtin_amdgcn_s_waitcnt(0);
        unsigned nloc = b.st[0], nx = b.st[1];
        if (nloc == 0u) { xcd_barrier_complete(bar, b.x, nloc, nx); b.st[0] = nloc; b.st[1] = nx; }
        const unsigned old = xb_add(&bar[XB_XSUB(b.x)], 1u);
        const unsigned gen = old / nloc;
        if (old + 1u == (gen + 1u) * nloc) {
            __builtin_amdgcn_fence(__ATOMIC_RELEASE, "agent");
            asm volatile("s_waitcnt vmcnt(0)" ::: "memory");
            const unsigned og = xb_add(&bar[XB_TOP], 1u);
            const unsigned tg = og / nx;
            if (og + 1u == (tg + 1u) * nx) xb_add(&bar[XB_TOPGEN], 1u);
            else XB_SPIN(xb_ld(&bar[XB_TOPGEN]) == tg, bar);
            __builtin_amdgcn_fence(__ATOMIC_ACQUIRE, "agent");
            xb_add(&bar[XB_XGEN(b.x)], 1u);
            asm volatile("s_waitcnt vmcnt(0)" ::: "memory");
        } else {
            XB_SPIN(xb_ld(&bar[XB_XGEN(b.x)]) == gen, bar);
            __builtin_amdgcn_fence(__ATOMIC_ACQUIRE, "agent");
            asm volatile("s_waitcnt vmcnt(0)" ::: "memory");
        }
    }
    __syncthreads();
}

constexpr int D = 1024, NP = 16384, NS = 512, M = NP + NS, INW = 3072, FF = 4096, TP = 4096;
constexpr int C_AV = 0, C_AG = 256, C_Q = 512, C_F = 1024, C_I = 1536, C_G = 2048, C_QA = 2560, C_KA = 2816, C_VA = 2944;
constexpr int MODR = 132, MODLD = 6144;
constexpr float EPS = 1e-6f;
constexpr size_t O_CONVP = (size_t)M * D, O_CONVS = O_CONVP + 2 * 4 * 30 * 256, O_HGP = O_CONVS + 2 * 128 * 30 * 256, O_HGS = O_HGP + 2 * 4 * 4 * 16384,
                 O_KP = O_HGS + (size_t)2 * 128 * 4 * 16384, O_KS = O_KP + 2 * 4 * 128 * 128, O_VP = O_KS + (size_t)2 * 128 * 128 * 128, O_VS = O_VP + 2 * 4 * 128 * 128,
                 O_END = O_VS + (size_t)2 * 128 * 128 * 128;
constexpr size_t MiB = 1u << 20;
constexpr size_t WS_CTL = 0, CTL_ZERO_BYTES = 1 * MiB, WS_TAB = 1 * MiB, WS_MOD = 2 * MiB, WS_DC = 9 * MiB, WS_WIN = 10 * MiB, WS_WOUT = 22 * MiB, WS_WUP = 26 * MiB, WS_WDN = 42 * MiB,
                 WS_XN = 58 * MiB, WS_HG = 58 * MiB, WS_PROJ = 91 * MiB, WS_MIX = 190 * MiB, WS_HB = 91 * MiB, WS_SHB = 224 * MiB, WS_SHW = 226 * MiB, WS_END = 236 * MiB;
constexpr size_t CTL_RSS = 65536;
constexpr size_t WS_SC = WS_TAB + 65536;
constexpr int CW_BAR = 4096;
constexpr int RING_BYTES = 131072, LDSCTL_OFF = RING_BYTES, MISC_OFF = LDSCTL_OFF + 320, LDS_BYTES = 147456;
constexpr int NPH = 21;

typedef float f32x16 __attribute__((ext_vector_type(16)));
typedef unsigned v2u __attribute__((ext_vector_type(2)));
__device__ __forceinline__ float bf2f(unsigned h) { return __builtin_bit_cast(float, h << 16); }
__device__ __forceinline__ float wave_sum(float v) {
#pragma unroll
    for (int o = 1; o < 64; o <<= 1) v += __shfl_xor(v, o);
    return v;
}
__device__ __forceinline__ float wave_max(float v) {
#pragma unroll
    for (int o = 1; o < 64; o <<= 1) v = fmaxf(v, __shfl_xor(v, o));
    return v;
}
__device__ __forceinline__ int modrow(int r) { return r < NP ? (r >> 12) : 4 + ((r - NP) >> 2); }
__device__ __forceinline__ int crow(int r, int hi) { return (r & 3) + 8 * (r >> 2) + 4 * hi; }
__device__ __forceinline__ bf16x8 pk8(float a0, float a1, float a2, float a3, float a4, float a5, float a6, float a7) {
    v4u w; w.x = pk2(a0, a1); w.y = pk2(a2, a3); w.z = pk2(a4, a5); w.w = pk2(a6, a7); return __builtin_bit_cast(bf16x8, w);
}
__device__ __forceinline__ float sigm(float x) { return __builtin_amdgcn_rcpf(1.f + __expf(-x)); }
#define MFMA32(a, b, c) __builtin_amdgcn_mfma_f32_32x32x16_bf16((a), (b), (c), 0, 0, 0)
#define MFMA16(a, b, c) __builtin_amdgcn_mfma_f32_16x16x32_bf16((a), (b), (c), 0, 0, 0)

#ifndef PROBE_SPIN
#define PROBE_SPIN -1
#endif
#ifndef PROBE_N
#define PROBE_N 0
#endif
#define TSEC_BEGIN(k) const unsigned long long ts0_##k = PROBE_SPIN == (k) ? __builtin_amdgcn_s_memrealtime() : 0ull
#define TSEC_END(k) do { if (PROBE_SPIN == (k)) { const unsigned long long ts1_ = __builtin_amdgcn_s_memrealtime(), du_ = (ts1_ - ts0_##k) * PROBE_N; while (__builtin_amdgcn_s_memrealtime() - ts1_ < du_) __builtin_amdgcn_s_sleep(4); } } while (0)
struct Args { const float* in[25]; float* out; unsigned char* ws; int ph_lo, ph_hi; };
struct Ctx {
    LAS unsigned char* lds;
    int tid, lane, wave, G, bid, z;
    float* out; unsigned char* ws;
};

__device__ __forceinline__ void p0_transpose_item(const float* W, int K, int N, bf16* WT, LAS float* scr, int item, int lane) {
    const int nblk = N / 32, kb = item / nblk, nb = item % nblk, k0 = 64 * kb, n0 = 32 * nb;
    float tv[32];
#pragma unroll
    for (int i = 0; i < 32; ++i) { const int kk = 2 * i + (lane >> 5); tv[i] = W[(size_t)(k0 + kk) * N + n0 + (lane & 31)]; }
    __builtin_amdgcn_sched_barrier(0);
#pragma unroll
    for (int i = 0; i < 32; ++i) { const int kk = 2 * i + (lane >> 5); scr[kk * 33 + (lane & 31)] = tv[i]; }
    LDS_WAIT(); asm volatile("" ::: "memory");
    const int c = lane & 7;
#pragma unroll
    for (int j = 0; j < 4; ++j) { const int n = (lane >> 3) + 8 * j; const LAS float* s = scr + (8 * c) * 33 + n;
        v4u o; o.x = pk2(s[0 * 33], s[1 * 33]); o.y = pk2(s[2 * 33], s[3 * 33]); o.z = pk2(s[4 * 33], s[5 * 33]); o.w = pk2(s[6 * 33], s[7 * 33]);
        *(GAS v4u*)(WT + (size_t)(n0 + n) * K + k0 + 8 * c) = o; }
    LDS_WAIT(); asm volatile("" ::: "memory");
}
__device__ __forceinline__ void mod_unit(const Args& A, Ctx& F, int u) {
    const int l = u / 192, n0 = 32 * (u % 192), k0 = 128 * F.wave, c = F.lane & 31, h2 = F.lane >> 5;
    const float* W = A.in[9 + F.z] + (size_t)l * 1024 * 6144;
    f32x16 acc[5];
#pragma unroll
    for (int i = 0; i < 5; ++i)
#pragma unroll
        for (int e = 0; e < 16; ++e) acc[i][e] = 0.f;
    const bf16* SC = (const bf16*)(F.ws + WS_SC);
    LAS unsigned char* WL = F.lds + F.wave * 16384;
    const int lr = F.lane >> 3, lp = F.lane & 7;
    TSEC_BEGIN(42);
    __syncthreads();
#pragma unroll 1
    for (int jh = 0; jh < 2; ++jh) {
        const int kh = k0 + 64 * jh;
        float wv[4][8];
#pragma unroll
        for (int j = 0; j < 4; ++j)
#pragma unroll
            for (int e = 0; e < 8; ++e) wv[j][e] = W[(size_t)(kh + 16 * j + 8 * h2 + e) * 6144 + n0 + c];
        v4u rs[16];
#pragma unroll
        for (int t = 0; t < 16; ++t) rs[t] = *(const v4u*)(SC + (size_t)(4 + 8 * t + lr) * 1024 + kh + 8 * lp);
        bf16x8 ap4[4];
#pragma unroll
        for (int j = 0; j < 4; ++j) { ap4[j] = (bf16x8){0, 0, 0, 0, 0, 0, 0, 0}; if (c < 4) ap4[j] = *(const bf16x8*)(SC + (size_t)c * 1024 + kh + 16 * j + 8 * h2); }
        __builtin_amdgcn_sched_barrier(0);
#pragma unroll
        for (int t = 0; t < 16; ++t) { const int r = 8 * t + lr; *(LAS v4u*)(WL + r * 128 + ((lp ^ (r & 7)) << 4)) = rs[t]; }
        __builtin_amdgcn_sched_barrier(0);
#pragma unroll
        for (int j = 0; j < 4; ++j) {
            const bf16x8 b = pk8(wv[j][0], wv[j][1], wv[j][2], wv[j][3], wv[j][4], wv[j][5], wv[j][6], wv[j][7]);
            acc[0] = MFMA32(ap4[j], b, acc[0]);
#pragma unroll
            for (int rt = 1; rt < 5; ++rt) { const int r = 32 * (rt - 1) + c; const bf16x8 af = *(const LAS bf16x8*)(WL + r * 128 + (((2 * j + h2) ^ (r & 7)) << 4)); acc[rt] = MFMA32(af, b, acc[rt]); }
        }
        __builtin_amdgcn_sched_barrier(0);
    }
    TSEC_END(42);
    TSEC_BEGIN(43);
    LAS float* RED = (LAS float*)F.lds;
#define RED_WR(slot) do { _Pragma("unroll") for (int rt = 0; rt < 5; ++rt) _Pragma("unroll") for (int e = 0; e < 16; ++e) RED[(slot) * 5120 + (rt * 16 + e) * 64 + F.lane] = acc[rt][e]; } while (0)
#define RED_ADD(slot) do { _Pragma("unroll") for (int rt = 0; rt < 5; ++rt) _Pragma("unroll") for (int e = 0; e < 16; ++e) acc[rt][e] += RED[(slot) * 5120 + (rt * 16 + e) * 64 + F.lane]; } while (0)
    __syncthreads();
    if (F.wave >= 4) RED_WR(F.wave - 4);
    __syncthreads();
    if (F.wave < 4) RED_ADD(F.wave);
    __syncthreads();
    if (F.wave == 2 || F.wave == 3) RED_WR(F.wave - 2);
    __syncthreads();
    if (F.wave < 2) RED_ADD(F.wave);
    __syncthreads();
    if (F.wave == 1) RED_WR(0);
    __syncthreads();
    if (F.wave == 0) {
        RED_ADD(0);
        float* mo = (float*)(F.ws + WS_MOD) + (size_t)l * MODR * MODLD;
        const float bias = A.in[10 + F.z][l * MODLD + n0 + c];
#pragma unroll
        for (int rt = 0; rt < 5; ++rt)
#pragma unroll
            for (int e = 0; e < 16; ++e) { const int cr = crow(e, h2), r = rt == 0 ? cr : 4 + 32 * (rt - 1) + cr; if (rt > 0 || cr < 4) mo[(size_t)r * MODLD + n0 + c] = acc[rt][e] + bias; }
    }
#undef RED_WR
#undef RED_ADD
    TSEC_END(43);
}
__device__ __forceinline__ void p0_prologue(const Args& A, Ctx& F) {
    LAS float* scr = (LAS float*)(F.lds + F.wave * 16384);
    const int gw = F.bid * 8 + F.wave, NGW = F.G * 8;
    TSEC_BEGIN(40);
    for (int it = gw; it < 12288; it += NGW) {
        const int l = it / 6144; int r = it % 6144;
        if (r < 1536) { p0_transpose_item(A.in[12 + F.z] + (size_t)l * 1024 * 3072, 1024, 3072, (bf16*)(F.ws + WS_WIN) + (size_t)l * 3072 * 1024, scr, r, F.lane); continue; } r -= 1536;
        if (r < 512) { p0_transpose_item(A.in[20 + F.z] + (size_t)l * 1024 * 1024, 1024, 1024, (bf16*)(F.ws + WS_WOUT) + (size_t)l * 1024 * 1024, scr, r, F.lane); continue; } r -= 512;
        if (r < 2048) { p0_transpose_item(A.in[22 + F.z] + (size_t)l * 1024 * 4096, 1024, 4096, (bf16*)(F.ws + WS_WUP) + (size_t)l * 4096 * 1024, scr, r, F.lane); continue; } r -= 2048;
        p0_transpose_item(A.in[23 + F.z] + (size_t)l * 4096 * 1024, 4096, 1024, (bf16*)(F.ws + WS_WDN) + (size_t)l * 1024 * 4096, scr, r, F.lane);
    }
    TSEC_END(40);
    if (F.bid == 0) {
        float* BT = (float*)(F.ws + WS_TAB); float* LB1 = BT + 1024;
        for (int i = F.tid; i < 129 * 4; i += 512) { const int rel = i >> 2, h = i & 3; int bk = rel;
            if (rel >= 16) { bk = 16 + (int)(logf((float)rel / 16.f) / logf(8.f) * 16.f); bk = bk > 31 ? 31 : bk; }
            BT[i] = A.in[8 + F.z][bk * 4 + h]; }
        { const int i = F.tid; const float a = A.in[17 + F.z][i], b = A.in[17 + F.z][512 + i], mx = fmaxf(a, b), ea = expf(a - mx), eb = expf(b - mx); LB1[i] = eb / (ea + eb); }
    }
    for (int i = F.bid * 512 + F.tid; i < 160 * 128; i += F.G * 512) {
        const int r = i >> 7, k8 = 8 * (i & 127);
        v4u o = {0u, 0u, 0u, 0u};
        if (r < MODR) { const float* cp = (r < 4 ? A.in[6 + F.z] + r * 1024 : A.in[7 + F.z] + (r - 4) * 1024) + k8; const f32x4 c0 = *(const f32x4*)cp, c1 = *(const f32x4*)(cp + 4);
            o.x = pk2(c0.x * sigm(c0.x), c0.y * sigm(c0.y)); o.y = pk2(c0.z * sigm(c0.z), c0.w * sigm(c0.w)); o.z = pk2(c1.x * sigm(c1.x), c1.y * sigm(c1.y)); o.w = pk2(c1.z * sigm(c1.z), c1.w * sigm(c1.w)); }
        *(v4u*)((bf16*)(F.ws + WS_SC) + (size_t)r * 1024 + k8) = o;
    }
}
__device__ __forceinline__ void mod_phase(const Args& A, Ctx& F) {
    TSEC_BEGIN(41);
    if ((F.G & 7) == 0) { const int xg = F.bid & 7, wpx = F.G >> 3; for (int w = F.bid >> 3; w < 48; w += wpx) mod_unit(A, F, xg * 48 + w); }
    else for (int u = F.bid; u < 384; u += F.G) mod_unit(A, F, u);
    TSEC_END(41);
}
__device__ __forceinline__ void norm_phase(const Args& A, Ctx& F, int l, int which) {
    if (l == 0 && which == 0) {
        const float* MODp = (const float*)(F.ws + WS_MOD);
        for (int i = F.bid * 512 + F.tid; i < 3 * 192 * 128; i += F.G * 512) {
            const int f = i / (192 * 128), r = (i >> 7) % 192, k8 = 8 * (i & 127);
            v4u o = {0u, 0u, 0u, 0u};
            if (r < MODR) { const float* sp = MODp + (size_t)(f == 0 ? 0 : 1) * MODR * MODLD + (size_t)r * MODLD + (f == 1 ? 0 : 3 * D) + k8; const f32x4 c0 = *(const f32x4*)sp, c1 = *(const f32x4*)(sp + 4);
                o.x = pk2(c0.x, c0.y); o.y = pk2(c0.z, c0.w); o.z = pk2(c1.x, c1.y); o.w = pk2(c1.z, c1.w); }
            *(v4u*)((bf16*)(F.ws + WS_SHB) + (size_t)(f * 192 + r) * 1024 + k8) = o;
        }
    }
    const int gw = F.bid * 8 + F.wave, NGW = F.G * 8;
    const float* gamma = which == 0 ? A.in[11 + F.z] + l * D : (which == 1 ? A.in[21 + F.z] + l * D : A.in[24 + F.z]);
    const float* mod = (const float*)(F.ws + WS_MOD) + (size_t)l * MODR * MODLD;
    const int shc = which == 0 ? 0 : 3 * D, scc = shc + D;
    const bool from_in = (which == 0 && l == 0);
    bf16* XN = (bf16*)(F.ws + WS_XN);
    f32x4 gm[4];
#pragma unroll
    for (int j = 0; j < 4; ++j) gm[j] = *(const f32x4*)(gamma + 4 * F.lane + 256 * j);
    constexpr int NR = 4;
    for (int m0 = gw; m0 < M; m0 += NR * NGW) {
        f32x4 v[NR][4], msc[NR][4], msh[NR][4];
#pragma unroll
        for (int r = 0; r < NR; ++r) { const int mr_ = m0 + r * NGW, m = mr_ < M ? mr_ : m0;
            const float* xr = from_in ? (m < NP ? A.in[0 + F.z] + (size_t)m * D : A.in[1 + F.z] + (size_t)(m - NP) * D) : F.out + (size_t)m * D;
#pragma unroll
            for (int j = 0; j < 4; ++j) v[r][j] = *(const f32x4*)(xr + 4 * F.lane + 256 * j);
            if (which != 2) { const float* mr = mod + (size_t)modrow(m) * MODLD;
#pragma unroll
                for (int j = 0; j < 4; ++j) { msc[r][j] = *(const f32x4*)(mr + scc + 4 * F.lane + 256 * j); msh[r][j] = *(const f32x4*)(mr + shc + 4 * F.lane + 256 * j); } } }
        __builtin_amdgcn_sched_barrier(0);
        float ssq[NR];
#pragma unroll
        for (int r = 0; r < NR; ++r) { ssq[r] = 0.f;
#pragma unroll
            for (int j = 0; j < 4; ++j) ssq[r] += (v[r][j].x * v[r][j].x + v[r][j].y * v[r][j].y) + (v[r][j].z * v[r][j].z + v[r][j].w * v[r][j].w); }
#pragma unroll
        for (int o = 1; o < 64; o <<= 1) {
            float t_[NR];
#pragma unroll
            for (int r = 0; r < NR; ++r) t_[r] = __shfl_xor(ssq[r], o);
#pragma unroll
            for (int r = 0; r < NR; ++r) ssq[r] += t_[r];
        }
#pragma unroll
        for (int r = 0; r < NR; ++r) {
            const int m = m0 + r * NGW;
            if (m < M) {
                const float rstd = __builtin_amdgcn_rsqf(ssq[r] * (1.f / D) + EPS);
                if (which == 2) {
#pragma unroll
                    for (int j = 0; j < 4; ++j) *(f32x4*)(F.out + (size_t)m * D + 4 * F.lane + 256 * j) = v[r][j] * rstd * gm[j];
                } else {
#pragma unroll
                    for (int j = 0; j < 4; ++j) { const f32x4 y = v[r][j] * rstd * gm[j] * (msc[r][j] + 1.f) + msh[r][j]; v2u w; w.x = pk2(y.x, y.y); w.y = pk2(y.z, y.w);
                        *(v2u*)(XN + (size_t)m * D + 4 * F.lane + 256 * j) = w; }
                }
            }
        }
    }
}

constexpr int RS = 272;
constexpr int RS64 = 144;
struct HgGate { float cl[16], kf[16]; };
__device__ __forceinline__ void hg_gates(const float lb, const LAS unsigned short* rawf  , int d, HgGate& g) {
    float run = 0.f;
#pragma unroll
    for (int j = 0; j < 16; ++j) {
        const float x = bf2f(rawf[j * (RS / 2) + d]);
        const float e = __expf(-x), sg = __builtin_amdgcn_rcpf(1.f + e);
        const float f = lb + (1.f - lb) * sg;
        g.kf[j] = (1.f - lb) * e * sg;
        run += __logf(f); g.cl[j] = run;
    }
}
__device__ __forceinline__ void tile_load(const bf16* g0  , int tid, v4u (&r)[2]) {
#pragma unroll
    for (int i = 0; i < 2; ++i) { const int it = tid + 512 * i; r[i] = *(const v4u*)(g0 + (size_t)(it >> 4) * INW + 8 * (it & 15)); }
    __builtin_amdgcn_sched_barrier(0);
}
__device__ __forceinline__ void tile_store(LAS unsigned char* dst, int tid, const v4u (&r)[2]) {
#pragma unroll
    for (int i = 0; i < 2; ++i) { const int it = tid + 512 * i; *(LAS v4u*)(dst + (it >> 4) * RS + 16 * (it & 15)) = r[i]; }
}
__device__ __forceinline__ void h1_load(Ctx& F, int u, v4u (&rf)[2], v4u (&rv)[2]) {
    const int bh = u >> 6, b = bh >> 2, h = bh & 3, ch = u & 63, m0 = b * TP + ch * 64;
    const bf16* PROJ = (const bf16*)(F.ws + WS_PROJ);
    tile_load(PROJ + (size_t)m0 * INW + C_F + h * 128, F.tid, rf); tile_load(PROJ + (size_t)m0 * INW + C_I + h * 128, F.tid, rv);
}
__device__ __forceinline__ void h1_unit(const Args& A, Ctx& F, int l, int u, const v4u (&rf)[2], const v4u (&rv)[2]) {
    const int bh = u >> 6, b = bh >> 2, h = bh & 3, ch = u & 63, m0 = b * TP + ch * 64;
    const int d = F.tid & 127, sc = F.tid >> 7, c = F.lane & 31, h2 = F.lane >> 5;
    const bf16* PROJ = (const bf16*)(F.ws + WS_PROJ);
    LAS unsigned char* L = F.lds;
    constexpr int OKDT = 0, OVT = 128 * RS64, OTOT = 2 * 128 * RS64, ORF = OTOT + 2048, ORV = ORF + 64 * RS;
    LAS unsigned short* KDT = (LAS unsigned short*)(L + OKDT);
    LAS unsigned short* VT = (LAS unsigned short*)(L + OVT);
    LAS float* TOT = (LAS float*)(L + OTOT);
    const float lb = l == 0 ? 0.f : ((const float*)(F.ws + WS_TAB))[1024 + h * 128 + d];
    __syncthreads();
    tile_store(L + ORF, F.tid, rf); tile_store(L + ORV, F.tid, rv);
    __syncthreads();
    HgGate g; hg_gates(lb, (const LAS unsigned short*)(L + ORF + sc * 16 * RS), d, g);
    TOT[sc * 128 + d] = g.cl[15];
#pragma unroll
    for (int j = 0; j < 16; ++j) VT[d * (RS64 / 2) + sc * 16 + j] = ((const LAS unsigned short*)(L + ORV))[(sc * 16 + j) * (RS / 2) + d];
    __syncthreads();
    float after = 0.f;
#pragma unroll
    for (int i = 1; i < 4; ++i) if (i > sc) after += TOT[i * 128 + d];
    const float tot = g.cl[15];
#pragma unroll
    for (int j = 0; j < 16; ++j) KDT[d * (RS64 / 2) + sc * 16 + j] = (unsigned short)f2bf(g.kf[j] * __expf(after + tot - g.cl[j]));
    if (sc == 0) ((float*)(F.ws + WS_DC))[u * 128 + d] = __expf(after + tot);
    __syncthreads();
    const int vt = F.wave >> 1, dt0 = 2 * (F.wave & 1);
    f32x16 acc0, acc1;
#pragma unroll
    for (int e = 0; e < 16; ++e) { acc0[e] = 0.f; acc1[e] = 0.f; }
#pragma unroll
    for (int ks = 0; ks < 4; ++ks) {
        const bf16x8 a = *(const LAS bf16x8*)(L + OVT + (32 * vt + c) * RS64 + (16 * ks + 8 * h2) * 2);
        const bf16x8 b0 = *(const LAS bf16x8*)(L + OKDT + (32 * dt0 + c) * RS64 + (16 * ks + 8 * h2) * 2);
        const bf16x8 b1 = *(const LAS bf16x8*)(L + OKDT + (32 * dt0 + 32 + c) * RS64 + (16 * ks + 8 * h2) * 2);
        acc0 = MFMA32(a, b0, acc0); acc1 = MFMA32(a, b1, acc1);
    }
    LAS unsigned short* OT = (LAS unsigned short*)(L + ORF);
#pragma unroll
    for (int e = 0; e < 16; ++e) { const int v = 32 * vt + crow(e, h2);
        OT[v * (RS / 2) + 32 * dt0 + c] = (unsigned short)f2bf(acc0[e]); OT[v * (RS / 2) + 32 * dt0 + 32 + c] = (unsigned short)f2bf(acc1[e]); }
    __syncthreads();
    bf16* HG = (bf16*)(F.ws + WS_HG) + (size_t)u * 16384;
#pragma unroll
    for (int i = 0; i < 4; ++i) { const int it = F.tid + 512 * i, v = it >> 4, ch16 = it & 15;
        *(v4u*)(HG + v * 128 + 8 * ch16) = *(const LAS v4u*)(L + ORF + v * RS + 16 * ch16); }
}
__device__ __forceinline__ void h2_scan(const Args& A, Ctx& F, int l) {
    unsigned* HG32 = (unsigned*)(F.ws + WS_HG); const float* DC = (const float*)(F.ws + WS_DC);
    for (int gid = F.bid * 512 + F.tid; gid < 16 * 8192; gid += F.G * 512) {
        const int bh = gid >> 13, e2 = gid & 8191, v = e2 >> 6, d = 2 * (e2 & 63);
        float s0 = 0.f, s1 = 0.f;
        for (int c0 = 0; c0 < 64; c0 += 16) {
            unsigned kc[16]; float d0[16], d1[16];
#pragma unroll
            for (int i = 0; i < 16; ++i) { const int u = bh * 64 + c0 + i; kc[i] = HG32[(size_t)u * 8192 + e2]; d0[i] = DC[u * 128 + d]; d1[i] = DC[u * 128 + d + 1]; }
            __builtin_amdgcn_sched_barrier(0);
#pragma unroll
            for (int i = 0; i < 16; ++i) { const int u = bh * 64 + c0 + i;
                HG32[(size_t)u * 8192 + e2] = pk2(s0, s1);
                s0 = d0[i] * s0 + bf2f(kc[i] & 0xffffu); s1 = d1[i] * s1 + bf2f(kc[i] >> 16); }
        }
        float* o = F.out + O_HGP + ((size_t)l * 16 + bh) * 16384;
        o[d * 128 + v] = s0; o[(d + 1) * 128 + v] = s1;
    }
}
__device__ __forceinline__ void h3_load(Ctx& F, int u, v4u (&rf)[2], v4u (&rq)[2], v4u (&rv)[2]) {
    const int bh = u >> 6, b = bh >> 2, h = bh & 3, ch = u & 63, m0 = b * TP + ch * 64;
    const bf16* PROJ = (const bf16*)(F.ws + WS_PROJ);
    tile_load(PROJ + (size_t)m0 * INW + C_F + h * 128, F.tid, rf); tile_load(PROJ + (size_t)m0 * INW + C_Q + h * 128, F.tid, rq); tile_load(PROJ + (size_t)m0 * INW + C_I + h * 128, F.tid, rv);
}
__device__ __forceinline__ void h3_unit(const Args& A, Ctx& F, int l, int u, const v4u (&rf)[2], const v4u (&rq)[2], const v4u (&rv)[2], int un, v4u (&nf)[2], v4u (&nq)[2], v4u (&nv)[2]) {
    const int bh = u >> 6, b = bh >> 2, h = bh & 3, ch = u & 63, m0 = b * TP + ch * 64;
    const int d = F.tid & 127, sc = F.tid >> 7, c = F.lane & 31, h2 = F.lane >> 5;
    const bf16* PROJ = (const bf16*)(F.ws + WS_PROJ);
    LAS unsigned char* L = F.lds;
    constexpr int OQH = 0, OKH = 64 * RS, OKC = 2 * 64 * RS, OQG = 3 * 64 * RS, OQT = OQG + 48 * RS, OAM = OQT + 64 * RS, OVT = OAM + 64 * RS64, OTOT = OVT + 128 * RS64, OEND = OTOT + 2048;
    static_assert(OEND <= RING_BYTES, "h3 LDS map");
    LAS unsigned short* QH = (LAS unsigned short*)(L + OQH); LAS unsigned short* KH = (LAS unsigned short*)(L + OKH); LAS unsigned short* KC = (LAS unsigned short*)(L + OKC);
    LAS unsigned short* QG = (LAS unsigned short*)(L + OQG); LAS unsigned short* QT = (LAS unsigned short*)(L + OQT); LAS unsigned short* AM = (LAS unsigned short*)(L + OAM);
    LAS unsigned short* VT = (LAS unsigned short*)(L + OVT); LAS float* TOT = (LAS float*)(L + OTOT); LAS float* O32 = (LAS float*)(L + OQH);
    TSEC_BEGIN(30);
    const float lb = l == 0 ? 0.f : ((const float*)(F.ws + WS_TAB))[1024 + h * 128 + d];
    f32x4 gnv[4];
#pragma unroll
    for (int i = 0; i < 4; ++i) gnv[i] = *(const f32x4*)(A.in[18 + F.z] + l * 128 + (F.tid & 7) * 16 + 4 * i);
    __syncthreads();
    tile_store(L + OQH, F.tid, rf); tile_store(L + OKH, F.tid, rq); tile_store(L + OKC, F.tid, rv);
    const bf16* gp = PROJ + (size_t)(m0 + (F.tid >> 3)) * INW + C_G + h * 128 + (F.tid & 7) * 16;
    const v4u g0 = *(const v4u*)gp, g1 = *(const v4u*)(gp + 8);
    const bf16* Srow = (const bf16*)(F.ws + WS_HG) + (size_t)u * 16384 + (size_t)(32 * (F.wave & 3) + c) * 128 + 8 * h2;
    bf16x8 sb[8];
#pragma unroll
    for (int ks = 0; ks < 8; ++ks) sb[ks] = *(const bf16x8*)(Srow + 16 * ks);
    __builtin_amdgcn_sched_barrier(0);
    for (int i = F.tid; i < 64 * RS64 / 4; i += 512) ((LAS unsigned*)AM)[i] = 0u;
    __syncthreads();
    TSEC_END(30);
    TSEC_BEGIN(31);
    HgGate g; hg_gates(lb, (const LAS unsigned short*)(L + OQH + sc * 16 * RS), d, g);
    float q[16];
#pragma unroll
    for (int j = 0; j < 16; ++j) q[j] = bf2f(((const LAS unsigned short*)(L + OKH))[(sc * 16 + j) * (RS / 2) + d]);
    TOT[sc * 128 + d] = g.cl[15];
#pragma unroll
    for (int j = 0; j < 16; ++j) VT[d * (RS64 / 2) + sc * 16 + j] = ((const LAS unsigned short*)(L + OKC))[(sc * 16 + j) * (RS / 2) + d];
    __syncthreads();
    TSEC_END(31);
    TSEC_BEGIN(32);
    const float t0 = TOT[d], t1 = TOT[128 + d], t2 = TOT[256 + d];
    const float rsc = sc == 0 ? 0.f : (sc == 1 ? t0 : (sc == 2 ? t0 + t1 : t0 + t1 + t2));
    const float ers = __expf(rsc), tot = g.cl[15];
    const float ga = sc == 2 ? __expf(t1) : __expf(t1 + t2), gb = __expf(t2);
#pragma unroll
    for (int j = 0; j < 16; ++j) {
        const int row = sc * 16 + j;
        const float qh = q[j] * __expf(g.cl[j]);
        QH[row * (RS / 2) + d] = (unsigned short)f2bf(qh);
        QT[row * (RS / 2) + d] = (unsigned short)f2bf(qh * ers);
        if (sc == 2) QG[j * (RS / 2) + d] = (unsigned short)f2bf(qh * ga);
        if (sc == 3) { QG[(16 + j) * (RS / 2) + d] = (unsigned short)f2bf(qh * ga); QG[(32 + j) * (RS / 2) + d] = (unsigned short)f2bf(qh * gb); }
        KH[row * (RS / 2) + d] = (unsigned short)f2bf(g.kf[j] * __expf(tot - g.cl[j]));
        KC[row * (RS / 2) + d] = (unsigned short)f2bf(g.kf[j] * __expf(-g.cl[j]));
    }
    h3_load(F, un, nf, nq, nv);
    __syncthreads();
    TSEC_END(32);
    TSEC_BEGIN(33);
    {
        const int r16 = F.lane & 15, kq = F.lane >> 4;
        for (int blk = F.wave; blk < 10; blk += 8) {
            int bi, bj, qoff, koff;
            if (blk < 4) { bi = blk; bj = blk; qoff = OQH + 16 * bi * RS; koff = OKC + 16 * bj * RS; }
            else if (blk < 7) { bi = blk - 3; bj = bi - 1; qoff = OQH + 16 * bi * RS; koff = OKH + 16 * bj * RS; }
            else if (blk == 7) { bi = 2; bj = 0; qoff = OQG; koff = OKH; }
            else if (blk == 8) { bi = 3; bj = 0; qoff = OQG + 16 * RS; koff = OKH; }
            else { bi = 3; bj = 1; qoff = OQG + 32 * RS; koff = OKH + 16 * RS; }
            f32x4 a4 = {0.f, 0.f, 0.f, 0.f};
#pragma unroll
            for (int ks = 0; ks < 4; ++ks) {
                const bf16x8 qa = *(const LAS bf16x8*)(L + qoff + r16 * RS + (32 * ks + 8 * kq) * 2);
                const bf16x8 kb = *(const LAS bf16x8*)(L + koff + r16 * RS + (32 * ks + 8 * kq) * 2);
                a4 = MFMA16(qa, kb, a4);
            }
#pragma unroll
            for (int e = 0; e < 4; ++e) { const int t = 4 * kq + e; float val = a4[e]; if (bi == bj && r16 > t) val = 0.f;
                AM[(16 * bi + t) * (RS64 / 2) + 16 * bj + r16] = (unsigned short)f2bf(val); }
        }
    }
    __syncthreads();
    TSEC_END(33);
    TSEC_BEGIN(34);
    const int tt = F.wave >> 2, vt = F.wave & 3;
    f32x16 acc;
#pragma unroll
    for (int e = 0; e < 16; ++e) acc[e] = 0.f;
#pragma unroll
    for (int ks = 0; ks < 4; ++ks) {
        const bf16x8 a = *(const LAS bf16x8*)(L + OAM + (32 * tt + c) * RS64 + (16 * ks + 8 * h2) * 2);
        const bf16x8 bv = *(const LAS bf16x8*)(L + OVT + (32 * vt + c) * RS64 + (16 * ks + 8 * h2) * 2);
        acc = MFMA32(a, bv, acc);
    }
#pragma unroll
    for (int ks = 0; ks < 8; ++ks) {
        const bf16x8 a = *(const LAS bf16x8*)(L + OQT + (32 * tt + c) * RS + (16 * ks + 8 * h2) * 2);
        acc = MFMA32(a, sb[ks], acc);
    }
#pragma unroll
    for (int e = 0; e < 16; ++e) O32[(32 * tt + crow(e, h2)) * 132 + 32 * vt + c] = acc[e];
    __syncthreads();
    TSEC_END(34);
    TSEC_BEGIN(35);
    {
        const int t = F.tid >> 3, vq = F.tid & 7;
        float o[16]; float ss = 0.f;
#pragma unroll
        for (int i = 0; i < 4; ++i) { const f32x4 x = *(const LAS f32x4*)(O32 + t * 132 + vq * 16 + 4 * i); o[4 * i] = x.x; o[4 * i + 1] = x.y; o[4 * i + 2] = x.z; o[4 * i + 3] = x.w;
            ss += (x.x * x.x + x.y * x.y) + (x.z * x.z + x.w * x.w); }
        ss += __shfl_xor(ss, 1); ss += __shfl_xor(ss, 2); ss += __shfl_xor(ss, 4);
        const float rstd = __builtin_amdgcn_rsqf(ss * (1.f / 128.f) + EPS);
        const float gn[16] = {gnv[0].x, gnv[0].y, gnv[0].z, gnv[0].w, gnv[1].x, gnv[1].y, gnv[1].z, gnv[1].w, gnv[2].x, gnv[2].y, gnv[2].z, gnv[2].w, gnv[3].x, gnv[3].y, gnv[3].z, gnv[3].w};
        unsigned gw_[8] = {g0.x, g0.y, g0.z, g0.w, g1.x, g1.y, g1.z, g1.w};
        unsigned ow[8];
#pragma unroll
        for (int i = 0; i < 8; ++i) {
            const float ga0 = bf2f(gw_[i] & 0xffffu), ga1 = bf2f(gw_[i] >> 16);
            const float y0 = o[2 * i] * rstd * gn[2 * i] * (ga0 * sigm(ga0)), y1 = o[2 * i + 1] * rstd * gn[2 * i + 1] * (ga1 * sigm(ga1));
            ow[i] = pk2(y0, y1);
        }
        bf16* op = (bf16*)(F.ws + WS_MIX) + (size_t)(m0 + t) * D + 256 + h * 128 + vq * 16;
        v4u w0 = {ow[0], ow[1], ow[2], ow[3]}, w1 = {ow[4], ow[5], ow[6], ow[7]};
        *(v4u*)op = w0; *(v4u*)(op + 8) = w1;
    }
    TSEC_END(35);
}

__device__ __forceinline__ void conv_tail(const Args& A, Ctx& F, int l, f32x4 acc, bf16* orow) {
    const float mean = wave_sum((acc.x + acc.y) + (acc.z + acc.w)) * (1.f / 256.f);
    const f32x4 dv = acc - mean;
    const float rstd = __builtin_amdgcn_rsqf(wave_sum((dv.x * dv.x + dv.y * dv.y) + (dv.z * dv.z + dv.w * dv.w)) * (1.f / 256.f) + EPS);
    const f32x4 lg = *(const f32x4*)(A.in[15 + F.z] + l * 256 + 4 * F.lane), lb = *(const f32x4*)(A.in[16 + F.z] + l * 256 + 4 * F.lane);
    const f32x4 y = dv * rstd * lg + lb;
    v2u w; w.x = pk2(y.x * sigm(y.x), y.y * sigm(y.y)); w.y = pk2(y.z * sigm(y.z), y.w * sigm(y.w));
    *(v2u*)(orow + 4 * F.lane) = w;
}
__device__ __forceinline__ void conv_unit(const Args& A, Ctx& F, int l, int u) {
    const int b = u >> 6, tile = u & 63, t0 = tile * 64;
    const bf16* PROJ = (const bf16*)(F.ws + WS_PROJ);
    LAS float* AL = (LAS float*)F.lds;
    v4u sv[6], sg[6];
#pragma unroll
    for (int i = 0; i < 6; ++i) { const int it = F.tid + 512 * i, row = it >> 5, cg = it & 31, t = t0 - 30 + row;
        sv[i] = (v4u){0u, 0u, 0u, 0u}; sg[i] = sv[i];
        if (it < 94 * 32 && t >= 0) { const bf16* p = PROJ + (size_t)(b * TP + t) * INW + 8 * cg; sv[i] = *(const v4u*)(p + C_AV); sg[i] = *(const v4u*)(p + C_AG); } }
    __builtin_amdgcn_sched_barrier(0);
    __syncthreads();
#pragma unroll
    for (int i = 0; i < 6; ++i) { const int it = F.tid + 512 * i, row = it >> 5, cg = it & 31;
        if (it < 94 * 32) {
            const v4u vv = sv[i], gg = sg[i]; f32x4 a0, a1;
            a0.x = bf2f(vv.x & 0xffffu) * sigm(bf2f(gg.x & 0xffffu)); a0.y = bf2f(vv.x >> 16) * sigm(bf2f(gg.x >> 16));
            a0.z = bf2f(vv.y & 0xffffu) * sigm(bf2f(gg.y & 0xffffu)); a0.w = bf2f(vv.y >> 16) * sigm(bf2f(gg.y >> 16));
            a1.x = bf2f(vv.z & 0xffffu) * sigm(bf2f(gg.z & 0xffffu)); a1.y = bf2f(vv.z >> 16) * sigm(bf2f(gg.z >> 16));
            a1.z = bf2f(vv.w & 0xffffu) * sigm(bf2f(gg.w & 0xffffu)); a1.w = bf2f(vv.w >> 16) * sigm(bf2f(gg.w >> 16));
            *(LAS f32x4*)(AL + row * 256 + 8 * cg) = a0; *(LAS f32x4*)(AL + row * 256 + 8 * cg + 4) = a1; } }
    const f32x4 cb = *(const f32x4*)(A.in[14 + F.z] + l * 256 + 4 * F.lane);
    __syncthreads();
    f32x4 acc[8];
#pragma unroll
    for (int i = 0; i < 8; ++i) acc[i] = cb;
#pragma unroll
    for (int hf = 0; hf < 2; ++hf) {
        f32x4 cw[16];
#pragma unroll
        for (int j = 0; j < 16; ++j) if (16 * hf + j < 31) cw[j] = *(const f32x4*)(A.in[13 + F.z] + (size_t)(l * 31 + 16 * hf + j) * 256 + 4 * F.lane);
#pragma unroll
        for (int i = 0; i < 8; ++i) {
#pragma unroll
            for (int j = 0; j < 16; ++j) if (16 * hf + j < 31) acc[i] += cw[j] * *(const LAS f32x4*)(AL + (8 * F.wave + i + 16 * hf + j) * 256 + 4 * F.lane);
            asm volatile("" ::: "memory");
        }
    }
    {
        float s1[8], s2[8];
#pragma unroll
        for (int i = 0; i < 8; ++i) { s1[i] = (acc[i].x + acc[i].y) + (acc[i].z + acc[i].w); s2[i] = (acc[i].x * acc[i].x + acc[i].y * acc[i].y) + (acc[i].z * acc[i].z + acc[i].w * acc[i].w); }
#pragma unroll
        for (int o = 1; o < 64; o <<= 1) {
            float t1[8], t2[8];
#pragma unroll
            for (int i = 0; i < 8; ++i) { t1[i] = __shfl_xor(s1[i], o); t2[i] = __shfl_xor(s2[i], o); }
#pragma unroll
            for (int i = 0; i < 8; ++i) { s1[i] += t1[i]; s2[i] += t2[i]; }
        }
        const f32x4 lg = *(const f32x4*)(A.in[15 + F.z] + l * 256 + 4 * F.lane), lb = *(const f32x4*)(A.in[16 + F.z] + l * 256 + 4 * F.lane);
#pragma unroll
        for (int i = 0; i < 8; ++i) {
            const float mean = s1[i] * (1.f / 256.f), var = fmaxf(s2[i] * (1.f / 256.f) - mean * mean, 0.f);
            const float rstd = __builtin_amdgcn_rsqf(var + EPS);
            const f32x4 y = (acc[i] - mean) * rstd * lg + lb;
            v2u w; w.x = pk2(y.x * sigm(y.x), y.y * sigm(y.y)); w.y = pk2(y.z * sigm(y.z), y.w * sigm(y.w));
            *(v2u*)((bf16*)(F.ws + WS_MIX) + (size_t)(b * TP + t0 + 8 * F.wave + i) * D + 4 * F.lane) = w;
        }
    }
    if (tile == 63) {
        float* o = F.out + O_CONVP + (size_t)(l * 4 + b) * 30 * 256;
        for (int i = F.tid; i < 30 * 256; i += 512) o[i] = AL[64 * 256 + i];
    }
}
constexpr int VS = 528;
__device__ __forceinline__ void attn_unit(const Args& A, Ctx& F, int l, int u) {
    const int b = u >> 6, blk = (u >> 1) & 31, kvh = u & 1;
    const int c = F.lane & 31, h2 = F.lane >> 5;
    const bf16* PROJ = (const bf16*)(F.ws + WS_PROJ);
    LAS unsigned char* L = F.lds;
    LAS unsigned short* VTt = (LAS unsigned short*)L;
    LAS float* BTl = (LAS float*)(L + 64 * VS);
    const int tok0 = b * TP + (blk - 1) * 128;
    const int g = F.wave >> 2, qs = F.wave & 3, hq = 2 * kvh + g;
    const int mq = b * TP + blk * 128 + 32 * qs + c;
    bf16x8 bq[4];
#pragma unroll
    for (int ks = 0; ks < 4; ++ks) bq[ks] = *(const bf16x8*)(PROJ + (size_t)mq * INW + C_QA + hq * 64 + 16 * ks + 8 * h2);
#define ATTN_LOADK(dst, j) do { const int kidx_ = 32 * (qs + (j)) + c; const bool ex_ = (blk > 0 || kidx_ >= 128); \
        _Pragma("unroll") for (int ks = 0; ks < 4; ++ks) { dst[ks] = (bf16x8){0, 0, 0, 0, 0, 0, 0, 0}; \
            if (ex_) dst[ks] = *(const bf16x8*)(PROJ + (size_t)(tok0 + kidx_) * INW + C_KA + kvh * 64 + 16 * ks + 8 * h2); } } while (0)
    bf16x8 ak0[4], ak1[4];
    ATTN_LOADK(ak0, 0); ATTN_LOADK(ak1, 1);
    const float sink = A.in[19 + F.z][l * 4 + hq];
    float btv = 0.f; { const int gg = F.tid / 224, ix = F.tid % 224 - 32; if (F.tid < 448 && ix >= 0 && ix <= 128) btv = ((const float*)(F.ws + WS_TAB))[(128 - ix) * 4 + 2 * kvh + gg]; }
    __builtin_amdgcn_sched_barrier(0);
    __syncthreads();
    if (F.tid < 448) BTl[F.tid] = btv;
    f32x16 S[5];
#pragma unroll
    for (int j = 0; j < 5; ++j)
#pragma unroll
        for (int e = 0; e < 16; ++e) S[j][e] = 0.f;
    bf16x8 ak2[4], ak3[4];
    ATTN_LOADK(ak2, 2); ATTN_LOADK(ak3, 3);
    __builtin_amdgcn_sched_barrier(0);
#pragma unroll
    for (int ks = 0; ks < 4; ++ks) { S[0] = MFMA32(ak0[ks], bq[ks], S[0]); S[1] = MFMA32(ak1[ks], bq[ks], S[1]); }
    ATTN_LOADK(ak0, 4);
#pragma unroll
    for (int ks = 0; ks < 4; ++ks) { S[2] = MFMA32(ak2[ks], bq[ks], S[2]); S[3] = MFMA32(ak3[ks], bq[ks], S[3]); }
#pragma unroll
    for (int ks = 0; ks < 4; ++ks) S[4] = MFMA32(ak0[ks], bq[ks], S[4]);
#undef ATTN_LOADK
    v4u vst[4];
#pragma unroll
    for (int i = 0; i < 4; ++i) { const int it = F.tid + 512 * i, kidx = it >> 3, chn = it & 7; vst[i] = (v4u){0u, 0u, 0u, 0u};
        if (blk > 0 || kidx >= 128) vst[i] = *(const v4u*)(PROJ + (size_t)(tok0 + kidx) * INW + C_VA + kvh * 64 + 8 * chn); }
    __builtin_amdgcn_sched_barrier(0);
    __syncthreads();
    float mx = -INFINITY;
    const LAS float* trp = BTl + g * 224 + 32 + 4 * h2 - c;
#pragma unroll
    for (int j = 0; j < 5; ++j) {
        float bia[16];
#pragma unroll
        for (int e = 0; e < 16; ++e) bia[e] = trp[32 * j + 8 * (e >> 2) + (e & 3)];
#pragma unroll
        for (int e = 0; e < 16; e += 4) asm volatile("" : "+v"(bia[e]), "+v"(bia[e + 1]), "+v"(bia[e + 2]), "+v"(bia[e + 3]));
#pragma unroll
        for (int e = 0; e < 16; ++e) {
            const int cr = crow(e, h2), rel = 128 + c - 32 * j - cr, kidx = 32 * (qs + j) + cr;
            const bool ok = rel >= 0 && rel <= 128 && (blk > 0 || kidx >= 128);
            const float s = ok ? S[j][e] * 0.125f + bia[e] : -INFINITY;
            S[j][e] = s; mx = fmaxf(mx, s);
        }
        __builtin_amdgcn_sched_barrier(0);
    }
    mx = fmaxf(mx, __shfl_xor(mx, 32)); mx = fmaxf(mx, sink);
    float sum = 0.f;
#pragma unroll
    for (int j = 0; j < 5; ++j)
#pragma unroll
        for (int e = 0; e < 16; ++e) { const float p = __expf(S[j][e] - mx); S[j][e] = p; sum += p; if (e == 15) __builtin_amdgcn_sched_barrier(0); }
    sum += __shfl_xor(sum, 32);
    const float inv = 1.f / (sum + __expf(sink - mx));
#pragma unroll
    for (int i = 0; i < 4; ++i) { const int it = F.tid + 512 * i, kidx = it >> 3, chn = it & 7;
        const int kl = kidx & 31, pos = (kidx & ~31) | (kl & 0x13) | ((kl & 4) << 1) | ((kl & 8) >> 1);
        const unsigned w[4] = {vst[i].x, vst[i].y, vst[i].z, vst[i].w};
#pragma unroll
        for (int e = 0; e < 4; ++e) { VTt[(8 * chn + 2 * e) * (VS / 2) + pos] = (unsigned short)(w[e] & 0xffffu); VTt[(8 * chn + 2 * e + 1) * (VS / 2) + pos] = (unsigned short)(w[e] >> 16); } }
    __syncthreads();
    f32x16 O0, O1;
#pragma unroll
    for (int e = 0; e < 16; ++e) { O0[e] = 0.f; O1[e] = 0.f; }
#pragma unroll
    for (int j = 0; j < 5; ++j)
#pragma unroll
        for (int s2 = 0; s2 < 2; ++s2) {
            const bf16x8 pb = pk8(S[j][8 * s2], S[j][8 * s2 + 1], S[j][8 * s2 + 2], S[j][8 * s2 + 3], S[j][8 * s2 + 4], S[j][8 * s2 + 5], S[j][8 * s2 + 6], S[j][8 * s2 + 7]);
            const int slot = 32 * (qs + j) + 16 * s2 + 8 * h2;
            const bf16x8 av0 = *(const LAS bf16x8*)(L + c * VS + slot * 2), av1 = *(const LAS bf16x8*)(L + (32 + c) * VS + slot * 2);
            O0 = MFMA32(av0, pb, O0); O1 = MFMA32(av1, pb, O1);
            __builtin_amdgcn_sched_barrier(0);
        }
    bf16* op = (bf16*)(F.ws + WS_MIX) + (size_t)mq * D + 768 + hq * 64;
#pragma unroll
    for (int gq = 0; gq < 4; ++gq) {
        v2u w0, w1;
        w0.x = pk2(O0[4 * gq] * inv, O0[4 * gq + 1] * inv); w0.y = pk2(O0[4 * gq + 2] * inv, O0[4 * gq + 3] * inv);
        w1.x = pk2(O1[4 * gq] * inv, O1[4 * gq + 1] * inv); w1.y = pk2(O1[4 * gq + 2] * inv, O1[4 * gq + 3] * inv);
        *(v2u*)(op + 8 * gq + 4 * h2) = w0; *(v2u*)(op + 32 + 8 * gq + 4 * h2) = w1;
    }
    if (blk == 31) {
        v4u kk[2], vv[2];
#pragma unroll
        for (int i = 0; i < 2; ++i) { const int it = F.tid + 512 * i, j = it >> 3, c8 = 8 * (it & 7);
            const bf16* p = PROJ + (size_t)(b * TP + 3968 + j) * INW + kvh * 64 + c8; kk[i] = *(const v4u*)(p + C_KA); vv[i] = *(const v4u*)(p + C_VA); }
        __builtin_amdgcn_sched_barrier(0);
#pragma unroll
        for (int i = 0; i < 2; ++i) { const int it = F.tid + 512 * i, j = it >> 3, c8 = 8 * (it & 7);
            const size_t oi = (((size_t)(l * 4 + b) * 128 + j) * 2 + kvh) * 64 + c8;
            const unsigned kw[4] = {kk[i].x, kk[i].y, kk[i].z, kk[i].w}, vw[4] = {vv[i].x, vv[i].y, vv[i].z, vv[i].w};
#pragma unroll
            for (int h4 = 0; h4 < 2; ++h4) {
                f32x4 ko, vo;
                ko.x = bf2f(kw[2 * h4] & 0xffffu); ko.y = bf2f(kw[2 * h4] >> 16); ko.z = bf2f(kw[2 * h4 + 1] & 0xffffu); ko.w = bf2f(kw[2 * h4 + 1] >> 16);
                vo.x = bf2f(vw[2 * h4] & 0xffffu); vo.y = bf2f(vw[2 * h4] >> 16); vo.z = bf2f(vw[2 * h4 + 1] & 0xffffu); vo.w = bf2f(vw[2 * h4 + 1] >> 16);
                *(f32x4*)(F.out + O_KP + oi + 4 * h4) = ko; *(f32x4*)(F.out + O_VP + oi + 4 * h4) = vo; } }
    }
}

__device__ __forceinline__ void samp_b_unit(const Args& A, Ctx& F, int l, int u) {
    const bf16* PROJ = (const bf16*)(F.ws + WS_PROJ);
    const int bs = u >> 1, hf = u & 1, m0 = NP + 4 * bs;
    LAS unsigned char* L = F.lds;
    constexpr int OFL = 0, OCV = 34 * 1024, OKL = OCV + 4096, OVTL = OKL + 144 * RS64, OQL = OVTL + 64 * 336, OSL = 0, OPL = 16 * 592, OENDB = OQL + 16 * RS64;
    static_assert(OENDB <= RING_BYTES && OPL + 16 * 336 <= OCV, "samp_b LDS map");
    LAS float* FL = (LAS float*)(L + OFL); LAS float* CV = (LAS float*)(L + OCV);
    const float* ck = A.in[4 + F.z] + ((size_t)l * 128 + bs) * 128 * 128 + hf * 64;
    const float* cv = A.in[5 + F.z] + ((size_t)l * 128 + bs) * 128 * 128 + hf * 64;
    float* okp = F.out + O_KS + ((size_t)l * 128 + bs) * 128 * 128 + hf * 64; float* ovp = F.out + O_VS + ((size_t)l * 128 + bs) * 128 * 128 + hf * 64;
    const float* cc = A.in[2 + F.z] + ((size_t)l * 128 + bs) * 30 * 256;
    f32x4 fr4[4];
#pragma unroll
    for (int i = 0; i < 4; ++i) { const int it = F.tid + 512 * i; fr4[i] = it < 30 * 64 ? *(const f32x4*)(cc + 4 * it) : (f32x4){0.f, 0.f, 0.f, 0.f}; }
    f32x4 kr[2][2], vr[2][2];
#pragma unroll
    for (int i = 0; i < 2; ++i) { const int it = F.tid + 512 * i, j = it >> 3, c8 = 8 * (it & 7);
        kr[i][0] = *(const f32x4*)(ck + j * 128 + c8); kr[i][1] = *(const f32x4*)(ck + j * 128 + c8 + 4); vr[i][0] = *(const f32x4*)(cv + j * 128 + c8); vr[i][1] = *(const f32x4*)(cv + j * 128 + c8 + 4); }
    const int nt_ = F.tid >> 8, nch = F.tid & 255;
    const bf16* pa0 = PROJ + (size_t)(m0 + nt_) * INW + nch; const bf16* pa1 = PROJ + (size_t)(m0 + 2 + nt_) * INW + nch;
    const unsigned short av0 = pa0[C_AV], ag0 = pa0[C_AG], av1 = pa1[C_AV], ag1 = pa1[C_AG];
    unsigned short kb = 0, vb = 0;
    if (F.tid < 256) { const int t = F.tid >> 6, r = F.tid & 63; const bf16* p = PROJ + (size_t)(m0 + t) * INW + hf * 64 + r; kb = p[C_KA]; vb = p[C_VA]; }
    unsigned short qv[2];
#pragma unroll
    for (int i = 0; i < 2; ++i) { const int ix = F.tid + 512 * i, row = ix >> 6, dd = ix & 63; qv[i] = PROJ[(size_t)(m0 + (row >> 2)) * INW + C_QA + (row & 3) * 64 + dd]; }
    const float sinkv = A.in[19 + F.z][l * 4 + 2 * hf + (F.wave & 1)];
    const float cbias = A.in[14 + F.z][l * 256 + nch];
    __builtin_amdgcn_sched_barrier(0);
    __syncthreads();
#pragma unroll
    for (int i = 0; i < 4; ++i) { const int it = F.tid + 512 * i; if (it < 30 * 64) *(LAS f32x4*)(FL + 4 * it) = fr4[i]; }
    FL[(30 + nt_) * 256 + nch] = bf2f(av0) * sigm(bf2f(ag0)); FL[(32 + nt_) * 256 + nch] = bf2f(av1) * sigm(bf2f(ag1));
#pragma unroll
    for (int i = 0; i < 2; ++i) { const int it = F.tid + 512 * i, j = it >> 3, c8 = 8 * (it & 7);
        const f32x4 k0 = kr[i][0], k1 = kr[i][1], v0 = vr[i][0], v1 = vr[i][1];
        if (j >= 4) { *(f32x4*)(okp + (j - 4) * 128 + c8) = k0; *(f32x4*)(okp + (j - 4) * 128 + c8 + 4) = k1; *(f32x4*)(ovp + (j - 4) * 128 + c8) = v0; *(f32x4*)(ovp + (j - 4) * 128 + c8 + 4) = v1; }
        v4u kw; kw.x = pk2(k0.x, k0.y); kw.y = pk2(k0.z, k0.w); kw.z = pk2(k1.x, k1.y); kw.w = pk2(k1.z, k1.w);
        *(LAS v4u*)(L + OKL + j * RS64 + 2 * c8) = kw;
        const float vv[8] = {v0.x, v0.y, v0.z, v0.w, v1.x, v1.y, v1.z, v1.w};
#pragma unroll
        for (int e = 0; e < 8; ++e) *(LAS unsigned short*)(L + OVTL + (c8 + e) * 336 + 2 * j) = (unsigned short)f2bf(vv[e]); }
    if (F.tid < 256) { const int t = F.tid >> 6, r = F.tid & 63;
        *(LAS unsigned short*)(L + OKL + (128 + t) * RS64 + 2 * r) = kb; *(LAS unsigned short*)(L + OVTL + r * 336 + 2 * (128 + t)) = vb;
        okp[(124 + t) * 128 + r] = bf2f(kb); ovp[(124 + t) * 128 + r] = bf2f(vb); }
    for (int i = F.tid; i < 12 * 64; i += 512) *(LAS unsigned short*)(L + OKL + (132 + (i >> 6)) * RS64 + 2 * (i & 63)) = 0;
    for (int i = F.tid; i < 64 * 28; i += 512) *(LAS unsigned short*)(L + OVTL + (i / 28) * 336 + 2 * (132 + i % 28)) = 0;
#pragma unroll
    for (int i = 0; i < 2; ++i) { const int ix = F.tid + 512 * i, row = ix >> 6, dd = ix & 63; *(LAS unsigned short*)(L + OQL + row * RS64 + 2 * dd) = qv[i]; }
    __syncthreads();
    {
        const int ch = nch, tok = 2 * hf + nt_;
        float a0 = cbias;
#pragma unroll
        for (int j = 0; j < 31; ++j) a0 += A.in[13 + F.z][(size_t)(l * 31 + j) * 256 + ch] * FL[(tok + j) * 256 + ch];
        CV[tok * 256 + ch] = a0;
    }
    { float* o = F.out + O_CONVS + ((size_t)l * 128 + bs) * 30 * 256 + hf * 15 * 256; for (int i = F.tid; i < 15 * 64; i += 512) *(f32x4*)(o + 4 * i) = *(const LAS f32x4*)(FL + (4 + 15 * hf) * 256 + 4 * i); }
    __syncthreads();
    if (F.wave < 2) { const int tok = 2 * hf + F.wave; const f32x4 acc = *(const LAS f32x4*)(CV + tok * 256 + 4 * F.lane); conv_tail(A, F, l, acc, (bf16*)(F.ws + WS_MIX) + (size_t)(m0 + tok) * D); }
    const int r16 = F.lane & 15, q4 = F.lane >> 4;
    const float* BT = (const float*)(F.ws + WS_TAB);
    for (int kt = F.wave; kt < 9; kt += 8) {
        f32x4 s0 = {0.f, 0.f, 0.f, 0.f};
#pragma unroll
        for (int ks = 0; ks < 2; ++ks) {
            const bf16x8 qa = *(const LAS bf16x8*)(L + OQL + r16 * RS64 + (32 * ks + 8 * q4) * 2);
            const bf16x8 k0 = *(const LAS bf16x8*)(L + OKL + (16 * kt + r16) * RS64 + (32 * ks + 8 * q4) * 2);
            s0 = MFMA16(qa, k0, s0);
        }
        const int key = 16 * kt + r16, t = q4; const bool ok = key >= t && key <= 128 + t;
#pragma unroll
        for (int g = 0; g < 2; ++g) { const int e = 2 * hf + g; const float sv = (hf ? (g ? s0[3] : s0[2]) : (g ? s0[1] : s0[0])) * 0.125f;
            const int rel_ = 128 + t - key; float bia = BT[(rel_ < 0 ? 0 : (rel_ > 128 ? 128 : rel_)) * 4 + e]; asm volatile("" : "+v"(bia));
            ((LAS float*)(L + OSL))[(4 * t + e) * 148 + key] = ok ? sv + bia : -INFINITY; }
    }
    __syncthreads();
    {
        const int row = 4 * (F.wave >> 1) + 2 * hf + (F.wave & 1);
        const LAS float* sl = (const LAS float*)(L + OSL) + row * 148;
        float sc[3];
#pragma unroll
        for (int i = 0; i < 3; ++i) { const int j = F.lane + 64 * i; sc[i] = j < 144 ? sl[j] : -INFINITY; }
        const float mx = fmaxf(wave_max(fmaxf(fmaxf(sc[0], sc[1]), sc[2])), sinkv);
        float p[3], ps = 0.f;
#pragma unroll
        for (int i = 0; i < 3; ++i) { p[i] = __expf(sc[i] - mx); ps += p[i]; }
        const float inv = __builtin_amdgcn_rcpf(wave_sum(ps) + __expf(sinkv - mx));
#pragma unroll
        for (int i = 0; i < 3; ++i) { const int j = F.lane + 64 * i; if (j < 160) *(LAS unsigned short*)(L + OPL + row * 336 + 2 * j) = (unsigned short)f2bf(p[i] * inv); }
    }
    __syncthreads();
    if (F.wave < 4) {
        const int dt = F.wave;
        f32x4 o4 = {0.f, 0.f, 0.f, 0.f};
#pragma unroll
        for (int ks = 0; ks < 5; ++ks) {
            const bf16x8 pa = *(const LAS bf16x8*)(L + OPL + r16 * 336 + (32 * ks + 8 * q4) * 2);
            const bf16x8 vb8 = *(const LAS bf16x8*)(L + OVTL + (16 * dt + r16) * 336 + (32 * ks + 8 * q4) * 2);
            o4 = MFMA16(pa, vb8, o4);
        }
#pragma unroll
        for (int g = 0; g < 2; ++g) { const int e = 2 * hf + g; const float ov = hf ? (g ? o4[3] : o4[2]) : (g ? o4[1] : o4[0]);
            ((bf16*)(F.ws + WS_MIX))[(size_t)(m0 + q4) * D + 768 + e * 64 + 16 * dt + r16] = (bf16)f2bf(ov); }
    }
}
__device__ __forceinline__ void samp_hg_load(const Args& A, Ctx& F, int l, int u, float (&S)[32]) {
    const int bs = u >> 2, h = u & 3, v = F.tid & 127, dq = F.tid >> 7;
    const float* S0 = A.in[3 + F.z] + (((size_t)l * 128 + bs) * 4 + h) * 16384 + (size_t)(dq * 32) * 128 + v;
#pragma unroll
    for (int i = 0; i < 32; ++i) S[i] = S0[i * 128];
    __builtin_amdgcn_sched_barrier(0);
}
__device__ __forceinline__ void samp_hg_unit(const Args& A, Ctx& F, int l, int u, float (&S)[32]) {
    const int bs = u >> 2, h = u & 3, m0 = NP + 4 * bs;
    const bf16* PROJ = (const bf16*)(F.ws + WS_PROJ);
    LAS float* FT = (LAS float*)F.lds;
    LAS float* KT = FT + 512;
    LAS float* QT = KT + 512;
    LAS float* VV = QT + 512;
    LAS float* OP = VV + 512;
    LAS float* SS = OP + 2048;
    const int t_ = F.tid >> 7, d_ = F.tid & 127; const bf16* p_ = PROJ + (size_t)(m0 + t_) * INW + h * 128 + d_;
    const float lb_ = l == 0 ? 0.f : ((const float*)(F.ws + WS_TAB))[1024 + h * 128 + d_];
    const float xf_ = bf2f(p_[C_F]), xq_ = bf2f(p_[C_Q]), xi_ = bf2f(p_[C_I]), gg_ = bf2f(p_[C_G]), gn_ = A.in[18 + F.z][l * 128 + d_];
    __syncthreads();
    {
        const float e = __expf(-xf_), sg = __builtin_amdgcn_rcpf(1.f + e);
        FT[F.tid] = lb_ + (1.f - lb_) * sg; KT[F.tid] = (1.f - lb_) * e * sg; QT[F.tid] = xq_; VV[F.tid] = xi_;
    }
    __syncthreads();
    const int v = F.tid & 127, dq = F.tid >> 7;
#pragma unroll
    for (int t = 0; t < 4; ++t) {
        const float vt = VV[t * 128 + v]; float part = 0.f;
#pragma unroll
        for (int i = 0; i < 32; ++i) { const int d = dq * 32 + i; S[i] = FT[t * 128 + d] * S[i] + KT[t * 128 + d] * vt; part += QT[t * 128 + d] * S[i]; }
        OP[(dq * 4 + t) * 128 + v] = part;
    }
    float* So = F.out + O_HGS + (((size_t)l * 128 + bs) * 4 + h) * 16384 + (size_t)(dq * 32) * 128 + v;
#pragma unroll
    for (int i = 0; i < 32; ++i) So[i * 128] = S[i];
    __syncthreads();
    {
        const int t = F.tid >> 7, vv = F.tid & 127;
        const float o = (OP[(0 * 4 + t) * 128 + vv] + OP[(1 * 4 + t) * 128 + vv]) + (OP[(2 * 4 + t) * 128 + vv] + OP[(3 * 4 + t) * 128 + vv]);
        const float ss = wave_sum(o * o);
        if (F.lane == 0) SS[t * 2 + (F.wave & 1)] = ss;
        __syncthreads();
        const float rstd = __builtin_amdgcn_rsqf((SS[t * 2] + SS[t * 2 + 1]) * (1.f / 128.f) + EPS);
        ((bf16*)(F.ws + WS_MIX))[(size_t)(m0 + t) * D + 256 + h * 128 + vv] = (bf16)f2bf(o * rstd * gn_ * (gg_ * sigm(gg_)));
    }
}

constexpr int SHWLD = 4096;
template <int ACT> struct SEpiStore {
    bf16* O; int ldc; const float* rss; const float* shw;
    __device__ __forceinline__ void operator()(int row, int col, const f32x4 v, int lane) const {
        f32x4 w = v;
        if (rss) { const float rstd = __builtin_amdgcn_rsqf(rss[row] * (1.f / D) + EPS); w = v * rstd + *(const f32x4*)(shw + (size_t)modrow(row) * SHWLD + col); }
        if (ACT == 1) {
#pragma unroll
            for (int i = 0; i < 4; ++i) { const float r = w[i] > 0.f ? w[i] : 0.f; w[i] = r * r; } }
        v2u o; o.x = pk2(w[0], w[1]); o.y = pk2(w[2], w[3]);
        *(v2u*)(O + (size_t)row * ldc + col) = o;
    }
};
struct SEpiGateRes {
    const float* baseS; float* out; const float* gate; bf16* xs; float* rss; const float* gam; const float* sc;
    __device__ __forceinline__ void operator()(int row, int col, const f32x4 v, int lane) const {
        const int mr = modrow(row);
        const f32x4 g4 = *(const f32x4*)(gate + (size_t)mr * MODLD + col), b4 = *(const f32x4*)(baseS + (size_t)(row - NP) * D + col);
        const f32x4 x = b4 + g4 * v;
        *(f32x4*)(out + (size_t)row * D + col) = x;
        if (xs) {
            const f32x4 s4 = *(const f32x4*)(gam + col) * (*(const f32x4*)(sc + (size_t)mr * MODLD + col) + 1.f), y = x * s4;
            v2u o; o.x = pk2(y[0], y[1]); o.y = pk2(y[2], y[3]);
            *(v2u*)(xs + (size_t)row * D + col) = o;
            float ss = (x[0] * x[0] + x[1] * x[1]) + (x[2] * x[2] + x[3] * x[3]);
            ss += __shfl_xor(ss, 16); ss += __shfl_xor(ss, 32);
            if ((lane >> 4) == 0) (void)__hip_atomic_fetch_add(rss + row, ss, __ATOMIC_RELAXED, __HIP_MEMORY_SCOPE_AGENT);
        }
    }
};
struct SEpiF32 {
    float* O; int ld;
    __device__ __forceinline__ void operator()(int row, int col, const f32x4 v, int lane) const { *(f32x4*)(O + (size_t)row * ld + col) = v; }
};
template <int NJ, class Epi>
__device__ __forceinline__ void sgemm_phase(Ctx& F, const bf16* Arow  , const bf16* Bt, int N, int K, const Epi& E, const int ntm = 8, const int row0 = NP) {
    static_assert(NJ <= 4, "wave-private image: 8 KiB of A + 2 NJ KiB of B");
    const int r16 = F.lane & 15, q4 = F.lane >> 4, lr = F.lane >> 3, lp = F.lane & 7;
    const int ntn = N / (16 * NJ), ksl = K / 8, nss = ksl / 64;
    LAS unsigned char* WL = F.lds + F.wave * 16384;
    LAS f32x4* RED = (LAS f32x4*)F.lds;
    TSEC_BEGIN(50);
    constexpr int SLOT = 4 * NJ * 64;
    const bool grp = ((F.G & 7) == 0) && ((ntn & 7) == 0);
    const int xg = F.bid & 7, wpx = grp ? (F.G >> 3) : F.G, cpx = ntn >> 3;
    for (int w = grp ? (F.bid >> 3) : F.bid; w < (grp ? ntm * cpx : ntm * ntn); w += wpx) {
        const int tm = w % ntm, tn = grp ? xg * cpx + w / ntm : w / ntm;
        const bf16* ap = Arow + (size_t)(64 * tm + lr) * K + F.wave * ksl + 8 * lp;
        const bf16* bp = Bt + (size_t)(16 * NJ * tn + lr) * K + F.wave * ksl + 8 * lp;
        f32x4 acc[4][NJ];
#pragma unroll
        for (int i = 0; i < 4; ++i)
#pragma unroll
            for (int j = 0; j < NJ; ++j) acc[i][j] = (f32x4){0.f, 0.f, 0.f, 0.f};
        v4u ra[8], rb[2 * NJ];
#define SG_LOAD(ss) do { _Pragma("unroll") for (int t = 0; t < 8; ++t) ra[t] = *(const v4u*)(ap + (size_t)(8 * t) * K + 64 * (ss)); \
                          _Pragma("unroll") for (int t = 0; t < 2 * NJ; ++t) rb[t] = *(const v4u*)(bp + (size_t)(8 * t) * K + 64 * (ss)); } while (0)
        SG_LOAD(0);
        __builtin_amdgcn_sched_barrier(0);
        __syncthreads();
        for (int ss = 0; ss < nss; ++ss) {
#pragma unroll
            for (int t = 0; t < 8; ++t) { const int r = 8 * t + lr; *(LAS v4u*)(WL + r * 128 + ((lp ^ (r & 7)) << 4)) = ra[t]; }
#pragma unroll
            for (int t = 0; t < 2 * NJ; ++t) { const int r = 8 * t + lr; *(LAS v4u*)(WL + 8192 + r * 128 + ((lp ^ (r & 7)) << 4)) = rb[t]; }
            __builtin_amdgcn_sched_barrier(0);
            if (ss + 1 < nss) SG_LOAD(ss + 1);
            __builtin_amdgcn_sched_barrier(0);
#pragma unroll
            for (int s = 0; s < 2; ++s) {
                bf16x8 fa[4], fb[NJ];
#pragma unroll
                for (int i = 0; i < 4; ++i) { const int r = 16 * i + r16; fa[i] = *(const LAS bf16x8*)(WL + r * 128 + (((4 * s + q4) ^ (r & 7)) << 4)); }
#pragma unroll
                for (int j = 0; j < NJ; ++j) { const int r = 16 * j + r16; fb[j] = *(const LAS bf16x8*)(WL + 8192 + r * 128 + (((4 * s + q4) ^ (r & 7)) << 4)); }
#pragma unroll
                for (int i = 0; i < 4; ++i)
#pragma unroll
                    for (int j = 0; j < NJ; ++j) acc[i][j] = MFMA16(fb[j], fa[i], acc[i][j]);
            }
            __builtin_amdgcn_sched_barrier(0);
        }
#undef SG_LOAD
        __syncthreads();
#pragma unroll
        for (int i = 0; i < 4; ++i)
#pragma unroll
            for (int j = 0; j < NJ; ++j) RED[(F.wave * 4 + i) * NJ * 64 + j * 64 + F.lane] = acc[i][j];
        __syncthreads();
#pragma unroll
        for (int q = 0; q < (SLOT + 511) / 512; ++q) {
            const int p = F.tid + 512 * q, ln = p & 63, ij = p >> 6, j = ij % NJ, mi = ij / NJ;
            if (p >= SLOT) break;
            f32x4 v = RED[p];
#pragma unroll
            for (int k4 = 1; k4 < 8; ++k4) v += RED[k4 * SLOT + p];
            E(row0 + 64 * tm + 16 * mi + (ln & 15), 16 * NJ * tn + 16 * j + 4 * (ln >> 4), v, ln);
        }
    }
    TSEC_END(50);
}

#ifndef MK_PER_PHASE
#define MK_PER_PHASE 0
#endif
#ifndef PH_MASK
#define PH_MASK 0xFFFF
#endif
#define PHON(k) ((PH_MASK >> (k)) & 1)
#ifndef PROBE_REP
#define PROBE_REP -1
#endif
#ifndef PROBE_SPIN
#define PROBE_SPIN -1
#endif
#define RELAUNDER() do { int tid_ = F.tid, bid_ = __builtin_amdgcn_readfirstlane(F.bid), g_ = __builtin_amdgcn_readfirstlane(F.G), z_ = __builtin_amdgcn_readfirstlane(F.z); asm volatile("" : "+s"(z_), "+s"(bid_), "+s"(g_)); asm volatile("" : "+v"(tid_)); \
    F.ws = args.ws + z_; F.out = args.out + z_; F.z = z_; F.tid = tid_; F.lane = tid_ & 63; F.wave = __builtin_amdgcn_readfirstlane(tid_ >> 6); F.bid = bid_; F.G = g_; } while (0)
#define SUBPROBE(k, ...) do { RELAUNDER(); const unsigned long long st0_ = PROBE_SPIN == (k) ? __builtin_amdgcn_s_memrealtime() : 0ull; __VA_ARGS__; if (PROBE_SPIN == (k)) { __syncthreads(); const unsigned long long st1_ = __builtin_amdgcn_s_memrealtime(), du_ = (st1_ - st0_) * PROBE_N; while (__builtin_amdgcn_s_memrealtime() - st1_ < du_) __builtin_amdgcn_s_sleep(8); } } while (0)
__global__ void __launch_bounds__(512, 2) mk_fwd(Args args) {
    extern __shared__ __attribute__((aligned(16))) unsigned char lds[];
    Ctx F;
    F.lds = (LAS unsigned char*)lds;
    F.tid = threadIdx.x; F.lane = F.tid & 63; F.wave = __builtin_amdgcn_readfirstlane(F.tid >> 6);
    F.G = gridDim.x; F.bid = blockIdx.x; F.z = 0;
    F.out = args.out; F.ws = args.ws;
    volatile LAS unsigned* MISC = (volatile LAS unsigned*)(F.lds + MISC_OFF);
    for (int u = F.tid; u < (LDS_BYTES - LDSCTL_OFF) / 4; u += 512) ((LAS unsigned*)(F.lds + LDSCTL_OFF))[u] = 0u;
    __syncthreads();
    const int lo = args.ph_lo, hi = args.ph_hi;
    const int wave0 = F.wave;
    XcdBarrier bar; bar.bar = (unsigned*)(F.ws + WS_CTL) + CW_BAR; bar.x = 0; bar.st = nullptr;
    if (hi - lo > 1) bar = xcd_barrier_post((unsigned*)(F.ws + WS_CTL) + CW_BAR, MISC + 8, F.tid);
    for (int p = lo; p < hi; ++p) {
        const int l = p < 2 ? 0 : (p - 2) / 9, s = (p < 2 || p == NPH - 1) ? -1 : (p - 2) % 9;
        const int which = p == NPH - 1 ? 2 : (s == 0 ? 0 : (s == 6 ? 1 : -1));
        const int kind = p == 0 ? 0 : p == 1 ? 12 : (which == 2 ? 10 : (which >= 0 ? 1 : (s == 1 ? 2 : (s == 2 ? 3 : (s == 3 ? 4 : (s == 4 ? 5 : (s == 5 ? (l == 0 ? 6 : 11) : (s == 7 ? 7 : 8))))))));
        if (s == 6 || (s == 0 && l == 1)) continue;
        const int nrep = (kind == PROBE_REP) ? 1 + PROBE_N : 1;
        const unsigned long long pt0 = PROBE_SPIN >= 0 ? __builtin_amdgcn_s_memrealtime() : 0ull;
        for (int rep = 0; rep < nrep; ++rep) {
        { int z_ = 0, tid_ = wave0 * 64 + (int)__builtin_amdgcn_mbcnt_hi(~0u, __builtin_amdgcn_mbcnt_lo(~0u, 0u)), bid_ = blockIdx.x, g_ = gridDim.x;
          asm volatile("" : "+s"(z_), "+s"(bid_), "+s"(g_)); asm volatile("" : "+v"(tid_));
          F.ws = args.ws + z_; F.out = args.out + z_; F.z = z_; F.tid = tid_; F.lane = tid_ & 63; F.wave = __builtin_amdgcn_readfirstlane(tid_ >> 6); F.bid = bid_; F.G = g_; }
        if (PROBE_REP == 9 && hi - lo > 1) { for (int xb = 0; xb < PROBE_N; ++xb) xcd_barrier(bar, F.tid); }
        if (p == 0) { if (PHON(0)) p0_prologue(args, F); }
        else if (p == 1) { if (PHON(0)) mod_phase(args, F); }
        else if (which >= 0) { if (PHON(1)) norm_phase(args, F, p == NPH - 1 ? 0 : l, which); }
        else if (s == 1 && PHON(2)) {
            pg8::Gemm g{(const pg8::bf16_t*)(F.ws + WS_XN), (const pg8::bf16_t*)(F.ws + WS_WIN) + (size_t)l * INW * D, NP, INW, D};
            pg8::StaticOrder S; S.init(NP, INW, F.G, F.bid);
            const float* rss = l == 0 ? nullptr : (const float*)(F.ws + WS_CTL + CTL_RSS) + (size_t)1 * M;
            const float* shw = (const float*)(F.ws + WS_SHW) + (size_t)1 * 192 * SHWLD;
            pg8::EpiStore<0> E{(pg8::bf16_t*)(F.ws + WS_PROJ), INW, rss, shw};
            SEpiStore<0> SE{(bf16*)(F.ws + WS_PROJ), INW, rss, shw};
            if (l == 0) {
                const bf16* SHB = (const bf16*)(F.ws + WS_SHB); float* SHW = (float*)(F.ws + WS_SHW);
                { SEpiF32 HE{SHW + (size_t)0 * 192 * SHWLD, SHWLD}; sgemm_phase<4>(F, SHB + (size_t)0 * 192 * 1024, (const bf16*)(F.ws + WS_WUP), FF, D, HE, 3, 0); }
                { SEpiF32 HE{SHW + (size_t)2 * 192 * SHWLD, SHWLD}; sgemm_phase<4>(F, SHB + (size_t)2 * 192 * 1024, (const bf16*)(F.ws + WS_WUP) + (size_t)FF * D, FF, D, HE, 3, 0); }
                { SEpiF32 HE{SHW + (size_t)1 * 192 * SHWLD, SHWLD}; sgemm_phase<3>(F, SHB + (size_t)1 * 192 * 1024, (const bf16*)(F.ws + WS_WIN) + (size_t)INW * D, INW, D, HE, 3, 0); }
            }
            sgemm_phase<3>(F, (const bf16*)(F.ws + WS_XN) + (size_t)NP * D, (const bf16*)(F.ws + WS_WIN) + (size_t)l * INW * D, INW, D, SE);
            __syncthreads();
            pg8::gemm_phase<pg8::EpiStore<0>, pg8::StaticOrder, true, true>(F.lds, g, S, E, F.tid);
        } else if (s == 2) {
            for (int slot = 0; slot < 5; ++slot) {
                const int ty = __builtin_amdgcn_readfirstlane((slot + F.bid) % 5);
#if PHON(7)
                if (ty == 0) {
            SUBPROBE(20, for (int u = F.bid; u < 256; u += F.G) samp_b_unit(args, F, l, u));
                }
#endif
#if PHON(6)
                if (ty == 1) {
            SUBPROBE(21, { float S[32]; samp_hg_load(args, F, l, F.bid & 511, S); for (int u = F.bid; u < 512; u += F.G) { float Sn[32]; samp_hg_load(args, F, l, (u + F.G) & 511, Sn); samp_hg_unit(args, F, l, u, S); _Pragma("unroll") for (int i = 0; i < 32; ++i) S[i] = Sn[i]; } });
                }
#endif
#if PHON(3)
                if (ty == 2) {
            SUBPROBE(22, for (int u = F.bid; u < 256; u += F.G) attn_unit(args, F, l, u));
                }
#endif
#if PHON(4)
                if (ty == 3) {
            SUBPROBE(23, for (int u = F.bid; u < 256; u += F.G) conv_unit(args, F, l, u));
                }
#endif
#if PHON(5)
                if (ty == 4) {
                        SUBPROBE(24, {   const int nh1 = -1; auto h1idx = [&](int k) -> int { if (nh1 < 0) return F.bid + F.G * k; return k < 4 ? F.bid + 256 * k : F.bid + 640; }; const int cnt = nh1 < 0 ? (1024 - F.bid + F.G - 1) / F.G : nh1; v4u rf[2], rv[2]; h1_load(F, h1idx(0) & 1023, rf, rv); for (int k = 0; k < cnt; ++k) { v4u nf[2], nv[2]; h1_load(F, h1idx(k + 1 < cnt ? k + 1 : k) & 1023, nf, nv); h1_unit(args, F, l, h1idx(k), rf, rv); rf[0] = nf[0]; rf[1] = nf[1]; rv[0] = nv[0]; rv[1] = nv[1]; } });
                }
#endif
            }
        } else if (s == 3) { if (PHON(8)) h2_scan(args, F, l); }
        else if (s == 4 && PHON(9)) { v4u rf[2], rq[2], rv[2]; h3_load(F, F.bid & 1023, rf, rq, rv); for (int u = F.bid; u < 1024; u += F.G) { v4u nf[2], nq[2], nv[2]; h3_unit(args, F, l, u, rf, rq, rv, (u + F.G) & 1023, nf, nq, nv); rf[0] = nf[0]; rf[1] = nf[1]; rq[0] = nq[0]; rq[1] = nq[1]; rv[0] = nv[0]; rv[1] = nv[1]; } }
        else if ((s == 5 || s == 8) && PHON(10)) {
            const bool dn = s == 8;
            pg8::Gemm g{(const pg8::bf16_t*)(F.ws + (dn ? WS_HB : WS_MIX)), (const pg8::bf16_t*)(F.ws + (dn ? WS_WDN : WS_WOUT)) + (size_t)l * (dn ? D * FF : D * D), NP, D, dn ? FF : D};
            pg8::StaticOrder S; S.init(NP, D, F.G, F.bid);
            const bool from_in = (!dn && l == 0);
            const int f = dn ? 1 : 2 * l; const bool fold = !(dn && l == 1);
            bf16* xs = fold ? (bf16*)(F.ws + WS_XN) : nullptr; float* rssw = (float*)(F.ws + WS_CTL + CTL_RSS) + (size_t)f * M;
            const float* gam = dn ? args.in[11 + F.z] + D : args.in[21 + F.z] + l * D;
            const float* scp = (const float*)(F.ws + WS_MOD) + (size_t)(dn ? 1 : l) * MODR * MODLD + (dn ? 1 * D : 4 * D);
            pg8::EpiGateRes E{from_in ? args.in[0 + F.z] : F.out, from_in ? args.in[1 + F.z] : F.out + (size_t)NP * D, F.out, (const float*)(F.ws + WS_MOD) + (size_t)l * MODR * MODLD + (dn ? 5 * D : 2 * D),
                              (pg8::bf16_t*)xs, rssw, gam, scp};
            SEpiGateRes SE{from_in ? args.in[1 + F.z] : F.out + (size_t)NP * D, F.out, (const float*)(F.ws + WS_MOD) + (size_t)l * MODR * MODLD + (dn ? 5 * D : 2 * D), xs, rssw, gam, scp};
            sgemm_phase<2>(F, (const bf16*)(F.ws + (dn ? WS_HB : WS_MIX)) + (size_t)NP * (dn ? FF : D), (const bf16*)(F.ws + (dn ? WS_WDN : WS_WOUT)) + (size_t)l * (dn ? D * FF : D * D), D, dn ? FF : D, SE);
            __syncthreads();
            pg8::gemm_phase<pg8::EpiGateRes, pg8::StaticOrder, true, true>(F.lds, g, S, E, F.tid);
        } else if (s == 7 && PHON(11)) {
            pg8::Gemm g{(const pg8::bf16_t*)(F.ws + WS_XN), (const pg8::bf16_t*)(F.ws + WS_WUP) + (size_t)l * FF * D, NP, FF, D};
            pg8::StaticOrder S; S.init(NP, FF, F.G, F.bid);
            const float* rss = (const float*)(F.ws + WS_CTL + CTL_RSS) + (size_t)(2 * l) * M;
            const float* shw = (const float*)(F.ws + WS_SHW) + (size_t)(2 * l) * 192 * SHWLD;
            pg8::EpiStore<1> E{(pg8::bf16_t*)(F.ws + WS_HB), FF, rss, shw};
            SEpiStore<1> SE{(bf16*)(F.ws + WS_HB), FF, rss, shw};
            sgemm_phase<4>(F, (const bf16*)(F.ws + WS_XN) + (size_t)NP * D, (const bf16*)(F.ws + WS_WUP) + (size_t)l * FF * D, FF, D, SE);
            __syncthreads();
            pg8::gemm_phase<pg8::EpiStore<1>, pg8::StaticOrder, true, true>(F.lds, g, S, E, F.tid);
        }
        }
        if (PROBE_SPIN >= 0 && kind == PROBE_SPIN) { const unsigned long long pt1 = __builtin_amdgcn_s_memrealtime(), dur = (pt1 - pt0) * PROBE_N; while (__builtin_amdgcn_s_memrealtime() - pt1 < dur) __builtin_amdgcn_s_sleep(8); }
        if (p + 1 < hi) xcd_barrier(bar, F.tid);
    }
}

extern "C" void kernel_launch(void* const* d_in, const int* in_sizes, int n_in, void* d_out, int out_size, void* d_ws, size_t ws_size, hipStream_t stream) {
    static int grid = 0;
    if (grid == 0) {
        if (n_in != 25 || in_sizes[0] != NP * D || (size_t)out_size != O_END || ws_size < WS_END) {
            fprintf(stderr, "kernel_launch: unexpected shapes (n_in %d, in0 %d, out %d, ws %zu)\n", n_in, n_in > 0 ? in_sizes[0] : -1, out_size, ws_size); grid = -1; return; }
        int dev = 0, cus = 0, per_cu = 0;
        if (hipGetDevice(&dev) != hipSuccess || hipDeviceGetAttribute(&cus, hipDeviceAttributeMultiprocessorCount, dev) != hipSuccess) { grid = -1; return; }
        if (hipFuncSetAttribute((const void*)mk_fwd, hipFuncAttributeMaxDynamicSharedMemorySize, LDS_BYTES) != hipSuccess) { fprintf(stderr, "kernel_launch: hipFuncSetAttribute failed\n"); grid = -1; return; }
        if (hipOccupancyMaxActiveBlocksPerMultiprocessor(&per_cu, (const void*)mk_fwd, 512, LDS_BYTES) != hipSuccess || per_cu < 1) {
            fprintf(stderr, "kernel_launch: occupancy query reports %d blocks per CU; nothing launched\n", per_cu); (void)hipGetLastError(); grid = -1; return; }
        grid = cus;
    }
    if (grid < 0) return;
    (void)hipMemsetAsync((char*)d_ws + WS_CTL, 0, CTL_ZERO_BYTES, stream);
    Args a{};
    for (int i = 0; i < 25; ++i) a.in[i] = (const float*)d_in[i];
    a.out = (float*)d_out; a.ws = (unsigned char*)d_ws;
#if MK_PER_PHASE
    for (int p = 0; p < NPH; ++p) { a.ph_lo = p; a.ph_hi = p + 1; hipLaunchKernelGGL(mk_fwd, dim3(grid), dim3(512), LDS_BYTES, stream, a); }
#else
    a.ph_lo = 0; a.ph_hi = NPH; hipLaunchKernelGGL(mk_fwd, dim3(grid), dim3(512), LDS_BYTES, stream, a);
#endif
}
```

```cpp
#define MK_PER_PHASE 0
#include <hip/hip_runtime.h>
#include <cstdio>
#include <cstdint>
namespace pg8 {
#define PG8_LAS __attribute__((address_space(3)))
typedef unsigned short bf16_t;
typedef short bf16x8 __attribute__((ext_vector_type(8)));
typedef float f32x4 __attribute__((ext_vector_type(4)));
typedef unsigned u32x4 __attribute__((ext_vector_type(4)));
constexpr int BM = 256, BK = 64, HALF = 128, HTB = HALF * BK * 2  , STAGE_BYTES = 8 * HTB, NXCD = 8, WGM = 8;

__host__ __device__ __forceinline__ int lds_byte(int r, int c) { const int st = (r >> 4) * 2 + (c >> 5), rr = r & 15, cc = c & 31, ob = rr * 64 + cc * 2; return st * 1024 + (ob ^ (((ob >> 9) & 1) << 5)); }
__host__ __device__ __forceinline__ void stage_rc(int b, int& R, int& C) { const int st = b / 1024, sb = b % 1024, swz = sb ^ (((sb >> 9) & 1) << 5); R = (st >> 1) * 16 + swz / 64; C = (st & 1) * 32 + (swz % 64) / 2; }
__host__ __device__ __forceinline__ int perm32(int rho) { const int n = rho >> 4, i = rho & 15; return 8 * (i >> 2) + 4 * n + (i & 3); }

struct Unit { int pm, pn; };
struct Gemm { const bf16_t* A; const bf16_t* Bt; int M, N, K; };

struct StaticOrder {
    int nM, nN, nwg, G, c;
    __host__ __device__ void init(int M, int N, int G_, int c_) { nM = M / BM; nN = N / BM; nwg = nM * nN; G = G_; c = c_; }
    __host__ __device__ bool next(int i, Unit& u) const {
        const long L = (long)i * G + c; if (L >= nwg) return false;
        int wgid = (int)L; { const int q = nwg / NXCD, r = nwg % NXCD, xcd = wgid % NXCD, off = wgid / NXCD; wgid = (xcd < r ? xcd * (q + 1) : r * (q + 1) + (xcd - r) * q) + off; }
        const int nig = WGM * nN, gid = wgid / nig, fm = gid * WGM, gsz = (nM - fm) < WGM ? (nM - fm) : WGM;
        u.pm = fm + ((wgid % nig) % gsz); u.pn = (wgid % nig) / gsz; return true;
    }
    __device__ __forceinline__ void a_ready(const Unit&) const {}
    __device__ __forceinline__ void done(const Unit&) const {}
};

__device__ __forceinline__ unsigned cvt_pk_bf16(float lo, float hi) { unsigned r; asm volatile("v_cvt_pk_bf16_f32 %0, %1, %2" : "=v"(r) : "v"(lo), "v"(hi)); return r; }
typedef float f32x2 __attribute__((ext_vector_type(2)));
constexpr int EP_NP = 16384, EP_D = 1024, EP_MODLD = 6144, EP_SHWLD = 4096;
constexpr float EP_EPS = 1e-6f;
__device__ __forceinline__ int ep_modrow(int r) { return r < EP_NP ? (r >> 12) : 4 + ((r - EP_NP) >> 2); }
template <int ACT> struct EpiStore {
    static constexpr bool PERM = true, AFTER_DRAIN = false;
    bf16_t* O; int ldc; const float* rss; const float* shw;
    __device__ __forceinline__ void operator()(const f32x4 (&acc)[2][2][4][2], const Unit& u, int wr, int wc, int fr, int fq) const {
        const int row0 = u.pm * BM + wr * 64 + fr, col0 = u.pn * BM + wc * 32 + 8 * fq;
        f32x4 h4[2][2]; float rs[8];
#pragma unroll
        for (int bj = 0; bj < 2; ++bj)
#pragma unroll
            for (int n = 0; n < 2; ++n) h4[bj][n] = (f32x4){0.f, 0.f, 0.f, 0.f};
#pragma unroll
        for (int i = 0; i < 8; ++i) rs[i] = 1.f;
        if (rss) {
            const float* hp = shw + (size_t)ep_modrow(u.pm * BM) * EP_SHWLD + col0;
#pragma unroll
            for (int bj = 0; bj < 2; ++bj)
#pragma unroll
                for (int n = 0; n < 2; ++n) h4[bj][n] = *(const f32x4*)(hp + bj * HALF + 4 * n);
#pragma unroll
            for (int i = 0; i < 8; ++i) rs[i] = rss[row0 + (i >> 2) * HALF + (i & 3) * 16];
#pragma unroll
            for (int i = 0; i < 8; ++i) rs[i] = __builtin_amdgcn_rsqf(rs[i] * (1.f / EP_D) + EP_EPS);
        }
#pragma unroll
        for (int ai = 0; ai < 2; ++ai)
#pragma unroll
            for (int m = 0; m < 4; ++m) { bf16_t* rowp = O + (size_t)(row0 + ai * HALF + m * 16) * ldc + col0; const float rstd = rs[ai * 4 + m];
#pragma unroll
                for (int bj = 0; bj < 2; ++bj) { f32x4 v0 = acc[ai][bj][m][0] * rstd + h4[bj][0], v1 = acc[ai][bj][m][1] * rstd + h4[bj][1];
                    if (ACT == 1) {
#pragma unroll
                        for (int e = 0; e < 4; ++e) { const float a = v0[e] > 0.f ? v0[e] : 0.f, b = v1[e] > 0.f ? v1[e] : 0.f; v0[e] = a * a; v1[e] = b * b; } }
                    u32x4 w; w.x = cvt_pk_bf16(v0[0], v0[1]); w.y = cvt_pk_bf16(v0[2], v0[3]); w.z = cvt_pk_bf16(v1[0], v1[1]); w.w = cvt_pk_bf16(v1[2], v1[3]);
                    *(u32x4*)(rowp + bj * HALF) = w; } }
    }
};
struct EpiGateRes {
    static constexpr bool PERM = true, AFTER_DRAIN = false;
    const float* baseP; const float* baseS; float* out; const float* gate;
    bf16_t* xs; float* rss; const float* gam; const float* sc;
    __device__ __forceinline__ void operator()(const f32x4 (&acc)[2][2][4][2], const Unit& u, int wr, int wc, int fr, int fq) const {
        const int col0 = u.pn * BM + wc * 32 + 8 * fq;
        const int mr = ep_modrow(u.pm * BM);
        f32x4 g4[2][2], s4[2][2];
#pragma unroll
        for (int bj = 0; bj < 2; ++bj)
#pragma unroll
            for (int n = 0; n < 2; ++n) { g4[bj][n] = *(const f32x4*)(gate + (size_t)mr * EP_MODLD + col0 + bj * HALF + 4 * n); s4[bj][n] = (f32x4){0.f, 0.f, 0.f, 0.f}; }
        if (xs) {
#pragma unroll
            for (int bj = 0; bj < 2; ++bj)
#pragma unroll
                for (int n = 0; n < 2; ++n) s4[bj][n] = *(const f32x4*)(gam + col0 + bj * HALF + 4 * n) * (*(const f32x4*)(sc + (size_t)mr * EP_MODLD + col0 + bj * HALF + 4 * n) + 1.f);
        }
#pragma unroll
        for (int ai = 0; ai < 2; ++ai)
#pragma unroll
            for (int mp = 0; mp < 2; ++mp) {
                f32x4 b4[2][2][2];
#pragma unroll
                for (int mm = 0; mm < 2; ++mm) { const int r = u.pm * BM + ai * HALF + wr * 64 + (2 * mp + mm) * 16 + fr;
                    const float* bp = (r < EP_NP ? baseP + (size_t)r * EP_D : baseS + (size_t)(r - EP_NP) * EP_D) + col0;
#pragma unroll
                    for (int bj = 0; bj < 2; ++bj)
#pragma unroll
                        for (int n = 0; n < 2; ++n) b4[mm][bj][n] = *(const f32x4*)(bp + bj * HALF + 4 * n); }
                __builtin_amdgcn_sched_barrier(0);
#pragma unroll
                for (int mm = 0; mm < 2; ++mm) { const int m = 2 * mp + mm, r = u.pm * BM + ai * HALF + wr * 64 + m * 16 + fr;
                    float* op = out + (size_t)r * EP_D + col0; float ss = 0.f;
#pragma unroll
                    for (int bj = 0; bj < 2; ++bj) {
                        const f32x4 x0 = b4[mm][bj][0] + g4[bj][0] * acc[ai][bj][m][0], x1 = b4[mm][bj][1] + g4[bj][1] * acc[ai][bj][m][1];
                        *(f32x4*)(op + bj * HALF) = x0; *(f32x4*)(op + bj * HALF + 4) = x1;
                        if (xs) {
                            ss += ((x0[0] * x0[0] + x0[1] * x0[1]) + (x0[2] * x0[2] + x0[3] * x0[3])) + ((x1[0] * x1[0] + x1[1] * x1[1]) + (x1[2] * x1[2] + x1[3] * x1[3]));
                            const f32x4 y0 = x0 * s4[bj][0], y1 = x1 * s4[bj][1];
                            u32x4 w; w.x = cvt_pk_bf16(y0[0], y0[1]); w.y = cvt_pk_bf16(y0[2], y0[3]); w.z = cvt_pk_bf16(y1[0], y1[1]); w.w = cvt_pk_bf16(y1[2], y1[3]);
                            *(u32x4*)(xs + (size_t)r * EP_D + col0 + bj * HALF) = w; } }
                    if (xs) { ss += __shfl_xor(ss, 16); ss += __shfl_xor(ss, 32);
                        if (fq == 0) (void)__hip_atomic_fetch_add(rss + r, ss, __ATOMIC_RELAXED, __HIP_MEMORY_SCOPE_AGENT); } }
                __builtin_amdgcn_sched_barrier(0);
            }
    }
};
template <class Epi, class Sched, bool ALIGN_EPI = false, bool SP2 = false>
__device__ __forceinline__ void gemm_phase(PG8_LAS unsigned char* lds, const Gemm g, const Sched& S, const Epi& E, const int tid) {
    const int wid = __builtin_amdgcn_readfirstlane(tid >> 6), lane = tid & 63, wr = wid >> 2, wc = wid & 3, fr = lane & 15, fq = lane >> 4;
    const int K = g.K, nt = K / BK;
    unsigned voffA[2], voffB[2];
#pragma unroll
    for (int i = 0; i < 2; ++i) { int R, C; stage_rc(tid * 16 + i * 8192, R, C); const int Rb = Epi::PERM ? ((R & ~31) + perm32(R & 31)) : R;
        voffA[i] = (unsigned)(R * K + C) * 2u; voffB[i] = (unsigned)(Rb * K + C) * 2u; }
    const size_t kstep = (size_t)(BK * 2);
    const size_t hstep = (size_t)HALF * K * 2;
    const size_t tstep = 2 * hstep;
    const unsigned ldsw = (unsigned)wid * 1024u;
    const int aoff = lds_byte(wr * 64 + fr, fq * 8), boff = lds_byte(wc * 32 + fr, fq * 8);
#define PG8_SA(b, h) (((b) * 2 + (h)) * HTB)
#define PG8_SB(b, h) ((4 + (b) * 2 + (h)) * HTB)
#define PG8_STAGE(bufoff, gbase, voff) do { _Pragma("unroll") for (int _i = 0; _i < 2; ++_i) \
        __builtin_amdgcn_global_load_lds((const unsigned*)((const char*)(gbase) + (voff)[_i]), (PG8_LAS unsigned*)(lds + (bufoff) + ldsw + _i * 8192), 16, 0, 0); } while (0)
#define PG8_LDA(dst, b, h) do { _Pragma("unroll") for (int m = 0; m < 4; ++m) _Pragma("unroll") for (int k = 0; k < 2; ++k) dst[m][k] = *(const PG8_LAS bf16x8*)(lds + PG8_SA(b, h) + aoff + m * 2048 + k * 1024); } while (0)
#define PG8_LDB(dst, b, h) do { _Pragma("unroll") for (int n = 0; n < 2; ++n) _Pragma("unroll") for (int k = 0; k < 2; ++k) dst[n][k] = *(const PG8_LAS bf16x8*)(lds + PG8_SB(b, h) + boff + n * 2048 + k * 1024); } while (0)
#define PG8_MMA(ai, bj, At, Bt) do { __builtin_amdgcn_s_setprio(1); _Pragma("unroll") for (int m = 0; m < 4; ++m) _Pragma("unroll") for (int n = 0; n < 2; ++n) _Pragma("unroll") for (int k = 0; k < 2; ++k) \
        acc[ai][bj][m][n] = __builtin_amdgcn_mfma_f32_16x16x32_bf16(Bt[n][k], At[m][k], acc[ai][bj][m][n], 0, 0, 0); __builtin_amdgcn_s_setprio(0); } while (0)
#define PG8_WAIT_V(n) asm volatile("s_waitcnt vmcnt(" #n ")" ::: "memory")
#define PG8_WAIT_L(n) asm volatile("s_waitcnt lgkmcnt(" #n ")" ::: "memory")
#define PG8_BAR __builtin_amdgcn_s_barrier()
#define PG8_SCHED __builtin_amdgcn_sched_barrier(0)
    Unit cur, nxt; int ui = 0;
    if (!S.next(0, cur)) return;
    f32x4 acc[2][2][4][2];
#pragma unroll
    for (int a = 0; a < 2; ++a)
#pragma unroll
        for (int b = 0; b < 2; ++b)
#pragma unroll
            for (int m = 0; m < 4; ++m)
#pragma unroll
                for (int n = 0; n < 2; ++n) acc[a][b][m][n] = (f32x4){0.f, 0.f, 0.f, 0.f};
    bf16x8 At[4][2], B0[2][2], B1[2][2];
    const char* cA = (const char*)g.A + (size_t)cur.pm * tstep; const char* cB = (const char*)g.Bt + (size_t)cur.pn * tstep;
    S.a_ready(cur);
    if constexpr (SP2) {
        PG8_STAGE(PG8_SB(0, 0), cB, voffB); PG8_STAGE(PG8_SB(0, 1), cB + hstep, voffB); PG8_STAGE(PG8_SA(0, 0), cA, voffA); PG8_STAGE(PG8_SA(0, 1), cA + hstep, voffA);
        if (wr == 1) PG8_BAR;
        PG8_WAIT_V(2); PG8_BAR;
        PG8_STAGE(PG8_SB(1, 0), cB + kstep, voffB); PG8_STAGE(PG8_SA(1, 0), cA + kstep, voffA); PG8_STAGE(PG8_SB(1, 1), cB + hstep + kstep, voffB);
        PG8_WAIT_V(6); PG8_BAR;
    } else {
        PG8_STAGE(PG8_SB(0, 0), cB, voffB); PG8_STAGE(PG8_SA(0, 0), cA, voffA); PG8_STAGE(PG8_SB(0, 1), cB + hstep, voffB); PG8_STAGE(PG8_SA(0, 1), cA + hstep, voffA);
        if (wr == 1) PG8_BAR;
        PG8_WAIT_V(4); PG8_BAR;
        PG8_STAGE(PG8_SB(1, 0), cB + kstep, voffB); PG8_STAGE(PG8_SA(1, 0), cA + kstep, voffA); PG8_STAGE(PG8_SB(1, 1), cB + hstep + kstep, voffB);
        PG8_WAIT_V(6); PG8_BAR;
    }
    for (;;) {
        const bool has_next = S.next(ui + 1, nxt);
        const char* nA = has_next ? (const char*)g.A + (size_t)nxt.pm * tstep : cA; const char* nB = has_next ? (const char*)g.Bt + (size_t)nxt.pn * tstep : cB;
        for (int t = 0; t < nt; t += 2) {
            const bool last = (t == nt - 2);
            const char* a1 = cA + (size_t)(t + 1) * kstep;
            const char* a2 = last ? nA : cA + (size_t)(t + 2) * kstep; const char* b2 = last ? nB : cB + (size_t)(t + 2) * kstep;
            const char* a3 = a2 + kstep; const char* b3 = b2 + kstep;
            if (last && has_next) S.a_ready(nxt);
            if constexpr (SP2) {
            PG8_LDB(B0, 0, 0); PG8_LDB(B1, 0, 1); PG8_SCHED; PG8_LDA(At, 0, 0); PG8_STAGE(PG8_SA(1, 1), a1 + hstep, voffA);
            PG8_WAIT_V(8); PG8_WAIT_L(0); PG8_BAR; PG8_MMA(0, 0, At, B0); PG8_MMA(0, 1, At, B1); PG8_BAR; PG8_SCHED;
            PG8_LDA(At, 0, 1); PG8_STAGE(PG8_SB(0, 0), b2, voffB); PG8_STAGE(PG8_SB(0, 1), b2 + hstep, voffB); PG8_STAGE(PG8_SA(0, 0), a2, voffA);
            PG8_WAIT_V(8); PG8_WAIT_L(0); PG8_BAR; PG8_MMA(1, 0, At, B0); PG8_MMA(1, 1, At, B1); PG8_BAR; PG8_SCHED;
            PG8_LDB(B0, 1, 0); PG8_LDB(B1, 1, 1); PG8_SCHED; PG8_LDA(At, 1, 0); PG8_STAGE(PG8_SA(0, 1), a2 + hstep, voffA);
            PG8_WAIT_V(8); PG8_WAIT_L(0); PG8_BAR; PG8_MMA(0, 0, At, B0); PG8_MMA(0, 1, At, B1); PG8_BAR; PG8_SCHED;
            PG8_LDA(At, 1, 1); PG8_STAGE(PG8_SB(1, 0), b3, voffB); PG8_STAGE(PG8_SB(1, 1), b3 + hstep, voffB); PG8_STAGE(PG8_SA(1, 0), a3, voffA);
            PG8_WAIT_V(8); PG8_WAIT_L(0); PG8_BAR; PG8_MMA(1, 0, At, B0); PG8_MMA(1, 1, At, B1); PG8_BAR; PG8_SCHED;
            } else {
            PG8_LDB(B0, 0, 0); PG8_SCHED; PG8_LDA(At, 0, 0); PG8_STAGE(PG8_SA(1, 1), a1 + hstep, voffA);
            PG8_WAIT_L(8); PG8_BAR; PG8_WAIT_L(0); PG8_MMA(0, 0, At, B0); PG8_BAR; PG8_SCHED;
            PG8_LDB(B1, 0, 1); PG8_STAGE(PG8_SB(0, 0), b2, voffB);
            PG8_BAR; PG8_WAIT_L(0); PG8_MMA(0, 1, At, B1); PG8_BAR;
            PG8_LDA(At, 0, 1); PG8_STAGE(PG8_SA(0, 0), a2, voffA);
            PG8_BAR; PG8_WAIT_L(0); PG8_MMA(1, 0, At, B0); PG8_BAR; PG8_SCHED;
            PG8_STAGE(PG8_SB(0, 1), b2 + hstep, voffB);
            PG8_WAIT_V(6); PG8_BAR; PG8_MMA(1, 1, At, B1); PG8_BAR;
            PG8_LDB(B0, 1, 0); PG8_SCHED; PG8_LDA(At, 1, 0); PG8_STAGE(PG8_SA(0, 1), a2 + hstep, voffA);
            PG8_WAIT_L(8); PG8_BAR; PG8_WAIT_L(0); PG8_MMA(0, 0, At, B0); PG8_BAR; PG8_SCHED;
            PG8_LDB(B1, 1, 1); PG8_STAGE(PG8_SB(1, 0), b3, voffB);
            PG8_BAR; PG8_WAIT_L(0); PG8_MMA(0, 1, At, B1); PG8_BAR;
            PG8_LDA(At, 1, 1); PG8_STAGE(PG8_SA(1, 0), a3, voffA);
            PG8_BAR; PG8_WAIT_L(0); PG8_MMA(1, 0, At, B0); PG8_BAR; PG8_SCHED;
            PG8_STAGE(PG8_SB(1, 1), b3 + hstep, voffB);
            PG8_WAIT_V(6); PG8_BAR; PG8_MMA(1, 1, At, B1); PG8_BAR;
            }
        }
        if constexpr (ALIGN_EPI) { if (wr == 0) PG8_BAR; }
        if constexpr (!Epi::AFTER_DRAIN) { E(acc, cur, wr, wc, fr, fq); S.done(cur); }
        if (!has_next) break;
#pragma unroll
        for (int a = 0; a < 2; ++a)
#pragma unroll
            for (int b = 0; b < 2; ++b)
#pragma unroll
                for (int m = 0; m < 4; ++m)
#pragma unroll
                    for (int n = 0; n < 2; ++n) acc[a][b][m][n] = (f32x4){0.f, 0.f, 0.f, 0.f};
        cur = nxt; cA = nA; cB = nB; ++ui;
        if constexpr (ALIGN_EPI) { if (wr == 1) PG8_BAR; }
    }
    PG8_WAIT_V(0);
    if constexpr (!ALIGN_EPI) { if (wr == 0) PG8_BAR; }
    PG8_BAR;
    if constexpr (Epi::AFTER_DRAIN) { E.fused(acc, cur, wr, wc, fr, fq, lds, wid, lane); S.done(cur); }
#undef PG8_SA
#undef PG8_SB
#undef PG8_STAGE
#undef PG8_LDA
#undef PG8_LDB
#undef PG8_MMA
#undef PG8_WAIT_V
#undef PG8_WAIT_L
#undef PG8_BAR
#undef PG8_SCHED
}
}
#define GAS __attribute__((address_space(1)))
#define LAS __attribute__((address_space(3)))
typedef unsigned short bf16;
typedef unsigned v4u __attribute__((ext_vector_type(4)));
typedef float f32x4 __attribute__((ext_vector_type(4)));
typedef short bf16x8 __attribute__((ext_vector_type(8)));
typedef GAS unsigned gu32;
typedef GAS unsigned long long gu64;
#define RLX_AGENT __ATOMIC_RELAXED, __HIP_MEMORY_SCOPE_AGENT
#define LDS_WAIT() asm volatile("s_waitcnt lgkmcnt(0)" ::: "memory")
#define VM_WAIT() asm volatile("s_waitcnt vmcnt(0)" ::: "memory")
__device__ __forceinline__ unsigned long long rt() { return __builtin_amdgcn_s_memrealtime(); }
typedef float f32x2_ __attribute__((ext_vector_type(2)));
typedef __bf16 bf16x2_ __attribute__((ext_vector_type(2)));
__device__ __forceinline__ unsigned pk2(float lo, float hi) { const f32x2_ v = {lo, hi}; const bf16x2_ b = __builtin_convertvector(v, bf16x2_); return __builtin_bit_cast(unsigned, b); }
__device__ __forceinline__ unsigned f2bf(float f) { return (unsigned)__builtin_bit_cast(unsigned short, (__bf16)f); }

#define XB_TMO      128
#define XB_XCNT(j)  (256  + 64 * (j))
#define XB_XSUB(j)  (1280 + 64 * (j))
#define XB_XGEN(j)  (2304 + 64 * (j))
#define XB_TOP      3328
#define XB_TOPGEN   3392
#define XCD_BAR_WORDS 3456
#define XB_SPIN_CAP (1u << 18)

__device__ __forceinline__ unsigned xb_ld(unsigned* p)              { return __hip_atomic_load(p, __ATOMIC_RELAXED, __HIP_MEMORY_SCOPE_AGENT); }
__device__ __forceinline__ unsigned xb_add(unsigned* p, unsigned v) { return __hip_atomic_fetch_add(p, v, __ATOMIC_RELAXED, __HIP_MEMORY_SCOPE_AGENT); }
__device__ __forceinline__ unsigned xb_xcc_id() { return (unsigned)__builtin_amdgcn_s_getreg((3 << 11) | 20) & 0xFu; }
#define XB_SPIN(cond, bar) do { unsigned _sp = 0; while (cond) { __builtin_amdgcn_s_sleep(1); \
    if ((++_sp & 255u) == 0u) { if (xb_ld(&(bar)[XB_TMO])) break; if (_sp > XB_SPIN_CAP) { atomicAdd(&(bar)[XB_TMO], 1u); break; } } } } while (0)

struct XcdBarrier {
    unsigned* bar; unsigned x;
    volatile LAS unsigned* st;
};

__device__ __forceinline__ XcdBarrier xcd_barrier_post(unsigned* bar, volatile LAS unsigned* st, const int tid_) {
    XcdBarrier b; b.bar = bar; b.x = xb_xcc_id(); b.st = st;
    if (tid_ == 0) (void)xb_add(&bar[XB_XCNT(b.x)], 1u);
    return b;
}
__device__ __forceinline__ void xcd_barrier_complete(unsigned* bar, unsigned x, unsigned& nloc, unsigned& nx) {
    const unsigned G = gridDim.x * gridDim.y * gridDim.z;
    unsigned sum, cnt, mine, sp = 0u;
    for (;;) {
        sum = 0u; cnt = 0u; mine = 0u;
#pragma unroll
        for (unsigned j = 0; j < 16; ++j) { const unsigned c = xb_ld(&bar[XB_XCNT(j)]); sum += c; cnt += (c > 0u) ? 1u : 0u; mine = (j == x) ? c : mine; }
        if (sum == G) break;
        __builtin_amdgcn_s_sleep(1);
        if ((++sp & 255u) == 0u) { if (xb_ld(&bar[XB_TMO])) break; if (sp > XB_SPIN_CAP) { atomicAdd(&bar[XB_TMO], 1u); break; } }
    }
    nloc = mine > 0u ? mine : 1u; nx = cnt > 0u ? cnt : 1u;
}

__device__ __forceinline__ void xcd_barrier(const XcdBarrier& b, const int tid_) {
    asm volatile("s_waitcnt vmcnt(0)" ::: "memory");
    __syncthreads();
    if (tid_ == 0) {
        unsigned* bar = b.bar;
        __builtin_amdgcn_s_waitcnt(0);
        unsigned nloc = b.st[0], nx = b.st[1];
        if (nloc == 0u) { xcd_barrier_complete(bar, b.x, nloc, nx); b.st[0] = nloc; b.st[1] = nx; }
        const unsigned old = xb_add(&bar[XB_XSUB(b.x)], 1u);
        const unsigned gen = old / nloc;
        if (old + 1u == (gen + 1u) * nloc) {
            __builtin_amdgcn_fence(__ATOMIC_RELEASE, "agent");
            asm volatile("s_waitcnt vmcnt(0)" ::: "memory");
            const unsigned og = xb_add(&bar[XB_TOP], 1u);
            const unsigned tg = og / nx;
            if (og + 1u == (tg + 1u) * nx) xb_add(&bar[XB_TOPGEN], 1u);
            else XB_SPIN(xb_ld(&bar[XB_TOPGEN]) == tg, bar);
            __builtin_amdgcn_fence(__ATOMIC_ACQUIRE, "agent");
            xb_add(&bar[XB_XGEN(b.x)], 1u);
            asm volatile("s_waitcnt vmcnt(0)" ::: "memory");
        } else {
            XB_SPIN(xb_ld(&bar[XB_XGEN(b.x)]) == gen, bar);
            __builtin_amdgcn_fence(__ATOMIC_ACQUIRE, "agent");
            asm volatile("s_waitcnt vmcnt(0)" ::: "memory");
        }
    }
    __syncthreads();
}

constexpr int D = 1024, NP = 16384, NS = 512, M = NP + NS, INW = 3072, FF = 4096, TP = 4096;
constexpr int C_AV = 0, C_AG = 256, C_Q = 512, C_F = 1024, C_I = 1536, C_G = 2048, C_QA = 2560, C_KA = 2816, C_VA = 2944;
constexpr int MODR = 132, MODLD = 6144;
constexpr float EPS = 1e-6f;
constexpr size_t O_CONVP = (size_t)M * D, O_CONVS = O_CONVP + 2 * 4 * 30 * 256, O_HGP = O_CONVS + 2 * 128 * 30 * 256, O_HGS = O_HGP + 2 * 4 * 4 * 16384,
                 O_KP = O_HGS + (size_t)2 * 128 * 4 * 16384, O_KS = O_KP + 2 * 4 * 128 * 128, O_VP = O_KS + (size_t)2 * 128 * 128 * 128, O_VS = O_VP + 2 * 4 * 128 * 128,
                 O_END = O_VS + (size_t)2 * 128 * 128 * 128;
constexpr size_t MiB = 1u << 20;
constexpr size_t WS_CTL = 0, CTL_ZERO_BYTES = 1 * MiB, WS_TAB = 1 * MiB, WS_MOD = 2 * MiB, WS_DC = 9 * MiB, WS_WIN = 10 * MiB, WS_WOUT = 22 * MiB, WS_WUP = 26 * MiB, WS_WDN = 42 * MiB,
                 WS_XN = 58 * MiB, WS_HG = 58 * MiB, WS_PROJ = 91 * MiB, WS_MIX = 190 * MiB, WS_HB = 91 * MiB, WS_SHB = 224 * MiB, WS_SHW = 226 * MiB, WS_END = 236 * MiB;
constexpr size_t CTL_RSS = 65536;
constexpr size_t WS_SC = WS_TAB + 65536;
constexpr int CW_BAR = 4096;
constexpr int RING_BYTES = 131072, LDSCTL_OFF = RING_BYTES, MISC_OFF = LDSCTL_OFF + 320, LDS_BYTES = 147456;
constexpr int NPH = 21;

typedef float f32x16 __attribute__((ext_vector_type(16)));
typedef unsigned v2u __attribute__((ext_vector_type(2)));
__device__ __forceinline__ float bf2f(unsigned h) { return __builtin_bit_cast(float, h << 16); }
__device__ __forceinline__ float wave_sum(float v) {
#pragma unroll
    for (int o = 1; o < 64; o <<= 1) v += __shfl_xor(v, o);
    return v;
}
__device__ __forceinline__ float wave_max(float v) {
#pragma unroll
    for (int o = 1; o < 64; o <<= 1) v = fmaxf(v, __shfl_xor(v, o));
    return v;
}
__device__ __forceinline__ int modrow(int r) { return r < NP ? (r >> 12) : 4 + ((r - NP) >> 2); }
__device__ __forceinline__ int crow(int r, int hi) { return (r & 3) + 8 * (r >> 2) + 4 * hi; }
__device__ __forceinline__ bf16x8 pk8(float a0, float a1, float a2, float a3, float a4, float a5, float a6, float a7) {
    v4u w; w.x = pk2(a0, a1); w.y = pk2(a2, a3); w.z = pk2(a4, a5); w.w = pk2(a6, a7); return __builtin_bit_cast(bf16x8, w);
}
__device__ __forceinline__ float sigm(float x) { return __builtin_amdgcn_rcpf(1.f + __expf(-x)); }
#define MFMA32(a, b, c) __builtin_amdgcn_mfma_f32_32x32x16_bf16((a), (b), (c), 0, 0, 0)
#define MFMA16(a, b, c) __builtin_amdgcn_mfma_f32_16x16x32_bf16((a), (b), (c), 0, 0, 0)

#ifndef PROBE_SPIN
#define PROBE_SPIN -1
#endif
#ifndef PROBE_N
#define PROBE_N 0
#endif
#define TSEC_BEGIN(k) const unsigned long long ts0_##k = PROBE_SPIN == (k) ? __builtin_amdgcn_s_memrealtime() : 0ull
#define TSEC_END(k) do { if (PROBE_SPIN == (k)) { const unsigned long long ts1_ = __builtin_amdgcn_s_memrealtime(), du_ = (ts1_ - ts0_##k) * PROBE_N; while (__builtin_amdgcn_s_memrealtime() - ts1_ < du_) __builtin_amdgcn_s_sleep(4); } } while (0)
struct Args { const float* in[25]; float* out; unsigned char* ws; int ph_lo, ph_hi; };
struct Ctx {
    LAS unsigned char* lds;
    int tid, lane, wave, G, bid, z;
    float* out; unsigned char* ws;
};

__device__ __forceinline__ void p0_transpose_item(const float* W, int K, int N, bf16* WT, LAS float* scr, int item, int lane) {
    const int nblk = N / 32, kb = item / nblk, nb = item % nblk, k0 = 64 * kb, n0 = 32 * nb;
    float tv[32];
#pragma unroll
    for (int i = 0; i < 32; ++i) { const int kk = 2 * i + (lane >> 5); tv[i] = W[(size_t)(k0 + kk) * N + n0 + (lane & 31)]; }
    __builtin_amdgcn_sched_barrier(0);
#pragma unroll
    for (int i = 0; i < 32; ++i) { const int kk = 2 * i + (lane >> 5); scr[kk * 33 + (lane & 31)] = tv[i]; }
    LDS_WAIT(); asm volatile("" ::: "memory");
    const int c = lane & 7;
#pragma unroll
    for (int j = 0; j < 4; ++j) { const int n = (lane >> 3) + 8 * j; const LAS float* s = scr + (8 * c) * 33 + n;
        v4u o; o.x = pk2(s[0 * 33], s[1 * 33]); o.y = pk2(s[2 * 33], s[3 * 33]); o.z = pk2(s[4 * 33], s[5 * 33]); o.w = pk2(s[6 * 33], s[7 * 33]);
        *(GAS v4u*)(WT + (size_t)(n0 + n) * K + k0 + 8 * c) = o; }
    LDS_WAIT(); asm volatile("" ::: "memory");
}
__device__ __forceinline__ void mod_unit(const Args& A, Ctx& F, int u) {
    const int l = u / 192, n0 = 32 * (u % 192), k0 = 128 * F.wave, c = F.lane & 31, h2 = F.lane >> 5;
    const float* W = A.in[9 + F.z] + (size_t)l * 1024 * 6144;
    f32x16 acc[5];
#pragma unroll
    for (int i = 0; i < 5; ++i)
#pragma unroll
        for (int e = 0; e < 16; ++e) acc[i][e] = 0.f;
    const bf16* SC = (const bf16*)(F.ws + WS_SC);
    LAS unsigned char* WL = F.lds + F.wave * 16384;
    const int lr = F.lane >> 3, lp = F.lane & 7;
    TSEC_BEGIN(42);
    __syncthreads();
#pragma unroll 1
    for (int jh = 0; jh < 2; ++jh) {
        const int kh = k0 + 64 * jh;
        float wv[4][8];
#pragma unroll
        for (int j = 0; j < 4; ++j)
#pragma unroll
            for (int e = 0; e < 8; ++e) wv[j][e] = W[(size_t)(kh + 16 * j + 8 * h2 + e) * 6144 + n0 + c];
        v4u rs[16];
#pragma unroll
        for (int t = 0; t < 16; ++t) rs[t] = *(const v4u*)(SC + (size_t)(4 + 8 * t + lr) * 1024 + kh + 8 * lp);
        bf16x8 ap4[4];
#pragma unroll
        for (int j = 0; j < 4; ++j) { ap4[j] = (bf16x8){0, 0, 0, 0, 0, 0, 0, 0}; if (c < 4) ap4[j] = *(const bf16x8*)(SC + (size_t)c * 1024 + kh + 16 * j + 8 * h2); }
        __builtin_amdgcn_sched_barrier(0);
#pragma unroll
        for (int t = 0; t < 16; ++t) { const int r = 8 * t + lr; *(LAS v4u*)(WL + r * 128 + ((lp ^ (r & 7)) << 4)) = rs[t]; }
        __builtin_amdgcn_sched_barrier(0);
#pragma unroll
        for (int j = 0; j < 4; ++j) {
            const bf16x8 b = pk8(wv[j][0], wv[j][1], wv[j][2], wv[j][3], wv[j][4], wv[j][5], wv[j][6], wv[j][7]);
            acc[0] = MFMA32(ap4[j], b, acc[0]);
#pragma unroll
            for (int rt = 1; rt < 5; ++rt) { const int r = 32 * (rt - 1) + c; const bf16x8 af = *(const LAS bf16x8*)(WL + r * 128 + (((2 * j + h2) ^ (r & 7)) << 4)); acc[rt] = MFMA32(af, b, acc[rt]); }
        }
        __builtin_amdgcn_sched_barrier(0);
    }
    TSEC_END(42);
    TSEC_BEGIN(43);
    LAS float* RED = (LAS float*)F.lds;
#define RED_WR(slot) do { _Pragma("unroll") for (int rt = 0; rt < 5; ++rt) _Pragma("unroll") for (int e = 0; e < 16; ++e) RED[(slot) * 5120 + (rt * 16 + e) * 64 + F.lane] = acc[rt][e]; } while (0)
#define RED_ADD(slot) do { _Pragma("unroll") for (int rt = 0; rt < 5; ++rt) _Pragma("unroll") for (int e = 0; e < 16; ++e) acc[rt][e] += RED[(slot) * 5120 + (rt * 16 + e) * 64 + F.lane]; } while (0)
    __syncthreads();
    if (F.wave >= 4) RED_WR(F.wave - 4);
    __syncthreads();
    if (F.wave < 4) RED_ADD(F.wave);
    __syncthreads();
    if (F.wave == 2 || F.wave == 3) RED_WR(F.wave - 2);
    __syncthreads();
    if (F.wave < 2) RED_ADD(F.wave);
    __syncthreads();
    if (F.wave == 1) RED_WR(0);
    __syncthreads();
    if (F.wave == 0) {
        RED_ADD(0);
        float* mo = (float*)(F.ws + WS_MOD) + (size_t)l * MODR * MODLD;
        const float bias = A.in[10 + F.z][l * MODLD + n0 + c];
#pragma unroll
        for (int rt = 0; rt < 5; ++rt)
#pragma unroll
            for (int e = 0; e < 16; ++e) { const int cr = crow(e, h2), r = rt == 0 ? cr : 4 + 32 * (rt - 1) + cr; if (rt > 0 || cr < 4) mo[(size_t)r * MODLD + n0 + c] = acc[rt][e] + bias; }
    }
#undef RED_WR
#undef RED_ADD
    TSEC_END(43);
}
__device__ __forceinline__ void p0_prologue(const Args& A, Ctx& F) {
    LAS float* scr = (LAS float*)(F.lds + F.wave * 16384);
    const int gw = F.bid * 8 + F.wave, NGW = F.G * 8;
    TSEC_BEGIN(40);
    for (int it = gw; it < 12288; it += NGW) {
        const int l = it / 6144; int r = it % 6144;
        if (r < 1536) { p0_transpose_item(A.in[12 + F.z] + (size_t)l * 1024 * 3072, 1024, 3072, (bf16*)(F.ws + WS_WIN) + (size_t)l * 3072 * 1024, scr, r, F.lane); continue; } r -= 1536;
        if (r < 512) { p0_transpose_item(A.in[20 + F.z] + (size_t)l * 1024 * 1024, 1024, 1024, (bf16*)(F.ws + WS_WOUT) + (size_t)l * 1024 * 1024, scr, r, F.lane); continue; } r -= 512;
        if (r < 2048) { p0_transpose_item(A.in[22 + F.z] + (size_t)l * 1024 * 4096, 1024, 4096, (bf16*)(F.ws + WS_WUP) + (size_t)l * 4096 * 1024, scr, r, F.lane); continue; } r -= 2048;
        p0_transpose_item(A.in[23 + F.z] + (size_t)l * 4096 * 1024, 4096, 1024, (bf16*)(F.ws + WS_WDN) + (size_t)l * 1024 * 4096, scr, r, F.lane);
    }
    TSEC_END(40);
    if (F.bid == 0) {
        float* BT = (float*)(F.ws + WS_TAB); float* LB1 = BT + 1024;
        for (int i = F.tid; i < 129 * 4; i += 512) { const int rel = i >> 2, h = i & 3; int bk = rel;
            if (rel >= 16) { bk = 16 + (int)(logf((float)rel / 16.f) / logf(8.f) * 16.f); bk = bk > 31 ? 31 : bk; }
            BT[i] = A.in[8 + F.z][bk * 4 + h]; }
        { const int i = F.tid; const float a = A.in[17 + F.z][i], b = A.in[17 + F.z][512 + i], mx = fmaxf(a, b), ea = expf(a - mx), eb = expf(b - mx); LB1[i] = eb / (ea + eb); }
    }
    for (int i = F.bid * 512 + F.tid; i < 160 * 128; i += F.G * 512) {
        const int r = i >> 7, k8 = 8 * (i & 127);
        v4u o = {0u, 0u, 0u, 0u};
        if (r < MODR) { const float* cp = (r < 4 ? A.in[6 + F.z] + r * 1024 : A.in[7 + F.z] + (r - 4) * 1024) + k8; const f32x4 c0 = *(const f32x4*)cp, c1 = *(const f32x4*)(cp + 4);
            o.x = pk2(c0.x * sigm(c0.x), c0.y * sigm(c0.y)); o.y = pk2(c0.z * sigm(c0.z), c0.w * sigm(c0.w)); o.z = pk2(c1.x * sigm(c1.x), c1.y * sigm(c1.y)); o.w = pk2(c1.z * sigm(c1.z), c1.w * sigm(c1.w)); }
        *(v4u*)((bf16*)(F.ws + WS_SC) + (size_t)r * 1024 + k8) = o;
    }
}
__device__ __forceinline__ void mod_phase(const Args& A, Ctx& F) {
    TSEC_BEGIN(41);
    if ((F.G & 7) == 0) { const int xg = F.bid & 7, wpx = F.G >> 3; for (int w = F.bid >> 3; w < 48; w += wpx) mod_unit(A, F, xg * 48 + w); }
    else for (int u = F.bid; u < 384; u += F.G) mod_unit(A, F, u);
    TSEC_END(41);
}
__device__ __forceinline__ void norm_phase(const Args& A, Ctx& F, int l, int which) {
    if (l == 0 && which == 0) {
        const float* MODp = (const float*)(F.ws + WS_MOD);
        for (int i = F.bid * 512 + F.tid; i < 3 * 192 * 128; i += F.G * 512) {
            const int f = i / (192 * 128), r = (i >> 7) % 192, k8 = 8 * (i & 127);
            v4u o = {0u, 0u, 0u, 0u};
            if (r < MODR) { const float* sp = MODp + (size_t)(f == 0 ? 0 : 1) * MODR * MODLD + (size_t)r * MODLD + (f == 1 ? 0 : 3 * D) + k8; const f32x4 c0 = *(const f32x4*)sp, c1 = *(const f32x4*)(sp + 4);
                o.x = pk2(c0.x, c0.y); o.y = pk2(c0.z, c0.w); o.z = pk2(c1.x, c1.y); o.w = pk2(c1.z, c1.w); }
            *(v4u*)((bf16*)(F.ws + WS_SHB) + (size_t)(f * 192 + r) * 1024 + k8) = o;
        }
    }
    const int gw = F.bid * 8 + F.wave, NGW = F.G * 8;
    const float* gamma = which == 0 ? A.in[11 + F.z] + l * D : (which == 1 ? A.in[21 + F.z] + l * D : A.in[24 + F.z]);
    const float* mod = (const float*)(F.ws + WS_MOD) + (size_t)l * MODR * MODLD;
    const int shc = which == 0 ? 0 : 3 * D, scc = shc + D;
    const bool from_in = (which == 0 && l == 0);
    bf16* XN = (bf16*)(F.ws + WS_XN);
    f32x4 gm[4];
#pragma unroll
    for (int j = 0; j < 4; ++j) gm[j] = *(const f32x4*)(gamma + 4 * F.lane + 256 * j);
    constexpr int NR = 4;
    for (int m0 = gw; m0 < M; m0 += NR * NGW) {
        f32x4 v[NR][4], msc[NR][4], msh[NR][4];
#pragma unroll
        for (int r = 0; r < NR; ++r) { const int mr_ = m0 + r * NGW, m = mr_ < M ? mr_ : m0;
            const float* xr = from_in ? (m < NP ? A.in[0 + F.z] + (size_t)m * D : A.in[1 + F.z] + (size_t)(m - NP) * D) : F.out + (size_t)m * D;
#pragma unroll
            for (int j = 0; j < 4; ++j) v[r][j] = *(const f32x4*)(xr + 4 * F.lane + 256 * j);
            if (which != 2) { const float* mr = mod + (size_t)modrow(m) * MODLD;
#pragma unroll
                for (int j = 0; j < 4; ++j) { msc[r][j] = *(const f32x4*)(mr + scc + 4 * F.lane + 256 * j); msh[r][j] = *(const f32x4*)(mr + shc + 4 * F.lane + 256 * j); } } }
        __builtin_amdgcn_sched_barrier(0);
        float ssq[NR];
#pragma unroll
        for (int r = 0; r < NR; ++r) { ssq[r] = 0.f;
#pragma unroll
            for (int j = 0; j < 4; ++j) ssq[r] += (v[r][j].x * v[r][j].x + v[r][j].y * v[r][j].y) + (v[r][j].z * v[r][j].z + v[r][j].w * v[r][j].w); }
#pragma unroll
        for (int o = 1; o < 64; o <<= 1) {
            float t_[NR];
#pragma unroll
            for (int r = 0; r < NR; ++r) t_[r] = __shfl_xor(ssq[r], o);
#pragma unroll
            for (int r = 0; r < NR; ++r) ssq[r] += t_[r];
        }
#pragma unroll
        for (int r = 0; r < NR; ++r) {
            const int m = m0 + r * NGW;
            if (m < M) {
                const float rstd = __builtin_amdgcn_rsqf(ssq[r] * (1.f / D) + EPS);
                if (which == 2) {
#pragma unroll
                    for (int j = 0; j < 4; ++j) *(f32x4*)(F.out + (size_t)m * D + 4 * F.lane + 256 * j) = v[r][j] * rstd * gm[j];
                } else {
#pragma unroll
                    for (int j = 0; j < 4; ++j) { const f32x4 y = v[r][j] * rstd * gm[j] * (msc[r][j] + 1.f) + msh[r][j]; v2u w; w.x = pk2(y.x, y.y); w.y = pk2(y.z, y.w);
                        *(v2u*)(XN + (size_t)m * D + 4 * F.lane + 256 * j) = w; }
                }
            }
        }
    }
}

constexpr int RS = 272;
constexpr int RS64 = 144;
struct HgGate { float cl[16], kf[16]; };
__device__ __forceinline__ void hg_gates(const float lb, const LAS unsigned short* rawf  , int d, HgGate& g) {
    float run = 0.f;
#pragma unroll
    for (int j = 0; j < 16; ++j) {
        const float x = bf2f(rawf[j * (RS / 2) + d]);
        const float e = __expf(-x), sg = __builtin_amdgcn_rcpf(1.f + e);
        const float f = lb + (1.f - lb) * sg;
        g.kf[j] = (1.f - lb) * e * sg;
        run += __logf(f); g.cl[j] = run;
    }
}
__device__ __forceinline__ void tile_load(const bf16* g0  , int tid, v4u (&r)[2]) {
#pragma unroll
    for (int i = 0; i < 2; ++i) { const int it = tid + 512 * i; r[i] = *(const v4u*)(g0 + (size_t)(it >> 4) * INW + 8 * (it & 15)); }
    __builtin_amdgcn_sched_barrier(0);
}
__device__ __forceinline__ void tile_store(LAS unsigned char* dst, int tid, const v4u (&r)[2]) {
#pragma unroll
    for (int i = 0; i < 2; ++i) { const int it = tid + 512 * i; *(LAS v4u*)(dst + (it >> 4) * RS + 16 * (it & 15)) = r[i]; }
}
__device__ __forceinline__ void h1_load(Ctx& F, int u, v4u (&rf)[2], v4u (&rv)[2]) {
    const int bh = u >> 6, b = bh >> 2, h = bh & 3, ch = u & 63, m0 = b * TP + ch * 64;
    const bf16* PROJ = (const bf16*)(F.ws + WS_PROJ);
    tile_load(PROJ + (size_t)m0 * INW + C_F + h * 128, F.tid, rf); tile_load(PROJ + (size_t)m0 * INW + C_I + h * 128, F.tid, rv);
}
__device__ __forceinline__ void h1_unit(const Args& A, Ctx& F, int l, int u, const v4u (&rf)[2], const v4u (&rv)[2]) {
    const int bh = u >> 6, b = bh >> 2, h = bh & 3, ch = u & 63, m0 = b * TP + ch * 64;
    const int d = F.tid & 127, sc = F.tid >> 7, c = F.lane & 31, h2 = F.lane >> 5;
    const bf16* PROJ = (const bf16*)(F.ws + WS_PROJ);
    LAS unsigned char* L = F.lds;
    constexpr int OKDT = 0, OVT = 128 * RS64, OTOT = 2 * 128 * RS64, ORF = OTOT + 2048, ORV = ORF + 64 * RS;
    LAS unsigned short* KDT = (LAS unsigned short*)(L + OKDT);
    LAS unsigned short* VT = (LAS unsigned short*)(L + OVT);
    LAS float* TOT = (LAS float*)(L + OTOT);
    const float lb = l == 0 ? 0.f : ((const float*)(F.ws + WS_TAB))[1024 + h * 128 + d];
    __syncthreads();
    tile_store(L + ORF, F.tid, rf); tile_store(L + ORV, F.tid, rv);
    __syncthreads();
    HgGate g; hg_gates(lb, (const LAS unsigned short*)(L + ORF + sc * 16 * RS), d, g);
    TOT[sc * 128 + d] = g.cl[15];
#pragma unroll
    for (int j = 0; j < 16; ++j) VT[d * (RS64 / 2) + sc * 16 + j] = ((const LAS unsigned short*)(L + ORV))[(sc * 16 + j) * (RS / 2) + d];
    __syncthreads();
    float after = 0.f;
#pragma unroll
    for (int i = 1; i < 4; ++i) if (i > sc) after += TOT[i * 128 + d];
    const float tot = g.cl[15];
#pragma unroll
    for (int j = 0; j < 16; ++j) KDT[d * (RS64 / 2) + sc * 16 + j] = (unsigned short)f2bf(g.kf[j] * __expf(after + tot - g.cl[j]));
    if (sc == 0) ((float*)(F.ws + WS_DC))[u * 128 + d] = __expf(after + tot);
    __syncthreads();
    const int vt = F.wave >> 1, dt0 = 2 * (F.wave & 1);
    f32x16 acc0, acc1;
#pragma unroll
    for (int e = 0; e < 16; ++e) { acc0[e] = 0.f; acc1[e] = 0.f; }
#pragma unroll
    for (int ks = 0; ks < 4; ++ks) {
        const bf16x8 a = *(const LAS bf16x8*)(L + OVT + (32 * vt + c) * RS64 + (16 * ks + 8 * h2) * 2);
        const bf16x8 b0 = *(const LAS bf16x8*)(L + OKDT + (32 * dt0 + c) * RS64 + (16 * ks + 8 * h2) * 2);
        const bf16x8 b1 = *(const LAS bf16x8*)(L + OKDT + (32 * dt0 + 32 + c) * RS64 + (16 * ks + 8 * h2) * 2);
        acc0 = MFMA32(a, b0, acc0); acc1 = MFMA32(a, b1, acc1);
    }
    LAS unsigned short* OT = (LAS unsigned short*)(L + ORF);
#pragma unroll
    for (int e = 0; e < 16; ++e) { const int v = 32 * vt + crow(e, h2);
        OT[v * (RS / 2) + 32 * dt0 + c] = (unsigned short)f2bf(acc0[e]); OT[v * (RS / 2) + 32 * dt0 + 32 + c] = (unsigned short)f2bf(acc1[e]); }
    __syncthreads();
    bf16* HG = (bf16*)(F.ws + WS_HG) + (size_t)u * 16384;
#pragma unroll
    for (int i = 0; i < 4; ++i) { const int it = F.tid + 512 * i, v = it >> 4, ch16 = it & 15;
        *(v4u*)(HG + v * 128 + 8 * ch16) = *(const LAS v4u*)(L + ORF + v * RS + 16 * ch16); }
}
__device__ __forceinline__ void h2_scan(const Args& A, Ctx& F, int l) {
    unsigned* HG32 = (unsigned*)(F.ws + WS_HG); const float* DC = (const float*)(F.ws + WS_DC);
    for (int gid = F.bid * 512 + F.tid; gid < 16 * 8192; gid += F.G * 512) {
        const int bh = gid >> 13, e2 = gid & 8191, v = e2 >> 6, d = 2 * (e2 & 63);
        float s0 = 0.f, s1 = 0.f;
        for (int c0 = 0; c0 < 64; c0 += 16) {
            unsigned kc[16]; float d0[16], d1[16];
#pragma unroll
            for (int i = 0; i < 16; ++i) { const int u = bh * 64 + c0 + i; kc[i] = HG32[(size_t)u * 8192 + e2]; d0[i] = DC[u * 128 + d]; d1[i] = DC[u * 128 + d + 1]; }
            __builtin_amdgcn_sched_barrier(0);
#pragma unroll
            for (int i = 0; i < 16; ++i) { const int u = bh * 64 + c0 + i;
                HG32[(size_t)u * 8192 + e2] = pk2(s0, s1);
                s0 = d0[i] * s0 + bf2f(kc[i] & 0xffffu); s1 = d1[i] * s1 + bf2f(kc[i] >> 16); }
        }
        float* o = F.out + O_HGP + ((size_t)l * 16 + bh) * 16384;
        o[d * 128 + v] = s0; o[(d + 1) * 128 + v] = s1;
    }
}
__device__ __forceinline__ void h3_load(Ctx& F, int u, v4u (&rf)[2], v4u (&rq)[2], v4u (&rv)[2]) {
    const int bh = u >> 6, b = bh >> 2, h = bh & 3, ch = u & 63, m0 = b * TP + ch * 64;
    const bf16* PROJ = (const bf16*)(F.ws + WS_PROJ);
    tile_load(PROJ + (size_t)m0 * INW + C_F + h * 128, F.tid, rf); tile_load(PROJ + (size_t)m0 * INW + C_Q + h * 128, F.tid, rq); tile_load(PROJ + (size_t)m0 * INW + C_I + h * 128, F.tid, rv);
}
__device__ __forceinline__ void h3_unit(const Args& A, Ctx& F, int l, int u, const v4u (&rf)[2], const v4u (&rq)[2], const v4u (&rv)[2], int un, v4u (&nf)[2], v4u (&nq)[2], v4u (&nv)[2]) {
    const int bh = u >> 6, b = bh >> 2, h = bh & 3, ch = u & 63, m0 = b * TP + ch * 64;
    const int d = F.tid & 127, sc = F.tid >> 7, c = F.lane & 31, h2 = F.lane >> 5;
    const bf16* PROJ = (const bf16*)(F.ws + WS_PROJ);
    LAS unsigned char* L = F.lds;
    constexpr int OQH = 0, OKH = 64 * RS, OKC = 2 * 64 * RS, OQG = 3 * 64 * RS, OQT = OQG + 48 * RS, OAM = OQT + 64 * RS, OVT = OAM + 64 * RS64, OTOT = OVT + 128 * RS64, OEND = OTOT + 2048;
    static_assert(OEND <= RING_BYTES, "h3 LDS map");
    LAS unsigned short* QH = (LAS unsigned short*)(L + OQH); LAS unsigned short* KH = (LAS unsigned short*)(L + OKH); LAS unsigned short* KC = (LAS unsigned short*)(L + OKC);
    LAS unsigned short* QG = (LAS unsigned short*)(L + OQG); LAS unsigned short* QT = (LAS unsigned short*)(L + OQT); LAS unsigned short* AM = (LAS unsigned short*)(L + OAM);
    LAS unsigned short* VT = (LAS unsigned short*)(L + OVT); LAS float* TOT = (LAS float*)(L + OTOT); LAS float* O32 = (LAS float*)(L + OQH);
    TSEC_BEGIN(30);
    const float lb = l == 0 ? 0.f : ((const float*)(F.ws + WS_TAB))[1024 + h * 128 + d];
    f32x4 gnv[4];
#pragma unroll
    for (int i = 0; i < 4; ++i) gnv[i] = *(const f32x4*)(A.in[18 + F.z] + l * 128 + (F.tid & 7) * 16 + 4 * i);
    __syncthreads();
    tile_store(L + OQH, F.tid, rf); tile_store(L + OKH, F.tid, rq); tile_store(L + OKC, F.tid, rv);
    const bf16* gp = PROJ + (size_t)(m0 + (F.tid >> 3)) * INW + C_G + h * 128 + (F.tid & 7) * 16;
    const v4u g0 = *(const v4u*)gp, g1 = *(const v4u*)(gp + 8);
    const bf16* Srow = (const bf16*)(F.ws + WS_HG) + (size_t)u * 16384 + (size_t)(32 * (F.wave & 3) + c) * 128 + 8 * h2;
    bf16x8 sb[8];
#pragma unroll
    for (int ks = 0; ks < 8; ++ks) sb[ks] = *(const bf16x8*)(Srow + 16 * ks);
    __builtin_amdgcn_sched_barrier(0);
    for (int i = F.tid; i < 64 * RS64 / 4; i += 512) ((LAS unsigned*)AM)[i] = 0u;
    __syncthreads();
    TSEC_END(30);
    TSEC_BEGIN(31);
    HgGate g; hg_gates(lb, (const LAS unsigned short*)(L + OQH + sc * 16 * RS), d, g);
    float q[16];
#pragma unroll
    for (int j = 0; j < 16; ++j) q[j] = bf2f(((const LAS unsigned short*)(L + OKH))[(sc * 16 + j) * (RS / 2) + d]);
    TOT[sc * 128 + d] = g.cl[15];
#pragma unroll
    for (int j = 0; j < 16; ++j) VT[d * (RS64 / 2) + sc * 16 + j] = ((const LAS unsigned short*)(L + OKC))[(sc * 16 + j) * (RS / 2) + d];
    __syncthreads();
    TSEC_END(31);
    TSEC_BEGIN(32);
    const float t0 = TOT[d], t1 = TOT[128 + d], t2 = TOT[256 + d];
    const float rsc = sc == 0 ? 0.f : (sc == 1 ? t0 : (sc == 2 ? t0 + t1 : t0 + t1 + t2));
    const float ers = __expf(rsc), tot = g.cl[15];
    const float ga = sc == 2 ? __expf(t1) : __expf(t1 + t2), gb = __expf(t2);
#pragma unroll
    for (int j = 0; j < 16; ++j) {
        const int row = sc * 16 + j;
        const float qh = q[j] * __expf(g.cl[j]);
        QH[row * (RS / 2) + d] = (unsigned short)f2bf(qh);
        QT[row * (RS / 2) + d] = (unsigned short)f2bf(qh * ers);
        if (sc == 2) QG[j * (RS / 2) + d] = (unsigned short)f2bf(qh * ga);
        if (sc == 3) { QG[(16 + j) * (RS / 2) + d] = (unsigned short)f2bf(qh * ga); QG[(32 + j) * (RS / 2) + d] = (unsigned short)f2bf(qh * gb); }
        KH[row * (RS / 2) + d] = (unsigned short)f2bf(g.kf[j] * __expf(tot - g.cl[j]));
        KC[row * (RS / 2) + d] = (unsigned short)f2bf(g.kf[j] * __expf(-g.cl[j]));
    }
    h3_load(F, un, nf, nq, nv);
    __syncthreads();
    TSEC_END(32);
    TSEC_BEGIN(33);
    {
        const int r16 = F.lane & 15, kq = F.lane >> 4;
        for (int blk = F.wave; blk < 10; blk += 8) {
            int bi, bj, qoff, koff;
            if (blk < 4) { bi = blk; bj = blk; qoff = OQH + 16 * bi * RS; koff = OKC + 16 * bj * RS; }
            else if (blk < 7) { bi = blk - 3; bj = bi - 1; qoff = OQH + 16 * bi * RS; koff = OKH + 16 * bj * RS; }
            else if (blk == 7) { bi = 2; bj = 0; qoff = OQG; koff = OKH; }
            else if (blk == 8) { bi = 3; bj = 0; qoff = OQG + 16 * RS; koff = OKH; }
            else { bi = 3; bj = 1; qoff = OQG + 32 * RS; koff = OKH + 16 * RS; }
            f32x4 a4 = {0.f, 0.f, 0.f, 0.f};
#pragma unroll
            for (int ks = 0; ks < 4; ++ks) {
                const bf16x8 qa = *(const LAS bf16x8*)(L + qoff + r16 * RS + (32 * ks + 8 * kq) * 2);
                const bf16x8 kb = *(const LAS bf16x8*)(L + koff + r16 * RS + (32 * ks + 8 * kq) * 2);
                a4 = MFMA16(qa, kb, a4);
            }
#pragma unroll
            for (int e = 0; e < 4; ++e) { const int t = 4 * kq + e; float val = a4[e]; if (bi == bj && r16 > t) val = 0.f;
                AM[(16 * bi + t) * (RS64 / 2) + 16 * bj + r16] = (unsigned short)f2bf(val); }
        }
    }
    __syncthreads();
    TSEC_END(33);
    TSEC_BEGIN(34);
    const int tt = F.wave >> 2, vt = F.wave & 3;
    f32x16 acc;
#pragma unroll
    for (int e = 0; e < 16; ++e) acc[e] = 0.f;
#pragma unroll
    for (int ks = 0; ks < 4; ++ks) {
        const bf16x8 a = *(const LAS bf16x8*)(L + OAM + (32 * tt + c) * RS64 + (16 * ks + 8 * h2) * 2);
        const bf16x8 bv = *(const LAS bf16x8*)(L + OVT + (32 * vt + c) * RS64 + (16 * ks + 8 * h2) * 2);
        acc = MFMA32(a, bv, acc);
    }
#pragma unroll
    for (int ks = 0; ks < 8; ++ks) {
        const bf16x8 a = *(const LAS bf16x8*)(L + OQT + (32 * tt + c) * RS + (16 * ks + 8 * h2) * 2);
        acc = MFMA32(a, sb[ks], acc);
    }
#pragma unroll
    for (int e = 0; e < 16; ++e) O32[(32 * tt + crow(e, h2)) * 132 + 32 * vt + c] = acc[e];
    __syncthreads();
    TSEC_END(34);
    TSEC_BEGIN(35);
    {
        const int t = F.tid >> 3, vq = F.tid & 7;
        float o[16]; float ss = 0.f;
#pragma unroll
        for (int i = 0; i < 4; ++i) { const f32x4 x = *(const LAS f32x4*)(O32 + t * 132 + vq * 16 + 4 * i); o[4 * i] = x.x; o[4 * i + 1] = x.y; o[4 * i + 2] = x.z; o[4 * i + 3] = x.w;
            ss += (x.x * x.x + x.y * x.y) + (x.z * x.z + x.w * x.w); }
        ss += __shfl_xor(ss, 1); ss += __shfl_xor(ss, 2); ss += __shfl_xor(ss, 4);
        const float rstd = __builtin_amdgcn_rsqf(ss * (1.f / 128.f) + EPS);
        const float gn[16] = {gnv[0].x, gnv[0].y, gnv[0].z, gnv[0].w, gnv[1].x, gnv[1].y, gnv[1].z, gnv[1].w, gnv[2].x, gnv[2].y, gnv[2].z, gnv[2].w, gnv[3].x, gnv[3].y, gnv[3].z, gnv[3].w};
        unsigned gw_[8] = {g0.x, g0.y, g0.z, g0.w, g1.x, g1.y, g1.z, g1.w};
        unsigned ow[8];
#pragma unroll
        for (int i = 0; i < 8; ++i) {
            const float ga0 = bf2f(gw_[i] & 0xffffu), ga1 = bf2f(gw_[i] >> 16);
            const float y0 = o[2 * i] * rstd * gn[2 * i] * (ga0 * sigm(ga0)), y1 = o[2 * i + 1] * rstd * gn[2 * i + 1] * (ga1 * sigm(ga1));
            ow[i] = pk2(y0, y1);
        }
        bf16* op = (bf16*)(F.ws + WS_MIX) + (size_t)(m0 + t) * D + 256 + h * 128 + vq * 16;
        v4u w0 = {ow[0], ow[1], ow[2], ow[3]}, w1 = {ow[4], ow[5], ow[6], ow[7]};
        *(v4u*)op = w0; *(v4u*)(op + 8) = w1;
    }
    TSEC_END(35);
}

__device__ __forceinline__ void conv_tail(const Args& A, Ctx& F, int l, f32x4 acc, bf16* orow) {
    const float mean = wave_sum((acc.x + acc.y) + (acc.z + acc.w)) * (1.f / 256.f);
    const f32x4 dv = acc - mean;
    const float rstd = __builtin_amdgcn_rsqf(wave_sum((dv.x * dv.x + dv.y * dv.y) + (dv.z * dv.z + dv.w * dv.w)) * (1.f / 256.f) + EPS);
    const f32x4 lg = *(const f32x4*)(A.in[15 + F.z] + l * 256 + 4 * F.lane), lb = *(const f32x4*)(A.in[16 + F.z] + l * 256 + 4 * F.lane);
    const f32x4 y = dv * rstd * lg + lb;
    v2u w; w.x = pk2(y.x * sigm(y.x), y.y * sigm(y.y)); w.y = pk2(y.z * sigm(y.z), y.w * sigm(y.w));
    *(v2u*)(orow + 4 * F.lane) = w;
}
__device__ __forceinline__ void conv_unit(const Args& A, Ctx& F, int l, int u) {
    const int b = u >> 6, tile = u & 63, t0 = tile * 64;
    const bf16* PROJ = (const bf16*)(F.ws + WS_PROJ);
    LAS float* AL = (LAS float*)F.lds;
    v4u sv[6], sg[6];
#pragma unroll
    for (int i = 0; i < 6; ++i) { const int it = F.tid + 512 * i, row = it >> 5, cg = it & 31, t = t0 - 30 + row;
        sv[i] = (v4u){0u, 0u, 0u, 0u}; sg[i] = sv[i];
        if (it < 94 * 32 && t >= 0) { const bf16* p = PROJ + (size_t)(b * TP + t) * INW + 8 * cg; sv[i] = *(const v4u*)(p + C_AV); sg[i] = *(const v4u*)(p + C_AG); } }
    __builtin_amdgcn_sched_barrier(0);
    __syncthreads();
#pragma unroll
    for (int i = 0; i < 6; ++i) { const int it = F.tid + 512 * i, row = it >> 5, cg = it & 31;
        if (it < 94 * 32) {
            const v4u vv = sv[i], gg = sg[i]; f32x4 a0, a1;
            a0.x = bf2f(vv.x & 0xffffu) * sigm(bf2f(gg.x & 0xffffu)); a0.y = bf2f(vv.x >> 16) * sigm(bf2f(gg.x >> 16));
            a0.z = bf2f(vv.y & 0xffffu) * sigm(bf2f(gg.y & 0xffffu)); a0.w = bf2f(vv.y >> 16) * sigm(bf2f(gg.y >> 16));
            a1.x = bf2f(vv.z & 0xffffu) * sigm(bf2f(gg.z & 0xffffu)); a1.y = bf2f(vv.z >> 16) * sigm(bf2f(gg.z >> 16));
            a1.z = bf2f(vv.w & 0xffffu) * sigm(bf2f(gg.w & 0xffffu)); a1.w = bf2f(vv.w >> 16) * sigm(bf2f(gg.w >> 16));
            *(LAS f32x4*)(AL + row * 256 + 8 * cg) = a0; *(LAS f32x4*)(AL + row * 256 + 8 * cg + 4) = a1; } }
    const f32x4 cb = *(const f32x4*)(A.in[14 + F.z] + l * 256 + 4 * F.lane);
    __syncthreads();
    typedef float f32x2c __attribute__((ext_vector_type(2)));
    f32x4 acc[8];
#pragma unroll
    for (int hc = 0; hc < 2; ++hc) {
        __builtin_amdgcn_sched_barrier(0);
        f32x2c cw[31], a2[8];
#pragma unroll
        for (int j = 0; j < 31; ++j) cw[j] = *(const f32x2c*)(A.in[13 + F.z] + (size_t)(l * 31 + j) * 256 + 4 * F.lane + 2 * hc);
#pragma unroll
        for (int i = 0; i < 8; ++i) a2[i] = (f32x2c){hc ? cb.z : cb.x, hc ? cb.w : cb.y};
        __builtin_amdgcn_sched_barrier(0);
#pragma unroll
        for (int r = 0; r < 38; ++r) {
            const f32x2c row = *(const LAS f32x2c*)(AL + (8 * F.wave + r) * 256 + 4 * F.lane + 2 * hc);
#pragma unroll
            for (int i = 0; i < 8; ++i) if (r - i >= 0 && r - i <= 30) a2[i] += cw[r - i] * row;
            if ((r & 7) == 7) __builtin_amdgcn_sched_barrier(0);
        }
#pragma unroll
        for (int i = 0; i < 8; ++i) { if (hc) { acc[i].z = a2[i].x; acc[i].w = a2[i].y; } else { acc[i].x = a2[i].x; acc[i].y = a2[i].y; } }
    }
    {
        float s1[8], s2[8];
#pragma unroll
        for (int i = 0; i < 8; ++i) { s1[i] = (acc[i].x + acc[i].y) + (acc[i].z + acc[i].w); s2[i] = (acc[i].x * acc[i].x + acc[i].y * acc[i].y) + (acc[i].z * acc[i].z + acc[i].w * acc[i].w); }
#pragma unroll
        for (int o = 1; o < 64; o <<= 1) {
            float t1[8], t2[8];
#pragma unroll
            for (int i = 0; i < 8; ++i) { t1[i] = __shfl_xor(s1[i], o); t2[i] = __shfl_xor(s2[i], o); }
#pragma unroll
            for (int i = 0; i < 8; ++i) { s1[i] += t1[i]; s2[i] += t2[i]; }
        }
        const f32x4 lg = *(const f32x4*)(A.in[15 + F.z] + l * 256 + 4 * F.lane), lb = *(const f32x4*)(A.in[16 + F.z] + l * 256 + 4 * F.lane);
#pragma unroll
        for (int i = 0; i < 8; ++i) {
            const float mean = s1[i] * (1.f / 256.f), var = fmaxf(s2[i] * (1.f / 256.f) - mean * mean, 0.f);
            const float rstd = __builtin_amdgcn_rsqf(var + EPS);
            const f32x4 y = (acc[i] - mean) * rstd * lg + lb;
            v2u w; w.x = pk2(y.x * sigm(y.x), y.y * sigm(y.y)); w.y = pk2(y.z * sigm(y.z), y.w * sigm(y.w));
            *(v2u*)((bf16*)(F.ws + WS_MIX) + (size_t)(b * TP + t0 + 8 * F.wave + i) * D + 4 * F.lane) = w;
        }
    }
    if (tile == 63) {
        float* o = F.out + O_CONVP + (size_t)(l * 4 + b) * 30 * 256;
        for (int i = F.tid; i < 30 * 256; i += 512) o[i] = AL[64 * 256 + i];
    }
}
constexpr int VS = 528;
__device__ __forceinline__ void attn_unit(const Args& A, Ctx& F, int l, int u) {
    const int b = u >> 6, blk = (u >> 1) & 31, kvh = u & 1;
    const int c = F.lane & 31, h2 = F.lane >> 5;
    const bf16* PROJ = (const bf16*)(F.ws + WS_PROJ);
    LAS unsigned char* L = F.lds;
    LAS unsigned short* VTt = (LAS unsigned short*)L;
    LAS float* BTl = (LAS float*)(L + 64 * VS);
    const int tok0 = b * TP + (blk - 1) * 128;
    const int g = F.wave >> 2, qs = F.wave & 3, hq = 2 * kvh + g;
    const int mq = b * TP + blk * 128 + 32 * qs + c;
    bf16x8 bq[4];
#pragma unroll
    for (int ks = 0; ks < 4; ++ks) bq[ks] = *(const bf16x8*)(PROJ + (size_t)mq * INW + C_QA + hq * 64 + 16 * ks + 8 * h2);
#define ATTN_LOADK(dst, j) do { const int kidx_ = 32 * (qs + (j)) + c; const bool ex_ = (blk > 0 || kidx_ >= 128); \
        _Pragma("unroll") for (int ks = 0; ks < 4; ++ks) { dst[ks] = (bf16x8){0, 0, 0, 0, 0, 0, 0, 0}; \
            if (ex_) dst[ks] = *(const bf16x8*)(PROJ + (size_t)(tok0 + kidx_) * INW + C_KA + kvh * 64 + 16 * ks + 8 * h2); } } while (0)
    bf16x8 ak0[4], ak1[4];
    ATTN_LOADK(ak0, 0); ATTN_LOADK(ak1, 1);
    const float sink = A.in[19 + F.z][l * 4 + hq];
    float btv = 0.f; { const int gg = F.tid / 224, ix = F.tid % 224 - 32; if (F.tid < 448 && ix >= 0 && ix <= 128) btv = ((const float*)(F.ws + WS_TAB))[(128 - ix) * 4 + 2 * kvh + gg]; }
    __builtin_amdgcn_sched_barrier(0);
    __syncthreads();
    if (F.tid < 448) BTl[F.tid] = btv;
    f32x16 S[5];
#pragma unroll
    for (int j = 0; j < 5; ++j)
#pragma unroll
        for (int e = 0; e < 16; ++e) S[j][e] = 0.f;
    bf16x8 ak2[4], ak3[4];
    ATTN_LOADK(ak2, 2); ATTN_LOADK(ak3, 3);
    __builtin_amdgcn_sched_barrier(0);
#pragma unroll
    for (int ks = 0; ks < 4; ++ks) { S[0] = MFMA32(ak0[ks], bq[ks], S[0]); S[1] = MFMA32(ak1[ks], bq[ks], S[1]); }
    ATTN_LOADK(ak0, 4);
#pragma unroll
    for (int ks = 0; ks < 4; ++ks) { S[2] = MFMA32(ak2[ks], bq[ks], S[2]); S[3] = MFMA32(ak3[ks], bq[ks], S[3]); }
#pragma unroll
    for (int ks = 0; ks < 4; ++ks) S[4] = MFMA32(ak0[ks], bq[ks], S[4]);
#undef ATTN_LOADK
    v4u vst[4];
#pragma unroll
    for (int i = 0; i < 4; ++i) { const int it = F.tid + 512 * i, kidx = it >> 3, chn = it & 7; vst[i] = (v4u){0u, 0u, 0u, 0u};
        if (blk > 0 || kidx >= 128) vst[i] = *(const v4u*)(PROJ + (size_t)(tok0 + kidx) * INW + C_VA + kvh * 64 + 8 * chn); }
    __builtin_amdgcn_sched_barrier(0);
    __syncthreads();
    float mx = -INFINITY;
    const LAS float* trp = BTl + g * 224 + 32 + 4 * h2 - c;
#pragma unroll
    for (int j = 0; j < 5; ++j) {
        float bia[16];
#pragma unroll
        for (int e = 0; e < 16; ++e) bia[e] = trp[32 * j + 8 * (e >> 2) + (e & 3)];
#pragma unroll
        for (int e = 0; e < 16; e += 4) asm volatile("" : "+v"(bia[e]), "+v"(bia[e + 1]), "+v"(bia[e + 2]), "+v"(bia[e + 3]));
#pragma unroll
        for (int e = 0; e < 16; ++e) {
            const int cr = crow(e, h2), rel = 128 + c - 32 * j - cr, kidx = 32 * (qs + j) + cr;
            const bool ok = rel >= 0 && rel <= 128 && (blk > 0 || kidx >= 128);
            const float s = ok ? S[j][e] * 0.125f + bia[e] : -INFINITY;
            S[j][e] = s; mx = fmaxf(mx, s);
        }
        __builtin_amdgcn_sched_barrier(0);
    }
    mx = fmaxf(mx, __shfl_xor(mx, 32)); mx = fmaxf(mx, sink);
    float sum = 0.f;
#pragma unroll
    for (int j = 0; j < 5; ++j)
#pragma unroll
        for (int e = 0; e < 16; ++e) { const float p = __expf(S[j][e] - mx); S[j][e] = p; sum += p; if (e == 15) __builtin_amdgcn_sched_barrier(0); }
    sum += __shfl_xor(sum, 32);
    const float inv = 1.f / (sum + __expf(sink - mx));
#pragma unroll
    for (int i = 0; i < 4; ++i) { const int it = F.tid + 512 * i, kidx = it >> 3, chn = it & 7;
        const int kl = kidx & 31, pos = (kidx & ~31) | (kl & 0x13) | ((kl & 4) << 1) | ((kl & 8) >> 1);
        const unsigned w[4] = {vst[i].x, vst[i].y, vst[i].z, vst[i].w};
#pragma unroll
        for (int e = 0; e < 4; ++e) { VTt[(8 * chn + 2 * e) * (VS / 2) + pos] = (unsigned short)(w[e] & 0xffffu); VTt[(8 * chn + 2 * e + 1) * (VS / 2) + pos] = (unsigned short)(w[e] >> 16); } }
    __syncthreads();
    f32x16 O0, O1;
#pragma unroll
    for (int e = 0; e < 16; ++e) { O0[e] = 0.f; O1[e] = 0.f; }
#pragma unroll
    for (int j = 0; j < 5; ++j)
#pragma unroll
        for (int s2 = 0; s2 < 2; ++s2) {
            const bf16x8 pb = pk8(S[j][8 * s2], S[j][8 * s2 + 1], S[j][8 * s2 + 2], S[j][8 * s2 + 3], S[j][8 * s2 + 4], S[j][8 * s2 + 5], S[j][8 * s2 + 6], S[j][8 * s2 + 7]);
            const int slot = 32 * (qs + j) + 16 * s2 + 8 * h2;
            const bf16x8 av0 = *(const LAS bf16x8*)(L + c * VS + slot * 2), av1 = *(const LAS bf16x8*)(L + (32 + c) * VS + slot * 2);
            O0 = MFMA32(av0, pb, O0); O1 = MFMA32(av1, pb, O1);
            __builtin_amdgcn_sched_barrier(0);
        }
    bf16* op = (bf16*)(F.ws + WS_MIX) + (size_t)mq * D + 768 + hq * 64;
#pragma unroll
    for (int gq = 0; gq < 4; ++gq) {
        v2u w0, w1;
        w0.x = pk2(O0[4 * gq] * inv, O0[4 * gq + 1] * inv); w0.y = pk2(O0[4 * gq + 2] * inv, O0[4 * gq + 3] * inv);
        w1.x = pk2(O1[4 * gq] * inv, O1[4 * gq + 1] * inv); w1.y = pk2(O1[4 * gq + 2] * inv, O1[4 * gq + 3] * inv);
        *(v2u*)(op + 8 * gq + 4 * h2) = w0; *(v2u*)(op + 32 + 8 * gq + 4 * h2) = w1;
    }
    if (blk == 31) {
        v4u kk[2], vv[2];
#pragma unroll
        for (int i = 0; i < 2; ++i) { const int it = F.tid + 512 * i, j = it >> 3, c8 = 8 * (it & 7);
            const bf16* p = PROJ + (size_t)(b * TP + 3968 + j) * INW + kvh * 64 + c8; kk[i] = *(const v4u*)(p + C_KA); vv[i] = *(const v4u*)(p + C_VA); }
        __builtin_amdgcn_sched_barrier(0);
#pragma unroll
        for (int i = 0; i < 2; ++i) { const int it = F.tid + 512 * i, j = it >> 3, c8 = 8 * (it & 7);
            const size_t oi = (((size_t)(l * 4 + b) * 128 + j) * 2 + kvh) * 64 + c8;
            const unsigned kw[4] = {kk[i].x, kk[i].y, kk[i].z, kk[i].w}, vw[4] = {vv[i].x, vv[i].y, vv[i].z, vv[i].w};
#pragma unroll
            for (int h4 = 0; h4 < 2; ++h4) {
                f32x4 ko, vo;
                ko.x = bf2f(kw[2 * h4] & 0xffffu); ko.y = bf2f(kw[2 * h4] >> 16); ko.z = bf2f(kw[2 * h4 + 1] & 0xffffu); ko.w = bf2f(kw[2 * h4 + 1] >> 16);
                vo.x = bf2f(vw[2 * h4] & 0xffffu); vo.y = bf2f(vw[2 * h4] >> 16); vo.z = bf2f(vw[2 * h4 + 1] & 0xffffu); vo.w = bf2f(vw[2 * h4 + 1] >> 16);
                *(f32x4*)(F.out + O_KP + oi + 4 * h4) = ko; *(f32x4*)(F.out + O_VP + oi + 4 * h4) = vo; } }
    }
}

__device__ __forceinline__ void samp_b_unit(const Args& A, Ctx& F, int l, int u) {
    const bf16* PROJ = (const bf16*)(F.ws + WS_PROJ);
    const int bs = u >> 1, hf = u & 1, m0 = NP + 4 * bs;
    LAS unsigned char* L = F.lds;
    constexpr int OFL = 0, OCV = 34 * 1024, OKL = OCV + 4096, OVTL = OKL + 144 * RS64, OQL = OVTL + 64 * 336, OSL = 0, OPL = 16 * 592, OENDB = OQL + 16 * RS64;
    static_assert(OENDB <= RING_BYTES && OPL + 16 * 336 <= OCV, "samp_b LDS map");
    LAS float* FL = (LAS float*)(L + OFL); LAS float* CV = (LAS float*)(L + OCV);
    const float* ck = A.in[4 + F.z] + ((size_t)l * 128 + bs) * 128 * 128 + hf * 64;
    const float* cv = A.in[5 + F.z] + ((size_t)l * 128 + bs) * 128 * 128 + hf * 64;
    float* okp = F.out + O_KS + ((size_t)l * 128 + bs) * 128 * 128 + hf * 64; float* ovp = F.out + O_VS + ((size_t)l * 128 + bs) * 128 * 128 + hf * 64;
    const float* cc = A.in[2 + F.z] + ((size_t)l * 128 + bs) * 30 * 256;
    f32x4 fr4[4];
#pragma unroll
    for (int i = 0; i < 4; ++i) { const int it = F.tid + 512 * i; fr4[i] = it < 30 * 64 ? *(const f32x4*)(cc + 4 * it) : (f32x4){0.f, 0.f, 0.f, 0.f}; }
    f32x4 kr[2][2], vr[2][2];
#pragma unroll
    for (int i = 0; i < 2; ++i) { const int it = F.tid + 512 * i, j = it >> 3, c8 = 8 * (it & 7);
        kr[i][0] = *(const f32x4*)(ck + j * 128 + c8); kr[i][1] = *(const f32x4*)(ck + j * 128 + c8 + 4); vr[i][0] = *(const f32x4*)(cv + j * 128 + c8); vr[i][1] = *(const f32x4*)(cv + j * 128 + c8 + 4); }
    const int nt_ = F.tid >> 8, nch = F.tid & 255;
    const bf16* pa0 = PROJ + (size_t)(m0 + nt_) * INW + nch; const bf16* pa1 = PROJ + (size_t)(m0 + 2 + nt_) * INW + nch;
    const unsigned short av0 = pa0[C_AV], ag0 = pa0[C_AG], av1 = pa1[C_AV], ag1 = pa1[C_AG];
    unsigned short kb = 0, vb = 0;
    if (F.tid < 256) { const int t = F.tid >> 6, r = F.tid & 63; const bf16* p = PROJ + (size_t)(m0 + t) * INW + hf * 64 + r; kb = p[C_KA]; vb = p[C_VA]; }
    unsigned short qv[2];
#pragma unroll
    for (int i = 0; i < 2; ++i) { const int ix = F.tid + 512 * i, row = ix >> 6, dd = ix & 63; qv[i] = PROJ[(size_t)(m0 + (row >> 2)) * INW + C_QA + (row & 3) * 64 + dd]; }
    const float sinkv = A.in[19 + F.z][l * 4 + 2 * hf + (F.wave & 1)];
    const float cbias = A.in[14 + F.z][l * 256 + nch];
    __builtin_amdgcn_sched_barrier(0);
    __syncthreads();
#pragma unroll
    for (int i = 0; i < 4; ++i) { const int it = F.tid + 512 * i; if (it < 30 * 64) *(LAS f32x4*)(FL + 4 * it) = fr4[i]; }
    FL[(30 + nt_) * 256 + nch] = bf2f(av0) * sigm(bf2f(ag0)); FL[(32 + nt_) * 256 + nch] = bf2f(av1) * sigm(bf2f(ag1));
#pragma unroll
    for (int i = 0; i < 2; ++i) { const int it = F.tid + 512 * i, j = it >> 3, c8 = 8 * (it & 7);
        const f32x4 k0 = kr[i][0], k1 = kr[i][1], v0 = vr[i][0], v1 = vr[i][1];
        if (j >= 4) { *(f32x4*)(okp + (j - 4) * 128 + c8) = k0; *(f32x4*)(okp + (j - 4) * 128 + c8 + 4) = k1; *(f32x4*)(ovp + (j - 4) * 128 + c8) = v0; *(f32x4*)(ovp + (j - 4) * 128 + c8 + 4) = v1; }
        v4u kw; kw.x = pk2(k0.x, k0.y); kw.y = pk2(k0.z, k0.w); kw.z = pk2(k1.x, k1.y); kw.w = pk2(k1.z, k1.w);
        *(LAS v4u*)(L + OKL + j * RS64 + 2 * c8) = kw;
        const float vv[8] = {v0.x, v0.y, v0.z, v0.w, v1.x, v1.y, v1.z, v1.w};
#pragma unroll
        for (int e = 0; e < 8; ++e) *(LAS unsigned short*)(L + OVTL + (c8 + e) * 336 + 2 * j) = (unsigned short)f2bf(vv[e]); }
    if (F.tid < 256) { const int t = F.tid >> 6, r = F.tid & 63;
        *(LAS unsigned short*)(L + OKL + (128 + t) * RS64 + 2 * r) = kb; *(LAS unsigned short*)(L + OVTL + r * 336 + 2 * (128 + t)) = vb;
        okp[(124 + t) * 128 + r] = bf2f(kb); ovp[(124 + t) * 128 + r] = bf2f(vb); }
    for (int i = F.tid; i < 12 * 64; i += 512) *(LAS unsigned short*)(L + OKL + (132 + (i >> 6)) * RS64 + 2 * (i & 63)) = 0;
    for (int i = F.tid; i < 64 * 28; i += 512) *(LAS unsigned short*)(L + OVTL + (i / 28) * 336 + 2 * (132 + i % 28)) = 0;
#pragma unroll
    for (int i = 0; i < 2; ++i) { const int ix = F.tid + 512 * i, row = ix >> 6, dd = ix & 63; *(LAS unsigned short*)(L + OQL + row * RS64 + 2 * dd) = qv[i]; }
    __syncthreads();
    {
        const int ch = nch, tok = 2 * hf + nt_;
        float a0 = cbias;
#pragma unroll
        for (int j = 0; j < 31; ++j) a0 += A.in[13 + F.z][(size_t)(l * 31 + j) * 256 + ch] * FL[(tok + j) * 256 + ch];
        CV[tok * 256 + ch] = a0;
    }
    { float* o = F.out + O_CONVS + ((size_t)l * 128 + bs) * 30 * 256 + hf * 15 * 256; for (int i = F.tid; i < 15 * 64; i += 512) *(f32x4*)(o + 4 * i) = *(const LAS f32x4*)(FL + (4 + 15 * hf) * 256 + 4 * i); }
    __syncthreads();
    if (F.wave < 2) { const int tok = 2 * hf + F.wave; const f32x4 acc = *(const LAS f32x4*)(CV + tok * 256 + 4 * F.lane); conv_tail(A, F, l, acc, (bf16*)(F.ws + WS_MIX) + (size_t)(m0 + tok) * D); }
    const int r16 = F.lane & 15, q4 = F.lane >> 4;
    const float* BT = (const float*)(F.ws + WS_TAB);
    for (int kt = F.wave; kt < 9; kt += 8) {
        f32x4 s0 = {0.f, 0.f, 0.f, 0.f};
#pragma unroll
        for (int ks = 0; ks < 2; ++ks) {
            const bf16x8 qa = *(const LAS bf16x8*)(L + OQL + r16 * RS64 + (32 * ks + 8 * q4) * 2);
            const bf16x8 k0 = *(const LAS bf16x8*)(L + OKL + (16 * kt + r16) * RS64 + (32 * ks + 8 * q4) * 2);
            s0 = MFMA16(qa, k0, s0);
        }
        const int key = 16 * kt + r16, t = q4; const bool ok = key >= t && key <= 128 + t;
#pragma unroll
        for (int g = 0; g < 2; ++g) { const int e = 2 * hf + g; const float sv = (hf ? (g ? s0[3] : s0[2]) : (g ? s0[1] : s0[0])) * 0.125f;
            const int rel_ = 128 + t - key; float bia = BT[(rel_ < 0 ? 0 : (rel_ > 128 ? 128 : rel_)) * 4 + e]; asm volatile("" : "+v"(bia));
            ((LAS float*)(L + OSL))[(4 * t + e) * 148 + key] = ok ? sv + bia : -INFINITY; }
    }
    __syncthreads();
    {
        const int row = 4 * (F.wave >> 1) + 2 * hf + (F.wave & 1);
        const LAS float* sl = (const LAS float*)(L + OSL) + row * 148;
        float sc[3];
#pragma unroll
        for (int i = 0; i < 3; ++i) { const int j = F.lane + 64 * i; sc[i] = j < 144 ? sl[j] : -INFINITY; }
        const float mx = fmaxf(wave_max(fmaxf(fmaxf(sc[0], sc[1]), sc[2])), sinkv);
        float p[3], ps = 0.f;
#pragma unroll
        for (int i = 0; i < 3; ++i) { p[i] = __expf(sc[i] - mx); ps += p[i]; }
        const float inv = __builtin_amdgcn_rcpf(wave_sum(ps) + __expf(sinkv - mx));
#pragma unroll
        for (int i = 0; i < 3; ++i) { const int j = F.lane + 64 * i; if (j < 160) *(LAS unsigned short*)(L + OPL + row * 336 + 2 * j) = (unsigned short)f2bf(p[i] * inv); }
    }
    __syncthreads();
    if (F.wave < 4) {
        const int dt = F.wave;
        f32x4 o4 = {0.f, 0.f, 0.f, 0.f};
#pragma unroll
        for (int ks = 0; ks < 5; ++ks) {
            const bf16x8 pa = *(const LAS bf16x8*)(L + OPL + r16 * 336 + (32 * ks + 8 * q4) * 2);
            const bf16x8 vb8 = *(const LAS bf16x8*)(L + OVTL + (16 * dt + r16) * 336 + (32 * ks + 8 * q4) * 2);
            o4 = MFMA16(pa, vb8, o4);
        }
#pragma unroll
        for (int g = 0; g < 2; ++g) { const int e = 2 * hf + g; const float ov = hf ? (g ? o4[3] : o4[2]) : (g ? o4[1] : o4[0]);
            ((bf16*)(F.ws + WS_MIX))[(size_t)(m0 + q4) * D + 768 + e * 64 + 16 * dt + r16] = (bf16)f2bf(ov); }
    }
}
__device__ __forceinline__ void samp_hg_load(const Args& A, Ctx& F, int l, int u, float (&S)[32]) {
    const int bs = u >> 2, h = u & 3, v = F.tid & 127, dq = F.tid >> 7;
    const float* S0 = A.in[3 + F.z] + (((size_t)l * 128 + bs) * 4 + h) * 16384 + (size_t)(dq * 32) * 128 + v;
#pragma unroll
    for (int i = 0; i < 32; ++i) S[i] = S0[i * 128];
    __builtin_amdgcn_sched_barrier(0);
}
__device__ __forceinline__ void samp_hg_unit(const Args& A, Ctx& F, int l, int u, float (&S)[32]) {
    const int bs = u >> 2, h = u & 3, m0 = NP + 4 * bs;
    const bf16* PROJ = (const bf16*)(F.ws + WS_PROJ);
    LAS float* FT = (LAS float*)F.lds;
    LAS float* KT = FT + 512;
    LAS float* QT = KT + 512;
    LAS float* VV = QT + 512;
    LAS float* OP = VV + 512;
    LAS float* SS = OP + 2048;
    const int t_ = F.tid >> 7, d_ = F.tid & 127; const bf16* p_ = PROJ + (size_t)(m0 + t_) * INW + h * 128 + d_;
    const float lb_ = l == 0 ? 0.f : ((const float*)(F.ws + WS_TAB))[1024 + h * 128 + d_];
    const float xf_ = bf2f(p_[C_F]), xq_ = bf2f(p_[C_Q]), xi_ = bf2f(p_[C_I]), gg_ = bf2f(p_[C_G]), gn_ = A.in[18 + F.z][l * 128 + d_];
    __syncthreads();
    {
        const float e = __expf(-xf_), sg = __builtin_amdgcn_rcpf(1.f + e);
        FT[F.tid] = lb_ + (1.f - lb_) * sg; KT[F.tid] = (1.f - lb_) * e * sg; QT[F.tid] = xq_; VV[F.tid] = xi_;
    }
    __syncthreads();
    const int v = F.tid & 127, dq = F.tid >> 7;
#pragma unroll
    for (int t = 0; t < 4; ++t) {
        const float vt = VV[t * 128 + v]; float part = 0.f;
#pragma unroll
        for (int i = 0; i < 32; ++i) { const int d = dq * 32 + i; S[i] = FT[t * 128 + d] * S[i] + KT[t * 128 + d] * vt; part += QT[t * 128 + d] * S[i]; }
        OP[(dq * 4 + t) * 128 + v] = part;
    }
    float* So = F.out + O_HGS + (((size_t)l * 128 + bs) * 4 + h) * 16384 + (size_t)(dq * 32) * 128 + v;
#pragma unroll
    for (int i = 0; i < 32; ++i) So[i * 128] = S[i];
    __syncthreads();
    {
        const int t = F.tid >> 7, vv = F.tid & 127;
        const float o = (OP[(0 * 4 + t) * 128 + vv] + OP[(1 * 4 + t) * 128 + vv]) + (OP[(2 * 4 + t) * 128 + vv] + OP[(3 * 4 + t) * 128 + vv]);
        const float ss = wave_sum(o * o);
        if (F.lane == 0) SS[t * 2 + (F.wave & 1)] = ss;
        __syncthreads();
        const float rstd = __builtin_amdgcn_rsqf((SS[t * 2] + SS[t * 2 + 1]) * (1.f / 128.f) + EPS);
        ((bf16*)(F.ws + WS_MIX))[(size_t)(m0 + t) * D + 256 + h * 128 + vv] = (bf16)f2bf(o * rstd * gn_ * (gg_ * sigm(gg_)));
    }
}

constexpr int SHWLD = 4096;
template <int ACT> struct SEpiStore {
    bf16* O; int ldc; const float* rss; const float* shw;
    __device__ __forceinline__ void operator()(int row, int col, const f32x4 v, int lane) const {
        f32x4 w = v;
        if (rss) { const float rstd = __builtin_amdgcn_rsqf(rss[row] * (1.f / D) + EPS); w = v * rstd + *(const f32x4*)(shw + (size_t)modrow(row) * SHWLD + col); }
        if (ACT == 1) {
#pragma unroll
            for (int i = 0; i < 4; ++i) { const float r = w[i] > 0.f ? w[i] : 0.f; w[i] = r * r; } }
        v2u o; o.x = pk2(w[0], w[1]); o.y = pk2(w[2], w[3]);
        *(v2u*)(O + (size_t)row * ldc + col) = o;
    }
};
struct SEpiGateRes {
    const float* baseS; float* out; const float* gate; bf16* xs; float* rss; const float* gam; const float* sc;
    __device__ __forceinline__ void operator()(int row, int col, const f32x4 v, int lane) const {
        const int mr = modrow(row);
        const f32x4 g4 = *(const f32x4*)(gate + (size_t)mr * MODLD + col), b4 = *(const f32x4*)(baseS + (size_t)(row - NP) * D + col);
        const f32x4 x = b4 + g4 * v;
        *(f32x4*)(out + (size_t)row * D + col) = x;
        if (xs) {
            const f32x4 s4 = *(const f32x4*)(gam + col) * (*(const f32x4*)(sc + (size_t)mr * MODLD + col) + 1.f), y = x * s4;
            v2u o; o.x = pk2(y[0], y[1]); o.y = pk2(y[2], y[3]);
            *(v2u*)(xs + (size_t)row * D + col) = o;
            float ss = (x[0] * x[0] + x[1] * x[1]) + (x[2] * x[2] + x[3] * x[3]);
            ss += __shfl_xor(ss, 16); ss += __shfl_xor(ss, 32);
            if ((lane >> 4) == 0) (void)__hip_atomic_fetch_add(rss + row, ss, __ATOMIC_RELAXED, __HIP_MEMORY_SCOPE_AGENT);
        }
    }
};
struct SEpiF32 {
    float* O; int ld;
    __device__ __forceinline__ void operator()(int row, int col, const f32x4 v, int lane) const { *(f32x4*)(O + (size_t)row * ld + col) = v; }
};
template <int NJ, class Epi>
__device__ __forceinline__ void sgemm_phase(Ctx& F, const bf16* Arow  , const bf16* Bt, int N, int K, const Epi& E, const int ntm = 8, const int row0 = NP) {
    static_assert(NJ <= 4, "wave-private image: 8 KiB of A + 2 NJ KiB of B");
    const int r16 = F.lane & 15, q4 = F.lane >> 4, lr = F.lane >> 3, lp = F.lane & 7;
    const int ntn = N / (16 * NJ), ksl = K / 8, nss = ksl / 64;
    LAS unsigned char* WL = F.lds + F.wave * 16384;
    LAS f32x4* RED = (LAS f32x4*)F.lds;
    TSEC_BEGIN(50);
    constexpr int SLOT = 4 * NJ * 64;
    const bool grp = ((F.G & 7) == 0) && ((ntn & 7) == 0);
    const int xg = F.bid & 7, wpx = grp ? (F.G >> 3) : F.G, cpx = ntn >> 3;
    for (int w = grp ? (F.bid >> 3) : F.bid; w < (grp ? ntm * cpx : ntm * ntn); w += wpx) {
        const int tm = w % ntm, tn = grp ? xg * cpx + w / ntm : w / ntm;
        const bf16* ap = Arow + (size_t)(64 * tm + lr) * K + F.wave * ksl + 8 * lp;
        const bf16* bp = Bt + (size_t)(16 * NJ * tn + lr) * K + F.wave * ksl + 8 * lp;
        f32x4 acc[4][NJ];
#pragma unroll
        for (int i = 0; i < 4; ++i)
#pragma unroll
            for (int j = 0; j < NJ; ++j) acc[i][j] = (f32x4){0.f, 0.f, 0.f, 0.f};
        v4u ra[8], rb[2 * NJ];
#define SG_LOAD(ss) do { _Pragma("unroll") for (int t = 0; t < 8; ++t) ra[t] = *(const v4u*)(ap + (size_t)(8 * t) * K + 64 * (ss)); \
                          _Pragma("unroll") for (int t = 0; t < 2 * NJ; ++t) rb[t] = *(const v4u*)(bp + (size_t)(8 * t) * K + 64 * (ss)); } while (0)
        SG_LOAD(0);
        __builtin_amdgcn_sched_barrier(0);
        __syncthreads();
        for (int ss = 0; ss < nss; ++ss) {
#pragma unroll
            for (int t = 0; t < 8; ++t) { const int r = 8 * t + lr; *(LAS v4u*)(WL + r * 128 + ((lp ^ (r & 7)) << 4)) = ra[t]; }
#pragma unroll
            for (int t = 0; t < 2 * NJ; ++t) { const int r = 8 * t + lr; *(LAS v4u*)(WL + 8192 + r * 128 + ((lp ^ (r & 7)) << 4)) = rb[t]; }
            __builtin_amdgcn_sched_barrier(0);
            if (ss + 1 < nss) SG_LOAD(ss + 1);
            __builtin_amdgcn_sched_barrier(0);
#pragma unroll
            for (int s = 0; s < 2; ++s) {
                bf16x8 fa[4], fb[NJ];
#pragma unroll
                for (int i = 0; i < 4; ++i) { const int r = 16 * i + r16; fa[i] = *(const LAS bf16x8*)(WL + r * 128 + (((4 * s + q4) ^ (r & 7)) << 4)); }
#pragma unroll
                for (int j = 0; j < NJ; ++j) { const int r = 16 * j + r16; fb[j] = *(const LAS bf16x8*)(WL + 8192 + r * 128 + (((4 * s + q4) ^ (r & 7)) << 4)); }
#pragma unroll
                for (int i = 0; i < 4; ++i)
#pragma unroll
                    for (int j = 0; j < NJ; ++j) acc[i][j] = MFMA16(fb[j], fa[i], acc[i][j]);
            }
            __builtin_amdgcn_sched_barrier(0);
        }
#undef SG_LOAD
        __syncthreads();
#pragma unroll
        for (int i = 0; i < 4; ++i)
#pragma unroll
            for (int j = 0; j < NJ; ++j) RED[(F.wave * 4 + i) * NJ * 64 + j * 64 + F.lane] = acc[i][j];
        __syncthreads();
#pragma unroll
        for (int q = 0; q < (SLOT + 511) / 512; ++q) {
            const int p = F.tid + 512 * q, ln = p & 63, ij = p >> 6, j = ij % NJ, mi = ij / NJ;
            if (p >= SLOT) break;
            f32x4 v = RED[p];
#pragma unroll
            for (int k4 = 1; k4 < 8; ++k4) v += RED[k4 * SLOT + p];
            E(row0 + 64 * tm + 16 * mi + (ln & 15), 16 * NJ * tn + 16 * j + 4 * (ln >> 4), v, ln);
        }
    }
    TSEC_END(50);
}

#ifndef MK_PER_PHASE
#define MK_PER_PHASE 0
#endif
#ifndef PH_MASK
#define PH_MASK 0xFFFF
#endif
#define PHON(k) ((PH_MASK >> (k)) & 1)
#ifndef PROBE_REP
#define PROBE_REP -1
#endif
#ifndef PROBE_SPIN
#define PROBE_SPIN -1
#endif
#define RELAUNDER() do { int tid_ = F.tid, bid_ = __builtin_amdgcn_readfirstlane(F.bid), g_ = __builtin_amdgcn_readfirstlane(F.G), z_ = __builtin_amdgcn_readfirstlane(F.z); asm volatile("" : "+s"(z_), "+s"(bid_), "+s"(g_)); asm volatile("" : "+v"(tid_)); \
    F.ws = args.ws + z_; F.out = args.out + z_; F.z = z_; F.tid = tid_; F.lane = tid_ & 63; F.wave = __builtin_amdgcn_readfirstlane(tid_ >> 6); F.bid = bid_; F.G = g_; } while (0)
#define SUBPROBE(k, ...) do { RELAUNDER(); const unsigned long long st0_ = PROBE_SPIN == (k) ? __builtin_amdgcn_s_memrealtime() : 0ull; __VA_ARGS__; if (PROBE_SPIN == (k)) { __syncthreads(); const unsigned long long st1_ = __builtin_amdgcn_s_memrealtime(), du_ = (st1_ - st0_) * PROBE_N; while (__builtin_amdgcn_s_memrealtime() - st1_ < du_) __builtin_amdgcn_s_sleep(8); } } while (0)
__global__ void __launch_bounds__(512, 2) mk_fwd(Args args) {
    extern __shared__ __attribute__((aligned(16))) unsigned char lds[];
    Ctx F;
    F.lds = (LAS unsigned char*)lds;
    F.tid = threadIdx.x; F.lane = F.tid & 63; F.wave = __builtin_amdgcn_readfirstlane(F.tid >> 6);
    F.G = gridDim.x; F.bid = blockIdx.x; F.z = 0;
    F.out = args.out; F.ws = args.ws;
    volatile LAS unsigned* MISC = (volatile LAS unsigned*)(F.lds + MISC_OFF);
    for (int u = F.tid; u < (LDS_BYTES - LDSCTL_OFF) / 4; u += 512) ((LAS unsigned*)(F.lds + LDSCTL_OFF))[u] = 0u;
    __syncthreads();
    const int lo = args.ph_lo, hi = args.ph_hi;
    const int wave0 = F.wave;
    XcdBarrier bar; bar.bar = (unsigned*)(F.ws + WS_CTL) + CW_BAR; bar.x = 0; bar.st = nullptr;
    if (hi - lo > 1) bar = xcd_barrier_post((unsigned*)(F.ws + WS_CTL) + CW_BAR, MISC + 8, F.tid);
    for (int p = lo; p < hi; ++p) {
        const int l = p < 2 ? 0 : (p - 2) / 9, s = (p < 2 || p == NPH - 1) ? -1 : (p - 2) % 9;
        const int which = p == NPH - 1 ? 2 : (s == 0 ? 0 : (s == 6 ? 1 : -1));
        const int kind = p == 0 ? 0 : p == 1 ? 12 : (which == 2 ? 10 : (which >= 0 ? 1 : (s == 1 ? 2 : (s == 2 ? 3 : (s == 3 ? 4 : (s == 4 ? 5 : (s == 5 ? (l == 0 ? 6 : 11) : (s == 7 ? 7 : 8))))))));
        if (s == 6 || (s == 0 && l == 1)) continue;
        const int nrep = (kind == PROBE_REP) ? 1 + PROBE_N : 1;
        const unsigned long long pt0 = PROBE_SPIN >= 0 ? __builtin_amdgcn_s_memrealtime() : 0ull;
        for (int rep = 0; rep < nrep; ++rep) {
        { int z_ = 0, tid_ = wave0 * 64 + (int)__builtin_amdgcn_mbcnt_hi(~0u, __builtin_amdgcn_mbcnt_lo(~0u, 0u)), bid_ = blockIdx.x, g_ = gridDim.x;
          asm volatile("" : "+s"(z_), "+s"(bid_), "+s"(g_)); asm volatile("" : "+v"(tid_));
          F.ws = args.ws + z_; F.out = args.out + z_; F.z = z_; F.tid = tid_; F.lane = tid_ & 63; F.wave = __builtin_amdgcn_readfirstlane(tid_ >> 6); F.bid = bid_; F.G = g_; }
        if (PROBE_REP == 9 && hi - lo > 1) { for (int xb = 0; xb < PROBE_N; ++xb) xcd_barrier(bar, F.tid); }
        if (p == 0) { if (PHON(0)) p0_prologue(args, F); }
        else if (p == 1) { if (PHON(0)) mod_phase(args, F); }
        else if (which >= 0) { if (PHON(1)) norm_phase(args, F, p == NPH - 1 ? 0 : l, which); }
        else if (s == 1 && PHON(2)) {
            pg8::Gemm g{(const pg8::bf16_t*)(F.ws + WS_XN), (const pg8::bf16_t*)(F.ws + WS_WIN) + (size_t)l * INW * D, NP, INW, D};
            pg8::StaticOrder S; S.init(NP, INW, F.G, F.bid);
            const float* rss = l == 0 ? nullptr : (const float*)(F.ws + WS_CTL + CTL_RSS) + (size_t)1 * M;
            const float* shw = (const float*)(F.ws + WS_SHW) + (size_t)1 * 192 * SHWLD;
            pg8::EpiStore<0> E{(pg8::bf16_t*)(F.ws + WS_PROJ), INW, rss, shw};
            SEpiStore<0> SE{(bf16*)(F.ws + WS_PROJ), INW, rss, shw};
            if (l == 0) {
                const bf16* SHB = (const bf16*)(F.ws + WS_SHB); float* SHW = (float*)(F.ws + WS_SHW);
                { SEpiF32 HE{SHW + (size_t)0 * 192 * SHWLD, SHWLD}; sgemm_phase<4>(F, SHB + (size_t)0 * 192 * 1024, (const bf16*)(F.ws + WS_WUP), FF, D, HE, 3, 0); }
                { SEpiF32 HE{SHW + (size_t)2 * 192 * SHWLD, SHWLD}; sgemm_phase<4>(F, SHB + (size_t)2 * 192 * 1024, (const bf16*)(F.ws + WS_WUP) + (size_t)FF * D, FF, D, HE, 3, 0); }
                { SEpiF32 HE{SHW + (size_t)1 * 192 * SHWLD, SHWLD}; sgemm_phase<3>(F, SHB + (size_t)1 * 192 * 1024, (const bf16*)(F.ws + WS_WIN) + (size_t)INW * D, INW, D, HE, 3, 0); }
            }
            sgemm_phase<3>(F, (const bf16*)(F.ws + WS_XN) + (size_t)NP * D, (const bf16*)(F.ws + WS_WIN) + (size_t)l * INW * D, INW, D, SE);
            __syncthreads();
            pg8::gemm_phase<pg8::EpiStore<0>, pg8::StaticOrder, true, true>(F.lds, g, S, E, F.tid);
        } else if (s == 2) {
            for (int slot = 0; slot < 5; ++slot) {
                const int ty = __builtin_amdgcn_readfirstlane((slot + F.bid) % 5);
#if PHON(7)
                if (ty == 0) {
            SUBPROBE(20, for (int u = F.bid; u < 256; u += F.G) samp_b_unit(args, F, l, u));
                }
#endif
#if PHON(6)
                if (ty == 1) {
            SUBPROBE(21, { float S[32]; samp_hg_load(args, F, l, F.bid & 511, S); for (int u = F.bid; u < 512; u += F.G) { float Sn[32]; samp_hg_load(args, F, l, (u + F.G) & 511, Sn); samp_hg_unit(args, F, l, u, S); _Pragma("unroll") for (int i = 0; i < 32; ++i) S[i] = Sn[i]; } });
                }
#endif
#if PHON(3)
                if (ty == 2) {
            SUBPROBE(22, for (int u = F.bid; u < 256; u += F.G) attn_unit(args, F, l, u));
                }
#endif
#if PHON(4)
                if (ty == 3) {
            SUBPROBE(23, for (int u = F.bid; u < 256; u += F.G) conv_unit(args, F, l, u));
                }
#endif
#if PHON(5)
                if (ty == 4) {
                        SUBPROBE(24, {   const int nh1 = -1; auto h1idx = [&](int k) -> int { if (nh1 < 0) return F.bid + F.G * k; return k < 4 ? F.bid + 256 * k : F.bid + 640; }; const int cnt = nh1 < 0 ? (1024 - F.bid + F.G - 1) / F.G : nh1; v4u rf[2], rv[2]; h1_load(F, h1idx(0) & 1023, rf, rv); for (int k = 0; k < cnt; ++k) { v4u nf[2], nv[2]; h1_load(F, h1idx(k + 1 < cnt ? k + 1 : k) & 1023, nf, nv); h1_unit(args, F, l, h1idx(k), rf, rv); rf[0] = nf[0]; rf[1] = nf[1]; rv[0] = nv[0]; rv[1] = nv[1]; } });
                }
#endif
            }
        } else if (s == 3) { if (PHON(8)) h2_scan(args, F, l); }
        else if (s == 4 && PHON(9)) { v4u rf[2], rq[2], rv[2]; h3_load(F, F.bid & 1023, rf, rq, rv); for (int u = F.bid; u < 1024; u += F.G) { v4u nf[2], nq[2], nv[2]; h3_unit(args, F, l, u, rf, rq, rv, (u + F.G) & 1023, nf, nq, nv); rf[0] = nf[0]; rf[1] = nf[1]; rq[0] = nq[0]; rq[1] = nq[1]; rv[0] = nv[0]; rv[1] = nv[1]; } }
        else if ((s == 5 || s == 8) && PHON(10)) {
            const bool dn = s == 8;
            pg8::Gemm g{(const pg8::bf16_t*)(F.ws + (dn ? WS_HB : WS_MIX)), (const pg8::bf16_t*)(F.ws + (dn ? WS_WDN : WS_WOUT)) + (size_t)l * (dn ? D * FF : D * D), NP, D, dn ? FF : D};
            pg8::StaticOrder S; S.init(NP, D, F.G, F.bid);
            const bool from_in = (!dn && l == 0);
            const int f = dn ? 1 : 2 * l; const bool fold = !(dn && l == 1);
            bf16* xs = fold ? (bf16*)(F.ws + WS_XN) : nullptr; float* rssw = (float*)(F.ws + WS_CTL + CTL_RSS) + (size_t)f * M;
            const float* gam = dn ? args.in[11 + F.z] + D : args.in[21 + F.z] + l * D;
            const float* scp = (const float*)(F.ws + WS_MOD) + (size_t)(dn ? 1 : l) * MODR * MODLD + (dn ? 1 * D : 4 * D);
            pg8::EpiGateRes E{from_in ? args.in[0 + F.z] : F.out, from_in ? args.in[1 + F.z] : F.out + (size_t)NP * D, F.out, (const float*)(F.ws + WS_MOD) + (size_t)l * MODR * MODLD + (dn ? 5 * D : 2 * D),
                              (pg8::bf16_t*)xs, rssw, gam, scp};
            SEpiGateRes SE{from_in ? args.in[1 + F.z] : F.out + (size_t)NP * D, F.out, (const float*)(F.ws + WS_MOD) + (size_t)l * MODR * MODLD + (dn ? 5 * D : 2 * D), xs, rssw, gam, scp};
            sgemm_phase<2>(F, (const bf16*)(F.ws + (dn ? WS_HB : WS_MIX)) + (size_t)NP * (dn ? FF : D), (const bf16*)(F.ws + (dn ? WS_WDN : WS_WOUT)) + (size_t)l * (dn ? D * FF : D * D), D, dn ? FF : D, SE);
            __syncthreads();
            pg8::gemm_phase<pg8::EpiGateRes, pg8::StaticOrder, true, true>(F.lds, g, S, E, F.tid);
        } else if (s == 7 && PHON(11)) {
            pg8::Gemm g{(const pg8::bf16_t*)(F.ws + WS_XN), (const pg8::bf16_t*)(F.ws + WS_WUP) + (size_t)l * FF * D, NP, FF, D};
            pg8::StaticOrder S; S.init(NP, FF, F.G, F.bid);
            const float* rss = (const float*)(F.ws + WS_CTL + CTL_RSS) + (size_t)(2 * l) * M;
            const float* shw = (const float*)(F.ws + WS_SHW) + (size_t)(2 * l) * 192 * SHWLD;
            pg8::EpiStore<1> E{(pg8::bf16_t*)(F.ws + WS_HB), FF, rss, shw};
            SEpiStore<1> SE{(bf16*)(F.ws + WS_HB), FF, rss, shw};
            sgemm_phase<4>(F, (const bf16*)(F.ws + WS_XN) + (size_t)NP * D, (const bf16*)(F.ws + WS_WUP) + (size_t)l * FF * D, FF, D, SE);
            __syncthreads();
            pg8::gemm_phase<pg8::EpiStore<1>, pg8::StaticOrder, true, true>(F.lds, g, S, E, F.tid);
        }
        }
        if (PROBE_SPIN >= 0 && kind == PROBE_SPIN) { const unsigned long long pt1 = __builtin_amdgcn_s_memrealtime(), dur = (pt1 - pt0) * PROBE_N; while (__builtin_amdgcn_s_memrealtime() - pt1 < dur) __builtin_amdgcn_s_sleep(8); }
        if (p + 1 < hi) xcd_barrier(bar, F.tid);
    }
}

extern "C" void kernel_launch(void* const* d_in, const int* in_sizes, int n_in, void* d_out, int out_size, void* d_ws, size_t ws_size, hipStream_t stream) {
    static int grid = 0;
    if (grid == 0) {
        if (n_in != 25 || in_sizes[0] != NP * D || (size_t)out_size != O_END || ws_size < WS_END) {
            fprintf(stderr, "kernel_launch: unexpected shapes (n_in %d, in0 %d, out %d, ws %zu)\n", n_in, n_in > 0 ? in_sizes[0] : -1, out_size, ws_size); grid = -1; return; }
        int dev = 0, cus = 0, per_cu = 0;
        if (hipGetDevice(&dev) != hipSuccess || hipDeviceGetAttribute(&cus, hipDeviceAttributeMultiprocessorCount, dev) != hipSuccess) { grid = -1; return; }
        if (hipFuncSetAttribute((const void*)mk_fwd, hipFuncAttributeMaxDynamicSharedMemorySize, LDS_BYTES) != hipSuccess) { fprintf(stderr, "kernel_launch: hipFuncSetAttribute failed\n"); grid = -1; return; }
        if (hipOccupancyMaxActiveBlocksPerMultiprocessor(&per_cu, (const void*)mk_fwd, 512, LDS_BYTES) != hipSuccess || per_cu < 1) {
            fprintf(stderr, "kernel_launch: occupancy query reports %d blocks per CU; nothing launched\n", per_cu); (void)hipGetLastError(); grid = -1; return; }
        grid = cus;
    }
    if (grid < 0) return;
    (void)hipMemsetAsync((char*)d_ws + WS_CTL, 0, CTL_ZERO_BYTES, stream);
    Args a{};
    for (int i = 0; i < 25; ++i) a.in[i] = (const float*)d_in[i];
    a.out = (float*)d_out; a.ws = (unsigned char*)d_ws;
#if MK_PER_PHASE
    for (int p = 0; p < NPH; ++p) { a.ph_lo = p; a.ph_hi = p + 1; hipLaunchKernelGGL(mk_fwd, dim3(grid), dim3(512), LDS_BYTES, stream, a); }
#else
    a.ph_lo = 0; a.ph_hi = NPH; hipLaunchKernelGGL(mk_fwd, dim3(grid), dim3(512), LDS_BYTES, stream, a);
#endif
}
```

```cpp
#define MK_PER_PHASE 0
#include <hip/hip_runtime.h>
#include <cstdio>
#include <cstdint>
namespace pg8 {
#define PG8_LAS __attribute__((address_space(3)))
typedef unsigned short bf16_t;
typedef short bf16x8 __attribute__((ext_vector_type(8)));
typedef float f32x4 __attribute__((ext_vector_type(4)));
typedef unsigned u32x4 __attribute__((ext_vector_type(4)));
constexpr int BM = 256, BK = 64, HALF = 128, HTB = HALF * BK * 2  , STAGE_BYTES = 8 * HTB, NXCD = 8, WGM = 8;

__host__ __device__ __forceinline__ int lds_byte(int r, int c) { const int st = (r >> 4) * 2 + (c >> 5), rr = r & 15, cc = c & 31, ob = rr * 64 + cc * 2; return st * 1024 + (ob ^ (((ob >> 9) & 1) << 5)); }
__host__ __device__ __forceinline__ void stage_rc(int b, int& R, int& C) { const int st = b / 1024, sb = b % 1024, swz = sb ^ (((sb >> 9) & 1) << 5); R = (st >> 1) * 16 + swz / 64; C = (st & 1) * 32 + (swz % 64) / 2; }
__host__ __device__ __forceinline__ int perm32(int rho) { const int n = rho >> 4, i = rho & 15; return 8 * (i >> 2) + 4 * n + (i & 3); }

struct Unit { int pm, pn; };
struct Gemm { const bf16_t* A; const bf16_t* Bt; int M, N, K; };

struct StaticOrder {
    int nM, nN, nwg, G, c;
    __host__ __device__ void init(int M, int N, int G_, int c_) { nM = M / BM; nN = N / BM; nwg = nM * nN; G = G_; c = c_; }
    __host__ __device__ bool next(int i, Unit& u) const {
        const long L = (long)i * G + c; if (L >= nwg) return false;
        int wgid = (int)L; { const int q = nwg / NXCD, r = nwg % NXCD, xcd = wgid % NXCD, off = wgid / NXCD; wgid = (xcd < r ? xcd * (q + 1) : r * (q + 1) + (xcd - r) * q) + off; }
        const int nig = WGM * nN, gid = wgid / nig, fm = gid * WGM, gsz = (nM - fm) < WGM ? (nM - fm) : WGM;
        u.pm = fm + ((wgid % nig) % gsz); u.pn = (wgid % nig) / gsz; return true;
    }
    __device__ __forceinline__ void a_ready(const Unit&) const {}
    __device__ __forceinline__ void done(const Unit&) const {}
};

__device__ __forceinline__ unsigned cvt_pk_bf16(float lo, float hi) { unsigned r; asm volatile("v_cvt_pk_bf16_f32 %0, %1, %2" : "=v"(r) : "v"(lo), "v"(hi)); return r; }
typedef float f32x2 __attribute__((ext_vector_type(2)));
constexpr int EP_NP = 16384, EP_D = 1024, EP_MODLD = 6144, EP_SHWLD = 4096;
constexpr float EP_EPS = 1e-6f;
__device__ __forceinline__ int ep_modrow(int r) { return r < EP_NP ? (r >> 12) : 4 + ((r - EP_NP) >> 2); }
template <int ACT> struct EpiStore {
    static constexpr bool PERM = true, AFTER_DRAIN = false;
    bf16_t* O; int ldc; const float* rss; const float* shw;
    __device__ __forceinline__ void operator()(const f32x4 (&acc)[2][2][4][2], const Unit& u, int wr, int wc, int fr, int fq) const {
        const int row0 = u.pm * BM + wr * 64 + fr, col0 = u.pn * BM + wc * 32 + 8 * fq;
        f32x4 h4[2][2]; float rs[8];
#pragma unroll
        for (int bj = 0; bj < 2; ++bj)
#pragma unroll
            for (int n = 0; n < 2; ++n) h4[bj][n] = (f32x4){0.f, 0.f, 0.f, 0.f};
#pragma unroll
        for (int i = 0; i < 8; ++i) rs[i] = 1.f;
        if (rss) {
            const float* hp = shw + (size_t)ep_modrow(u.pm * BM) * EP_SHWLD + col0;
#pragma unroll
            for (int bj = 0; bj < 2; ++bj)
#pragma unroll
                for (int n = 0; n < 2; ++n) h4[bj][n] = *(const f32x4*)(hp + bj * HALF + 4 * n);
#pragma unroll
            for (int i = 0; i < 8; ++i) rs[i] = rss[row0 + (i >> 2) * HALF + (i & 3) * 16];
#pragma unroll
            for (int i = 0; i < 8; ++i) rs[i] = __builtin_amdgcn_rsqf(rs[i] * (1.f / EP_D) + EP_EPS);
        }
#pragma unroll
        for (int ai = 0; ai < 2; ++ai)
#pragma unroll
            for (int m = 0; m < 4; ++m) { bf16_t* rowp = O + (size_t)(row0 + ai * HALF + m * 16) * ldc + col0; const float rstd = rs[ai * 4 + m];
#pragma unroll
                for (int bj = 0; bj < 2; ++bj) { f32x4 v0 = acc[ai][bj][m][0] * rstd + h4[bj][0], v1 = acc[ai][bj][m][1] * rstd + h4[bj][1];
                    if (ACT == 1) {
#pragma unroll
                        for (int e = 0; e < 4; ++e) { const float a = v0[e] > 0.f ? v0[e] : 0.f, b = v1[e] > 0.f ? v1[e] : 0.f; v0[e] = a * a; v1[e] = b * b; } }
                    u32x4 w; w.x = cvt_pk_bf16(v0[0], v0[1]); w.y = cvt_pk_bf16(v0[2], v0[3]); w.z = cvt_pk_bf16(v1[0], v1[1]); w.w = cvt_pk_bf16(v1[2], v1[3]);
                    *(u32x4*)(rowp + bj * HALF) = w; } }
    }
};
struct EpiGateRes {
    static constexpr bool PERM = true, AFTER_DRAIN = false;
    const float* baseP; const float* baseS; float* out; const float* gate;
    bf16_t* xs; float* rss; const float* gam; const float* sc;
    __device__ __forceinline__ void operator()(const f32x4 (&acc)[2][2][4][2], const Unit& u, int wr, int wc, int fr, int fq) const {
        const int col0 = u.pn * BM + wc * 32 + 8 * fq;
        const int mr = ep_modrow(u.pm * BM);
        f32x4 g4[2][2], s4[2][2];
#pragma unroll
        for (int bj = 0; bj < 2; ++bj)
#pragma unroll
            for (int n = 0; n < 2; ++n) { g4[bj][n] = *(const f32x4*)(gate + (size_t)mr * EP_MODLD + col0 + bj * HALF + 4 * n); s4[bj][n] = (f32x4){0.f, 0.f, 0.f, 0.f}; }
        if (xs) {
#pragma unroll
            for (int bj = 0; bj < 2; ++bj)
#pragma unroll
                for (int n = 0; n < 2; ++n) s4[bj][n] = *(const f32x4*)(gam + col0 + bj * HALF + 4 * n) * (*(const f32x4*)(sc + (size_t)mr * EP_MODLD + col0 + bj * HALF + 4 * n) + 1.f);
        }
#pragma unroll
        for (int ai = 0; ai < 2; ++ai)
#pragma unroll
            for (int mp = 0; mp < 2; ++mp) {
                f32x4 b4[2][2][2];
#pragma unroll
                for (int mm = 0; mm < 2; ++mm) { const int r = u.pm * BM + ai * HALF + wr * 64 + (2 * mp + mm) * 16 + fr;
                    const float* bp = (r < EP_NP ? baseP + (size_t)r * EP_D : baseS + (size_t)(r - EP_NP) * EP_D) + col0;
#pragma unroll
                    for (int bj = 0; bj < 2; ++bj)
#pragma unroll
                        for (int n = 0; n < 2; ++n) b4[mm][bj][n] = *(const f32x4*)(bp + bj * HALF + 4 * n); }
                __builtin_amdgcn_sched_barrier(0);
#pragma unroll
                for (int mm = 0; mm < 2; ++mm) { const int m = 2 * mp + mm, r = u.pm * BM + ai * HALF + wr * 64 + m * 16 + fr;
                    float* op = out + (size_t)r * EP_D + col0; float ss = 0.f;
#pragma unroll
                    for (int bj = 0; bj < 2; ++bj) {
                        const f32x4 x0 = b4[mm][bj][0] + g4[bj][0] * acc[ai][bj][m][0], x1 = b4[mm][bj][1] + g4[bj][1] * acc[ai][bj][m][1];
                        *(f32x4*)(op + bj * HALF) = x0; *(f32x4*)(op + bj * HALF + 4) = x1;
                        if (xs) {
                            ss += ((x0[0] * x0[0] + x0[1] * x0[1]) + (x0[2] * x0[2] + x0[3] * x0[3])) + ((x1[0] * x1[0] + x1[1] * x1[1]) + (x1[2] * x1[2] + x1[3] * x1[3]));
                            const f32x4 y0 = x0 * s4[bj][0], y1 = x1 * s4[bj][1];
                            u32x4 w; w.x = cvt_pk_bf16(y0[0], y0[1]); w.y = cvt_pk_bf16(y0[2], y0[3]); w.z = cvt_pk_bf16(y1[0], y1[1]); w.w = cvt_pk_bf16(y1[2], y1[3]);
                            *(u32x4*)(xs + (size_t)r * EP_D + col0 + bj * HALF) = w; } }
                    if (xs) { ss += __shfl_xor(ss, 16); ss += __shfl_xor(ss, 32);
                        if (fq == 0) (void)__hip_atomic_fetch_add(rss + r, ss, __ATOMIC_RELAXED, __HIP_MEMORY_SCOPE_AGENT); } }
                __builtin_amdgcn_sched_barrier(0);
            }
    }
};
template <class Epi, class Sched, bool ALIGN_EPI = false, bool SP2 = false>
__device__ __forceinline__ void gemm_phase(PG8_LAS unsigned char* lds, const Gemm g, const Sched& S, const Epi& E, const int tid) {
    const int wid = __builtin_amdgcn_readfirstlane(tid >> 6), lane = tid & 63, wr = wid >> 2, wc = wid & 3, fr = lane & 15, fq = lane >> 4;
    const int K = g.K, nt = K / BK;
    unsigned voffA[2], voffB[2];
#pragma unroll
    for (int i = 0; i < 2; ++i) { int R, C; stage_rc(tid * 16 + i * 8192, R, C); const int Rb = Epi::PERM ? ((R & ~31) + perm32(R & 31)) : R;
        voffA[i] = (unsigned)(R * K + C) * 2u; voffB[i] = (unsigned)(Rb * K + C) * 2u; }
    const size_t kstep = (size_t)(BK * 2);
    const size_t hstep = (size_t)HALF * K * 2;
    const size_t tstep = 2 * hstep;
    const unsigned ldsw = (unsigned)wid * 1024u;
    const int aoff = lds_byte(wr * 64 + fr, fq * 8), boff = lds_byte(wc * 32 + fr, fq * 8);
#define PG8_SA(b, h) (((b) * 2 + (h)) * HTB)
#define PG8_SB(b, h) ((4 + (b) * 2 + (h)) * HTB)
#define PG8_STAGE(bufoff, gbase, voff) do { _Pragma("unroll") for (int _i = 0; _i < 2; ++_i) \
        __builtin_amdgcn_global_load_lds((const unsigned*)((const char*)(gbase) + (voff)[_i]), (PG8_LAS unsigned*)(lds + (bufoff) + ldsw + _i * 8192), 16, 0, 0); } while (0)
#define PG8_LDA(dst, b, h) do { _Pragma("unroll") for (int m = 0; m < 4; ++m) _Pragma("unroll") for (int k = 0; k < 2; ++k) dst[m][k] = *(const PG8_LAS bf16x8*)(lds + PG8_SA(b, h) + aoff + m * 2048 + k * 1024); } while (0)
#define PG8_LDB(dst, b, h) do { _Pragma("unroll") for (int n = 0; n < 2; ++n) _Pragma("unroll") for (int k = 0; k < 2; ++k) dst[n][k] = *(const PG8_LAS bf16x8*)(lds + PG8_SB(b, h) + boff + n * 2048 + k * 1024); } while (0)
#define PG8_MMA(ai, bj, At, Bt) do { __builtin_amdgcn_s_setprio(1); _Pragma("unroll") for (int m = 0; m < 4; ++m) _Pragma("unroll") for (int n = 0; n < 2; ++n) _Pragma("unroll") for (int k = 0; k < 2; ++k) \
        acc[ai][bj][m][n] = __builtin_amdgcn_mfma_f32_16x16x32_bf16(Bt[n][k], At[m][k], acc[ai][bj][m][n], 0, 0, 0); __builtin_amdgcn_s_setprio(0); } while (0)
#define PG8_WAIT_V(n) asm volatile("s_waitcnt vmcnt(" #n ")" ::: "memory")
#define PG8_WAIT_L(n) asm volatile("s_waitcnt lgkmcnt(" #n ")" ::: "memory")
#define PG8_BAR __builtin_amdgcn_s_barrier()
#define PG8_SCHED __builtin_amdgcn_sched_barrier(0)
    Unit cur, nxt; int ui = 0;
    if (!S.next(0, cur)) return;
    f32x4 acc[2][2][4][2];
#pragma unroll
    for (int a = 0; a < 2; ++a)
#pragma unroll
        for (int b = 0; b < 2; ++b)
#pragma unroll
            for (int m = 0; m < 4; ++m)
#pragma unroll
                for (int n = 0; n < 2; ++n) acc[a][b][m][n] = (f32x4){0.f, 0.f, 0.f, 0.f};
    bf16x8 At[4][2], B0[2][2], B1[2][2];
    const char* cA = (const char*)g.A + (size_t)cur.pm * tstep; const char* cB = (const char*)g.Bt + (size_t)cur.pn * tstep;
    S.a_ready(cur);
    if constexpr (SP2) {
        PG8_STAGE(PG8_SB(0, 0), cB, voffB); PG8_STAGE(PG8_SB(0, 1), cB + hstep, voffB); PG8_STAGE(PG8_SA(0, 0), cA, voffA); PG8_STAGE(PG8_SA(0, 1), cA + hstep, voffA);
        if (wr == 1) PG8_BAR;
        PG8_WAIT_V(2); PG8_BAR;
        PG8_STAGE(PG8_SB(1, 0), cB + kstep, voffB); PG8_STAGE(PG8_SA(1, 0), cA + kstep, voffA); PG8_STAGE(PG8_SB(1, 1), cB + hstep + kstep, voffB);
        PG8_WAIT_V(6); PG8_BAR;
    } else {
        PG8_STAGE(PG8_SB(0, 0), cB, voffB); PG8_STAGE(PG8_SA(0, 0), cA, voffA); PG8_STAGE(PG8_SB(0, 1), cB + hstep, voffB); PG8_STAGE(PG8_SA(0, 1), cA + hstep, voffA);
        if (wr == 1) PG8_BAR;
        PG8_WAIT_V(4); PG8_BAR;
        PG8_STAGE(PG8_SB(1, 0), cB + kstep, voffB); PG8_STAGE(PG8_SA(1, 0), cA + kstep, voffA); PG8_STAGE(PG8_SB(1, 1), cB + hstep + kstep, voffB);
        PG8_WAIT_V(6); PG8_BAR;
    }
    for (;;) {
        const bool has_next = S.next(ui + 1, nxt);
        const char* nA = has_next ? (const char*)g.A + (size_t)nxt.pm * tstep : cA; const char* nB = has_next ? (const char*)g.Bt + (size_t)nxt.pn * tstep : cB;
        for (int t = 0; t < nt; t += 2) {
            const bool last = (t == nt - 2);
            const char* a1 = cA + (size_t)(t + 1) * kstep;
            const char* a2 = last ? nA : cA + (size_t)(t + 2) * kstep; const char* b2 = last ? nB : cB + (size_t)(t + 2) * kstep;
            const char* a3 = a2 + kstep; const char* b3 = b2 + kstep;
            if (last && has_next) S.a_ready(nxt);
            if constexpr (SP2) {
            PG8_LDB(B0, 0, 0); PG8_LDB(B1, 0, 1); PG8_SCHED; PG8_LDA(At, 0, 0); PG8_STAGE(PG8_SA(1, 1), a1 + hstep, voffA);
            PG8_WAIT_V(8); PG8_WAIT_L(0); PG8_BAR; PG8_MMA(0, 0, At, B0); PG8_MMA(0, 1, At, B1); PG8_BAR; PG8_SCHED;
            PG8_LDA(At, 0, 1); PG8_STAGE(PG8_SB(0, 0), b2, voffB); PG8_STAGE(PG8_SB(0, 1), b2 + hstep, voffB); PG8_STAGE(PG8_SA(0, 0), a2, voffA);
            PG8_WAIT_V(8); PG8_WAIT_L(0); PG8_BAR; PG8_MMA(1, 0, At, B0); PG8_MMA(1, 1, At, B1); PG8_BAR; PG8_SCHED;
            PG8_LDB(B0, 1, 0); PG8_LDB(B1, 1, 1); PG8_SCHED; PG8_LDA(At, 1, 0); PG8_STAGE(PG8_SA(0, 1), a2 + hstep, voffA);
            PG8_WAIT_V(8); PG8_WAIT_L(0); PG8_BAR; PG8_MMA(0, 0, At, B0); PG8_MMA(0, 1, At, B1); PG8_BAR; PG8_SCHED;
            PG8_LDA(At, 1, 1); PG8_STAGE(PG8_SB(1, 0), b3, voffB); PG8_STAGE(PG8_SB(1, 1), b3 + hstep, voffB); PG8_STAGE(PG8_SA(1, 0), a3, voffA);
            PG8_WAIT_V(8); PG8_WAIT_L(0); PG8_BAR; PG8_MMA(1, 0, At, B0); PG8_MMA(1, 1, At, B1); PG8_BAR; PG8_SCHED;
            } else {
            PG8_LDB(B0, 0, 0); PG8_SCHED; PG8_LDA(At, 0, 0); PG8_STAGE(PG8_SA(1, 1), a1 + hstep, voffA);
            PG8_WAIT_L(8); PG8_BAR; PG8_WAIT_L(0); PG8_MMA(0, 0, At, B0); PG8_BAR; PG8_SCHED;
            PG8_LDB(B1, 0, 1); PG8_STAGE(PG8_SB(0, 0), b2, voffB);
            PG8_BAR; PG8_WAIT_L(0); PG8_MMA(0, 1, At, B1); PG8_BAR;
            PG8_LDA(At, 0, 1); PG8_STAGE(PG8_SA(0, 0), a2, voffA);
            PG8_BAR; PG8_WAIT_L(0); PG8_MMA(1, 0, At, B0); PG8_BAR; PG8_SCHED;
            PG8_STAGE(PG8_SB(0, 1), b2 + hstep, voffB);
            PG8_WAIT_V(6); PG8_BAR; PG8_MMA(1, 1, At, B1); PG8_BAR;
            PG8_LDB(B0, 1, 0); PG8_SCHED; PG8_LDA(At, 1, 0); PG8_STAGE(PG8_SA(0, 1), a2 + hstep, voffA);
            PG8_WAIT_L(8); PG8_BAR; PG8_WAIT_L(0); PG8_MMA(0, 0, At, B0); PG8_BAR; PG8_SCHED;
            PG8_LDB(B1, 1, 1); PG8_STAGE(PG8_SB(1, 0), b3, voffB);
            PG8_BAR; PG8_WAIT_L(0); PG8_MMA(0, 1, At, B1); PG8_BAR;
            PG8_LDA(At, 1, 1); PG8_STAGE(PG8_SA(1, 0), a3, voffA);
            PG8_BAR; PG8_WAIT_L(0); PG8_MMA(1, 0, At, B0); PG8_BAR; PG8_SCHED;
            PG8_STAGE(PG8_SB(1, 1), b3 + hstep, voffB);
            PG8_WAIT_V(6); PG8_BAR; PG8_MMA(1, 1, At, B1); PG8_BAR;
            }
        }
        if constexpr (ALIGN_EPI) { if (wr == 0) PG8_BAR; }
        if constexpr (!Epi::AFTER_DRAIN) { E(acc, cur, wr, wc, fr, fq); S.done(cur); }
        if (!has_next) break;
#pragma unroll
        for (int a = 0; a < 2; ++a)
#pragma unroll
            for (int b = 0; b < 2; ++b)
#pragma unroll
                for (int m = 0; m < 4; ++m)
#pragma unroll
                    for (int n = 0; n < 2; ++n) acc[a][b][m][n] = (f32x4){0.f, 0.f, 0.f, 0.f};
        cur = nxt; cA = nA; cB = nB; ++ui;
        if constexpr (ALIGN_EPI) { if (wr == 1) PG8_BAR; }
    }
    PG8_WAIT_V(0);
    if constexpr (!ALIGN_EPI) { if (wr == 0) PG8_BAR; }
    PG8_BAR;
    if constexpr (Epi::AFTER_DRAIN) { E.fused(acc, cur, wr, wc, fr, fq, lds, wid, lane); S.done(cur); }
#undef PG8_SA
#undef PG8_SB
#undef PG8_STAGE
#undef PG8_LDA
#undef PG8_LDB
#undef PG8_MMA
#undef PG8_WAIT_V
#undef PG8_WAIT_L
#undef PG8_BAR
#undef PG8_SCHED
}
}
#define GAS __attribute__((address_space(1)))
#define LAS __attribute__((address_space(3)))
typedef unsigned short bf16;
typedef unsigned v4u __attribute__((ext_vector_type(4)));
typedef float f32x4 __attribute__((ext_vector_type(4)));
typedef short bf16x8 __attribute__((ext_vector_type(8)));
typedef GAS unsigned gu32;
typedef GAS unsigned long long gu64;
#define RLX_AGENT __ATOMIC_RELAXED, __HIP_MEMORY_SCOPE_AGENT
#define LDS_WAIT() asm volatile("s_waitcnt lgkmcnt(0)" ::: "memory")
#define VM_WAIT() asm volatile("s_waitcnt vmcnt(0)" ::: "memory")
__device__ __forceinline__ unsigned long long rt() { return __builtin_amdgcn_s_memrealtime(); }
typedef float f32x2_ __attribute__((ext_vector_type(2)));
typedef __bf16 bf16x2_ __attribute__((ext_vector_type(2)));
__device__ __forceinline__ unsigned pk2(float lo, float hi) { const f32x2_ v = {lo, hi}; const bf16x2_ b = __builtin_convertvector(v, bf16x2_); return __builtin_bit_cast(unsigned, b); }
__device__ __forceinline__ unsigned f2bf(float f) { return (unsigned)__builtin_bit_cast(unsigned short, (__bf16)f); }

#define XB_TMO      128
#define XB_XCNT(j)  (256  + 64 * (j))
#define XB_XSUB(j)  (1280 + 64 * (j))
#define XB_XGEN(j)  (2304 + 64 * (j))
#define XB_TOP      3328
#define XB_TOPGEN   3392
#define XCD_BAR_WORDS 3456
#define XB_SPIN_CAP (1u << 18)

__device__ __forceinline__ unsigned xb_ld(unsigned* p)              { return __hip_atomic_load(p, __ATOMIC_RELAXED, __HIP_MEMORY_SCOPE_AGENT); }
__device__ __forceinline__ unsigned xb_add(unsigned* p, unsigned v) { return __hip_atomic_fetch_add(p, v, __ATOMIC_RELAXED, __HIP_MEMORY_SCOPE_AGENT); }
__device__ __forceinline__ unsigned xb_xcc_id() { return (unsigned)__builtin_amdgcn_s_getreg((3 << 11) | 20) & 0xFu; }
#define XB_SPIN(cond, bar) do { unsigned _sp = 0; while (cond) { __builtin_amdgcn_s_sleep(1); \
    if ((++_sp & 255u) == 0u) { if (xb_ld(&(bar)[XB_TMO])) break; if (_sp > XB_SPIN_CAP) { atomicAdd(&(bar)[XB_TMO], 1u); break; } } } } while (0)

struct XcdBarrier {
    unsigned* bar; unsigned x;
    volatile LAS unsigned* st;
};

__device__ __forceinline__ XcdBarrier xcd_barrier_post(unsigned* bar, volatile LAS unsigned* st, const int tid_) {
    XcdBarrier b; b.bar = bar; b.x = xb_xcc_id(); b.st = st;
    if (tid_ == 0) (void)xb_add(&bar[XB_XCNT(b.x)], 1u);
    return b;
}
__device__ __forceinline__ void xcd_barrier_complete(unsigned* bar, unsigned x, unsigned& nloc, unsigned& nx) {
    const unsigned G = gridDim.x * gridDim.y * gridDim.z;
    unsigned sum, cnt, mine, sp = 0u;
    for (;;) {
        sum = 0u; cnt = 0u; mine = 0u;
#pragma unroll
        for (unsigned j = 0; j < 16; ++j) { const unsigned c = xb_ld(&bar[XB_XCNT(j)]); sum += c; cnt += (c > 0u) ? 1u : 0u; mine = (j == x) ? c : mine; }
        if (sum == G) break;
        __builtin_amdgcn_s_sleep(1);
        if ((++sp & 255u) == 0u) { if (xb_ld(&bar[XB_TMO])) break; if (sp > XB_SPIN_CAP) { atomicAdd(&bar[XB_TMO], 1u); break; } }
    }
    nloc = mine > 0u ? mine : 1u; nx = cnt > 0u ? cnt : 1u;
}

__device__ __forceinline__ void xcd_barrier(const XcdBarrier& b, const int tid_) {
    asm volatile("s_waitcnt vmcnt(0)" ::: "memory");
    __syncthreads();
    if (tid_ == 0) {
        unsigned* bar = b.bar;
        __builtin_amdgcn_s_waitcnt(0);
        unsigned nloc = b.st[0], nx = b.st[1];
        if (nloc == 0u) { xcd_barrier_complete(bar, b.x, nloc, nx); b.st[0] = nloc; b.st[1] = nx; }
        const unsigned old = xb_add(&bar[XB_XSUB(b.x)], 1u);
        const unsigned gen = old / nloc;
        if (old + 1u == (gen + 1u) * nloc) {
            __builtin_amdgcn_fence(__ATOMIC_RELEASE, "agent");
            asm volatile("s_waitcnt vmcnt(0)" ::: "memory");
            const unsigned og = xb_add(&bar[XB_TOP], 1u);
            const unsigned tg = og / nx;
            if (og + 1u == (tg + 1u) * nx) xb_add(&bar[XB_TOPGEN], 1u);
            else XB_SPIN(xb_ld(&bar[XB_TOPGEN]) == tg, bar);
            __builtin_amdgcn_fence(__ATOMIC_ACQUIRE, "agent");
            xb_add(&bar[XB_XGEN(b.x)], 1u);
            asm volatile("s_waitcnt vmcnt(0)" ::: "memory");
        } else {
            XB_SPIN(xb_ld(&bar[XB_XGEN(b.x)]) == gen, bar);
            __builtin_amdgcn_fence(__ATOMIC_ACQUIRE, "agent");
            asm volatile("s_waitcnt vmcnt(0)" ::: "memory");
        }
    }
    __syncthreads();
}

constexpr int D = 1024, NP = 16384, NS = 512, M = NP + NS, INW = 3072, FF = 4096, TP = 4096;
constexpr int C_AV = 0, C_AG = 256, C_Q = 512, C_F = 1024, C_I = 1536, C_G = 2048, C_QA = 2560, C_KA = 2816, C_VA = 2944;
constexpr int MODR = 132, MODLD = 6144;
constexpr float EPS = 1e-6f;
constexpr size_t O_CONVP = (size_t)M * D, O_CONVS = O_CONVP + 2 * 4 * 30 * 256, O_HGP = O_CONVS + 2 * 128 * 30 * 256, O_HGS = O_HGP + 2 * 4 * 4 * 16384,
                 O_KP = O_HGS + (size_t)2 * 128 * 4 * 16384, O_KS = O_KP + 2 * 4 * 128 * 128, O_VP = O_KS + (size_t)2 * 128 * 128 * 128, O_VS = O_VP + 2 * 4 * 128 * 128,
                 O_END = O_VS + (size_t)2 * 128 * 128 * 128;
constexpr size_t MiB = 1u << 20;
constexpr size_t WS_CTL = 0, CTL_ZERO_BYTES = 1 * MiB, WS_TAB = 1 * MiB, WS_MOD = 2 * MiB, WS_DC = 9 * MiB, WS_WIN = 10 * MiB, WS_WOUT = 22 * MiB, WS_WUP = 26 * MiB, WS_WDN = 42 * MiB,
                 WS_XN = 58 * MiB, WS_HG = 58 * MiB, WS_PROJ = 91 * MiB, WS_MIX = 190 * MiB, WS_HB = 91 * MiB, WS_SHB = 224 * MiB, WS_SHW = 226 * MiB, WS_END = 236 * MiB;
constexpr size_t CTL_RSS = 65536;
constexpr size_t WS_SC = WS_TAB + 65536;
constexpr int CW_BAR = 4096;
constexpr int RING_BYTES = 131072, LDSCTL_OFF = RING_BYTES, MISC_OFF = LDSCTL_OFF + 320, LDS_BYTES = 147456;
constexpr int NPH = 21;

typedef float f32x16 __attribute__((ext_vector_type(16)));
typedef unsigned v2u __attribute__((ext_vector_type(2)));
__device__ __forceinline__ float bf2f(unsigned h) { return __builtin_bit_cast(float, h << 16); }
__device__ __forceinline__ float wave_sum(float v) {
#pragma unroll
    for (int o = 1; o < 64; o <<= 1) v += __shfl_xor(v, o);
    return v;
}
__device__ __forceinline__ float wave_max(float v) {
#pragma unroll
    for (int o = 1; o < 64; o <<= 1) v = fmaxf(v, __shfl_xor(v, o));
    return v;
}
__device__ __forceinline__ int modrow(int r) { return r < NP ? (r >> 12) : 4 + ((r - NP) >> 2); }
__device__ __forceinline__ int crow(int r, int hi) { return (r & 3) + 8 * (r >> 2) + 4 * hi; }
__device__ __forceinline__ bf16x8 pk8(float a0, float a1, float a2, float a3, float a4, float a5, float a6, float a7) {
    v4u w; w.x = pk2(a0, a1); w.y = pk2(a2, a3); w.z = pk2(a4, a5); w.w = pk2(a6, a7); return __builtin_bit_cast(bf16x8, w);
}
__device__ __forceinline__ float sigm(float x) { return __builtin_amdgcn_rcpf(1.f + __expf(-x)); }
#define MFMA32(a, b, c) __builtin_amdgcn_mfma_f32_32x32x16_bf16((a), (b), (c), 0, 0, 0)
#define MFMA16(a, b, c) __builtin_amdgcn_mfma_f32_16x16x32_bf16((a), (b), (c), 0, 0, 0)

#ifndef PROBE_SPIN
#define PROBE_SPIN -1
#endif
#ifndef PROBE_N
#define PROBE_N 0
#endif
#define TSEC_BEGIN(k) const unsigned long long ts0_##k = PROBE_SPIN == (k) ? __builtin_amdgcn_s_memrealtime() : 0ull
#define TSEC_END(k) do { if (PROBE_SPIN == (k)) { const unsigned long long ts1_ = __builtin_amdgcn_s_memrealtime(), du_ = (ts1_ - ts0_##k) * PROBE_N; while (__builtin_amdgcn_s_memrealtime() - ts1_ < du_) __builtin_amdgcn_s_sleep(4); } } while (0)
struct Args { const float* in[25]; float* out; unsigned char* ws; int ph_lo, ph_hi; };
struct Ctx {
    LAS unsigned char* lds;
    int tid, lane, wave, G, bid, z;
    float* out; unsigned char* ws;
};

__device__ __forceinline__ void p0_transpose_item(const float* W, int K, int N, bf16* WT, LAS float* scr, int item, int lane) {
    const int nblk = N / 32, kb = item / nblk, nb = item % nblk, k0 = 64 * kb, n0 = 32 * nb;
    float tv[32];
#pragma unroll
    for (int i = 0; i < 32; ++i) { const int kk = 2 * i + (lane >> 5); tv[i] = W[(size_t)(k0 + kk) * N + n0 + (lane & 31)]; }
    __builtin_amdgcn_sched_barrier(0);
#pragma unroll
    for (int i = 0; i < 32; ++i) { const int kk = 2 * i + (lane >> 5); scr[kk * 33 + (lane & 31)] = tv[i]; }
    LDS_WAIT(); asm volatile("" ::: "memory");
    const int c = lane & 7;
#pragma unroll
    for (int j = 0; j < 4; ++j) { const int n = (lane >> 3) + 8 * j; const LAS float* s = scr + (8 * c) * 33 + n;
        v4u o; o.x = pk2(s[0 * 33], s[1 * 33]); o.y = pk2(s[2 * 33], s[3 * 33]); o.z = pk2(s[4 * 33], s[5 * 33]); o.w = pk2(s[6 * 33], s[7 * 33]);
        *(GAS v4u*)(WT + (size_t)(n0 + n) * K + k0 + 8 * c) = o; }
    LDS_WAIT(); asm volatile("" ::: "memory");
}
__device__ __forceinline__ void mod_unit(const Args& A, Ctx& F, int u) {
    const int l = u / 192, n0 = 32 * (u % 192), k0 = 128 * F.wave, c = F.lane & 31, h2 = F.lane >> 5;
    const float* W = A.in[9 + F.z] + (size_t)l * 1024 * 6144;
    f32x16 acc[5];
#pragma unroll
    for (int i = 0; i < 5; ++i)
#pragma unroll
        for (int e = 0; e < 16; ++e) acc[i][e] = 0.f;
    const bf16* SC = (const bf16*)(F.ws + WS_SC);
    LAS unsigned char* WL = F.lds + F.wave * 16384;
    const int lr = F.lane >> 3, lp = F.lane & 7;
    TSEC_BEGIN(42);
    __syncthreads();
#pragma unroll 1
    for (int jh = 0; jh < 2; ++jh) {
        const int kh = k0 + 64 * jh;
        float wv[4][8];
#pragma unroll
        for (int j = 0; j < 4; ++j)
#pragma unroll
            for (int e = 0; e < 8; ++e) wv[j][e] = W[(size_t)(kh + 16 * j + 8 * h2 + e) * 6144 + n0 + c];
        v4u rs[16];
#pragma unroll
        for (int t = 0; t < 16; ++t) rs[t] = *(const v4u*)(SC + (size_t)(4 + 8 * t + lr) * 1024 + kh + 8 * lp);
        bf16x8 ap4[4];
#pragma unroll
        for (int j = 0; j < 4; ++j) { ap4[j] = (bf16x8){0, 0, 0, 0, 0, 0, 0, 0}; if (c < 4) ap4[j] = *(const bf16x8*)(SC + (size_t)c * 1024 + kh + 16 * j + 8 * h2); }
        __builtin_amdgcn_sched_barrier(0);
#pragma unroll
        for (int t = 0; t < 16; ++t) { const int r = 8 * t + lr; *(LAS v4u*)(WL + r * 128 + ((lp ^ (r & 7)) << 4)) = rs[t]; }
        __builtin_amdgcn_sched_barrier(0);
#pragma unroll
        for (int j = 0; j < 4; ++j) {
            const bf16x8 b = pk8(wv[j][0], wv[j][1], wv[j][2], wv[j][3], wv[j][4], wv[j][5], wv[j][6], wv[j][7]);
            acc[0] = MFMA32(ap4[j], b, acc[0]);
#pragma unroll
            for (int rt = 1; rt < 5; ++rt) { const int r = 32 * (rt - 1) + c; const bf16x8 af = *(const LAS bf16x8*)(WL + r * 128 + (((2 * j + h2) ^ (r & 7)) << 4)); acc[rt] = MFMA32(af, b, acc[rt]); }
        }
        __builtin_amdgcn_sched_barrier(0);
    }
    TSEC_END(42);
    TSEC_BEGIN(43);
    LAS float* RED = (LAS float*)F.lds;
#define RED_WR(slot) do { _Pragma("unroll") for (int rt = 0; rt < 5; ++rt) _Pragma("unroll") for (int e = 0; e < 16; ++e) RED[(slot) * 5120 + (rt * 16 + e) * 64 + F.lane] = acc[rt][e]; } while (0)
#define RED_ADD(slot) do { _Pragma("unroll") for (int rt = 0; rt < 5; ++rt) _Pragma("unroll") for (int e = 0; e < 16; ++e) acc[rt][e] += RED[(slot) * 5120 + (rt * 16 + e) * 64 + F.lane]; } while (0)
    __syncthreads();
    if (F.wave >= 4) RED_WR(F.wave - 4);
    __syncthreads();
    if (F.wave < 4) RED_ADD(F.wave);
    __syncthreads();
    if (F.wave == 2 || F.wave == 3) RED_WR(F.wave - 2);
    __syncthreads();
    if (F.wave < 2) RED_ADD(F.wave);
    __syncthreads();
    if (F.wave == 1) RED_WR(0);
    __syncthreads();
    if (F.wave == 0) {
        RED_ADD(0);
        float* mo = (float*)(F.ws + WS_MOD) + (size_t)l * MODR * MODLD;
        const float bias = A.in[10 + F.z][l * MODLD + n0 + c];
#pragma unroll
        for (int rt = 0; rt < 5; ++rt)
#pragma unroll
            for (int e = 0; e < 16; ++e) { const int cr = crow(e, h2), r = rt == 0 ? cr : 4 + 32 * (rt - 1) + cr; if (rt > 0 || cr < 4) mo[(size_t)r * MODLD + n0 + c] = acc[rt][e] + bias; }
    }
#undef RED_WR
#undef RED_ADD
    TSEC_END(43);
}
__device__ __forceinline__ void p0_prologue(const Args& A, Ctx& F) {
    LAS float* scr = (LAS float*)(F.lds + F.wave * 16384);
    const int gw = F.bid * 8 + F.wave, NGW = F.G * 8;
    TSEC_BEGIN(40);
    for (int it = gw; it < 12288; it += NGW) {
        const int l = it / 6144; int r = it % 6144;
        if (r < 1536) { p0_transpose_item(A.in[12 + F.z] + (size_t)l * 1024 * 3072, 1024, 3072, (bf16*)(F.ws + WS_WIN) + (size_t)l * 3072 * 1024, scr, r, F.lane); continue; } r -= 1536;
        if (r < 512) { p0_transpose_item(A.in[20 + F.z] + (size_t)l * 1024 * 1024, 1024, 1024, (bf16*)(F.ws + WS_WOUT) + (size_t)l * 1024 * 1024, scr, r, F.lane); continue; } r -= 512;
        if (r < 2048) { p0_transpose_item(A.in[22 + F.z] + (size_t)l * 1024 * 4096, 1024, 4096, (bf16*)(F.ws + WS_WUP) + (size_t)l * 4096 * 1024, scr, r, F.lane); continue; } r -= 2048;
        p0_transpose_item(A.in[23 + F.z] + (size_t)l * 4096 * 1024, 4096, 1024, (bf16*)(F.ws + WS_WDN) + (size_t)l * 1024 * 4096, scr, r, F.lane);
    }
    TSEC_END(40);
    if (F.bid == 0) {
        float* BT = (float*)(F.ws + WS_TAB); float* LB1 = BT + 1024;
        for (int i = F.tid; i < 129 * 4; i += 512) { const int rel = i >> 2, h = i & 3; int bk = rel;
            if (rel >= 16) { bk = 16 + (int)(logf((float)rel / 16.f) / logf(8.f) * 16.f); bk = bk > 31 ? 31 : bk; }
            BT[i] = A.in[8 + F.z][bk * 4 + h]; }
        { const int i = F.tid; const float a = A.in[17 + F.z][i], b = A.in[17 + F.z][512 + i], mx = fmaxf(a, b), ea = expf(a - mx), eb = expf(b - mx); LB1[i] = eb / (ea + eb); }
    }
    for (int i = F.bid * 512 + F.tid; i < 160 * 128; i += F.G * 512) {
        const int r = i >> 7, k8 = 8 * (i & 127);
        v4u o = {0u, 0u, 0u, 0u};
        if (r < MODR) { const float* cp = (r < 4 ? A.in[6 + F.z] + r * 1024 : A.in[7 + F.z] + (r - 4) * 1024) + k8; const f32x4 c0 = *(const f32x4*)cp, c1 = *(const f32x4*)(cp + 4);
            o.x = pk2(c0.x * sigm(c0.x), c0.y * sigm(c0.y)); o.y = pk2(c0.z * sigm(c0.z), c0.w * sigm(c0.w)); o.z = pk2(c1.x * sigm(c1.x), c1.y * sigm(c1.y)); o.w = pk2(c1.z * sigm(c1.z), c1.w * sigm(c1.w)); }
        *(v4u*)((bf16*)(F.ws + WS_SC) + (size_t)r * 1024 + k8) = o;
    }
}
__device__ __forceinline__ void mod_phase(const Args& A, Ctx& F) {
    TSEC_BEGIN(41);
    if ((F.G & 7) == 0) { const int xg = F.bid & 7, wpx = F.G >> 3; for (int w = F.bid >> 3; w < 48; w += wpx) mod_unit(A, F, xg * 48 + w); }
    else for (int u = F.bid; u < 384; u += F.G) mod_unit(A, F, u);
    TSEC_END(41);
}
__device__ __forceinline__ void norm_phase(const Args& A, Ctx& F, int l, int which) {
    if (l == 0 && which == 0) {
        const float* MODp = (const float*)(F.ws + WS_MOD);
        for (int i = F.bid * 512 + F.tid; i < 3 * 192 * 128; i += F.G * 512) {
            const int f = i / (192 * 128), r = (i >> 7) % 192, k8 = 8 * (i & 127);
            v4u o = {0u, 0u, 0u, 0u};
            if (r < MODR) { const float* sp = MODp + (size_t)(f == 0 ? 0 : 1) * MODR * MODLD + (size_t)r * MODLD + (f == 1 ? 0 : 3 * D) + k8; const f32x4 c0 = *(const f32x4*)sp, c1 = *(const f32x4*)(sp + 4);
                o.x = pk2(c0.x, c0.y); o.y = pk2(c0.z, c0.w); o.z = pk2(c1.x, c1.y); o.w = pk2(c1.z, c1.w); }
            *(v4u*)((bf16*)(F.ws + WS_SHB) + (size_t)(f * 192 + r) * 1024 + k8) = o;
        }
    }
    const int gw = F.bid * 8 + F.wave, NGW = F.G * 8;
    const float* gamma = which == 0 ? A.in[11 + F.z] + l * D : (which == 1 ? A.in[21 + F.z] + l * D : A.in[24 + F.z]);
    const float* mod = (const float*)(F.ws + WS_MOD) + (size_t)l * MODR * MODLD;
    const int shc = which == 0 ? 0 : 3 * D, scc = shc + D;
    const bool from_in = (which == 0 && l == 0);
    bf16* XN = (bf16*)(F.ws + WS_XN);
    f32x4 gm[4];
#pragma unroll
    for (int j = 0; j < 4; ++j) gm[j] = *(const f32x4*)(gamma + 4 * F.lane + 256 * j);
    constexpr int NR = 4;
    for (int m0 = gw; m0 < M; m0 += NR * NGW) {
        f32x4 v[NR][4], msc[NR][4], msh[NR][4];
#pragma unroll
        for (int r = 0; r < NR; ++r) { const int mr_ = m0 + r * NGW, m = mr_ < M ? mr_ : m0;
            const float* xr = from_in ? (m < NP ? A.in[0 + F.z] + (size_t)m * D : A.in[1 + F.z] + (size_t)(m - NP) * D) : F.out + (size_t)m * D;
#pragma unroll
            for (int j = 0; j < 4; ++j) v[r][j] = *(const f32x4*)(xr + 4 * F.lane + 256 * j);
            if (which != 2) { const float* mr = mod + (size_t)modrow(m) * MODLD;
#pragma unroll
                for (int j = 0; j < 4; ++j) { msc[r][j] = *(const f32x4*)(mr + scc + 4 * F.lane + 256 * j); msh[r][j] = *(const f32x4*)(mr + shc + 4 * F.lane + 256 * j); } } }
        __builtin_amdgcn_sched_barrier(0);
        float ssq[NR];
#pragma unroll
        for (int r = 0; r < NR; ++r) { ssq[r] = 0.f;
#pragma unroll
            for (int j = 0; j < 4; ++j) ssq[r] += (v[r][j].x * v[r][j].x + v[r][j].y * v[r][j].y) + (v[r][j].z * v[r][j].z + v[r][j].w * v[r][j].w); }
#pragma unroll
        for (int o = 1; o < 64; o <<= 1) {
            float t_[NR];
#pragma unroll
            for (int r = 0; r < NR; ++r) t_[r] = __shfl_xor(ssq[r], o);
#pragma unroll
            for (int r = 0; r < NR; ++r) ssq[r] += t_[r];
        }
#pragma unroll
        for (int r = 0; r < NR; ++r) {
            const int m = m0 + r * NGW;
            if (m < M) {
                const float rstd = __builtin_amdgcn_rsqf(ssq[r] * (1.f / D) + EPS);
                if (which == 2) {
#pragma unroll
                    for (int j = 0; j < 4; ++j) *(f32x4*)(F.out + (size_t)m * D + 4 * F.lane + 256 * j) = v[r][j] * rstd * gm[j];
                } else {
#pragma unroll
                    for (int j = 0; j < 4; ++j) { const f32x4 y = v[r][j] * rstd * gm[j] * (msc[r][j] + 1.f) + msh[r][j]; v2u w; w.x = pk2(y.x, y.y); w.y = pk2(y.z, y.w);
                        *(v2u*)(XN + (size_t)m * D + 4 * F.lane + 256 * j) = w; }
                }
            }
        }
    }
}

constexpr int RS = 272;
constexpr int RS64 = 144;
struct HgGate { float cl[16], kf[16]; };
__device__ __forceinline__ void hg_gates(const float lb, const LAS unsigned short* rawf  , int d, HgGate& g) {
    float run = 0.f;
#pragma unroll
    for (int j = 0; j < 16; ++j) {
        const float x = bf2f(rawf[j * (RS / 2) + d]);
        const float e = __expf(-x), sg = __builtin_amdgcn_rcpf(1.f + e);
        const float f = lb + (1.f - lb) * sg;
        g.kf[j] = (1.f - lb) * e * sg;
        run += __logf(f); g.cl[j] = run;
    }
}
__device__ __forceinline__ void tile_load(const bf16* g0  , int tid, v4u (&r)[2]) {
#pragma unroll
    for (int i = 0; i < 2; ++i) { const int it = tid + 512 * i; r[i] = *(const v4u*)(g0 + (size_t)(it >> 4) * INW + 8 * (it & 15)); }
    __builtin_amdgcn_sched_barrier(0);
}
__device__ __forceinline__ void tile_store(LAS unsigned char* dst, int tid, const v4u (&r)[2]) {
#pragma unroll
    for (int i = 0; i < 2; ++i) { const int it = tid + 512 * i; *(LAS v4u*)(dst + (it >> 4) * RS + 16 * (it & 15)) = r[i]; }
}
__device__ __forceinline__ void h1_load(Ctx& F, int u, v4u (&rf)[2], v4u (&rv)[2]) {
    const int bh = u >> 6, b = bh >> 2, h = bh & 3, ch = u & 63, m0 = b * TP + ch * 64;
    const bf16* PROJ = (const bf16*)(F.ws + WS_PROJ);
    tile_load(PROJ + (size_t)m0 * INW + C_F + h * 128, F.tid, rf); tile_load(PROJ + (size_t)m0 * INW + C_I + h * 128, F.tid, rv);
}
__device__ __forceinline__ void h1_unit(const Args& A, Ctx& F, int l, int u, const v4u (&rf)[2], const v4u (&rv)[2]) {
    const int bh = u >> 6, b = bh >> 2, h = bh & 3, ch = u & 63, m0 = b * TP + ch * 64;
    const int d = F.tid & 127, sc = F.tid >> 7, c = F.lane & 31, h2 = F.lane >> 5;
    const bf16* PROJ = (const bf16*)(F.ws + WS_PROJ);
    LAS unsigned char* L = F.lds;
    constexpr int OKDT = 0, OVT = 128 * RS64, OTOT = 2 * 128 * RS64, ORF = OTOT + 2048, ORV = ORF + 64 * RS;
    LAS unsigned short* KDT = (LAS unsigned short*)(L + OKDT);
    LAS unsigned short* VT = (LAS unsigned short*)(L + OVT);
    LAS float* TOT = (LAS float*)(L + OTOT);
    const float lb = l == 0 ? 0.f : ((const float*)(F.ws + WS_TAB))[1024 + h * 128 + d];
    __syncthreads();
    tile_store(L + ORF, F.tid, rf); tile_store(L + ORV, F.tid, rv);
    __syncthreads();
    HgGate g; hg_gates(lb, (const LAS unsigned short*)(L + ORF + sc * 16 * RS), d, g);
    TOT[sc * 128 + d] = g.cl[15];
#pragma unroll
    for (int j = 0; j < 16; ++j) VT[d * (RS64 / 2) + sc * 16 + j] = ((const LAS unsigned short*)(L + ORV))[(sc * 16 + j) * (RS / 2) + d];
    __syncthreads();
    float after = 0.f;
#pragma unroll
    for (int i = 1; i < 4; ++i) if (i > sc) after += TOT[i * 128 + d];
    const float tot = g.cl[15];
#pragma unroll
    for (int j = 0; j < 16; ++j) KDT[d * (RS64 / 2) + sc * 16 + j] = (unsigned short)f2bf(g.kf[j] * __expf(after + tot - g.cl[j]));
    if (sc == 0) ((float*)(F.ws + WS_DC))[u * 128 + d] = __expf(after + tot);
    __syncthreads();
    const int vt = F.wave >> 1, dt0 = 2 * (F.wave & 1);
    f32x16 acc0, acc1;
#pragma unroll
    for (int e = 0; e < 16; ++e) { acc0[e] = 0.f; acc1[e] = 0.f; }
#pragma unroll
    for (int ks = 0; ks < 4; ++ks) {
        const bf16x8 a = *(const LAS bf16x8*)(L + OVT + (32 * vt + c) * RS64 + (16 * ks + 8 * h2) * 2);
        const bf16x8 b0 = *(const LAS bf16x8*)(L + OKDT + (32 * dt0 + c) * RS64 + (16 * ks + 8 * h2) * 2);
        const bf16x8 b1 = *(const LAS bf16x8*)(L + OKDT + (32 * dt0 + 32 + c) * RS64 + (16 * ks + 8 * h2) * 2);
        acc0 = MFMA32(a, b0, acc0); acc1 = MFMA32(a, b1, acc1);
    }
    LAS unsigned short* OT = (LAS unsigned short*)(L + ORF);
#pragma unroll
    for (int e = 0; e < 16; ++e) { const int v = 32 * vt + crow(e, h2);
        OT[v * (RS / 2) + 32 * dt0 + c] = (unsigned short)f2bf(acc0[e]); OT[v * (RS / 2) + 32 * dt0 + 32 + c] = (unsigned short)f2bf(acc1[e]); }
    __syncthreads();
    bf16* HG = (bf16*)(F.ws + WS_HG) + (size_t)u * 16384;
#pragma unroll
    for (int i = 0; i < 4; ++i) { const int it = F.tid + 512 * i, v = it >> 4, ch16 = it & 15;
        *(v4u*)(HG + v * 128 + 8 * ch16) = *(const LAS v4u*)(L + ORF + v * RS + 16 * ch16); }
}
__device__ __forceinline__ void h2_scan(const Args& A, Ctx& F, int l) {
    unsigned* HG32 = (unsigned*)(F.ws + WS_HG); const float* DC = (const float*)(F.ws + WS_DC);
    for (int gid = F.bid * 512 + F.tid; gid < 16 * 8192; gid += F.G * 512) {
        const int bh = gid >> 13, e2 = gid & 8191, v = e2 >> 6, d = 2 * (e2 & 63);
        float s0 = 0.f, s1 = 0.f;
        for (int c0 = 0; c0 < 64; c0 += 16) {
            unsigned kc[16]; float d0[16], d1[16];
#pragma unroll
            for (int i = 0; i < 16; ++i) { const int u = bh * 64 + c0 + i; kc[i] = HG32[(size_t)u * 8192 + e2]; d0[i] = DC[u * 128 + d]; d1[i] = DC[u * 128 + d + 1]; }
            __builtin_amdgcn_sched_barrier(0);
#pragma unroll
            for (int i = 0; i < 16; ++i) { const int u = bh * 64 + c0 + i;
                HG32[(size_t)u * 8192 + e2] = pk2(s0, s1);
                s0 = d0[i] * s0 + bf2f(kc[i] & 0xffffu); s1 = d1[i] * s1 + bf2f(kc[i] >> 16); }
        }
        float* o = F.out + O_HGP + ((size_t)l * 16 + bh) * 16384;
        o[d * 128 + v] = s0; o[(d + 1) * 128 + v] = s1;
    }
}
__device__ __forceinline__ void h3_load(Ctx& F, int u, v4u (&rf)[2], v4u (&rq)[2], v4u (&rv)[2]) {
    const int bh = u >> 6, b = bh >> 2, h = bh & 3, ch = u & 63, m0 = b * TP + ch * 64;
    const bf16* PROJ = (const bf16*)(F.ws + WS_PROJ);
    tile_load(PROJ + (size_t)m0 * INW + C_F + h * 128, F.tid, rf); tile_load(PROJ + (size_t)m0 * INW + C_Q + h * 128, F.tid, rq); tile_load(PROJ + (size_t)m0 * INW + C_I + h * 128, F.tid, rv);
}
__device__ __forceinline__ void h3_unit(const Args& A, Ctx& F, int l, int u, const v4u (&rf)[2], const v4u (&rq)[2], const v4u (&rv)[2], int un, v4u (&nf)[2], v4u (&nq)[2], v4u (&nv)[2]) {
    const int bh = u >> 6, b = bh >> 2, h = bh & 3, ch = u & 63, m0 = b * TP + ch * 64;
    const int d = F.tid & 127, sc = F.tid >> 7, c = F.lane & 31, h2 = F.lane >> 5;
    const bf16* PROJ = (const bf16*)(F.ws + WS_PROJ);
    LAS unsigned char* L = F.lds;
    constexpr int OQH = 0, OKH = 64 * RS, OKC = 2 * 64 * RS, OQG = 3 * 64 * RS, OQT = OQG + 48 * RS, OAM = OQT + 64 * RS, OVT = OAM + 64 * RS64, OTOT = OVT + 128 * RS64, OEND = OTOT + 2048;
    static_assert(OEND <= RING_BYTES, "h3 LDS map");
    LAS unsigned short* QH = (LAS unsigned short*)(L + OQH); LAS unsigned short* KH = (LAS unsigned short*)(L + OKH); LAS unsigned short* KC = (LAS unsigned short*)(L + OKC);
    LAS unsigned short* QG = (LAS unsigned short*)(L + OQG); LAS unsigned short* QT = (LAS unsigned short*)(L + OQT); LAS unsigned short* AM = (LAS unsigned short*)(L + OAM);
    LAS unsigned short* VT = (LAS unsigned short*)(L + OVT); LAS float* TOT = (LAS float*)(L + OTOT); LAS float* O32 = (LAS float*)(L + OQH);
    TSEC_BEGIN(30);
    const float lb = l == 0 ? 0.f : ((const float*)(F.ws + WS_TAB))[1024 + h * 128 + d];
    f32x4 gnv[4];
#pragma unroll
    for (int i = 0; i < 4; ++i) gnv[i] = *(const f32x4*)(A.in[18 + F.z] + l * 128 + (F.tid & 7) * 16 + 4 * i);
    __syncthreads();
    tile_store(L + OQH, F.tid, rf); tile_store(L + OKH, F.tid, rq); tile_store(L + OKC, F.tid, rv);
    const bf16* gp = PROJ + (size_t)(m0 + (F.tid >> 3)) * INW + C_G + h * 128 + (F.tid & 7) * 16;
    const v4u g0 = *(const v4u*)gp, g1 = *(const v4u*)(gp + 8);
    const bf16* Srow = (const bf16*)(F.ws + WS_HG) + (size_t)u * 16384 + (size_t)(32 * (F.wave & 3) + c) * 128 + 8 * h2;
    bf16x8 sb[8];
#pragma unroll
    for (int ks = 0; ks < 8; ++ks) sb[ks] = *(const bf16x8*)(Srow + 16 * ks);
    __builtin_amdgcn_sched_barrier(0);
    for (int i = F.tid; i < 64 * RS64 / 4; i += 512) ((LAS unsigned*)AM)[i] = 0u;
    __syncthreads();
    TSEC_END(30);
    TSEC_BEGIN(31);
    HgGate g; hg_gates(lb, (const LAS unsigned short*)(L + OQH + sc * 16 * RS), d, g);
    float q[16];
#pragma unroll
    for (int j = 0; j < 16; ++j) q[j] = bf2f(((const LAS unsigned short*)(L + OKH))[(sc * 16 + j) * (RS / 2) + d]);
    TOT[sc * 128 + d] = g.cl[15];
#pragma unroll
    for (int j = 0; j < 16; ++j) VT[d * (RS64 / 2) + sc * 16 + j] = ((const LAS unsigned short*)(L + OKC))[(sc * 16 + j) * (RS / 2) + d];
    __syncthreads();
    TSEC_END(31);
    TSEC_BEGIN(32);
    const float t0 = TOT[d], t1 = TOT[128 + d], t2 = TOT[256 + d];
    const float rsc = sc == 0 ? 0.f : (sc == 1 ? t0 : (sc == 2 ? t0 + t1 : t0 + t1 + t2));
    const float ers = __expf(rsc), tot = g.cl[15];
    const float ga = sc == 2 ? __expf(t1) : __expf(t1 + t2), gb = __expf(t2);
#pragma unroll
    for (int j = 0; j < 16; ++j) {
        const int row = sc * 16 + j;
        const float qh = q[j] * __expf(g.cl[j]);
        QH[row * (RS / 2) + d] = (unsigned short)f2bf(qh);
        QT[row * (RS / 2) + d] = (unsigned short)f2bf(qh * ers);
        if (sc == 2) QG[j * (RS / 2) + d] = (unsigned short)f2bf(qh * ga);
        if (sc == 3) { QG[(16 + j) * (RS / 2) + d] = (unsigned short)f2bf(qh * ga); QG[(32 + j) * (RS / 2) + d] = (unsigned short)f2bf(qh * gb); }
        KH[row * (RS / 2) + d] = (unsigned short)f2bf(g.kf[j] * __expf(tot - g.cl[j]));
        KC[row * (RS / 2) + d] = (unsigned short)f2bf(g.kf[j] * __expf(-g.cl[j]));
    }
    h3_load(F, un, nf, nq, nv);
    __syncthreads();
    TSEC_END(32);
    TSEC_BEGIN(33);
    {
        const int r16 = F.lane & 15, kq = F.lane >> 4;
        for (int blk = F.wave; blk < 10; blk += 8) {
            int bi, bj, qoff, koff;
            if (blk < 4) { bi = blk; bj = blk; qoff = OQH + 16 * bi * RS; koff = OKC + 16 * bj * RS; }
            else if (blk < 7) { bi = blk - 3; bj = bi - 1; qoff = OQH + 16 * bi * RS; koff = OKH + 16 * bj * RS; }
            else if (blk == 7) { bi = 2; bj = 0; qoff = OQG; koff = OKH; }
            else if (blk == 8) { bi = 3; bj = 0; qoff = OQG + 16 * RS; koff = OKH; }
            else { bi = 3; bj = 1; qoff = OQG + 32 * RS; koff = OKH + 16 * RS; }
            f32x4 a4 = {0.f, 0.f, 0.f, 0.f};
#pragma unroll
            for (int ks = 0; ks < 4; ++ks) {
                const bf16x8 qa = *(const LAS bf16x8*)(L + qoff + r16 * RS + (32 * ks + 8 * kq) * 2);
                const bf16x8 kb = *(const LAS bf16x8*)(L + koff + r16 * RS + (32 * ks + 8 * kq) * 2);
                a4 = MFMA16(qa, kb, a4);
            }
#pragma unroll
            for (int e = 0; e < 4; ++e) { const int t = 4 * kq + e; float val = a4[e]; if (bi == bj && r16 > t) val = 0.f;
                AM[(16 * bi + t) * (RS64 / 2) + 16 * bj + r16] = (unsigned short)f2bf(val); }
        }
    }
    __syncthreads();
    TSEC_END(33);
    TSEC_BEGIN(34);
    const int tt = F.wave >> 2, vt = F.wave & 3;
    f32x16 acc;
#pragma unroll
    for (int e = 0; e < 16; ++e) acc[e] = 0.f;
#pragma unroll
    for (int ks = 0; ks < 4; ++ks) {
        const bf16x8 a = *(const LAS bf16x8*)(L + OAM + (32 * tt + c) * RS64 + (16 * ks + 8 * h2) * 2);
        const bf16x8 bv = *(const LAS bf16x8*)(L + OVT + (32 * vt + c) * RS64 + (16 * ks + 8 * h2) * 2);
        acc = MFMA32(a, bv, acc);
    }
#pragma unroll
    for (int ks = 0; ks < 8; ++ks) {
        const bf16x8 a = *(const LAS bf16x8*)(L + OQT + (32 * tt + c) * RS + (16 * ks + 8 * h2) * 2);
        acc = MFMA32(a, sb[ks], acc);
    }
#pragma unroll
    for (int e = 0; e < 16; ++e) O32[(32 * tt + crow(e, h2)) * 132 + 32 * vt + c] = acc[e];
    __syncthreads();
    TSEC_END(34);
    TSEC_BEGIN(35);
    {
        const int t = F.tid >> 3, vq = F.tid & 7;
        float o[16]; float ss = 0.f;
#pragma unroll
        for (int i = 0; i < 4; ++i) { const f32x4 x = *(const LAS f32x4*)(O32 + t * 132 + vq * 16 + 4 * i); o[4 * i] = x.x; o[4 * i + 1] = x.y; o[4 * i + 2] = x.z; o[4 * i + 3] = x.w;
            ss += (x.x * x.x + x.y * x.y) + (x.z * x.z + x.w * x.w); }
        ss += __shfl_xor(ss, 1); ss += __shfl_xor(ss, 2); ss += __shfl_xor(ss, 4);
        const float rstd = __builtin_amdgcn_rsqf(ss * (1.f / 128.f) + EPS);
        const float gn[16] = {gnv[0].x, gnv[0].y, gnv[0].z, gnv[0].w, gnv[1].x, gnv[1].y, gnv[1].z, gnv[1].w, gnv[2].x, gnv[2].y, gnv[2].z, gnv[2].w, gnv[3].x, gnv[3].y, gnv[3].z, gnv[3].w};
        unsigned gw_[8] = {g0.x, g0.y, g0.z, g0.w, g1.x, g1.y, g1.z, g1.w};
        unsigned ow[8];
#pragma unroll
        for (int i = 0; i < 8; ++i) {
            const float ga0 = bf2f(gw_[i] & 0xffffu), ga1 = bf2f(gw_[i] >> 16);
            const float y0 = o[2 * i] * rstd * gn[2 * i] * (ga0 * sigm(ga0)), y1 = o[2 * i + 1] * rstd * gn[2 * i + 1] * (ga1 * sigm(ga1));
            ow[i] = pk2(y0, y1);
        }
        bf16* op = (bf16*)(F.ws + WS_MIX) + (size_t)(m0 + t) * D + 256 + h * 128 + vq * 16;
        v4u w0 = {ow[0], ow[1], ow[2], ow[3]}, w1 = {ow[4], ow[5], ow[6], ow[7]};
        *(v4u*)op = w0; *(v4u*)(op + 8) = w1;
    }
    TSEC_END(35);
}

__device__ __forceinline__ void conv_tail(const Args& A, Ctx& F, int l, f32x4 acc, bf16* orow) {
    const float mean = wave_sum((acc.x + acc.y) + (acc.z + acc.w)) * (1.f / 256.f);
    const f32x4 dv = acc - mean;
    const float rstd = __builtin_amdgcn_rsqf(wave_sum((dv.x * dv.x + dv.y * dv.y) + (dv.z * dv.z + dv.w * dv.w)) * (1.f / 256.f) + EPS);
    const f32x4 lg = *(const f32x4*)(A.in[15 + F.z] + l * 256 + 4 * F.lane), lb = *(const f32x4*)(A.in[16 + F.z] + l * 256 + 4 * F.lane);
    const f32x4 y = dv * rstd * lg + lb;
    v2u w; w.x = pk2(y.x * sigm(y.x), y.y * sigm(y.y)); w.y = pk2(y.z * sigm(y.z), y.w * sigm(y.w));
    *(v2u*)(orow + 4 * F.lane) = w;
}
__device__ __forceinline__ void conv_unit(const Args& A, Ctx& F, int l, int u) {
    const int b = u >> 6, tile = u & 63, t0 = tile * 64;
    const bf16* PROJ = (const bf16*)(F.ws + WS_PROJ);
    LAS float* AL = (LAS float*)F.lds;
    v4u sv[6], sg[6];
#pragma unroll
    for (int i = 0; i < 6; ++i) { const int it = F.tid + 512 * i, row = it >> 5, cg = it & 31, t = t0 - 30 + row;
        sv[i] = (v4u){0u, 0u, 0u, 0u}; sg[i] = sv[i];
        if (it < 94 * 32 && t >= 0) { const bf16* p = PROJ + (size_t)(b * TP + t) * INW + 8 * cg; sv[i] = *(const v4u*)(p + C_AV); sg[i] = *(const v4u*)(p + C_AG); } }
    __builtin_amdgcn_sched_barrier(0);
    __syncthreads();
#pragma unroll
    for (int i = 0; i < 6; ++i) { const int it = F.tid + 512 * i, row = it >> 5, cg = it & 31;
        if (it < 94 * 32) {
            const v4u vv = sv[i], gg = sg[i]; f32x4 a0, a1;
            a0.x = bf2f(vv.x & 0xffffu) * sigm(bf2f(gg.x & 0xffffu)); a0.y = bf2f(vv.x >> 16) * sigm(bf2f(gg.x >> 16));
            a0.z = bf2f(vv.y & 0xffffu) * sigm(bf2f(gg.y & 0xffffu)); a0.w = bf2f(vv.y >> 16) * sigm(bf2f(gg.y >> 16));
            a1.x = bf2f(vv.z & 0xffffu) * sigm(bf2f(gg.z & 0xffffu)); a1.y = bf2f(vv.z >> 16) * sigm(bf2f(gg.z >> 16));
            a1.z = bf2f(vv.w & 0xffffu) * sigm(bf2f(gg.w & 0xffffu)); a1.w = bf2f(vv.w >> 16) * sigm(bf2f(gg.w >> 16));
            *(LAS f32x4*)(AL + row * 256 + 8 * cg) = a0; *(LAS f32x4*)(AL + row * 256 + 8 * cg + 4) = a1; } }
    const f32x4 cb = *(const f32x4*)(A.in[14 + F.z] + l * 256 + 4 * F.lane);
    __syncthreads();
    typedef float f32x2c __attribute__((ext_vector_type(2)));
    f32x4 acc[8];
#pragma unroll
    for (int hc = 0; hc < 2; ++hc) {
        __builtin_amdgcn_sched_barrier(0);
        f32x2c cw[31], a2[8];
#pragma unroll
        for (int j = 0; j < 31; ++j) cw[j] = *(const f32x2c*)(A.in[13 + F.z] + (size_t)(l * 31 + j) * 256 + 4 * F.lane + 2 * hc);
#pragma unroll
        for (int i = 0; i < 8; ++i) a2[i] = (f32x2c){hc ? cb.z : cb.x, hc ? cb.w : cb.y};
        __builtin_amdgcn_sched_barrier(0);
#pragma unroll
        for (int r = 0; r < 38; ++r) {
            const f32x2c row = *(const LAS f32x2c*)(AL + (8 * F.wave + r) * 256 + 4 * F.lane + 2 * hc);
#pragma unroll
            for (int i = 0; i < 8; ++i) if (r - i >= 0 && r - i <= 30) a2[i] += cw[r - i] * row;
            if ((r & 7) == 7) __builtin_amdgcn_sched_barrier(0);
        }
#pragma unroll
        for (int i = 0; i < 8; ++i) { if (hc) { acc[i].z = a2[i].x; acc[i].w = a2[i].y; } else { acc[i].x = a2[i].x; acc[i].y = a2[i].y; } }
    }
    {
        float s1[8], s2[8];
#pragma unroll
        for (int i = 0; i < 8; ++i) { s1[i] = (acc[i].x + acc[i].y) + (acc[i].z + acc[i].w); s2[i] = (acc[i].x * acc[i].x + acc[i].y * acc[i].y) + (acc[i].z * acc[i].z + acc[i].w * acc[i].w); }
#pragma unroll
        for (int o = 1; o < 64; o <<= 1) {
            float t1[8], t2[8];
#pragma unroll
            for (int i = 0; i < 8; ++i) { t1[i] = __shfl_xor(s1[i], o); t2[i] = __shfl_xor(s2[i], o); }
#pragma unroll
            for (int i = 0; i < 8; ++i) { s1[i] += t1[i]; s2[i] += t2[i]; }
        }
        const f32x4 lg = *(const f32x4*)(A.in[15 + F.z] + l * 256 + 4 * F.lane), lb = *(const f32x4*)(A.in[16 + F.z] + l * 256 + 4 * F.lane);
#pragma unroll
        for (int i = 0; i < 8; ++i) {
            const float mean = s1[i] * (1.f / 256.f), var = fmaxf(s2[i] * (1.f / 256.f) - mean * mean, 0.f);
            const float rstd = __builtin_amdgcn_rsqf(var + EPS);
            const f32x4 y = (acc[i] - mean) * rstd * lg + lb;
            v2u w; w.x = pk2(y.x * sigm(y.x), y.y * sigm(y.y)); w.y = pk2(y.z * sigm(y.z), y.w * sigm(y.w));
            *(v2u*)((bf16*)(F.ws + WS_MIX) + (size_t)(b * TP + t0 + 8 * F.wave + i) * D + 4 * F.lane) = w;
        }
    }
    if (tile == 63) {
        float* o = F.out + O_CONVP + (size_t)(l * 4 + b) * 30 * 256;
        for (int i = F.tid; i < 30 * 256; i += 512) o[i] = AL[64 * 256 + i];
    }
}
constexpr int VS = 528;
__device__ __forceinline__ void attn_unit(const Args& A, Ctx& F, int l, int u) {
    const int b = u >> 6, blk = (u >> 1) & 31, kvh = u & 1;
    const int c = F.lane & 31, h2 = F.lane >> 5;
    const bf16* PROJ = (const bf16*)(F.ws + WS_PROJ);
    LAS unsigned char* L = F.lds;
    LAS unsigned short* VTt = (LAS unsigned short*)L;
    LAS float* BTl = (LAS float*)(L + 64 * VS);
    const int tok0 = b * TP + (blk - 1) * 128;
    const int g = F.wave >> 2, qs = F.wave & 3, hq = 2 * kvh + g;
    const int mq = b * TP + blk * 128 + 32 * qs + c;
    bf16x8 bq[4];
#pragma unroll
    for (int ks = 0; ks < 4; ++ks) bq[ks] = *(const bf16x8*)(PROJ + (size_t)mq * INW + C_QA + hq * 64 + 16 * ks + 8 * h2);
#define ATTN_LOADK(dst, j) do { const int kidx_ = 32 * (qs + (j)) + c; const bool ex_ = (blk > 0 || kidx_ >= 128); \
        _Pragma("unroll") for (int ks = 0; ks < 4; ++ks) { dst[ks] = (bf16x8){0, 0, 0, 0, 0, 0, 0, 0}; \
            if (ex_) dst[ks] = *(const bf16x8*)(PROJ + (size_t)(tok0 + kidx_) * INW + C_KA + kvh * 64 + 16 * ks + 8 * h2); } } while (0)
    bf16x8 ak0[4], ak1[4];
    ATTN_LOADK(ak0, 0); ATTN_LOADK(ak1, 1);
    const float sink = A.in[19 + F.z][l * 4 + hq];
    float btv = 0.f; { const int gg = F.tid / 224, ix = F.tid % 224 - 32; if (F.tid < 448 && ix >= 0 && ix <= 128) btv = ((const float*)(F.ws + WS_TAB))[(128 - ix) * 4 + 2 * kvh + gg]; }
    __builtin_amdgcn_sched_barrier(0);
    __syncthreads();
    if (F.tid < 448) BTl[F.tid] = btv;
    f32x16 S[5];
#pragma unroll
    for (int j = 0; j < 5; ++j)
#pragma unroll
        for (int e = 0; e < 16; ++e) S[j][e] = 0.f;
    bf16x8 ak2[4], ak3[4];
    ATTN_LOADK(ak2, 2); ATTN_LOADK(ak3, 3);
    __builtin_amdgcn_sched_barrier(0);
#pragma unroll
    for (int ks = 0; ks < 4; ++ks) { S[0] = MFMA32(ak0[ks], bq[ks], S[0]); S[1] = MFMA32(ak1[ks], bq[ks], S[1]); }
    ATTN_LOADK(ak0, 4);
#pragma unroll
    for (int ks = 0; ks < 4; ++ks) { S[2] = MFMA32(ak2[ks], bq[ks], S[2]); S[3] = MFMA32(ak3[ks], bq[ks], S[3]); }
#pragma unroll
    for (int ks = 0; ks < 4; ++ks) S[4] = MFMA32(ak0[ks], bq[ks], S[4]);
#undef ATTN_LOADK
    v4u vst[4];
#pragma unroll
    for (int i = 0; i < 4; ++i) { const int it = F.tid + 512 * i, pos = it >> 3, pl = pos & 31, kidx = (pos & ~31) | (pl & 0x13) | ((pl & 4) << 1) | ((pl & 8) >> 1), chn = it & 7; vst[i] = (v4u){0u, 0u, 0u, 0u};
        if (blk > 0 || kidx >= 128) vst[i] = *(const v4u*)(PROJ + (size_t)(tok0 + kidx) * INW + C_VA + kvh * 64 + 8 * chn); }
    __builtin_amdgcn_sched_barrier(0);
    __syncthreads();
    float mx = -INFINITY;
    const LAS float* trp = BTl + g * 224 + 32 + 4 * h2 - c;
#pragma unroll
    for (int j = 0; j < 5; ++j) {
        float bia[16];
#pragma unroll
        for (int e = 0; e < 16; ++e) bia[e] = trp[32 * j + 8 * (e >> 2) + (e & 3)];
#pragma unroll
        for (int e = 0; e < 16; e += 4) asm volatile("" : "+v"(bia[e]), "+v"(bia[e + 1]), "+v"(bia[e + 2]), "+v"(bia[e + 3]));
#pragma unroll
        for (int e = 0; e < 16; ++e) {
            const int cr = crow(e, h2), rel = 128 + c - 32 * j - cr, kidx = 32 * (qs + j) + cr;
            const bool ok = rel >= 0 && rel <= 128 && (blk > 0 || kidx >= 128);
            const float s = ok ? S[j][e] * 0.125f + bia[e] : -INFINITY;
            S[j][e] = s; mx = fmaxf(mx, s);
        }
        __builtin_amdgcn_sched_barrier(0);
    }
    mx = fmaxf(mx, __shfl_xor(mx, 32)); mx = fmaxf(mx, sink);
    float sum = 0.f;
#pragma unroll
    for (int j = 0; j < 5; ++j)
#pragma unroll
        for (int e = 0; e < 16; ++e) { const float p = __expf(S[j][e] - mx); S[j][e] = p; sum += p; if (e == 15) __builtin_amdgcn_sched_barrier(0); }
    sum += __shfl_xor(sum, 32);
    const float inv = 1.f / (sum + __expf(sink - mx));
#pragma unroll
    for (int i = 0; i < 4; ++i) { const int it = F.tid + 512 * i, pos = it >> 3, chn = it & 7;
        unsigned w0 = vst[i].x, w1 = vst[i].y, w2 = vst[i].z, w3 = vst[i].w;
        if (chn & 1) { const unsigned t0 = __builtin_amdgcn_alignbit(w1, w0, 16), t1 = __builtin_amdgcn_alignbit(w2, w1, 16), t2 = __builtin_amdgcn_alignbit(w3, w2, 16), t3 = __builtin_amdgcn_alignbit(w0, w3, 16); w0 = t0; w1 = t1; w2 = t2; w3 = t3; }
        if (chn & 2) { const unsigned t0 = w1, t1 = w2, t2 = w3, t3 = w0; w0 = t0; w1 = t1; w2 = t2; w3 = t3; }
        if (chn & 4) { const unsigned t0 = w2, t1 = w3, t2 = w0, t3 = w1; w0 = t0; w1 = t1; w2 = t2; w3 = t3; }
        const unsigned w[4] = {w0, w1, w2, w3};
#pragma unroll
        for (int e = 0; e < 8; ++e) VTt[(8 * chn + ((e + chn) & 7)) * (VS / 2) + pos] = (unsigned short)((e & 1) ? (w[e >> 1] >> 16) : (w[e >> 1] & 0xffffu)); }
    __syncthreads();
    f32x16 O0, O1;
#pragma unroll
    for (int e = 0; e < 16; ++e) { O0[e] = 0.f; O1[e] = 0.f; }
#pragma unroll
    for (int j = 0; j < 5; ++j)
#pragma unroll
        for (int s2 = 0; s2 < 2; ++s2) {
            const bf16x8 pb = pk8(S[j][8 * s2], S[j][8 * s2 + 1], S[j][8 * s2 + 2], S[j][8 * s2 + 3], S[j][8 * s2 + 4], S[j][8 * s2 + 5], S[j][8 * s2 + 6], S[j][8 * s2 + 7]);
            const int slot = 32 * (qs + j) + 16 * s2 + 8 * h2;
            const bf16x8 av0 = *(const LAS bf16x8*)(L + c * VS + slot * 2), av1 = *(const LAS bf16x8*)(L + (32 + c) * VS + slot * 2);
            O0 = MFMA32(av0, pb, O0); O1 = MFMA32(av1, pb, O1);
            __builtin_amdgcn_sched_barrier(0);
        }
    bf16* op = (bf16*)(F.ws + WS_MIX) + (size_t)mq * D + 768 + hq * 64;
#pragma unroll
    for (int gq = 0; gq < 4; ++gq) {
        v2u w0, w1;
        w0.x = pk2(O0[4 * gq] * inv, O0[4 * gq + 1] * inv); w0.y = pk2(O0[4 * gq + 2] * inv, O0[4 * gq + 3] * inv);
        w1.x = pk2(O1[4 * gq] * inv, O1[4 * gq + 1] * inv); w1.y = pk2(O1[4 * gq + 2] * inv, O1[4 * gq + 3] * inv);
        *(v2u*)(op + 8 * gq + 4 * h2) = w0; *(v2u*)(op + 32 + 8 * gq + 4 * h2) = w1;
    }
    if (blk == 31) {
        v4u kk[2], vv[2];
#pragma unroll
        for (int i = 0; i < 2; ++i) { const int it = F.tid + 512 * i, j = it >> 3, c8 = 8 * (it & 7);
            const bf16* p = PROJ + (size_t)(b * TP + 3968 + j) * INW + kvh * 64 + c8; kk[i] = *(const v4u*)(p + C_KA); vv[i] = *(const v4u*)(p + C_VA); }
        __builtin_amdgcn_sched_barrier(0);
#pragma unroll
        for (int i = 0; i < 2; ++i) { const int it = F.tid + 512 * i, j = it >> 3, c8 = 8 * (it & 7);
            const size_t oi = (((size_t)(l * 4 + b) * 128 + j) * 2 + kvh) * 64 + c8;
            const unsigned kw[4] = {kk[i].x, kk[i].y, kk[i].z, kk[i].w}, vw[4] = {vv[i].x, vv[i].y, vv[i].z, vv[i].w};
#pragma unroll
            for (int h4 = 0; h4 < 2; ++h4) {
                f32x4 ko, vo;
                ko.x = bf2f(kw[2 * h4] & 0xffffu); ko.y = bf2f(kw[2 * h4] >> 16); ko.z = bf2f(kw[2 * h4 + 1] & 0xffffu); ko.w = bf2f(kw[2 * h4 + 1] >> 16);
                vo.x = bf2f(vw[2 * h4] & 0xffffu); vo.y = bf2f(vw[2 * h4] >> 16); vo.z = bf2f(vw[2 * h4 + 1] & 0xffffu); vo.w = bf2f(vw[2 * h4 + 1] >> 16);
                *(f32x4*)(F.out + O_KP + oi + 4 * h4) = ko; *(f32x4*)(F.out + O_VP + oi + 4 * h4) = vo; } }
    }
}

__device__ __forceinline__ void samp_b_unit(const Args& A, Ctx& F, int l, int u) {
    const bf16* PROJ = (const bf16*)(F.ws + WS_PROJ);
    const int bs = u >> 1, hf = u & 1, m0 = NP + 4 * bs;
    LAS unsigned char* L = F.lds;
    constexpr int OFL = 0, OCV = 34 * 1024, OKL = OCV + 4096, OVTL = OKL + 144 * RS64, OQL = OVTL + 64 * 336, OSL = 0, OPL = 16 * 592, OENDB = OQL + 16 * RS64;
    static_assert(OENDB <= RING_BYTES && OPL + 16 * 336 <= OCV, "samp_b LDS map");
    LAS float* FL = (LAS float*)(L + OFL); LAS float* CV = (LAS float*)(L + OCV);
    const float* ck = A.in[4 + F.z] + ((size_t)l * 128 + bs) * 128 * 128 + hf * 64;
    const float* cv = A.in[5 + F.z] + ((size_t)l * 128 + bs) * 128 * 128 + hf * 64;
    float* okp = F.out + O_KS + ((size_t)l * 128 + bs) * 128 * 128 + hf * 64; float* ovp = F.out + O_VS + ((size_t)l * 128 + bs) * 128 * 128 + hf * 64;
    const float* cc = A.in[2 + F.z] + ((size_t)l * 128 + bs) * 30 * 256;
    f32x4 fr4[4];
#pragma unroll
    for (int i = 0; i < 4; ++i) { const int it = F.tid + 512 * i; fr4[i] = it < 30 * 64 ? *(const f32x4*)(cc + 4 * it) : (f32x4){0.f, 0.f, 0.f, 0.f}; }
    f32x4 kr[2][2], vr[2][2];
#pragma unroll
    for (int i = 0; i < 2; ++i) { const int it = F.tid + 512 * i, j = it >> 3, c8 = 8 * (it & 7);
        kr[i][0] = *(const f32x4*)(ck + j * 128 + c8); kr[i][1] = *(const f32x4*)(ck + j * 128 + c8 + 4); vr[i][0] = *(const f32x4*)(cv + j * 128 + c8); vr[i][1] = *(const f32x4*)(cv + j * 128 + c8 + 4); }
    const int nt_ = F.tid >> 8, nch = F.tid & 255;
    const bf16* pa0 = PROJ + (size_t)(m0 + nt_) * INW + nch; const bf16* pa1 = PROJ + (size_t)(m0 + 2 + nt_) * INW + nch;
    const unsigned short av0 = pa0[C_AV], ag0 = pa0[C_AG], av1 = pa1[C_AV], ag1 = pa1[C_AG];
    unsigned short kb = 0, vb = 0;
    if (F.tid < 256) { const int t = F.tid >> 6, r = F.tid & 63; const bf16* p = PROJ + (size_t)(m0 + t) * INW + hf * 64 + r; kb = p[C_KA]; vb = p[C_VA]; }
    unsigned short qv[2];
#pragma unroll
    for (int i = 0; i < 2; ++i) { const int ix = F.tid + 512 * i, row = ix >> 6, dd = ix & 63; qv[i] = PROJ[(size_t)(m0 + (row >> 2)) * INW + C_QA + (row & 3) * 64 + dd]; }
    const float sinkv = A.in[19 + F.z][l * 4 + 2 * hf + (F.wave & 1)];
    const float cbias = A.in[14 + F.z][l * 256 + nch];
    __builtin_amdgcn_sched_barrier(0);
    __syncthreads();
#pragma unroll
    for (int i = 0; i < 4; ++i) { const int it = F.tid + 512 * i; if (it < 30 * 64) *(LAS f32x4*)(FL + 4 * it) = fr4[i]; }
    FL[(30 + nt_) * 256 + nch] = bf2f(av0) * sigm(bf2f(ag0)); FL[(32 + nt_) * 256 + nch] = bf2f(av1) * sigm(bf2f(ag1));
#pragma unroll
    for (int i = 0; i < 2; ++i) { const int it = F.tid + 512 * i, j = it >> 3, c8 = 8 * (it & 7);
        const f32x4 k0 = kr[i][0], k1 = kr[i][1], v0 = vr[i][0], v1 = vr[i][1];
        if (j >= 4) { *(f32x4*)(okp + (j - 4) * 128 + c8) = k0; *(f32x4*)(okp + (j - 4) * 128 + c8 + 4) = k1; *(f32x4*)(ovp + (j - 4) * 128 + c8) = v0; *(f32x4*)(ovp + (j - 4) * 128 + c8 + 4) = v1; }
        v4u kw; kw.x = pk2(k0.x, k0.y); kw.y = pk2(k0.z, k0.w); kw.z = pk2(k1.x, k1.y); kw.w = pk2(k1.z, k1.w);
        *(LAS v4u*)(L + OKL + j * RS64 + 2 * c8) = kw;
        const float vv[8] = {v0.x, v0.y, v0.z, v0.w, v1.x, v1.y, v1.z, v1.w};
#pragma unroll
        for (int e = 0; e < 8; ++e) *(LAS unsigned short*)(L + OVTL + (c8 + e) * 336 + 2 * j) = (unsigned short)f2bf(vv[e]); }
    if (F.tid < 256) { const int t = F.tid >> 6, r = F.tid & 63;
        *(LAS unsigned short*)(L + OKL + (128 + t) * RS64 + 2 * r) = kb; *(LAS unsigned short*)(L + OVTL + r * 336 + 2 * (128 + t)) = vb;
        okp[(124 + t) * 128 + r] = bf2f(kb); ovp[(124 + t) * 128 + r] = bf2f(vb); }
    for (int i = F.tid; i < 12 * 64; i += 512) *(LAS unsigned short*)(L + OKL + (132 + (i >> 6)) * RS64 + 2 * (i & 63)) = 0;
    for (int i = F.tid; i < 64 * 28; i += 512) *(LAS unsigned short*)(L + OVTL + (i / 28) * 336 + 2 * (132 + i % 28)) = 0;
#pragma unroll
    for (int i = 0; i < 2; ++i) { const int ix = F.tid + 512 * i, row = ix >> 6, dd = ix & 63; *(LAS unsigned short*)(L + OQL + row * RS64 + 2 * dd) = qv[i]; }
    __syncthreads();
    {
        const int ch = nch, tok = 2 * hf + nt_;
        float a0 = cbias;
#pragma unroll
        for (int j = 0; j < 31; ++j) a0 += A.in[13 + F.z][(size_t)(l * 31 + j) * 256 + ch] * FL[(tok + j) * 256 + ch];
        CV[tok * 256 + ch] = a0;
    }
    { float* o = F.out + O_CONVS + ((size_t)l * 128 + bs) * 30 * 256 + hf * 15 * 256; for (int i = F.tid; i < 15 * 64; i += 512) *(f32x4*)(o + 4 * i) = *(const LAS f32x4*)(FL + (4 + 15 * hf) * 256 + 4 * i); }
    __syncthreads();
    if (F.wave < 2) { const int tok = 2 * hf + F.wave; const f32x4 acc = *(const LAS f32x4*)(CV + tok * 256 + 4 * F.lane); conv_tail(A, F, l, acc, (bf16*)(F.ws + WS_MIX) + (size_t)(m0 + tok) * D); }
    const int r16 = F.lane & 15, q4 = F.lane >> 4;
    const float* BT = (const float*)(F.ws + WS_TAB);
    for (int kt = F.wave; kt < 9; kt += 8) {
        f32x4 s0 = {0.f, 0.f, 0.f, 0.f};
#pragma unroll
        for (int ks = 0; ks < 2; ++ks) {
            const bf16x8 qa = *(const LAS bf16x8*)(L + OQL + r16 * RS64 + (32 * ks + 8 * q4) * 2);
            const bf16x8 k0 = *(const LAS bf16x8*)(L + OKL + (16 * kt + r16) * RS64 + (32 * ks + 8 * q4) * 2);
            s0 = MFMA16(qa, k0, s0);
        }
        const int key = 16 * kt + r16, t = q4; const bool ok = key >= t && key <= 128 + t;
#pragma unroll
        for (int g = 0; g < 2; ++g) { const int e = 2 * hf + g; const float sv = (hf ? (g ? s0[3] : s0[2]) : (g ? s0[1] : s0[0])) * 0.125f;
            const int rel_ = 128 + t - key; float bia = BT[(rel_ < 0 ? 0 : (rel_ > 128 ? 128 : rel_)) * 4 + e]; asm volatile("" : "+v"(bia));
            ((LAS float*)(L + OSL))[(4 * t + e) * 148 + key] = ok ? sv + bia : -INFINITY; }
    }
    __syncthreads();
    {
        const int row = 4 * (F.wave >> 1) + 2 * hf + (F.wave & 1);
        const LAS float* sl = (const LAS float*)(L + OSL) + row * 148;
        float sc[3];
#pragma unroll
        for (int i = 0; i < 3; ++i) { const int j = F.lane + 64 * i; sc[i] = j < 144 ? sl[j] : -INFINITY; }
        const float mx = fmaxf(wave_max(fmaxf(fmaxf(sc[0], sc[1]), sc[2])), sinkv);
        float p[3], ps = 0.f;
#pragma unroll
        for (int i = 0; i < 3; ++i) { p[i] = __expf(sc[i] - mx); ps += p[i]; }
        const float inv = __builtin_amdgcn_rcpf(wave_sum(ps) + __expf(sinkv - mx));
#pragma unroll
        for (int i = 0; i < 3; ++i) { const int j = F.lane + 64 * i; if (j < 160) *(LAS unsigned short*)(L + OPL + row * 336 + 2 * j) = (unsigned short)f2bf(p[i] * inv); }
    }
    __syncthreads();
    if (F.wave < 4) {
        const int dt = F.wave;
        f32x4 o4 = {0.f, 0.f, 0.f, 0.f};
#pragma unroll
        for (int ks = 0; ks < 5; ++ks) {
            const bf16x8 pa = *(const LAS bf16x8*)(L + OPL + r16 * 336 + (32 * ks + 8 * q4) * 2);
            const bf16x8 vb8 = *(const LAS bf16x8*)(L + OVTL + (16 * dt + r16) * 336 + (32 * ks + 8 * q4) * 2);
            o4 = MFMA16(pa, vb8, o4);
        }
#pragma unroll
        for (int g = 0; g < 2; ++g) { const int e = 2 * hf + g; const float ov = hf ? (g ? o4[3] : o4[2]) : (g ? o4[1] : o4[0]);
            ((bf16*)(F.ws + WS_MIX))[(size_t)(m0 + q4) * D + 768 + e * 64 + 16 * dt + r16] = (bf16)f2bf(ov); }
    }
}
__device__ __forceinline__ void samp_hg_load(const Args& A, Ctx& F, int l, int u, float (&S)[32]) {
    const int bs = u >> 2, h = u & 3, v = F.tid & 127, dq = F.tid >> 7;
    const float* S0 = A.in[3 + F.z] + (((size_t)l * 128 + bs) * 4 + h) * 16384 + (size_t)(dq * 32) * 128 + v;
#pragma unroll
    for (int i = 0; i < 32; ++i) S[i] = S0[i * 128];
    __builtin_amdgcn_sched_barrier(0);
}
__device__ __forceinline__ void samp_hg_unit(const Args& A, Ctx& F, int l, int u, float (&S)[32]) {
    const int bs = u >> 2, h = u & 3, m0 = NP + 4 * bs;
    const bf16* PROJ = (const bf16*)(F.ws + WS_PROJ);
    LAS float* FT = (LAS float*)F.lds;
    LAS float* KT = FT + 512;
    LAS float* QT = KT + 512;
    LAS float* VV = QT + 512;
    LAS float* OP = VV + 512;
    LAS float* SS = OP + 2048;
    const int t_ = F.tid >> 7, d_ = F.tid & 127; const bf16* p_ = PROJ + (size_t)(m0 + t_) * INW + h * 128 + d_;
    const float lb_ = l == 0 ? 0.f : ((const float*)(F.ws + WS_TAB))[1024 + h * 128 + d_];
    const float xf_ = bf2f(p_[C_F]), xq_ = bf2f(p_[C_Q]), xi_ = bf2f(p_[C_I]), gg_ = bf2f(p_[C_G]), gn_ = A.in[18 + F.z][l * 128 + d_];
    __syncthreads();
    {
        const float e = __expf(-xf_), sg = __builtin_amdgcn_rcpf(1.f + e);
        FT[F.tid] = lb_ + (1.f - lb_) * sg; KT[F.tid] = (1.f - lb_) * e * sg; QT[F.tid] = xq_; VV[F.tid] = xi_;
    }
    __syncthreads();
    const int v = F.tid & 127, dq = F.tid >> 7;
#pragma unroll
    for (int t = 0; t < 4; ++t) {
        const float vt = VV[t * 128 + v]; float part = 0.f;
#pragma unroll
        for (int i = 0; i < 32; ++i) { const int d = dq * 32 + i; S[i] = FT[t * 128 + d] * S[i] + KT[t * 128 + d] * vt; part += QT[t * 128 + d] * S[i]; }
        OP[(dq * 4 + t) * 128 + v] = part;
    }
    float* So = F.out + O_HGS + (((size_t)l * 128 + bs) * 4 + h) * 16384 + (size_t)(dq * 32) * 128 + v;
#pragma unroll
    for (int i = 0; i < 32; ++i) So[i * 128] = S[i];
    __syncthreads();
    {
        const int t = F.tid >> 7, vv = F.tid & 127;
        const float o = (OP[(0 * 4 + t) * 128 + vv] + OP[(1 * 4 + t) * 128 + vv]) + (OP[(2 * 4 + t) * 128 + vv] + OP[(3 * 4 + t) * 128 + vv]);
        const float ss = wave_sum(o * o);
        if (F.lane == 0) SS[t * 2 + (F.wave & 1)] = ss;
        __syncthreads();
        const float rstd = __builtin_amdgcn_rsqf((SS[t * 2] + SS[t * 2 + 1]) * (1.f / 128.f) + EPS);
        ((bf16*)(F.ws + WS_MIX))[(size_t)(m0 + t) * D + 256 + h * 128 + vv] = (bf16)f2bf(o * rstd * gn_ * (gg_ * sigm(gg_)));
    }
}

constexpr int SHWLD = 4096;
template <int ACT> struct SEpiStore {
    bf16* O; int ldc; const float* rss; const float* shw;
    __device__ __forceinline__ void operator()(int row, int col, const f32x4 v, int lane) const {
        f32x4 w = v;
        if (rss) { const float rstd = __builtin_amdgcn_rsqf(rss[row] * (1.f / D) + EPS); w = v * rstd + *(const f32x4*)(shw + (size_t)modrow(row) * SHWLD + col); }
        if (ACT == 1) {
#pragma unroll
            for (int i = 0; i < 4; ++i) { const float r = w[i] > 0.f ? w[i] : 0.f; w[i] = r * r; } }
        v2u o; o.x = pk2(w[0], w[1]); o.y = pk2(w[2], w[3]);
        *(v2u*)(O + (size_t)row * ldc + col) = o;
    }
};
struct SEpiGateRes {
    const float* baseS; float* out; const float* gate; bf16* xs; float* rss; const float* gam; const float* sc;
    __device__ __forceinline__ void operator()(int row, int col, const f32x4 v, int lane) const {
        const int mr = modrow(row);
        const f32x4 g4 = *(const f32x4*)(gate + (size_t)mr * MODLD + col), b4 = *(const f32x4*)(baseS + (size_t)(row - NP) * D + col);
        const f32x4 x = b4 + g4 * v;
        *(f32x4*)(out + (size_t)row * D + col) = x;
        if (xs) {
            const f32x4 s4 = *(const f32x4*)(gam + col) * (*(const f32x4*)(sc + (size_t)mr * MODLD + col) + 1.f), y = x * s4;
            v2u o; o.x = pk2(y[0], y[1]); o.y = pk2(y[2], y[3]);
            *(v2u*)(xs + (size_t)row * D + col) = o;
            float ss = (x[0] * x[0] + x[1] * x[1]) + (x[2] * x[2] + x[3] * x[3]);
            ss += __shfl_xor(ss, 16); ss += __shfl_xor(ss, 32);
            if ((lane >> 4) == 0) (void)__hip_atomic_fetch_add(rss + row, ss, __ATOMIC_RELAXED, __HIP_MEMORY_SCOPE_AGENT);
        }
    }
};
struct SEpiF32 {
    float* O; int ld;
    __device__ __forceinline__ void operator()(int row, int col, const f32x4 v, int lane) const { *(f32x4*)(O + (size_t)row * ld + col) = v; }
};
template <int NJ, class Epi>
__device__ __forceinline__ void sgemm_phase(Ctx& F, const bf16* Arow  , const bf16* Bt, int N, int K, const Epi& E, const int ntm = 8, const int row0 = NP) {
    static_assert(NJ <= 4, "wave-private image: 8 KiB of A + 2 NJ KiB of B");
    const int r16 = F.lane & 15, q4 = F.lane >> 4, lr = F.lane >> 3, lp = F.lane & 7;
    const int ntn = N / (16 * NJ), ksl = K / 8, nss = ksl / 64;
    LAS unsigned char* WL = F.lds + F.wave * 16384;
    LAS f32x4* RED = (LAS f32x4*)F.lds;
    TSEC_BEGIN(50);
    constexpr int SLOT = 4 * NJ * 64;
    const bool grp = ((F.G & 7) == 0) && ((ntn & 7) == 0);
    const int xg = F.bid & 7, wpx = grp ? (F.G >> 3) : F.G, cpx = ntn >> 3;
    for (int w = grp ? (F.bid >> 3) : F.bid; w < (grp ? ntm * cpx : ntm * ntn); w += wpx) {
        const int tm = w % ntm, tn = grp ? xg * cpx + w / ntm : w / ntm;
        const bf16* ap = Arow + (size_t)(64 * tm + lr) * K + F.wave * ksl + 8 * lp;
        const bf16* bp = Bt + (size_t)(16 * NJ * tn + lr) * K + F.wave * ksl + 8 * lp;
        f32x4 acc[4][NJ];
#pragma unroll
        for (int i = 0; i < 4; ++i)
#pragma unroll
            for (int j = 0; j < NJ; ++j) acc[i][j] = (f32x4){0.f, 0.f, 0.f, 0.f};
        v4u ra[8], rb[2 * NJ];
#define SG_LOAD(ss) do { _Pragma("unroll") for (int t = 0; t < 8; ++t) ra[t] = *(const v4u*)(ap + (size_t)(8 * t) * K + 64 * (ss)); \
                          _Pragma("unroll") for (int t = 0; t < 2 * NJ; ++t) rb[t] = *(const v4u*)(bp + (size_t)(8 * t) * K + 64 * (ss)); } while (0)
        SG_LOAD(0);
        __builtin_amdgcn_sched_barrier(0);
        __syncthreads();
        for (int ss = 0; ss < nss; ++ss) {
#pragma unroll
            for (int t = 0; t < 8; ++t) { const int r = 8 * t + lr; *(LAS v4u*)(WL + r * 128 + ((lp ^ (r & 7)) << 4)) = ra[t]; }
#pragma unroll
            for (int t = 0; t < 2 * NJ; ++t) { const int r = 8 * t + lr; *(LAS v4u*)(WL + 8192 + r * 128 + ((lp ^ (r & 7)) << 4)) = rb[t]; }
            __builtin_amdgcn_sched_barrier(0);
            if (ss + 1 < nss) SG_LOAD(ss + 1);
            __builtin_amdgcn_sched_barrier(0);
#pragma unroll
            for (int s = 0; s < 2; ++s) {
                bf16x8 fa[4], fb[NJ];
#pragma unroll
                for (int i = 0; i < 4; ++i) { const int r = 16 * i + r16; fa[i] = *(const LAS bf16x8*)(WL + r * 128 + (((4 * s + q4) ^ (r & 7)) << 4)); }
#pragma unroll
                for (int j = 0; j < NJ; ++j) { const int r = 16 * j + r16; fb[j] = *(const LAS bf16x8*)(WL + 8192 + r * 128 + (((4 * s + q4) ^ (r & 7)) << 4)); }
#pragma unroll
                for (int i = 0; i < 4; ++i)
#pragma unroll
                    for (int j = 0; j < NJ; ++j) acc[i][j] = MFMA16(fb[j], fa[i], acc[i][j]);
            }
            __builtin_amdgcn_sched_barrier(0);
        }
#undef SG_LOAD
        __syncthreads();
#pragma unroll
        for (int i = 0; i < 4; ++i)
#pragma unroll
            for (int j = 0; j < NJ; ++j) RED[(F.wave * 4 + i) * NJ * 64 + j * 64 + F.lane] = acc[i][j];
        __syncthreads();
#pragma unroll
        for (int q = 0; q < (SLOT + 511) / 512; ++q) {
            const int p = F.tid + 512 * q, ln = p & 63, ij = p >> 6, j = ij % NJ, mi = ij / NJ;
            if (p >= SLOT) break;
            f32x4 v = RED[p];
#pragma unroll
            for (int k4 = 1; k4 < 8; ++k4) v += RED[k4 * SLOT + p];
            E(row0 + 64 * tm + 16 * mi + (ln & 15), 16 * NJ * tn + 16 * j + 4 * (ln >> 4), v, ln);
        }
    }
    TSEC_END(50);
}

#ifndef MK_PER_PHASE
#define MK_PER_PHASE 0
#endif
#ifndef PH_MASK
#define PH_MASK 0xFFFF
#endif
#define PHON(k) ((PH_MASK >> (k)) & 1)
#ifndef PROBE_REP
#define PROBE_REP -1
#endif
#ifndef PROBE_SPIN
#define PROBE_SPIN -1
#endif
#define RELAUNDER() do { int tid_ = F.tid, bid_ = __builtin_amdgcn_readfirstlane(F.bid), g_ = __builtin_amdgcn_readfirstlane(F.G), z_ = __builtin_amdgcn_readfirstlane(F.z); asm volatile("" : "+s"(z_), "+s"(bid_), "+s"(g_)); asm volatile("" : "+v"(tid_)); \
    F.ws = args.ws + z_; F.out = args.out + z_; F.z = z_; F.tid = tid_; F.lane = tid_ & 63; F.wave = __builtin_amdgcn_readfirstlane(tid_ >> 6); F.bid = bid_; F.G = g_; } while (0)
#define SUBPROBE(k, ...) do { RELAUNDER(); const unsigned long long st0_ = PROBE_SPIN == (k) ? __builtin_amdgcn_s_memrealtime() : 0ull; __VA_ARGS__; if (PROBE_SPIN == (k)) { __syncthreads(); const unsigned long long st1_ = __builtin_amdgcn_s_memrealtime(), du_ = (st1_ - st0_) * PROBE_N; while (__builtin_amdgcn_s_memrealtime() - st1_ < du_) __builtin_amdgcn_s_sleep(8); } } while (0)
__global__ void __launch_bounds__(512, 2) mk_fwd(Args args) {
    extern __shared__ __attribute__((aligned(16))) unsigned char lds[];
    Ctx F;
    F.lds = (LAS unsigned char*)lds;
    F.tid = threadIdx.x; F.lane = F.tid & 63; F.wave = __builtin_amdgcn_readfirstlane(F.tid >> 6);
    F.G = gridDim.x; F.bid = blockIdx.x; F.z = 0;
    F.out = args.out; F.ws = args.ws;
    volatile LAS unsigned* MISC = (volatile LAS unsigned*)(F.lds + MISC_OFF);
    for (int u = F.tid; u < (LDS_BYTES - LDSCTL_OFF) / 4; u += 512) ((LAS unsigned*)(F.lds + LDSCTL_OFF))[u] = 0u;
    __syncthreads();
    const int lo = args.ph_lo, hi = args.ph_hi;
    const int wave0 = F.wave;
    XcdBarrier bar; bar.bar = (unsigned*)(F.ws + WS_CTL) + CW_BAR; bar.x = 0; bar.st = nullptr;
    if (hi - lo > 1) bar = xcd_barrier_post((unsigned*)(F.ws + WS_CTL) + CW_BAR, MISC + 8, F.tid);
    for (int p = lo; p < hi; ++p) {
        const int l = p < 2 ? 0 : (p - 2) / 9, s = (p < 2 || p == NPH - 1) ? -1 : (p - 2) % 9;
        const int which = p == NPH - 1 ? 2 : (s == 0 ? 0 : (s == 6 ? 1 : -1));
        const int kind = p == 0 ? 0 : p == 1 ? 12 : (which == 2 ? 10 : (which >= 0 ? 1 : (s == 1 ? 2 : (s == 2 ? 3 : (s == 3 ? 4 : (s == 4 ? 5 : (s == 5 ? (l == 0 ? 6 : 11) : (s == 7 ? 7 : 8))))))));
        if (s == 6 || (s == 0 && l == 1)) continue;
        const int nrep = (kind == PROBE_REP) ? 1 + PROBE_N : 1;
        const unsigned long long pt0 = PROBE_SPIN >= 0 ? __builtin_amdgcn_s_memrealtime() : 0ull;
        for (int rep = 0; rep < nrep; ++rep) {
        { int z_ = 0, tid_ = wave0 * 64 + (int)__builtin_amdgcn_mbcnt_hi(~0u, __builtin_amdgcn_mbcnt_lo(~0u, 0u)), bid_ = blockIdx.x, g_ = gridDim.x;
          asm volatile("" : "+s"(z_), "+s"(bid_), "+s"(g_)); asm volatile("" : "+v"(tid_));
          F.ws = args.ws + z_; F.out = args.out + z_; F.z = z_; F.tid = tid_; F.lane = tid_ & 63; F.wave = __builtin_amdgcn_readfirstlane(tid_ >> 6); F.bid = bid_; F.G = g_; }
        if (PROBE_REP == 9 && hi - lo > 1) { for (int xb = 0; xb < PROBE_N; ++xb) xcd_barrier(bar, F.tid); }
        if (p == 0) { if (PHON(0)) p0_prologue(args, F); }
        else if (p == 1) { if (PHON(0)) mod_phase(args, F); }
        else if (which >= 0) { if (PHON(1)) norm_phase(args, F, p == NPH - 1 ? 0 : l, which); }
        else if (s == 1 && PHON(2)) {
            pg8::Gemm g{(const pg8::bf16_t*)(F.ws + WS_XN), (const pg8::bf16_t*)(F.ws + WS_WIN) + (size_t)l * INW * D, NP, INW, D};
            pg8::StaticOrder S; S.init(NP, INW, F.G, F.bid);
            const float* rss = l == 0 ? nullptr : (const float*)(F.ws + WS_CTL + CTL_RSS) + (size_t)1 * M;
            const float* shw = (const float*)(F.ws + WS_SHW) + (size_t)1 * 192 * SHWLD;
            pg8::EpiStore<0> E{(pg8::bf16_t*)(F.ws + WS_PROJ), INW, rss, shw};
            SEpiStore<0> SE{(bf16*)(F.ws + WS_PROJ), INW, rss, shw};
            if (l == 0) {
                const bf16* SHB = (const bf16*)(F.ws + WS_SHB); float* SHW = (float*)(F.ws + WS_SHW);
                { SEpiF32 HE{SHW + (size_t)0 * 192 * SHWLD, SHWLD}; sgemm_phase<4>(F, SHB + (size_t)0 * 192 * 1024, (const bf16*)(F.ws + WS_WUP), FF, D, HE, 3, 0); }
                { SEpiF32 HE{SHW + (size_t)2 * 192 * SHWLD, SHWLD}; sgemm_phase<4>(F, SHB + (size_t)2 * 192 * 1024, (const bf16*)(F.ws + WS_WUP) + (size_t)FF * D, FF, D, HE, 3, 0); }
                { SEpiF32 HE{SHW + (size_t)1 * 192 * SHWLD, SHWLD}; sgemm_phase<3>(F, SHB + (size_t)1 * 192 * 1024, (const bf16*)(F.ws + WS_WIN) + (size_t)INW * D, INW, D, HE, 3, 0); }
            }
            sgemm_phase<3>(F, (const bf16*)(F.ws + WS_XN) + (size_t)NP * D, (const bf16*)(F.ws + WS_WIN) + (size_t)l * INW * D, INW, D, SE);
            __syncthreads();
            pg8::gemm_phase<pg8::EpiStore<0>, pg8::StaticOrder, true, true>(F.lds, g, S, E, F.tid);
        } else if (s == 2) {
            for (int slot = 0; slot < 5; ++slot) {
                const int ty = __builtin_amdgcn_readfirstlane((slot + F.bid) % 5);
#if PHON(7)
                if (ty == 0) {
            SUBPROBE(20, for (int u = F.bid; u < 256; u += F.G) samp_b_unit(args, F, l, u));
                }
#endif
#if PHON(6)
                if (ty == 1) {
            SUBPROBE(21, { float S[32]; samp_hg_load(args, F, l, F.bid & 511, S); for (int u = F.bid; u < 512; u += F.G) { float Sn[32]; samp_hg_load(args, F, l, (u + F.G) & 511, Sn); samp_hg_unit(args, F, l, u, S); _Pragma("unroll") for (int i = 0; i < 32; ++i) S[i] = Sn[i]; } });
                }
#endif
#if PHON(3)
                if (ty == 2) {
            SUBPROBE(22, for (int u = F.bid; u < 256; u += F.G) attn_unit(args, F, l, u));
                }
#endif
#if PHON(4)
                if (ty == 3) {
            SUBPROBE(23, for (int u = F.bid; u < 256; u += F.G) conv_unit(args, F, l, u));
                }
#endif
#if PHON(5)
                if (ty == 4) {
                        SUBPROBE(24, {   const int nh1 = -1; auto h1idx = [&](int k) -> int { if (nh1 < 0) return F.bid + F.G * k; return k < 4 ? F.bid + 256 * k : F.bid + 640; }; const int cnt = nh1 < 0 ? (1024 - F.bid + F.G - 1) / F.G : nh1; v4u rf[2], rv[2]; h1_load(F, h1idx(0) & 1023, rf, rv); for (int k = 0; k < cnt; ++k) { v4u nf[2], nv[2]; h1_load(F, h1idx(k + 1 < cnt ? k + 1 : k) & 1023, nf, nv); h1_unit(args, F, l, h1idx(k), rf, rv); rf[0] = nf[0]; rf[1] = nf[1]; rv[0] = nv[0]; rv[1] = nv[1]; } });
                }
#endif
            }
        } else if (s == 3) { if (PHON(8)) h2_scan(args, F, l); }
        else if (s == 4 && PHON(9)) { v4u rf[2], rq[2], rv[2]; h3_load(F, F.bid & 1023, rf, rq, rv); for (int u = F.bid; u < 1024; u += F.G) { v4u nf[2], nq[2], nv[2]; h3_unit(args, F, l, u, rf, rq, rv, (u + F.G) & 1023, nf, nq, nv); rf[0] = nf[0]; rf[1] = nf[1]; rq[0] = nq[0]; rq[1] = nq[1]; rv[0] = nv[0]; rv[1] = nv[1]; } }
        else if ((s == 5 || s == 8) && PHON(10)) {
            const bool dn = s == 8;
            pg8::Gemm g{(const pg8::bf16_t*)(F.ws + (dn ? WS_HB : WS_MIX)), (const pg8::bf16_t*)(F.ws + (dn ? WS_WDN : WS_WOUT)) + (size_t)l * (dn ? D * FF : D * D), NP, D, dn ? FF : D};
            pg8::StaticOrder S; S.init(NP, D, F.G, F.bid);
            const bool from_in = (!dn && l == 0);
            const int f = dn ? 1 : 2 * l; const bool fold = !(dn && l == 1);
            bf16* xs = fold ? (bf16*)(F.ws + WS_XN) : nullptr; float* rssw = (float*)(F.ws + WS_CTL + CTL_RSS) + (size_t)f * M;
            const float* gam = dn ? args.in[11 + F.z] + D : args.in[21 + F.z] + l * D;
            const float* scp = (const float*)(F.ws + WS_MOD) + (size_t)(dn ? 1 : l) * MODR * MODLD + (dn ? 1 * D : 4 * D);
            pg8::EpiGateRes E{from_in ? args.in[0 + F.z] : F.out, from_in ? args.in[1 + F.z] : F.out + (size_t)NP * D, F.out, (const float*)(F.ws + WS_MOD) + (size_t)l * MODR * MODLD + (dn ? 5 * D : 2 * D),
                              (pg8::bf16_t*)xs, rssw, gam, scp};
            SEpiGateRes SE{from_in ? args.in[1 + F.z] : F.out + (size_t)NP * D, F.out, (const float*)(F.ws + WS_MOD) + (size_t)l * MODR * MODLD + (dn ? 5 * D : 2 * D), xs, rssw, gam, scp};
            sgemm_phase<2>(F, (const bf16*)(F.ws + (dn ? WS_HB : WS_MIX)) + (size_t)NP * (dn ? FF : D), (const bf16*)(F.ws + (dn ? WS_WDN : WS_WOUT)) + (size_t)l * (dn ? D * FF : D * D), D, dn ? FF : D, SE);
            __syncthreads();
            pg8::gemm_phase<pg8::EpiGateRes, pg8::StaticOrder, true, true>(F.lds, g, S, E, F.tid);
        } else if (s == 7 && PHON(11)) {
            pg8::Gemm g{(const pg8::bf16_t*)(F.ws + WS_XN), (const pg8::bf16_t*)(F.ws + WS_WUP) + (size_t)l * FF * D, NP, FF, D};
            pg8::StaticOrder S; S.init(NP, FF, F.G, F.bid);
            const float* rss = (const float*)(F.ws + WS_CTL + CTL_RSS) + (size_t)(2 * l) * M;
            const float* shw = (const float*)(F.ws + WS_SHW) + (size_t)(2 * l) * 192 * SHWLD;
            pg8::EpiStore<1> E{(pg8::bf16_t*)(F.ws + WS_HB), FF, rss, shw};
            SEpiStore<1> SE{(bf16*)(F.ws + WS_HB), FF, rss, shw};
            sgemm_phase<4>(F, (const bf16*)(F.ws + WS_XN) + (size_t)NP * D, (const bf16*)(F.ws + WS_WUP) + (size_t)l * FF * D, FF, D, SE);
            __syncthreads();
            pg8::gemm_phase<pg8::EpiStore<1>, pg8::StaticOrder, true, true>(F.lds, g, S, E, F.tid);
        }
        }
        if (PROBE_SPIN >= 0 && kind == PROBE_SPIN) { const unsigned long long pt1 = __builtin_amdgcn_s_memrealtime(), dur = (pt1 - pt0) * PROBE_N; while (__builtin_amdgcn_s_memrealtime() - pt1 < dur) __builtin_amdgcn_s_sleep(8); }
        if (p + 1 < hi) xcd_barrier(bar, F.tid);
    }
}

extern "C" void kernel_launch(void* const* d_in, const int* in_sizes, int n_in, void* d_out, int out_size, void* d_ws, size_t ws_size, hipStream_t stream) {
    static int grid = 0;
    if (grid == 0) {
        if (n_in != 25 || in_sizes[0] != NP * D || (size_t)out_size != O_END || ws_size < WS_END) {
            fprintf(stderr, "kernel_launch: unexpected shapes (n_in %d, in0 %d, out %d, ws %zu)\n", n_in, n_in > 0 ? in_sizes[0] : -1, out_size, ws_size); grid = -1; return; }
        int dev = 0, cus = 0, per_cu = 0;
        if (hipGetDevice(&dev) != hipSuccess || hipDeviceGetAttribute(&cus, hipDeviceAttributeMultiprocessorCount, dev) != hipSuccess) { grid = -1; return; }
        if (hipFuncSetAttribute((const void*)mk_fwd, hipFuncAttributeMaxDynamicSharedMemorySize, LDS_BYTES) != hipSuccess) { fprintf(stderr, "kernel_launch: hipFuncSetAttribute failed\n"); grid = -1; return; }
        if (hipOccupancyMaxActiveBlocksPerMultiprocessor(&per_cu, (const void*)mk_fwd, 512, LDS_BYTES) != hipSuccess || per_cu < 1) {
            fprintf(stderr, "kernel_launch: occupancy query reports %d blocks per CU; nothing launched\n", per_cu); (void)hipGetLastError(); grid = -1; return; }
        grid = cus;
    }
    if (grid < 0) return;
    (void)hipMemsetAsync((char*)d_ws + WS_CTL, 0, CTL_ZERO_BYTES, stream);
    Args a{};
    for (int i = 0; i < 25; ++i) a.in[i] = (const float*)d_in[i];
    a.out = (float*)d_out; a.ws = (unsigned char*)d_ws;
#if MK_PER_PHASE
    for (int p = 0; p < NPH; ++p) { a.ph_lo = p; a.ph_hi = p + 1; hipLaunchKernelGGL(mk_fwd, dim3(grid), dim3(512), LDS_BYTES, stream, a); }
#else
    a.ph_lo = 0; a.ph_hi = NPH; hipLaunchKernelGGL(mk_fwd, dim3(grid), dim3(512), LDS_BYTES, stream, a);
#endif
}
```

```cpp
#define MK_PER_PHASE 0
#include <hip/hip_runtime.h>
#include <cstdio>
#include <cstdint>
namespace pg8 {
#define PG8_LAS __attribute__((address_space(3)))
typedef unsigned short bf16_t;
typedef short bf16x8 __attribute__((ext_vector_type(8)));
typedef float f32x4 __attribute__((ext_vector_type(4)));
typedef unsigned u32x4 __attribute__((ext_vector_type(4)));
constexpr int BM = 256, BK = 64, HALF = 128, HTB = HALF * BK * 2  , STAGE_BYTES = 8 * HTB, NXCD = 8, WGM = 8;

__host__ __device__ __forceinline__ int lds_byte(int r, int c) { const int st = (r >> 4) * 2 + (c >> 5), rr = r & 15, cc = c & 31, ob = rr * 64 + cc * 2; return st * 1024 + (ob ^ (((ob >> 9) & 1) << 5)); }
__host__ __device__ __forceinline__ void stage_rc(int b, int& R, int& C) { const int st = b / 1024, sb = b % 1024, swz = sb ^ (((sb >> 9) & 1) << 5); R = (st >> 1) * 16 + swz / 64; C = (st & 1) * 32 + (swz % 64) / 2; }
__host__ __device__ __forceinline__ int perm32(int rho) { const int n = rho >> 4, i = rho & 15; return 8 * (i >> 2) + 4 * n + (i & 3); }

struct Unit { int pm, pn; };
struct Gemm { const bf16_t* A; const bf16_t* Bt; int M, N, K; };

struct StaticOrder {
    int nM, nN, nwg, G, c;
    __host__ __device__ void init(int M, int N, int G_, int c_) { nM = M / BM; nN = N / BM; nwg = nM * nN; G = G_; c = c_; }
    __host__ __device__ bool next(int i, Unit& u) const {
        const long L = (long)i * G + c; if (L >= nwg) return false;
        int wgid = (int)L; { const int q = nwg / NXCD, r = nwg % NXCD, xcd = wgid % NXCD, off = wgid / NXCD; wgid = (xcd < r ? xcd * (q + 1) : r * (q + 1) + (xcd - r) * q) + off; }
        const int nig = WGM * nN, gid = wgid / nig, fm = gid * WGM, gsz = (nM - fm) < WGM ? (nM - fm) : WGM;
        u.pm = fm + ((wgid % nig) % gsz); u.pn = (wgid % nig) / gsz; return true;
    }
    __device__ __forceinline__ void a_ready(const Unit&) const {}
    __device__ __forceinline__ void done(const Unit&) const {}
};

__device__ __forceinline__ unsigned cvt_pk_bf16(float lo, float hi) { unsigned r; asm volatile("v_cvt_pk_bf16_f32 %0, %1, %2" : "=v"(r) : "v"(lo), "v"(hi)); return r; }
typedef float f32x2 __attribute__((ext_vector_type(2)));
constexpr int EP_NP = 16384, EP_D = 1024, EP_MODLD = 6144, EP_SHWLD = 4096;
constexpr float EP_EPS = 1e-6f;
__device__ __forceinline__ int ep_modrow(int r) { return r < EP_NP ? (r >> 12) : 4 + ((r - EP_NP) >> 2); }
template <int ACT> struct EpiStore {
    static constexpr bool PERM = true, AFTER_DRAIN = false;
    bf16_t* O; int ldc; const float* rss; const float* shw;
    __device__ __forceinline__ void operator()(const f32x4 (&acc)[2][2][4][2], const Unit& u, int wr, int wc, int fr, int fq) const {
        const int row0 = u.pm * BM + wr * 64 + fr, col0 = u.pn * BM + wc * 32 + 8 * fq;
        f32x4 h4[2][2]; float rs[8];
#pragma unroll
        for (int bj = 0; bj < 2; ++bj)
#pragma unroll
            for (int n = 0; n < 2; ++n) h4[bj][n] = (f32x4){0.f, 0.f, 0.f, 0.f};
#pragma unroll
        for (int i = 0; i < 8; ++i) rs[i] = 1.f;
        if (rss) {
            const float* hp = shw + (size_t)ep_modrow(u.pm * BM) * EP_SHWLD + col0;
#pragma unroll
            for (int bj = 0; bj < 2; ++bj)
#pragma unroll
                for (int n = 0; n < 2; ++n) h4[bj][n] = *(const f32x4*)(hp + bj * HALF + 4 * n);
#pragma unroll
            for (int i = 0; i < 8; ++i) rs[i] = rss[row0 + (i >> 2) * HALF + (i & 3) * 16];
#pragma unroll
            for (int i = 0; i < 8; ++i) rs[i] = __builtin_amdgcn_rsqf(rs[i] * (1.f / EP_D) + EP_EPS);
        }
#pragma unroll
        for (int ai = 0; ai < 2; ++ai)
#pragma unroll
            for (int m = 0; m < 4; ++m) { bf16_t* rowp = O + (size_t)(row0 + ai * HALF + m * 16) * ldc + col0; const float rstd = rs[ai * 4 + m];
#pragma unroll
                for (int bj = 0; bj < 2; ++bj) { f32x4 v0 = acc[ai][bj][m][0] * rstd + h4[bj][0], v1 = acc[ai][bj][m][1] * rstd + h4[bj][1];
                    if (ACT == 1) {
#pragma unroll
                        for (int e = 0; e < 4; ++e) { const float a = v0[e] > 0.f ? v0[e] : 0.f, b = v1[e] > 0.f ? v1[e] : 0.f; v0[e] = a * a; v1[e] = b * b; } }
                    u32x4 w; w.x = cvt_pk_bf16(v0[0], v0[1]); w.y = cvt_pk_bf16(v0[2], v0[3]); w.z = cvt_pk_bf16(v1[0], v1[1]); w.w = cvt_pk_bf16(v1[2], v1[3]);
                    *(u32x4*)(rowp + bj * HALF) = w; } }
    }
};
struct EpiGateRes {
    static constexpr bool PERM = true, AFTER_DRAIN = false;
    const float* baseP; const float* baseS; float* out; const float* gate;
    bf16_t* xs; float* rss; const float* gam; const float* sc;
    __device__ __forceinline__ void operator()(const f32x4 (&acc)[2][2][4][2], const Unit& u, int wr, int wc, int fr_, int fq_) const {
        int fr = fr_, fq = fq_; asm volatile("" : "+v"(fr), "+v"(fq));
        const int col0 = u.pn * BM + wc * 32 + 8 * fq;
        const int mr = ep_modrow(u.pm * BM);
        f32x4 g4[2][2], s4[2][2];
#pragma unroll
        for (int bj = 0; bj < 2; ++bj)
#pragma unroll
            for (int n = 0; n < 2; ++n) { g4[bj][n] = *(const f32x4*)(gate + (size_t)mr * EP_MODLD + col0 + bj * HALF + 4 * n); s4[bj][n] = (f32x4){0.f, 0.f, 0.f, 0.f}; }
        if (xs) {
#pragma unroll
            for (int bj = 0; bj < 2; ++bj)
#pragma unroll
                for (int n = 0; n < 2; ++n) s4[bj][n] = *(const f32x4*)(gam + col0 + bj * HALF + 4 * n) * (*(const f32x4*)(sc + (size_t)mr * EP_MODLD + col0 + bj * HALF + 4 * n) + 1.f);
        }
#pragma unroll
        for (int ai = 0; ai < 2; ++ai)
#pragma unroll
            for (int mp = 0; mp < 2; ++mp) {
                f32x4 b4[2][2][2];
#pragma unroll
                for (int mm = 0; mm < 2; ++mm) { const int r = u.pm * BM + ai * HALF + wr * 64 + (2 * mp + mm) * 16 + fr;
                    const float* bp = (r < EP_NP ? baseP + (size_t)r * EP_D : baseS + (size_t)(r - EP_NP) * EP_D) + col0;
#pragma unroll
                    for (int bj = 0; bj < 2; ++bj)
#pragma unroll
                        for (int n = 0; n < 2; ++n) b4[mm][bj][n] = *(const f32x4*)(bp + bj * HALF + 4 * n); }
                __builtin_amdgcn_sched_barrier(0);
#pragma unroll
                for (int mm = 0; mm < 2; ++mm) { const int m = 2 * mp + mm, r = u.pm * BM + ai * HALF + wr * 64 + m * 16 + fr;
                    float* op = out + (size_t)r * EP_D + col0; float ss = 0.f;
#pragma unroll
                    for (int bj = 0; bj < 2; ++bj) {
                        const f32x4 x0 = b4[mm][bj][0] + g4[bj][0] * acc[ai][bj][m][0], x1 = b4[mm][bj][1] + g4[bj][1] * acc[ai][bj][m][1];
                        *(f32x4*)(op + bj * HALF) = x0; *(f32x4*)(op + bj * HALF + 4) = x1;
                        if (xs) {
                            ss += ((x0[0] * x0[0] + x0[1] * x0[1]) + (x0[2] * x0[2] + x0[3] * x0[3])) + ((x1[0] * x1[0] + x1[1] * x1[1]) + (x1[2] * x1[2] + x1[3] * x1[3]));
                            const f32x4 y0 = x0 * s4[bj][0], y1 = x1 * s4[bj][1];
                            u32x4 w; w.x = cvt_pk_bf16(y0[0], y0[1]); w.y = cvt_pk_bf16(y0[2], y0[3]); w.z = cvt_pk_bf16(y1[0], y1[1]); w.w = cvt_pk_bf16(y1[2], y1[3]);
                            *(u32x4*)(xs + (size_t)r * EP_D + col0 + bj * HALF) = w; } }
                    if (xs) { ss += __shfl_xor(ss, 16); ss += __shfl_xor(ss, 32);
                        if (fq == 0) (void)__hip_atomic_fetch_add(rss + r, ss, __ATOMIC_RELAXED, __HIP_MEMORY_SCOPE_AGENT); } }
                __builtin_amdgcn_sched_barrier(0);
            }
    }
};
struct EpiGateResFin {
    static constexpr bool PERM = true, AFTER_DRAIN = false;
    const float* baseP; float* out; const float* gate; float* rss; const float* fing; unsigned* fcnt;
    __device__ __forceinline__ void operator()(const f32x4 (&acc)[2][2][4][2], const Unit& u, int wr, int wc, int fr_, int fq_) const {
        int fr = fr_, fq = fq_; asm volatile("" : "+v"(fr), "+v"(fq));
        const int col0 = u.pn * BM + wc * 32 + 8 * fq;
        const int mr = ep_modrow(u.pm * BM);
        f32x4 g4[2][2];
#pragma unroll
        for (int bj = 0; bj < 2; ++bj)
#pragma unroll
            for (int n = 0; n < 2; ++n) g4[bj][n] = *(const f32x4*)(gate + (size_t)mr * EP_MODLD + col0 + bj * HALF + 4 * n);
        f32x4 x[2][2][4][2];
#pragma unroll
        for (int ai = 0; ai < 2; ++ai)
#pragma unroll
            for (int mp = 0; mp < 2; ++mp) {
                f32x4 b4[2][2][2];
#pragma unroll
                for (int mm = 0; mm < 2; ++mm) { const int r = u.pm * BM + ai * HALF + wr * 64 + (2 * mp + mm) * 16 + fr;
                    const float* bp = baseP + (size_t)r * EP_D + col0;
#pragma unroll
                    for (int bj = 0; bj < 2; ++bj)
#pragma unroll
                        for (int n = 0; n < 2; ++n) b4[mm][bj][n] = *(const f32x4*)(bp + bj * HALF + 4 * n); }
                __builtin_amdgcn_sched_barrier(0);
#pragma unroll
                for (int mm = 0; mm < 2; ++mm) { const int m = 2 * mp + mm, r = u.pm * BM + ai * HALF + wr * 64 + m * 16 + fr; float ss = 0.f;
#pragma unroll
                    for (int bj = 0; bj < 2; ++bj) {
                        const f32x4 x0 = b4[mm][bj][0] + g4[bj][0] * acc[ai][bj][m][0], x1 = b4[mm][bj][1] + g4[bj][1] * acc[ai][bj][m][1];
                        x[ai][bj][m][0] = x0; x[ai][bj][m][1] = x1;
                        ss += ((x0[0] * x0[0] + x0[1] * x0[1]) + (x0[2] * x0[2] + x0[3] * x0[3])) + ((x1[0] * x1[0] + x1[1] * x1[1]) + (x1[2] * x1[2] + x1[3] * x1[3])); }
                    ss += __shfl_xor(ss, 16); ss += __shfl_xor(ss, 32);
                    if (fq == 0) (void)__hip_atomic_fetch_add(rss + r, ss, __ATOMIC_RELAXED, __HIP_MEMORY_SCOPE_AGENT);
                    __builtin_amdgcn_sched_barrier(0); }
            }
        unsigned* cp = fcnt + 32 * u.pm;
        __syncthreads();
        if (wr == 0 && wc == 0) {
            __builtin_amdgcn_fence(__ATOMIC_RELEASE, "agent");
            if (fr == 0 && fq == 0) (void)__hip_atomic_fetch_add(cp, 1u, __ATOMIC_RELAXED, __HIP_MEMORY_SCOPE_AGENT);
            while (__hip_atomic_load(cp, __ATOMIC_RELAXED, __HIP_MEMORY_SCOPE_AGENT) < 4u) __builtin_amdgcn_s_sleep(2);
            __builtin_amdgcn_fence(__ATOMIC_ACQUIRE, "agent");
        }
        __syncthreads();
        asm volatile("" : "+v"(fr), "+v"(fq));
        const int col1 = u.pn * BM + wc * 32 + 8 * fq;
        f32x4 gm[2][2];
#pragma unroll
        for (int bj = 0; bj < 2; ++bj)
#pragma unroll
            for (int n = 0; n < 2; ++n) gm[bj][n] = *(const f32x4*)(fing + col1 + bj * HALF + 4 * n);
        const int row0 = u.pm * BM + wr * 64 + fr;
        float rs[8];
#pragma unroll
        for (int i = 0; i < 8; ++i) rs[i] = rss[row0 + (i >> 2) * HALF + (i & 3) * 16];
#pragma unroll
        for (int i = 0; i < 8; ++i) rs[i] = __builtin_amdgcn_rsqf(rs[i] * (1.f / EP_D) + EP_EPS);
#pragma unroll
        for (int ai = 0; ai < 2; ++ai)
#pragma unroll
            for (int m = 0; m < 4; ++m) { float* op = out + (size_t)(row0 + ai * HALF + m * 16) * EP_D + col1; const float rstd = rs[ai * 4 + m];
#pragma unroll
                for (int bj = 0; bj < 2; ++bj) { const f32x4 x0 = x[ai][bj][m][0], x1 = x[ai][bj][m][1];
                    *(f32x4*)(op + bj * HALF) = x0 * rstd * gm[bj][0]; *(f32x4*)(op + bj * HALF + 4) = x1 * rstd * gm[bj][1]; } }
    }
};
template <class Epi, class Sched, bool ALIGN_EPI = false, bool SP2 = false>
__device__ __forceinline__ void gemm_phase(PG8_LAS unsigned char* lds, const Gemm g, const Sched& S, const Epi& E, const int tid) {
    const int wid = __builtin_amdgcn_readfirstlane(tid >> 6), lane = tid & 63, wr = wid >> 2, wc = wid & 3, fr = lane & 15, fq = lane >> 4;
    const int K = g.K, nt = K / BK;
    unsigned voffA[2], voffB[2];
#pragma unroll
    for (int i = 0; i < 2; ++i) { int R, C; stage_rc(tid * 16 + i * 8192, R, C); const int Rb = Epi::PERM ? ((R & ~31) + perm32(R & 31)) : R;
        voffA[i] = (unsigned)(R * K + C) * 2u; voffB[i] = (unsigned)(Rb * K + C) * 2u; }
    const size_t kstep = (size_t)(BK * 2);
    const size_t hstep = (size_t)HALF * K * 2;
    const size_t tstep = 2 * hstep;
    const unsigned ldsw = (unsigned)wid * 1024u;
    const int aoff = lds_byte(wr * 64 + fr, fq * 8), boff = lds_byte(wc * 32 + fr, fq * 8);
#define PG8_SA(b, h) (((b) * 2 + (h)) * HTB)
#define PG8_SB(b, h) ((4 + (b) * 2 + (h)) * HTB)
#define PG8_STAGE(bufoff, gbase, voff) do { _Pragma("unroll") for (int _i = 0; _i < 2; ++_i) \
        __builtin_amdgcn_global_load_lds((const unsigned*)((const char*)(gbase) + (voff)[_i]), (PG8_LAS unsigned*)(lds + (bufoff) + ldsw + _i * 8192), 16, 0, 0); } while (0)
#define PG8_LDA(dst, b, h) do { _Pragma("unroll") for (int m = 0; m < 4; ++m) _Pragma("unroll") for (int k = 0; k < 2; ++k) dst[m][k] = *(const PG8_LAS bf16x8*)(lds + PG8_SA(b, h) + aoff + m * 2048 + k * 1024); } while (0)
#define PG8_LDB(dst, b, h) do { _Pragma("unroll") for (int n = 0; n < 2; ++n) _Pragma("unroll") for (int k = 0; k < 2; ++k) dst[n][k] = *(const PG8_LAS bf16x8*)(lds + PG8_SB(b, h) + boff + n * 2048 + k * 1024); } while (0)
#define PG8_MMA(ai, bj, At, Bt) do { __builtin_amdgcn_s_setprio(1); _Pragma("unroll") for (int m = 0; m < 4; ++m) _Pragma("unroll") for (int n = 0; n < 2; ++n) _Pragma("unroll") for (int k = 0; k < 2; ++k) \
        acc[ai][bj][m][n] = __builtin_amdgcn_mfma_f32_16x16x32_bf16(Bt[n][k], At[m][k], acc[ai][bj][m][n], 0, 0, 0); __builtin_amdgcn_s_setprio(0); } while (0)
#define PG8_WAIT_V(n) asm volatile("s_waitcnt vmcnt(" #n ")" ::: "memory")
#define PG8_WAIT_L(n) asm volatile("s_waitcnt lgkmcnt(" #n ")" ::: "memory")
#define PG8_BAR __builtin_amdgcn_s_barrier()
#define PG8_SCHED __builtin_amdgcn_sched_barrier(0)
    Unit cur, nxt; int ui = 0;
    if (!S.next(0, cur)) return;
    f32x4 acc[2][2][4][2];
#pragma unroll
    for (int a = 0; a < 2; ++a)
#pragma unroll
        for (int b = 0; b < 2; ++b)
#pragma unroll
            for (int m = 0; m < 4; ++m)
#pragma unroll
                for (int n = 0; n < 2; ++n) acc[a][b][m][n] = (f32x4){0.f, 0.f, 0.f, 0.f};
    bf16x8 At[4][2], B0[2][2], B1[2][2];
    const char* cA = (const char*)g.A + (size_t)cur.pm * tstep; const char* cB = (const char*)g.Bt + (size_t)cur.pn * tstep;
    S.a_ready(cur);
    if constexpr (SP2) {
        PG8_STAGE(PG8_SB(0, 0), cB, voffB); PG8_STAGE(PG8_SB(0, 1), cB + hstep, voffB); PG8_STAGE(PG8_SA(0, 0), cA, voffA); PG8_STAGE(PG8_SA(0, 1), cA + hstep, voffA);
        if (wr == 1) PG8_BAR;
        PG8_WAIT_V(2); PG8_BAR;
        PG8_STAGE(PG8_SB(1, 0), cB + kstep, voffB); PG8_STAGE(PG8_SA(1, 0), cA + kstep, voffA); PG8_STAGE(PG8_SB(1, 1), cB + hstep + kstep, voffB);
        PG8_WAIT_V(6); PG8_BAR;
    } else {
        PG8_STAGE(PG8_SB(0, 0), cB, voffB); PG8_STAGE(PG8_SA(0, 0), cA, voffA); PG8_STAGE(PG8_SB(0, 1), cB + hstep, voffB); PG8_STAGE(PG8_SA(0, 1), cA + hstep, voffA);
        if (wr == 1) PG8_BAR;
        PG8_WAIT_V(4); PG8_BAR;
        PG8_STAGE(PG8_SB(1, 0), cB + kstep, voffB); PG8_STAGE(PG8_SA(1, 0), cA + kstep, voffA); PG8_STAGE(PG8_SB(1, 1), cB + hstep + kstep, voffB);
        PG8_WAIT_V(6); PG8_BAR;
    }
    for (;;) {
        const bool has_next = S.next(ui + 1, nxt);
        const char* nA = has_next ? (const char*)g.A + (size_t)nxt.pm * tstep : cA; const char* nB = has_next ? (const char*)g.Bt + (size_t)nxt.pn * tstep : cB;
        for (int t = 0; t < nt; t += 2) {
            const bool last = (t == nt - 2);
            const char* a1 = cA + (size_t)(t + 1) * kstep;
            const char* a2 = last ? nA : cA + (size_t)(t + 2) * kstep; const char* b2 = last ? nB : cB + (size_t)(t + 2) * kstep;
            const char* a3 = a2 + kstep; const char* b3 = b2 + kstep;
            if (last && has_next) S.a_ready(nxt);
            if constexpr (SP2) {
            PG8_LDB(B0, 0, 0); PG8_LDB(B1, 0, 1); PG8_SCHED; PG8_LDA(At, 0, 0); PG8_STAGE(PG8_SA(1, 1), a1 + hstep, voffA);
            PG8_WAIT_V(8); PG8_WAIT_L(0); PG8_BAR; PG8_MMA(0, 0, At, B0); PG8_MMA(0, 1, At, B1); PG8_BAR; PG8_SCHED;
            PG8_LDA(At, 0, 1); PG8_STAGE(PG8_SB(0, 0), b2, voffB); PG8_STAGE(PG8_SB(0, 1), b2 + hstep, voffB); PG8_STAGE(PG8_SA(0, 0), a2, voffA);
            PG8_WAIT_V(8); PG8_WAIT_L(0); PG8_BAR; PG8_MMA(1, 0, At, B0); PG8_MMA(1, 1, At, B1); PG8_BAR; PG8_SCHED;
            PG8_LDB(B0, 1, 0); PG8_LDB(B1, 1, 1); PG8_SCHED; PG8_LDA(At, 1, 0); PG8_STAGE(PG8_SA(0, 1), a2 + hstep, voffA);
            PG8_WAIT_V(8); PG8_WAIT_L(0); PG8_BAR; PG8_MMA(0, 0, At, B0); PG8_MMA(0, 1, At, B1); PG8_BAR; PG8_SCHED;
            PG8_LDA(At, 1, 1); PG8_STAGE(PG8_SB(1, 0), b3, voffB); PG8_STAGE(PG8_SB(1, 1), b3 + hstep, voffB); PG8_STAGE(PG8_SA(1, 0), a3, voffA);
            PG8_WAIT_V(8); PG8_WAIT_L(0); PG8_BAR; PG8_MMA(1, 0, At, B0); PG8_MMA(1, 1, At, B1); PG8_BAR; PG8_SCHED;
            } else {
            PG8_LDB(B0, 0, 0); PG8_SCHED; PG8_LDA(At, 0, 0); PG8_STAGE(PG8_SA(1, 1), a1 + hstep, voffA);
            PG8_WAIT_L(8); PG8_BAR; PG8_WAIT_L(0); PG8_MMA(0, 0, At, B0); PG8_BAR; PG8_SCHED;
            PG8_LDB(B1, 0, 1); PG8_STAGE(PG8_SB(0, 0), b2, voffB);
            PG8_BAR; PG8_WAIT_L(0); PG8_MMA(0, 1, At, B1); PG8_BAR;
            PG8_LDA(At, 0, 1); PG8_STAGE(PG8_SA(0, 0), a2, voffA);
            PG8_BAR; PG8_WAIT_L(0); PG8_MMA(1, 0, At, B0); PG8_BAR; PG8_SCHED;
            PG8_STAGE(PG8_SB(0, 1), b2 + hstep, voffB);
            PG8_WAIT_V(6); PG8_BAR; PG8_MMA(1, 1, At, B1); PG8_BAR;
            PG8_LDB(B0, 1, 0); PG8_SCHED; PG8_LDA(At, 1, 0); PG8_STAGE(PG8_SA(0, 1), a2 + hstep, voffA);
            PG8_WAIT_L(8); PG8_BAR; PG8_WAIT_L(0); PG8_MMA(0, 0, At, B0); PG8_BAR; PG8_SCHED;
            PG8_LDB(B1, 1, 1); PG8_STAGE(PG8_SB(1, 0), b3, voffB);
            PG8_BAR; PG8_WAIT_L(0); PG8_MMA(0, 1, At, B1); PG8_BAR;
            PG8_LDA(At, 1, 1); PG8_STAGE(PG8_SA(1, 0), a3, voffA);
            PG8_BAR; PG8_WAIT_L(0); PG8_MMA(1, 0, At, B0); PG8_BAR; PG8_SCHED;
            PG8_STAGE(PG8_SB(1, 1), b3 + hstep, voffB);
            PG8_WAIT_V(6); PG8_BAR; PG8_MMA(1, 1, At, B1); PG8_BAR;
            }
        }
        if constexpr (ALIGN_EPI) { if (wr == 0) PG8_BAR; }
        if constexpr (!Epi::AFTER_DRAIN) { E(acc, cur, wr, wc, fr, fq); S.done(cur); }
        if (!has_next) break;
#pragma unroll
        for (int a = 0; a < 2; ++a)
#pragma unroll
            for (int b = 0; b < 2; ++b)
#pragma unroll
                for (int m = 0; m < 4; ++m)
#pragma unroll
                    for (int n = 0; n < 2; ++n) acc[a][b][m][n] = (f32x4){0.f, 0.f, 0.f, 0.f};
        cur = nxt; cA = nA; cB = nB; ++ui;
        if constexpr (ALIGN_EPI) { if (wr == 1) PG8_BAR; }
    }
    PG8_WAIT_V(0);
    if constexpr (!ALIGN_EPI) { if (wr == 0) PG8_BAR; }
    PG8_BAR;
    if constexpr (Epi::AFTER_DRAIN) { E.fused(acc, cur, wr, wc, fr, fq, lds, wid, lane); S.done(cur); }
#undef PG8_SA
#undef PG8_SB
#undef PG8_STAGE
#undef PG8_LDA
#undef PG8_LDB
#undef PG8_MMA
#undef PG8_WAIT_V
#undef PG8_WAIT_L
#undef PG8_BAR
#undef PG8_SCHED
}
}
#define GAS __attribute__((address_space(1)))
#define LAS __attribute__((address_space(3)))
typedef unsigned short bf16;
typedef unsigned v4u __attribute__((ext_vector_type(4)));
typedef float f32x4 __attribute__((ext_vector_type(4)));
typedef short bf16x8 __attribute__((ext_vector_type(8)));
typedef GAS unsigned gu32;
typedef GAS unsigned long long gu64;
#define RLX_AGENT __ATOMIC_RELAXED, __HIP_MEMORY_SCOPE_AGENT
#define LDS_WAIT() asm volatile("s_waitcnt lgkmcnt(0)" ::: "memory")
#define VM_WAIT() asm volatile("s_waitcnt vmcnt(0)" ::: "memory")
__device__ __forceinline__ unsigned long long rt() { return __builtin_amdgcn_s_memrealtime(); }
typedef float f32x2_ __attribute__((ext_vector_type(2)));
typedef __bf16 bf16x2_ __attribute__((ext_vector_type(2)));
__device__ __forceinline__ unsigned pk2(float lo, float hi) { const f32x2_ v = {lo, hi}; const bf16x2_ b = __builtin_convertvector(v, bf16x2_); return __builtin_bit_cast(unsigned, b); }
__device__ __forceinline__ unsigned f2bf(float f) { return (unsigned)__builtin_bit_cast(unsigned short, (__bf16)f); }

#define XB_TMO      128
#define XB_XCNT(j)  (256  + 64 * (j))
#define XB_XSUB(j)  (1280 + 64 * (j))
#define XB_XGEN(j)  (2304 + 64 * (j))
#define XB_TOP      3328
#define XB_TOPGEN   3392
#define XCD_BAR_WORDS 3456
#define XB_SPIN_CAP (1u << 18)

__device__ __forceinline__ unsigned xb_ld(unsigned* p)              { return __hip_atomic_load(p, __ATOMIC_RELAXED, __HIP_MEMORY_SCOPE_AGENT); }
__device__ __forceinline__ unsigned xb_add(unsigned* p, unsigned v) { return __hip_atomic_fetch_add(p, v, __ATOMIC_RELAXED, __HIP_MEMORY_SCOPE_AGENT); }
__device__ __forceinline__ unsigned xb_xcc_id() { return (unsigned)__builtin_amdgcn_s_getreg((3 << 11) | 20) & 0xFu; }
#define XB_SPIN(cond, bar) do { unsigned _sp = 0; while (cond) { __builtin_amdgcn_s_sleep(1); \
    if ((++_sp & 255u) == 0u) { if (xb_ld(&(bar)[XB_TMO])) break; if (_sp > XB_SPIN_CAP) { atomicAdd(&(bar)[XB_TMO], 1u); break; } } } } while (0)

struct XcdBarrier {
    unsigned* bar; unsigned x;
    volatile LAS unsigned* st;
};

__device__ __forceinline__ XcdBarrier xcd_barrier_post(unsigned* bar, volatile LAS unsigned* st, const int tid_) {
    XcdBarrier b; b.bar = bar; b.x = xb_xcc_id(); b.st = st;
    if (tid_ == 0) (void)xb_add(&bar[XB_XCNT(b.x)], 1u);
    return b;
}
__device__ __forceinline__ void xcd_barrier_complete(unsigned* bar, unsigned x, unsigned& nloc, unsigned& nx) {
    const unsigned G = gridDim.x * gridDim.y * gridDim.z;
    unsigned sum, cnt, mine, sp = 0u;
    for (;;) {
        sum = 0u; cnt = 0u; mine = 0u;
#pragma unroll
        for (unsigned j = 0; j < 16; ++j) { const unsigned c = xb_ld(&bar[XB_XCNT(j)]); sum += c; cnt += (c > 0u) ? 1u : 0u; mine = (j == x) ? c : mine; }
        if (sum == G) break;
        __builtin_amdgcn_s_sleep(1);
        if ((++sp & 255u) == 0u) { if (xb_ld(&bar[XB_TMO])) break; if (sp > XB_SPIN_CAP) { atomicAdd(&bar[XB_TMO], 1u); break; } }
    }
    nloc = mine > 0u ? mine : 1u; nx = cnt > 0u ? cnt : 1u;
}

__device__ __forceinline__ void xcd_barrier(const XcdBarrier& b, const int tid_) {
    asm volatile("s_waitcnt vmcnt(0)" ::: "memory");
    __syncthreads();
    if (tid_ == 0) {
        unsigned* bar = b.bar;
        __builtin_amdgcn_s_waitcnt(0);
        unsigned nloc = b.st[0], nx = b.st[1];
        if (nloc == 0u) { xcd_barrier_complete(bar, b.x, nloc, nx); b.st[0] = nloc; b.st[1] = nx; }
        const unsigned old = xb_add(&bar[XB_XSUB(b.x)], 1u);
        const unsigned gen = old / nloc;
        if (old + 1u == (gen + 1u) * nloc) {
            __builtin_amdgcn_fence(__ATOMIC_RELEASE, "agent");
            asm volatile("s_waitcnt vmcnt(0)" ::: "memory");
            const unsigned og = xb_add(&bar[XB_TOP], 1u);
            const unsigned tg = og / nx;
            if (og + 1u == (tg + 1u) * nx) xb_add(&bar[XB_TOPGEN], 1u);
            else XB_SPIN(xb_ld(&bar[XB_TOPGEN]) == tg, bar);
            __builtin_amdgcn_fence(__ATOMIC_ACQUIRE, "agent");
            xb_add(&bar[XB_XGEN(b.x)], 1u);
            asm volatile("s_waitcnt vmcnt(0)" ::: "memory");
        } else {
            XB_SPIN(xb_ld(&bar[XB_XGEN(b.x)]) == gen, bar);
            __builtin_amdgcn_fence(__ATOMIC_ACQUIRE, "agent");
            asm volatile("s_waitcnt vmcnt(0)" ::: "memory");
        }
    }
    __syncthreads();
}

constexpr int D = 1024, NP = 16384, NS = 512, M = NP + NS, INW = 3072, FF = 4096, TP = 4096;
constexpr int C_AV = 0, C_AG = 256, C_Q = 512, C_F = 1024, C_I = 1536, C_G = 2048, C_QA = 2560, C_KA = 2816, C_VA = 2944;
constexpr int MODR = 132, MODLD = 6144;
constexpr float EPS = 1e-6f;
constexpr size_t O_CONVP = (size_t)M * D, O_CONVS = O_CONVP + 2 * 4 * 30 * 256, O_HGP = O_CONVS + 2 * 128 * 30 * 256, O_HGS = O_HGP + 2 * 4 * 4 * 16384,
                 O_KP = O_HGS + (size_t)2 * 128 * 4 * 16384, O_KS = O_KP + 2 * 4 * 128 * 128, O_VP = O_KS + (size_t)2 * 128 * 128 * 128, O_VS = O_VP + 2 * 4 * 128 * 128,
                 O_END = O_VS + (size_t)2 * 128 * 128 * 128;
constexpr size_t MiB = 1u << 20;
constexpr size_t WS_CTL = 0, CTL_ZERO_BYTES = 1 * MiB, WS_TAB = 1 * MiB, WS_MOD = 2 * MiB, WS_DC = 9 * MiB, WS_WIN = 10 * MiB, WS_WOUT = 22 * MiB, WS_WUP = 26 * MiB, WS_WDN = 42 * MiB,
                 WS_XN = 58 * MiB, WS_HG = 58 * MiB, WS_PROJ = 91 * MiB, WS_MIX = 190 * MiB, WS_HB = 91 * MiB, WS_SHB = 224 * MiB, WS_SHW = 226 * MiB, WS_END = 236 * MiB;
constexpr size_t CTL_RSS = 65536;
constexpr size_t WS_SC = WS_TAB + 65536;
constexpr int CW_BAR = 4096;
constexpr int CW_FIN = 131072;
constexpr int RING_BYTES = 131072, LDSCTL_OFF = RING_BYTES, MISC_OFF = LDSCTL_OFF + 320, LDS_BYTES = 147456;
constexpr int NPH = 21;

typedef float f32x16 __attribute__((ext_vector_type(16)));
typedef unsigned v2u __attribute__((ext_vector_type(2)));
__device__ __forceinline__ float bf2f(unsigned h) { return __builtin_bit_cast(float, h << 16); }
__device__ __forceinline__ float wave_sum(float v) {
#pragma unroll
    for (int o = 1; o < 64; o <<= 1) v += __shfl_xor(v, o);
    return v;
}
__device__ __forceinline__ float wave_max(float v) {
#pragma unroll
    for (int o = 1; o < 64; o <<= 1) v = fmaxf(v, __shfl_xor(v, o));
    return v;
}
__device__ __forceinline__ int modrow(int r) { return r < NP ? (r >> 12) : 4 + ((r - NP) >> 2); }
__device__ __forceinline__ int crow(int r, int hi) { return (r & 3) + 8 * (r >> 2) + 4 * hi; }
__device__ __forceinline__ bf16x8 pk8(float a0, float a1, float a2, float a3, float a4, float a5, float a6, float a7) {
    v4u w; w.x = pk2(a0, a1); w.y = pk2(a2, a3); w.z = pk2(a4, a5); w.w = pk2(a6, a7); return __builtin_bit_cast(bf16x8, w);
}
__device__ __forceinline__ float sigm(float x) { return __builtin_amdgcn_rcpf(1.f + __expf(-x)); }
#define MFMA32(a, b, c) __builtin_amdgcn_mfma_f32_32x32x16_bf16((a), (b), (c), 0, 0, 0)
#define MFMA16(a, b, c) __builtin_amdgcn_mfma_f32_16x16x32_bf16((a), (b), (c), 0, 0, 0)

#ifndef PROBE_SPIN
#define PROBE_SPIN -1
#endif
#ifndef PROBE_N
#define PROBE_N 0
#endif
#define TSEC_BEGIN(k) const unsigned long long ts0_##k = PROBE_SPIN == (k) ? __builtin_amdgcn_s_memrealtime() : 0ull
#define TSEC_END(k) do { if (PROBE_SPIN == (k)) { const unsigned long long ts1_ = __builtin_amdgcn_s_memrealtime(), du_ = (ts1_ - ts0_##k) * PROBE_N; while (__builtin_amdgcn_s_memrealtime() - ts1_ < du_) __builtin_amdgcn_s_sleep(4); } } while (0)
struct Args { const float* in[25]; float* out; unsigned char* ws; int ph_lo, ph_hi; };
struct Ctx {
    LAS unsigned char* lds;
    int tid, lane, wave, G, bid, z;
    float* out; unsigned char* ws;
};

__device__ __forceinline__ void p0_transpose_item(const float* W, int K, int N, bf16* WT, LAS float* scr, int item, int lane) {
    const int nblk = N / 32, kb = item / nblk, nb = item % nblk, k0 = 64 * kb, n0 = 32 * nb;
    float tv[32];
#pragma unroll
    for (int i = 0; i < 32; ++i) { const int kk = 2 * i + (lane >> 5); tv[i] = W[(size_t)(k0 + kk) * N + n0 + (lane & 31)]; }
    __builtin_amdgcn_sched_barrier(0);
#pragma unroll
    for (int i = 0; i < 32; ++i) { const int kk = 2 * i + (lane >> 5); scr[kk * 33 + (lane & 31)] = tv[i]; }
    LDS_WAIT(); asm volatile("" ::: "memory");
    const int c = lane & 7;
#pragma unroll
    for (int j = 0; j < 4; ++j) { const int n = (lane >> 3) + 8 * j; const LAS float* s = scr + (8 * c) * 33 + n;
        v4u o; o.x = pk2(s[0 * 33], s[1 * 33]); o.y = pk2(s[2 * 33], s[3 * 33]); o.z = pk2(s[4 * 33], s[5 * 33]); o.w = pk2(s[6 * 33], s[7 * 33]);
        *(GAS v4u*)(WT + (size_t)(n0 + n) * K + k0 + 8 * c) = o; }
    LDS_WAIT(); asm volatile("" ::: "memory");
}
__device__ __forceinline__ void mod_unit(const Args& A, Ctx& F, int u) {
    const int l = u / 192, n0 = 32 * (u % 192), k0 = 128 * F.wave, c = F.lane & 31, h2 = F.lane >> 5;
    const float* W = A.in[9 + F.z] + (size_t)l * 1024 * 6144;
    f32x16 acc[5];
#pragma unroll
    for (int i = 0; i < 5; ++i)
#pragma unroll
        for (int e = 0; e < 16; ++e) acc[i][e] = 0.f;
    const bf16* SC = (const bf16*)(F.ws + WS_SC);
    LAS unsigned char* WL = F.lds + F.wave * 16384;
    const int lr = F.lane >> 3, lp = F.lane & 7;
    TSEC_BEGIN(42);
    __syncthreads();
#pragma unroll 1
    for (int jh = 0; jh < 2; ++jh) {
        const int kh = k0 + 64 * jh;
        float wv[4][8];
#pragma unroll
        for (int j = 0; j < 4; ++j)
#pragma unroll
            for (int e = 0; e < 8; ++e) wv[j][e] = W[(size_t)(kh + 16 * j + 8 * h2 + e) * 6144 + n0 + c];
        v4u rs[16];
#pragma unroll
        for (int t = 0; t < 16; ++t) rs[t] = *(const v4u*)(SC + (size_t)(4 + 8 * t + lr) * 1024 + kh + 8 * lp);
        bf16x8 ap4[4];
#pragma unroll
        for (int j = 0; j < 4; ++j) { ap4[j] = (bf16x8){0, 0, 0, 0, 0, 0, 0, 0}; if (c < 4) ap4[j] = *(const bf16x8*)(SC + (size_t)c * 1024 + kh + 16 * j + 8 * h2); }
        __builtin_amdgcn_sched_barrier(0);
#pragma unroll
        for (int t = 0; t < 16; ++t) { const int r = 8 * t + lr; *(LAS v4u*)(WL + r * 128 + ((lp ^ (r & 7)) << 4)) = rs[t]; }
        __builtin_amdgcn_sched_barrier(0);
#pragma unroll
        for (int j = 0; j < 4; ++j) {
            const bf16x8 b = pk8(wv[j][0], wv[j][1], wv[j][2], wv[j][3], wv[j][4], wv[j][5], wv[j][6], wv[j][7]);
            acc[0] = MFMA32(ap4[j], b, acc[0]);
#pragma unroll
            for (int rt = 1; rt < 5; ++rt) { const int r = 32 * (rt - 1) + c; const bf16x8 af = *(const LAS bf16x8*)(WL + r * 128 + (((2 * j + h2) ^ (r & 7)) << 4)); acc[rt] = MFMA32(af, b, acc[rt]); }
        }
        __builtin_amdgcn_sched_barrier(0);
    }
    TSEC_END(42);
    TSEC_BEGIN(43);
    LAS float* RED = (LAS float*)F.lds;
#define RED_WR(slot) do { _Pragma("unroll") for (int rt = 0; rt < 5; ++rt) _Pragma("unroll") for (int e = 0; e < 16; ++e) RED[(slot) * 5120 + (rt * 16 + e) * 64 + F.lane] = acc[rt][e]; } while (0)
#define RED_ADD(slot) do { _Pragma("unroll") for (int rt = 0; rt < 5; ++rt) _Pragma("unroll") for (int e = 0; e < 16; ++e) acc[rt][e] += RED[(slot) * 5120 + (rt * 16 + e) * 64 + F.lane]; } while (0)
    __syncthreads();
    if (F.wave >= 4) RED_WR(F.wave - 4);
    __syncthreads();
    if (F.wave < 4) RED_ADD(F.wave);
    __syncthreads();
    if (F.wave == 2 || F.wave == 3) RED_WR(F.wave - 2);
    __syncthreads();
    if (F.wave < 2) RED_ADD(F.wave);
    __syncthreads();
    if (F.wave == 1) RED_WR(0);
    __syncthreads();
    if (F.wave == 0) {
        RED_ADD(0);
        float* mo = (float*)(F.ws + WS_MOD) + (size_t)l * MODR * MODLD;
        const float bias = A.in[10 + F.z][l * MODLD + n0 + c];
#pragma unroll
        for (int rt = 0; rt < 5; ++rt)
#pragma unroll
            for (int e = 0; e < 16; ++e) { const int cr = crow(e, h2), r = rt == 0 ? cr : 4 + 32 * (rt - 1) + cr; if (rt > 0 || cr < 4) mo[(size_t)r * MODLD + n0 + c] = acc[rt][e] + bias; }
    }
#undef RED_WR
#undef RED_ADD
    TSEC_END(43);
}
__device__ __forceinline__ void p0_prologue(const Args& A, Ctx& F) {
    LAS float* scr = (LAS float*)(F.lds + F.wave * 16384);
    const int gw = F.bid * 8 + F.wave, NGW = F.G * 8;
    TSEC_BEGIN(40);
    for (int it = gw; it < 12288; it += NGW) {
        const int l = it / 6144; int r = it % 6144;
        if (r < 1536) { p0_transpose_item(A.in[12 + F.z] + (size_t)l * 1024 * 3072, 1024, 3072, (bf16*)(F.ws + WS_WIN) + (size_t)l * 3072 * 1024, scr, r, F.lane); continue; } r -= 1536;
        if (r < 512) { p0_transpose_item(A.in[20 + F.z] + (size_t)l * 1024 * 1024, 1024, 1024, (bf16*)(F.ws + WS_WOUT) + (size_t)l * 1024 * 1024, scr, r, F.lane); continue; } r -= 512;
        if (r < 2048) { p0_transpose_item(A.in[22 + F.z] + (size_t)l * 1024 * 4096, 1024, 4096, (bf16*)(F.ws + WS_WUP) + (size_t)l * 4096 * 1024, scr, r, F.lane); continue; } r -= 2048;
        p0_transpose_item(A.in[23 + F.z] + (size_t)l * 4096 * 1024, 4096, 1024, (bf16*)(F.ws + WS_WDN) + (size_t)l * 1024 * 4096, scr, r, F.lane);
    }
    TSEC_END(40);
    if (F.bid == 0) {
        float* BT = (float*)(F.ws + WS_TAB); float* LB1 = BT + 1024;
        for (int i = F.tid; i < 129 * 4; i += 512) { const int rel = i >> 2, h = i & 3; int bk = rel;
            if (rel >= 16) { bk = 16 + (int)(logf((float)rel / 16.f) / logf(8.f) * 16.f); bk = bk > 31 ? 31 : bk; }
            BT[i] = A.in[8 + F.z][bk * 4 + h]; }
        { const int i = F.tid; const float a = A.in[17 + F.z][i], b = A.in[17 + F.z][512 + i], mx = fmaxf(a, b), ea = expf(a - mx), eb = expf(b - mx); LB1[i] = eb / (ea + eb); }
    }
    for (int i = F.bid * 512 + F.tid; i < 160 * 128; i += F.G * 512) {
        const int r = i >> 7, k8 = 8 * (i & 127);
        v4u o = {0u, 0u, 0u, 0u};
        if (r < MODR) { const float* cp = (r < 4 ? A.in[6 + F.z] + r * 1024 : A.in[7 + F.z] + (r - 4) * 1024) + k8; const f32x4 c0 = *(const f32x4*)cp, c1 = *(const f32x4*)(cp + 4);
            o.x = pk2(c0.x * sigm(c0.x), c0.y * sigm(c0.y)); o.y = pk2(c0.z * sigm(c0.z), c0.w * sigm(c0.w)); o.z = pk2(c1.x * sigm(c1.x), c1.y * sigm(c1.y)); o.w = pk2(c1.z * sigm(c1.z), c1.w * sigm(c1.w)); }
        *(v4u*)((bf16*)(F.ws + WS_SC) + (size_t)r * 1024 + k8) = o;
    }
}
__device__ __forceinline__ void mod_phase(const Args& A, Ctx& F) {
    TSEC_BEGIN(41);
    if ((F.G & 7) == 0) { const int xg = F.bid & 7, wpx = F.G >> 3; for (int w = F.bid >> 3; w < 48; w += wpx) mod_unit(A, F, xg * 48 + w); }
    else for (int u = F.bid; u < 384; u += F.G) mod_unit(A, F, u);
    TSEC_END(41);
}
__device__ __forceinline__ void norm_phase(const Args& A, Ctx& F, int l, int which) {
    if (l == 0 && which == 0) {
        const float* MODp = (const float*)(F.ws + WS_MOD);
        for (int i = F.bid * 512 + F.tid; i < 3 * 192 * 128; i += F.G * 512) {
            const int f = i / (192 * 128), r = (i >> 7) % 192, k8 = 8 * (i & 127);
            v4u o = {0u, 0u, 0u, 0u};
            if (r < MODR) { const float* sp = MODp + (size_t)(f == 0 ? 0 : 1) * MODR * MODLD + (size_t)r * MODLD + (f == 1 ? 0 : 3 * D) + k8; const f32x4 c0 = *(const f32x4*)sp, c1 = *(const f32x4*)(sp + 4);
                o.x = pk2(c0.x, c0.y); o.y = pk2(c0.z, c0.w); o.z = pk2(c1.x, c1.y); o.w = pk2(c1.z, c1.w); }
            *(v4u*)((bf16*)(F.ws + WS_SHB) + (size_t)(f * 192 + r) * 1024 + k8) = o;
        }
    }
    const int gw = F.bid * 8 + F.wave, NGW = F.G * 8;
    const float* gamma = which == 0 ? A.in[11 + F.z] + l * D : (which == 1 ? A.in[21 + F.z] + l * D : A.in[24 + F.z]);
    const float* mod = (const float*)(F.ws + WS_MOD) + (size_t)l * MODR * MODLD;
    const int shc = which == 0 ? 0 : 3 * D, scc = shc + D;
    const bool from_in = (which == 0 && l == 0);
    bf16* XN = (bf16*)(F.ws + WS_XN);
    f32x4 gm[4];
#pragma unroll
    for (int j = 0; j < 4; ++j) gm[j] = *(const f32x4*)(gamma + 4 * F.lane + 256 * j);
    constexpr int NR = 4;
    for (int m0 = gw; m0 < M; m0 += NR * NGW) {
        f32x4 v[NR][4], msc[NR][4], msh[NR][4];
#pragma unroll
        for (int r = 0; r < NR; ++r) { const int mr_ = m0 + r * NGW, m = mr_ < M ? mr_ : m0;
            const float* xr = from_in ? (m < NP ? A.in[0 + F.z] + (size_t)m * D : A.in[1 + F.z] + (size_t)(m - NP) * D) : F.out + (size_t)m * D;
#pragma unroll
            for (int j = 0; j < 4; ++j) v[r][j] = *(const f32x4*)(xr + 4 * F.lane + 256 * j);
            if (which != 2) { const float* mr = mod + (size_t)modrow(m) * MODLD;
#pragma unroll
                for (int j = 0; j < 4; ++j) { msc[r][j] = *(const f32x4*)(mr + scc + 4 * F.lane + 256 * j); msh[r][j] = *(const f32x4*)(mr + shc + 4 * F.lane + 256 * j); } } }
        __builtin_amdgcn_sched_barrier(0);
        float ssq[NR];
#pragma unroll
        for (int r = 0; r < NR; ++r) { ssq[r] = 0.f;
#pragma unroll
            for (int j = 0; j < 4; ++j) ssq[r] += (v[r][j].x * v[r][j].x + v[r][j].y * v[r][j].y) + (v[r][j].z * v[r][j].z + v[r][j].w * v[r][j].w); }
#pragma unroll
        for (int o = 1; o < 64; o <<= 1) {
            float t_[NR];
#pragma unroll
            for (int r = 0; r < NR; ++r) t_[r] = __shfl_xor(ssq[r], o);
#pragma unroll
            for (int r = 0; r < NR; ++r) ssq[r] += t_[r];
        }
#pragma unroll
        for (int r = 0; r < NR; ++r) {
            const int m = m0 + r * NGW;
            if (m < M) {
                const float rstd = __builtin_amdgcn_rsqf(ssq[r] * (1.f / D) + EPS);
                if (which == 2) {
#pragma unroll
                    for (int j = 0; j < 4; ++j) *(f32x4*)(F.out + (size_t)m * D + 4 * F.lane + 256 * j) = v[r][j] * rstd * gm[j];
                } else {
#pragma unroll
                    for (int j = 0; j < 4; ++j) { const f32x4 y = v[r][j] * rstd * gm[j] * (msc[r][j] + 1.f) + msh[r][j]; v2u w; w.x = pk2(y.x, y.y); w.y = pk2(y.z, y.w);
                        *(v2u*)(XN + (size_t)m * D + 4 * F.lane + 256 * j) = w; }
                }
            }
        }
    }
}

constexpr int RS = 272;
constexpr int RS64 = 144;
struct HgGate { float cl[16], kf[16]; };
__device__ __forceinline__ void hg_gates(const float lb, const LAS unsigned short* rawf  , int d, HgGate& g) {
    float run = 0.f;
#pragma unroll
    for (int j = 0; j < 16; ++j) {
        const float x = bf2f(rawf[j * (RS / 2) + d]);
        const float e = __expf(-x), sg = __builtin_amdgcn_rcpf(1.f + e);
        const float f = lb + (1.f - lb) * sg;
        g.kf[j] = (1.f - lb) * e * sg;
        run += __logf(f); g.cl[j] = run;
    }
}
__device__ __forceinline__ void tile_load(const bf16* g0  , int tid, v4u (&r)[2]) {
#pragma unroll
    for (int i = 0; i < 2; ++i) { const int it = tid + 512 * i; r[i] = *(const v4u*)(g0 + (size_t)(it >> 4) * INW + 8 * (it & 15)); }
    __builtin_amdgcn_sched_barrier(0);
}
__device__ __forceinline__ void tile_store(LAS unsigned char* dst, int tid, const v4u (&r)[2]) {
#pragma unroll
    for (int i = 0; i < 2; ++i) { const int it = tid + 512 * i; *(LAS v4u*)(dst + (it >> 4) * RS + 16 * (it & 15)) = r[i]; }
}
__device__ __forceinline__ void h1_load(Ctx& F, int u, v4u (&rf)[2], v4u (&rv)[2]) {
    const int bh = u >> 6, b = bh >> 2, h = bh & 3, ch = u & 63, m0 = b * TP + ch * 64;
    const bf16* PROJ = (const bf16*)(F.ws + WS_PROJ);
    tile_load(PROJ + (size_t)m0 * INW + C_F + h * 128, F.tid, rf); tile_load(PROJ + (size_t)m0 * INW + C_I + h * 128, F.tid, rv);
}
__device__ __forceinline__ void h1_unit(const Args& A, Ctx& F, int l, int u, const v4u (&rf)[2], const v4u (&rv)[2]) {
    const int bh = u >> 6, b = bh >> 2, h = bh & 3, ch = u & 63, m0 = b * TP + ch * 64;
    const int d = F.tid & 127, sc = F.tid >> 7, c = F.lane & 31, h2 = F.lane >> 5;
    const bf16* PROJ = (const bf16*)(F.ws + WS_PROJ);
    LAS unsigned char* L = F.lds;
    constexpr int OKDT = 0, OVT = 128 * RS64, OTOT = 2 * 128 * RS64, ORF = OTOT + 2048, ORV = ORF + 64 * RS;
    LAS unsigned short* KDT = (LAS unsigned short*)(L + OKDT);
    LAS unsigned short* VT = (LAS unsigned short*)(L + OVT);
    LAS float* TOT = (LAS float*)(L + OTOT);
    const float lb = l == 0 ? 0.f : ((const float*)(F.ws + WS_TAB))[1024 + h * 128 + d];
    __syncthreads();
    tile_store(L + ORF, F.tid, rf); tile_store(L + ORV, F.tid, rv);
    __syncthreads();
    HgGate g; hg_gates(lb, (const LAS unsigned short*)(L + ORF + sc * 16 * RS), d, g);
    TOT[sc * 128 + d] = g.cl[15];
#pragma unroll
    for (int j = 0; j < 16; ++j) VT[d * (RS64 / 2) + sc * 16 + j] = ((const LAS unsigned short*)(L + ORV))[(sc * 16 + j) * (RS / 2) + d];
    __syncthreads();
    float after = 0.f;
#pragma unroll
    for (int i = 1; i < 4; ++i) if (i > sc) after += TOT[i * 128 + d];
    const float tot = g.cl[15];
#pragma unroll
    for (int j = 0; j < 16; ++j) KDT[d * (RS64 / 2) + sc * 16 + j] = (unsigned short)f2bf(g.kf[j] * __expf(after + tot - g.cl[j]));
    if (sc == 0) ((float*)(F.ws + WS_DC))[u * 128 + d] = __expf(after + tot);
    __syncthreads();
    const int vt = F.wave >> 1, dt0 = 2 * (F.wave & 1);
    f32x16 acc0, acc1;
#pragma unroll
    for (int e = 0; e < 16; ++e) { acc0[e] = 0.f; acc1[e] = 0.f; }
#pragma unroll
    for (int ks = 0; ks < 4; ++ks) {
        const bf16x8 a = *(const LAS bf16x8*)(L + OVT + (32 * vt + c) * RS64 + (16 * ks + 8 * h2) * 2);
        const bf16x8 b0 = *(const LAS bf16x8*)(L + OKDT + (32 * dt0 + c) * RS64 + (16 * ks + 8 * h2) * 2);
        const bf16x8 b1 = *(const LAS bf16x8*)(L + OKDT + (32 * dt0 + 32 + c) * RS64 + (16 * ks + 8 * h2) * 2);
        acc0 = MFMA32(a, b0, acc0); acc1 = MFMA32(a, b1, acc1);
    }
    LAS unsigned short* OT = (LAS unsigned short*)(L + ORF);
#pragma unroll
    for (int e = 0; e < 16; ++e) { const int v = 32 * vt + crow(e, h2);
        OT[v * (RS / 2) + 32 * dt0 + c] = (unsigned short)f2bf(acc0[e]); OT[v * (RS / 2) + 32 * dt0 + 32 + c] = (unsigned short)f2bf(acc1[e]); }
    __syncthreads();
    bf16* HG = (bf16*)(F.ws + WS_HG) + (size_t)u * 16384;
#pragma unroll
    for (int i = 0; i < 4; ++i) { const int it = F.tid + 512 * i, v = it >> 4, ch16 = it & 15;
        *(v4u*)(HG + v * 128 + 8 * ch16) = *(const LAS v4u*)(L + ORF + v * RS + 16 * ch16); }
}
__device__ __forceinline__ void h2_scan(const Args& A, Ctx& F, int l) {
    unsigned* HG32 = (unsigned*)(F.ws + WS_HG); const float* DC = (const float*)(F.ws + WS_DC);
    for (int gid = F.bid * 512 + F.tid; gid < 16 * 8192; gid += F.G * 512) {
        const int bh = gid >> 13, e2 = gid & 8191, v = e2 >> 6, d = 2 * (e2 & 63);
        float s0 = 0.f, s1 = 0.f;
        for (int c0 = 0; c0 < 64; c0 += 16) {
            unsigned kc[16]; float d0[16], d1[16];
#pragma unroll
            for (int i = 0; i < 16; ++i) { const int u = bh * 64 + c0 + i; kc[i] = HG32[(size_t)u * 8192 + e2]; d0[i] = DC[u * 128 + d]; d1[i] = DC[u * 128 + d + 1]; }
            __builtin_amdgcn_sched_barrier(0);
#pragma unroll
            for (int i = 0; i < 16; ++i) { const int u = bh * 64 + c0 + i;
                HG32[(size_t)u * 8192 + e2] = pk2(s0, s1);
                s0 = d0[i] * s0 + bf2f(kc[i] & 0xffffu); s1 = d1[i] * s1 + bf2f(kc[i] >> 16); }
        }
        float* o = F.out + O_HGP + ((size_t)l * 16 + bh) * 16384;
        o[d * 128 + v] = s0; o[(d + 1) * 128 + v] = s1;
    }
}
__device__ __forceinline__ void h3_load(Ctx& F, int u, v4u (&rf)[2], v4u (&rq)[2], v4u (&rv)[2]) {
    const int bh = u >> 6, b = bh >> 2, h = bh & 3, ch = u & 63, m0 = b * TP + ch * 64;
    const bf16* PROJ = (const bf16*)(F.ws + WS_PROJ);
    tile_load(PROJ + (size_t)m0 * INW + C_F + h * 128, F.tid, rf); tile_load(PROJ + (size_t)m0 * INW + C_Q + h * 128, F.tid, rq); tile_load(PROJ + (size_t)m0 * INW + C_I + h * 128, F.tid, rv);
}
__device__ __forceinline__ void h3_unit(const Args& A, Ctx& F, int l, int u, const v4u (&rf)[2], const v4u (&rq)[2], const v4u (&rv)[2], int un, v4u (&nf)[2], v4u (&nq)[2], v4u (&nv)[2]) {
    const int bh = u >> 6, b = bh >> 2, h = bh & 3, ch = u & 63, m0 = b * TP + ch * 64;
    const int d = F.tid & 127, sc = F.tid >> 7, c = F.lane & 31, h2 = F.lane >> 5;
    const bf16* PROJ = (const bf16*)(F.ws + WS_PROJ);
    LAS unsigned char* L = F.lds;
    constexpr int OQH = 0, OKH = 64 * RS, OKC = 2 * 64 * RS, OQG = 3 * 64 * RS, OQT = OQG + 48 * RS, OAM = OQT + 64 * RS, OVT = OAM + 64 * RS64, OTOT = OVT + 128 * RS64, OEND = OTOT + 2048;
    static_assert(OEND <= RING_BYTES, "h3 LDS map");
    LAS unsigned short* QH = (LAS unsigned short*)(L + OQH); LAS unsigned short* KH = (LAS unsigned short*)(L + OKH); LAS unsigned short* KC = (LAS unsigned short*)(L + OKC);
    LAS unsigned short* QG = (LAS unsigned short*)(L + OQG); LAS unsigned short* QT = (LAS unsigned short*)(L + OQT); LAS unsigned short* AM = (LAS unsigned short*)(L + OAM);
    LAS unsigned short* VT = (LAS unsigned short*)(L + OVT); LAS float* TOT = (LAS float*)(L + OTOT); LAS float* O32 = (LAS float*)(L + OQH);
    TSEC_BEGIN(30);
    const float lb = l == 0 ? 0.f : ((const float*)(F.ws + WS_TAB))[1024 + h * 128 + d];
    f32x4 gnv[4];
#pragma unroll
    for (int i = 0; i < 4; ++i) gnv[i] = *(const f32x4*)(A.in[18 + F.z] + l * 128 + (F.tid & 7) * 16 + 4 * i);
    __syncthreads();
    tile_store(L + OQH, F.tid, rf); tile_store(L + OKH, F.tid, rq); tile_store(L + OKC, F.tid, rv);
    const bf16* gp = PROJ + (size_t)(m0 + (F.tid >> 3)) * INW + C_G + h * 128 + (F.tid & 7) * 16;
    const v4u g0 = *(const v4u*)gp, g1 = *(const v4u*)(gp + 8);
    const bf16* Srow = (const bf16*)(F.ws + WS_HG) + (size_t)u * 16384 + (size_t)(32 * (F.wave & 3) + c) * 128 + 8 * h2;
    bf16x8 sb[8];
#pragma unroll
    for (int ks = 0; ks < 8; ++ks) sb[ks] = *(const bf16x8*)(Srow + 16 * ks);
    __builtin_amdgcn_sched_barrier(0);
    for (int i = F.tid; i < 64 * RS64 / 4; i += 512) ((LAS unsigned*)AM)[i] = 0u;
    __syncthreads();
    TSEC_END(30);
    TSEC_BEGIN(31);
    HgGate g; hg_gates(lb, (const LAS unsigned short*)(L + OQH + sc * 16 * RS), d, g);
    float q[16];
#pragma unroll
    for (int j = 0; j < 16; ++j) q[j] = bf2f(((const LAS unsigned short*)(L + OKH))[(sc * 16 + j) * (RS / 2) + d]);
    TOT[sc * 128 + d] = g.cl[15];
#pragma unroll
    for (int j = 0; j < 16; ++j) VT[d * (RS64 / 2) + sc * 16 + j] = ((const LAS unsigned short*)(L + OKC))[(sc * 16 + j) * (RS / 2) + d];
    __syncthreads();
    TSEC_END(31);
    TSEC_BEGIN(32);
    const float t0 = TOT[d], t1 = TOT[128 + d], t2 = TOT[256 + d];
    const float rsc = sc == 0 ? 0.f : (sc == 1 ? t0 : (sc == 2 ? t0 + t1 : t0 + t1 + t2));
    const float ers = __expf(rsc), tot = g.cl[15];
    const float ga = sc == 2 ? __expf(t1) : __expf(t1 + t2), gb = __expf(t2);
#pragma unroll
    for (int j = 0; j < 16; ++j) {
        const int row = sc * 16 + j;
        const float qh = q[j] * __expf(g.cl[j]);
        QH[row * (RS / 2) + d] = (unsigned short)f2bf(qh);
        QT[row * (RS / 2) + d] = (unsigned short)f2bf(qh * ers);
        if (sc == 2) QG[j * (RS / 2) + d] = (unsigned short)f2bf(qh * ga);
        if (sc == 3) { QG[(16 + j) * (RS / 2) + d] = (unsigned short)f2bf(qh * ga); QG[(32 + j) * (RS / 2) + d] = (unsigned short)f2bf(qh * gb); }
        KH[row * (RS / 2) + d] = (unsigned short)f2bf(g.kf[j] * __expf(tot - g.cl[j]));
        KC[row * (RS / 2) + d] = (unsigned short)f2bf(g.kf[j] * __expf(-g.cl[j]));
    }
    h3_load(F, un, nf, nq, nv);
    __syncthreads();
    TSEC_END(32);
    TSEC_BEGIN(33);
    {
        const int r16 = F.lane & 15, kq = F.lane >> 4;
        for (int blk = F.wave; blk < 10; blk += 8) {
            int bi, bj, qoff, koff;
            if (blk < 4) { bi = blk; bj = blk; qoff = OQH + 16 * bi * RS; koff = OKC + 16 * bj * RS; }
            else if (blk < 7) { bi = blk - 3; bj = bi - 1; qoff = OQH + 16 * bi * RS; koff = OKH + 16 * bj * RS; }
            else if (blk == 7) { bi = 2; bj = 0; qoff = OQG; koff = OKH; }
            else if (blk == 8) { bi = 3; bj = 0; qoff = OQG + 16 * RS; koff = OKH; }
            else { bi = 3; bj = 1; qoff = OQG + 32 * RS; koff = OKH + 16 * RS; }
            f32x4 a4 = {0.f, 0.f, 0.f, 0.f};
#pragma unroll
            for (int ks = 0; ks < 4; ++ks) {
                const bf16x8 qa = *(const LAS bf16x8*)(L + qoff + r16 * RS + (32 * ks + 8 * kq) * 2);
                const bf16x8 kb = *(const LAS bf16x8*)(L + koff + r16 * RS + (32 * ks + 8 * kq) * 2);
                a4 = MFMA16(qa, kb, a4);
            }
#pragma unroll
            for (int e = 0; e < 4; ++e) { const int t = 4 * kq + e; float val = a4[e]; if (bi == bj && r16 > t) val = 0.f;
                AM[(16 * bi + t) * (RS64 / 2) + 16 * bj + r16] = (unsigned short)f2bf(val); }
        }
    }
    __syncthreads();
    TSEC_END(33);
    TSEC_BEGIN(34);
    const int tt = F.wave >> 2, vt = F.wave & 3;
    f32x16 acc;
#pragma unroll
    for (int e = 0; e < 16; ++e) acc[e] = 0.f;
#pragma unroll
    for (int ks = 0; ks < 4; ++ks) {
        const bf16x8 a = *(const LAS bf16x8*)(L + OAM + (32 * tt + c) * RS64 + (16 * ks + 8 * h2) * 2);
        const bf16x8 bv = *(const LAS bf16x8*)(L + OVT + (32 * vt + c) * RS64 + (16 * ks + 8 * h2) * 2);
        acc = MFMA32(a, bv, acc);
    }
#pragma unroll
    for (int ks = 0; ks < 8; ++ks) {
        const bf16x8 a = *(const LAS bf16x8*)(L + OQT + (32 * tt + c) * RS + (16 * ks + 8 * h2) * 2);
        acc = MFMA32(a, sb[ks], acc);
    }
#pragma unroll
    for (int e = 0; e < 16; ++e) O32[(32 * tt + crow(e, h2)) * 132 + 32 * vt + c] = acc[e];
    __syncthreads();
    TSEC_END(34);
    TSEC_BEGIN(35);
    {
        const int t = F.tid >> 3, vq = F.tid & 7;
        float o[16]; float ss = 0.f;
#pragma unroll
        for (int i = 0; i < 4; ++i) { const f32x4 x = *(const LAS f32x4*)(O32 + t * 132 + vq * 16 + 4 * i); o[4 * i] = x.x; o[4 * i + 1] = x.y; o[4 * i + 2] = x.z; o[4 * i + 3] = x.w;
            ss += (x.x * x.x + x.y * x.y) + (x.z * x.z + x.w * x.w); }
        ss += __shfl_xor(ss, 1); ss += __shfl_xor(ss, 2); ss += __shfl_xor(ss, 4);
        const float rstd = __builtin_amdgcn_rsqf(ss * (1.f / 128.f) + EPS);
        const float gn[16] = {gnv[0].x, gnv[0].y, gnv[0].z, gnv[0].w, gnv[1].x, gnv[1].y, gnv[1].z, gnv[1].w, gnv[2].x, gnv[2].y, gnv[2].z, gnv[2].w, gnv[3].x, gnv[3].y, gnv[3].z, gnv[3].w};
        unsigned gw_[8] = {g0.x, g0.y, g0.z, g0.w, g1.x, g1.y, g1.z, g1.w};
        unsigned ow[8];
#pragma unroll
        for (int i = 0; i < 8; ++i) {
            const float ga0 = bf2f(gw_[i] & 0xffffu), ga1 = bf2f(gw_[i] >> 16);
            const float y0 = o[2 * i] * rstd * gn[2 * i] * (ga0 * sigm(ga0)), y1 = o[2 * i + 1] * rstd * gn[2 * i + 1] * (ga1 * sigm(ga1));
            ow[i] = pk2(y0, y1);
        }
        bf16* op = (bf16*)(F.ws + WS_MIX) + (size_t)(m0 + t) * D + 256 + h * 128 + vq * 16;
        v4u w0 = {ow[0], ow[1], ow[2], ow[3]}, w1 = {ow[4], ow[5], ow[6], ow[7]};
        *(v4u*)op = w0; *(v4u*)(op + 8) = w1;
    }
    TSEC_END(35);
}

__device__ __forceinline__ void conv_tail(const Args& A, Ctx& F, int l, f32x4 acc, bf16* orow) {
    const float mean = wave_sum((acc.x + acc.y) + (acc.z + acc.w)) * (1.f / 256.f);
    const f32x4 dv = acc - mean;
    const float rstd = __builtin_amdgcn_rsqf(wave_sum((dv.x * dv.x + dv.y * dv.y) + (dv.z * dv.z + dv.w * dv.w)) * (1.f / 256.f) + EPS);
    const f32x4 lg = *(const f32x4*)(A.in[15 + F.z] + l * 256 + 4 * F.lane), lb = *(const f32x4*)(A.in[16 + F.z] + l * 256 + 4 * F.lane);
    const f32x4 y = dv * rstd * lg + lb;
    v2u w; w.x = pk2(y.x * sigm(y.x), y.y * sigm(y.y)); w.y = pk2(y.z * sigm(y.z), y.w * sigm(y.w));
    *(v2u*)(orow + 4 * F.lane) = w;
}
__device__ __forceinline__ void conv_unit(const Args& A, Ctx& F, int l, int u) {
    const int b = u >> 6, tile = u & 63, t0 = tile * 64;
    const bf16* PROJ = (const bf16*)(F.ws + WS_PROJ);
    LAS float* AL = (LAS float*)F.lds;
    v4u sv[6], sg[6];
#pragma unroll
    for (int i = 0; i < 6; ++i) { const int it = F.tid + 512 * i, row = it >> 5, cg = it & 31, t = t0 - 30 + row;
        sv[i] = (v4u){0u, 0u, 0u, 0u}; sg[i] = sv[i];
        if (it < 94 * 32 && t >= 0) { const bf16* p = PROJ + (size_t)(b * TP + t) * INW + 8 * cg; sv[i] = *(const v4u*)(p + C_AV); sg[i] = *(const v4u*)(p + C_AG); } }
    __builtin_amdgcn_sched_barrier(0);
    __syncthreads();
#pragma unroll
    for (int i = 0; i < 6; ++i) { const int it = F.tid + 512 * i, row = it >> 5, cg = it & 31;
        if (it < 94 * 32) {
            const v4u vv = sv[i], gg = sg[i]; f32x4 a0, a1;
            a0.x = bf2f(vv.x & 0xffffu) * sigm(bf2f(gg.x & 0xffffu)); a0.y = bf2f(vv.x >> 16) * sigm(bf2f(gg.x >> 16));
            a0.z = bf2f(vv.y & 0xffffu) * sigm(bf2f(gg.y & 0xffffu)); a0.w = bf2f(vv.y >> 16) * sigm(bf2f(gg.y >> 16));
            a1.x = bf2f(vv.z & 0xffffu) * sigm(bf2f(gg.z & 0xffffu)); a1.y = bf2f(vv.z >> 16) * sigm(bf2f(gg.z >> 16));
            a1.z = bf2f(vv.w & 0xffffu) * sigm(bf2f(gg.w & 0xffffu)); a1.w = bf2f(vv.w >> 16) * sigm(bf2f(gg.w >> 16));
            *(LAS f32x4*)(AL + row * 256 + 8 * cg) = a0; *(LAS f32x4*)(AL + row * 256 + 8 * cg + 4) = a1; } }
    const f32x4 cb = *(const f32x4*)(A.in[14 + F.z] + l * 256 + 4 * F.lane);
    __syncthreads();
    typedef float f32x2c __attribute__((ext_vector_type(2)));
    f32x4 acc[8];
#pragma unroll
    for (int hc = 0; hc < 2; ++hc) {
        __builtin_amdgcn_sched_barrier(0);
        f32x2c cw[31], a2[8];
#pragma unroll
        for (int j = 0; j < 31; ++j) cw[j] = *(const f32x2c*)(A.in[13 + F.z] + (size_t)(l * 31 + j) * 256 + 4 * F.lane + 2 * hc);
#pragma unroll
        for (int i = 0; i < 8; ++i) a2[i] = (f32x2c){hc ? cb.z : cb.x, hc ? cb.w : cb.y};
        __builtin_amdgcn_sched_barrier(0);
#pragma unroll
        for (int r = 0; r < 38; ++r) {
            const f32x2c row = *(const LAS f32x2c*)(AL + (8 * F.wave + r) * 256 + 4 * F.lane + 2 * hc);
#pragma unroll
            for (int i = 0; i < 8; ++i) if (r - i >= 0 && r - i <= 30) a2[i] += cw[r - i] * row;
            if ((r & 7) == 7) __builtin_amdgcn_sched_barrier(0);
        }
#pragma unroll
        for (int i = 0; i < 8; ++i) { if (hc) { acc[i].z = a2[i].x; acc[i].w = a2[i].y; } else { acc[i].x = a2[i].x; acc[i].y = a2[i].y; } }
    }
    {
        float s1[8], s2[8];
#pragma unroll
        for (int i = 0; i < 8; ++i) { s1[i] = (acc[i].x + acc[i].y) + (acc[i].z + acc[i].w); s2[i] = (acc[i].x * acc[i].x + acc[i].y * acc[i].y) + (acc[i].z * acc[i].z + acc[i].w * acc[i].w); }
#pragma unroll
        for (int o = 1; o < 64; o <<= 1) {
            float t1[8], t2[8];
#pragma unroll
            for (int i = 0; i < 8; ++i) { t1[i] = __shfl_xor(s1[i], o); t2[i] = __shfl_xor(s2[i], o); }
#pragma unroll
            for (int i = 0; i < 8; ++i) { s1[i] += t1[i]; s2[i] += t2[i]; }
        }
        const f32x4 lg = *(const f32x4*)(A.in[15 + F.z] + l * 256 + 4 * F.lane), lb = *(const f32x4*)(A.in[16 + F.z] + l * 256 + 4 * F.lane);
#pragma unroll
        for (int i = 0; i < 8; ++i) {
            const float mean = s1[i] * (1.f / 256.f), var = fmaxf(s2[i] * (1.f / 256.f) - mean * mean, 0.f);
            const float rstd = __builtin_amdgcn_rsqf(var + EPS);
            const f32x4 y = (acc[i] - mean) * rstd * lg + lb;
            v2u w; w.x = pk2(y.x * sigm(y.x), y.y * sigm(y.y)); w.y = pk2(y.z * sigm(y.z), y.w * sigm(y.w));
            *(v2u*)((bf16*)(F.ws + WS_MIX) + (size_t)(b * TP + t0 + 8 * F.wave + i) * D + 4 * F.lane) = w;
        }
    }
    if (tile == 63) {
        float* o = F.out + O_CONVP + (size_t)(l * 4 + b) * 30 * 256;
        for (int i = F.tid; i < 30 * 256; i += 512) o[i] = AL[64 * 256 + i];
    }
}
constexpr int VS = 528;
__device__ __forceinline__ void attn_unit(const Args& A, Ctx& F, int l, int u) {
    const int b = u >> 6, blk = (u >> 1) & 31, kvh = u & 1;
    const int c = F.lane & 31, h2 = F.lane >> 5;
    const bf16* PROJ = (const bf16*)(F.ws + WS_PROJ);
    LAS unsigned char* L = F.lds;
    LAS unsigned short* VTt = (LAS unsigned short*)L;
    LAS float* BTl = (LAS float*)(L + 64 * VS);
    const int tok0 = b * TP + (blk - 1) * 128;
    const int g = F.wave >> 2, qs = F.wave & 3, hq = 2 * kvh + g;
    const int mq = b * TP + blk * 128 + 32 * qs + c;
    bf16x8 bq[4];
#pragma unroll
    for (int ks = 0; ks < 4; ++ks) bq[ks] = *(const bf16x8*)(PROJ + (size_t)mq * INW + C_QA + hq * 64 + 16 * ks + 8 * h2);
#define ATTN_LOADK(dst, j) do { const int kidx_ = 32 * (qs + (j)) + c; const bool ex_ = (blk > 0 || kidx_ >= 128); \
        _Pragma("unroll") for (int ks = 0; ks < 4; ++ks) { dst[ks] = (bf16x8){0, 0, 0, 0, 0, 0, 0, 0}; \
            if (ex_) dst[ks] = *(const bf16x8*)(PROJ + (size_t)(tok0 + kidx_) * INW + C_KA + kvh * 64 + 16 * ks + 8 * h2); } } while (0)
    bf16x8 ak0[4], ak1[4];
    ATTN_LOADK(ak0, 0); ATTN_LOADK(ak1, 1);
    const float sink = A.in[19 + F.z][l * 4 + hq];
    float btv = 0.f; { const int gg = F.tid / 224, ix = F.tid % 224 - 32; if (F.tid < 448 && ix >= 0 && ix <= 128) btv = ((const float*)(F.ws + WS_TAB))[(128 - ix) * 4 + 2 * kvh + gg]; }
    __builtin_amdgcn_sched_barrier(0);
    __syncthreads();
    if (F.tid < 448) BTl[F.tid] = btv;
    f32x16 S[5];
#pragma unroll
    for (int j = 0; j < 5; ++j)
#pragma unroll
        for (int e = 0; e < 16; ++e) S[j][e] = 0.f;
    bf16x8 ak2[4], ak3[4];
    ATTN_LOADK(ak2, 2); ATTN_LOADK(ak3, 3);
    __builtin_amdgcn_sched_barrier(0);
#pragma unroll
    for (int ks = 0; ks < 4; ++ks) { S[0] = MFMA32(ak0[ks], bq[ks], S[0]); S[1] = MFMA32(ak1[ks], bq[ks], S[1]); }
    ATTN_LOADK(ak0, 4);
#pragma unroll
    for (int ks = 0; ks < 4; ++ks) { S[2] = MFMA32(ak2[ks], bq[ks], S[2]); S[3] = MFMA32(ak3[ks], bq[ks], S[3]); }
#pragma unroll
    for (int ks = 0; ks < 4; ++ks) S[4] = MFMA32(ak0[ks], bq[ks], S[4]);
#undef ATTN_LOADK
    v4u vst[4];
#pragma unroll
    for (int i = 0; i < 4; ++i) { const int it = F.tid + 512 * i, pos = it >> 3, pl = pos & 31, kidx = (pos & ~31) | (pl & 0x13) | ((pl & 4) << 1) | ((pl & 8) >> 1), chn = it & 7; vst[i] = (v4u){0u, 0u, 0u, 0u};
        if (blk > 0 || kidx >= 128) vst[i] = *(const v4u*)(PROJ + (size_t)(tok0 + kidx) * INW + C_VA + kvh * 64 + 8 * chn); }
    __builtin_amdgcn_sched_barrier(0);
    __syncthreads();
    float mx = -INFINITY;
    const LAS float* trp = BTl + g * 224 + 32 + 4 * h2 - c;
#pragma unroll
    for (int j = 0; j < 5; ++j) {
        float bia[16];
#pragma unroll
        for (int e = 0; e < 16; ++e) bia[e] = trp[32 * j + 8 * (e >> 2) + (e & 3)];
#pragma unroll
        for (int e = 0; e < 16; e += 4) asm volatile("" : "+v"(bia[e]), "+v"(bia[e + 1]), "+v"(bia[e + 2]), "+v"(bia[e + 3]));
#pragma unroll
        for (int e = 0; e < 16; ++e) {
            const int cr = crow(e, h2), rel = 128 + c - 32 * j - cr, kidx = 32 * (qs + j) + cr;
            const bool ok = rel >= 0 && rel <= 128 && (blk > 0 || kidx >= 128);
            const float s = ok ? S[j][e] * 0.125f + bia[e] : -INFINITY;
            S[j][e] = s; mx = fmaxf(mx, s);
        }
        __builtin_amdgcn_sched_barrier(0);
    }
    mx = fmaxf(mx, __shfl_xor(mx, 32)); mx = fmaxf(mx, sink);
    float sum = 0.f;
#pragma unroll
    for (int j = 0; j < 5; ++j)
#pragma unroll
        for (int e = 0; e < 16; ++e) { const float p = __expf(S[j][e] - mx); S[j][e] = p; sum += p; if (e == 15) __builtin_amdgcn_sched_barrier(0); }
    sum += __shfl_xor(sum, 32);
    const float inv = 1.f / (sum + __expf(sink - mx));
#pragma unroll
    for (int i = 0; i < 4; ++i) { const int it = F.tid + 512 * i, pos = it >> 3, chn = it & 7;
        unsigned w0 = vst[i].x, w1 = vst[i].y, w2 = vst[i].z, w3 = vst[i].w;
        if (chn & 1) { const unsigned t0 = __builtin_amdgcn_alignbit(w1, w0, 16), t1 = __builtin_amdgcn_alignbit(w2, w1, 16), t2 = __builtin_amdgcn_alignbit(w3, w2, 16), t3 = __builtin_amdgcn_alignbit(w0, w3, 16); w0 = t0; w1 = t1; w2 = t2; w3 = t3; }
        if (chn & 2) { const unsigned t0 = w1, t1 = w2, t2 = w3, t3 = w0; w0 = t0; w1 = t1; w2 = t2; w3 = t3; }
        if (chn & 4) { const unsigned t0 = w2, t1 = w3, t2 = w0, t3 = w1; w0 = t0; w1 = t1; w2 = t2; w3 = t3; }
        const unsigned w[4] = {w0, w1, w2, w3};
#pragma unroll
        for (int e = 0; e < 8; ++e) VTt[(8 * chn + ((e + chn) & 7)) * (VS / 2) + pos] = (unsigned short)((e & 1) ? (w[e >> 1] >> 16) : (w[e >> 1] & 0xffffu)); }
    __syncthreads();
    f32x16 O0, O1;
#pragma unroll
    for (int e = 0; e < 16; ++e) { O0[e] = 0.f; O1[e] = 0.f; }
#pragma unroll
    for (int j = 0; j < 5; ++j)
#pragma unroll
        for (int s2 = 0; s2 < 2; ++s2) {
            const bf16x8 pb = pk8(S[j][8 * s2], S[j][8 * s2 + 1], S[j][8 * s2 + 2], S[j][8 * s2 + 3], S[j][8 * s2 + 4], S[j][8 * s2 + 5], S[j][8 * s2 + 6], S[j][8 * s2 + 7]);
            const int slot = 32 * (qs + j) + 16 * s2 + 8 * h2;
            const bf16x8 av0 = *(const LAS bf16x8*)(L + c * VS + slot * 2), av1 = *(const LAS bf16x8*)(L + (32 + c) * VS + slot * 2);
            O0 = MFMA32(av0, pb, O0); O1 = MFMA32(av1, pb, O1);
            __builtin_amdgcn_sched_barrier(0);
        }
    bf16* op = (bf16*)(F.ws + WS_MIX) + (size_t)mq * D + 768 + hq * 64;
#pragma unroll
    for (int gq = 0; gq < 4; ++gq) {
        v2u w0, w1;
        w0.x = pk2(O0[4 * gq] * inv, O0[4 * gq + 1] * inv); w0.y = pk2(O0[4 * gq + 2] * inv, O0[4 * gq + 3] * inv);
        w1.x = pk2(O1[4 * gq] * inv, O1[4 * gq + 1] * inv); w1.y = pk2(O1[4 * gq + 2] * inv, O1[4 * gq + 3] * inv);
        *(v2u*)(op + 8 * gq + 4 * h2) = w0; *(v2u*)(op + 32 + 8 * gq + 4 * h2) = w1;
    }
    if (blk == 31) {
        v4u kk[2], vv[2];
#pragma unroll
        for (int i = 0; i < 2; ++i) { const int it = F.tid + 512 * i, j = it >> 3, c8 = 8 * (it & 7);
            const bf16* p = PROJ + (size_t)(b * TP + 3968 + j) * INW + kvh * 64 + c8; kk[i] = *(const v4u*)(p + C_KA); vv[i] = *(const v4u*)(p + C_VA); }
        __builtin_amdgcn_sched_barrier(0);
#pragma unroll
        for (int i = 0; i < 2; ++i) { const int it = F.tid + 512 * i, j = it >> 3, c8 = 8 * (it & 7);
            const size_t oi = (((size_t)(l * 4 + b) * 128 + j) * 2 + kvh) * 64 + c8;
            const unsigned kw[4] = {kk[i].x, kk[i].y, kk[i].z, kk[i].w}, vw[4] = {vv[i].x, vv[i].y, vv[i].z, vv[i].w};
#pragma unroll
            for (int h4 = 0; h4 < 2; ++h4) {
                f32x4 ko, vo;
                ko.x = bf2f(kw[2 * h4] & 0xffffu); ko.y = bf2f(kw[2 * h4] >> 16); ko.z = bf2f(kw[2 * h4 + 1] & 0xffffu); ko.w = bf2f(kw[2 * h4 + 1] >> 16);
                vo.x = bf2f(vw[2 * h4] & 0xffffu); vo.y = bf2f(vw[2 * h4] >> 16); vo.z = bf2f(vw[2 * h4 + 1] & 0xffffu); vo.w = bf2f(vw[2 * h4 + 1] >> 16);
                *(f32x4*)(F.out + O_KP + oi + 4 * h4) = ko; *(f32x4*)(F.out + O_VP + oi + 4 * h4) = vo; } }
    }
}

__device__ __forceinline__ void samp_b_unit(const Args& A, Ctx& F, int l, int u) {
    const bf16* PROJ = (const bf16*)(F.ws + WS_PROJ);
    const int bs = u >> 1, hf = u & 1, m0 = NP + 4 * bs;
    LAS unsigned char* L = F.lds;
    constexpr int OFL = 0, OCV = 34 * 1024, OKL = OCV + 4096, OVTL = OKL + 144 * RS64, OQL = OVTL + 64 * 336, OSL = 0, OPL = 16 * 592, OENDB = OQL + 16 * RS64;
    static_assert(OENDB <= RING_BYTES && OPL + 16 * 336 <= OCV, "samp_b LDS map");
    LAS float* FL = (LAS float*)(L + OFL); LAS float* CV = (LAS float*)(L + OCV);
    const float* ck = A.in[4 + F.z] + ((size_t)l * 128 + bs) * 128 * 128 + hf * 64;
    const float* cv = A.in[5 + F.z] + ((size_t)l * 128 + bs) * 128 * 128 + hf * 64;
    float* okp = F.out + O_KS + ((size_t)l * 128 + bs) * 128 * 128 + hf * 64; float* ovp = F.out + O_VS + ((size_t)l * 128 + bs) * 128 * 128 + hf * 64;
    const float* cc = A.in[2 + F.z] + ((size_t)l * 128 + bs) * 30 * 256;
    f32x4 fr4[4];
#pragma unroll
    for (int i = 0; i < 4; ++i) { const int it = F.tid + 512 * i; fr4[i] = it < 30 * 64 ? *(const f32x4*)(cc + 4 * it) : (f32x4){0.f, 0.f, 0.f, 0.f}; }
    f32x4 kr[2][2], vr[2][2];
#pragma unroll
    for (int i = 0; i < 2; ++i) { const int it = F.tid + 512 * i, j = it >> 3, c8 = 8 * (it & 7);
        kr[i][0] = *(const f32x4*)(ck + j * 128 + c8); kr[i][1] = *(const f32x4*)(ck + j * 128 + c8 + 4); vr[i][0] = *(const f32x4*)(cv + j * 128 + c8); vr[i][1] = *(const f32x4*)(cv + j * 128 + c8 + 4); }
    const int nt_ = F.tid >> 8, nch = F.tid & 255;
    const bf16* pa0 = PROJ + (size_t)(m0 + nt_) * INW + nch; const bf16* pa1 = PROJ + (size_t)(m0 + 2 + nt_) * INW + nch;
    const unsigned short av0 = pa0[C_AV], ag0 = pa0[C_AG], av1 = pa1[C_AV], ag1 = pa1[C_AG];
    unsigned short kb = 0, vb = 0;
    if (F.tid < 256) { const int t = F.tid >> 6, r = F.tid & 63; const bf16* p = PROJ + (size_t)(m0 + t) * INW + hf * 64 + r; kb = p[C_KA]; vb = p[C_VA]; }
    unsigned short qv[2];
#pragma unroll
    for (int i = 0; i < 2; ++i) { const int ix = F.tid + 512 * i, row = ix >> 6, dd = ix & 63; qv[i] = PROJ[(size_t)(m0 + (row >> 2)) * INW + C_QA + (row & 3) * 64 + dd]; }
    const float sinkv = A.in[19 + F.z][l * 4 + 2 * hf + (F.wave & 1)];
    const float cbias = A.in[14 + F.z][l * 256 + nch];
    __builtin_amdgcn_sched_barrier(0);
    __syncthreads();
#pragma unroll
    for (int i = 0; i < 4; ++i) { const int it = F.tid + 512 * i; if (it < 30 * 64) *(LAS f32x4*)(FL + 4 * it) = fr4[i]; }
    FL[(30 + nt_) * 256 + nch] = bf2f(av0) * sigm(bf2f(ag0)); FL[(32 + nt_) * 256 + nch] = bf2f(av1) * sigm(bf2f(ag1));
#pragma unroll
    for (int i = 0; i < 2; ++i) { const int it = F.tid + 512 * i, j = it >> 3, c8 = 8 * (it & 7);
        const f32x4 k0 = kr[i][0], k1 = kr[i][1], v0 = vr[i][0], v1 = vr[i][1];
        if (j >= 4) { *(f32x4*)(okp + (j - 4) * 128 + c8) = k0; *(f32x4*)(okp + (j - 4) * 128 + c8 + 4) = k1; *(f32x4*)(ovp + (j - 4) * 128 + c8) = v0; *(f32x4*)(ovp + (j - 4) * 128 + c8 + 4) = v1; }
        v4u kw; kw.x = pk2(k0.x, k0.y); kw.y = pk2(k0.z, k0.w); kw.z = pk2(k1.x, k1.y); kw.w = pk2(k1.z, k1.w);
        *(LAS v4u*)(L + OKL + j * RS64 + 2 * c8) = kw;
        const float vv[8] = {v0.x, v0.y, v0.z, v0.w, v1.x, v1.y, v1.z, v1.w};
#pragma unroll
        for (int e = 0; e < 8; ++e) *(LAS unsigned short*)(L + OVTL + (c8 + e) * 336 + 2 * j) = (unsigned short)f2bf(vv[e]); }
    if (F.tid < 256) { const int t = F.tid >> 6, r = F.tid & 63;
        *(LAS unsigned short*)(L + OKL + (128 + t) * RS64 + 2 * r) = kb; *(LAS unsigned short*)(L + OVTL + r * 336 + 2 * (128 + t)) = vb;
        okp[(124 + t) * 128 + r] = bf2f(kb); ovp[(124 + t) * 128 + r] = bf2f(vb); }
    for (int i = F.tid; i < 12 * 64; i += 512) *(LAS unsigned short*)(L + OKL + (132 + (i >> 6)) * RS64 + 2 * (i & 63)) = 0;
    for (int i = F.tid; i < 64 * 28; i += 512) *(LAS unsigned short*)(L + OVTL + (i / 28) * 336 + 2 * (132 + i % 28)) = 0;
#pragma unroll
    for (int i = 0; i < 2; ++i) { const int ix = F.tid + 512 * i, row = ix >> 6, dd = ix & 63; *(LAS unsigned short*)(L + OQL + row * RS64 + 2 * dd) = qv[i]; }
    __syncthreads();
    {
        const int ch = nch, tok = 2 * hf + nt_;
        float a0 = cbias;
#pragma unroll
        for (int j = 0; j < 31; ++j) a0 += A.in[13 + F.z][(size_t)(l * 31 + j) * 256 + ch] * FL[(tok + j) * 256 + ch];
        CV[tok * 256 + ch] = a0;
    }
    { float* o = F.out + O_CONVS + ((size_t)l * 128 + bs) * 30 * 256 + hf * 15 * 256; for (int i = F.tid; i < 15 * 64; i += 512) *(f32x4*)(o + 4 * i) = *(const LAS f32x4*)(FL + (4 + 15 * hf) * 256 + 4 * i); }
    __syncthreads();
    if (F.wave < 2) { const int tok = 2 * hf + F.wave; const f32x4 acc = *(const LAS f32x4*)(CV + tok * 256 + 4 * F.lane); conv_tail(A, F, l, acc, (bf16*)(F.ws + WS_MIX) + (size_t)(m0 + tok) * D); }
    const int r16 = F.lane & 15, q4 = F.lane >> 4;
    const float* BT = (const float*)(F.ws + WS_TAB);
    for (int kt = F.wave; kt < 9; kt += 8) {
        f32x4 s0 = {0.f, 0.f, 0.f, 0.f};
#pragma unroll
        for (int ks = 0; ks < 2; ++ks) {
            const bf16x8 qa = *(const LAS bf16x8*)(L + OQL + r16 * RS64 + (32 * ks + 8 * q4) * 2);
            const bf16x8 k0 = *(const LAS bf16x8*)(L + OKL + (16 * kt + r16) * RS64 + (32 * ks + 8 * q4) * 2);
            s0 = MFMA16(qa, k0, s0);
        }
        const int key = 16 * kt + r16, t = q4; const bool ok = key >= t && key <= 128 + t;
#pragma unroll
        for (int g = 0; g < 2; ++g) { const int e = 2 * hf + g; const float sv = (hf ? (g ? s0[3] : s0[2]) : (g ? s0[1] : s0[0])) * 0.125f;
            const int rel_ = 128 + t - key; float bia = BT[(rel_ < 0 ? 0 : (rel_ > 128 ? 128 : rel_)) * 4 + e]; asm volatile("" : "+v"(bia));
            ((LAS float*)(L + OSL))[(4 * t + e) * 148 + key] = ok ? sv + bia : -INFINITY; }
    }
    __syncthreads();
    {
        const int row = 4 * (F.wave >> 1) + 2 * hf + (F.wave & 1);
        const LAS float* sl = (const LAS float*)(L + OSL) + row * 148;
        float sc[3];
#pragma unroll
        for (int i = 0; i < 3; ++i) { const int j = F.lane + 64 * i; sc[i] = j < 144 ? sl[j] : -INFINITY; }
        const float mx = fmaxf(wave_max(fmaxf(fmaxf(sc[0], sc[1]), sc[2])), sinkv);
        float p[3], ps = 0.f;
#pragma unroll
        for (int i = 0; i < 3; ++i) { p[i] = __expf(sc[i] - mx); ps += p[i]; }
        const float inv = __builtin_amdgcn_rcpf(wave_sum(ps) + __expf(sinkv - mx));
#pragma unroll
        for (int i = 0; i < 3; ++i) { const int j = F.lane + 64 * i; if (j < 160) *(LAS unsigned short*)(L + OPL + row * 336 + 2 * j) = (unsigned short)f2bf(p[i] * inv); }
    }
    __syncthreads();
    if (F.wave < 4) {
        const int dt = F.wave;
        f32x4 o4 = {0.f, 0.f, 0.f, 0.f};
#pragma unroll
        for (int ks = 0; ks < 5; ++ks) {
            const bf16x8 pa = *(const LAS bf16x8*)(L + OPL + r16 * 336 + (32 * ks + 8 * q4) * 2);
            const bf16x8 vb8 = *(const LAS bf16x8*)(L + OVTL + (16 * dt + r16) * 336 + (32 * ks + 8 * q4) * 2);
            o4 = MFMA16(pa, vb8, o4);
        }
#pragma unroll
        for (int g = 0; g < 2; ++g) { const int e = 2 * hf + g; const float ov = hf ? (g ? o4[3] : o4[2]) : (g ? o4[1] : o4[0]);
            ((bf16*)(F.ws + WS_MIX))[(size_t)(m0 + q4) * D + 768 + e * 64 + 16 * dt + r16] = (bf16)f2bf(ov); }
    }
}
__device__ __forceinline__ void samp_hg_load(const Args& A, Ctx& F, int l, int u, float (&S)[32]) {
    const int bs = u >> 2, h = u & 3, v = F.tid & 127, dq = F.tid >> 7;
    const float* S0 = A.in[3 + F.z] + (((size_t)l * 128 + bs) * 4 + h) * 16384 + (size_t)(dq * 32) * 128 + v;
#pragma unroll
    for (int i = 0; i < 32; ++i) S[i] = S0[i * 128];
    __builtin_amdgcn_sched_barrier(0);
}
__device__ __forceinline__ void samp_hg_unit(const Args& A, Ctx& F, int l, int u, float (&S)[32]) {
    const int bs = u >> 2, h = u & 3, m0 = NP + 4 * bs;
    const bf16* PROJ = (const bf16*)(F.ws + WS_PROJ);
    LAS float* FT = (LAS float*)F.lds;
    LAS float* KT = FT + 512;
    LAS float* QT = KT + 512;
    LAS float* VV = QT + 512;
    LAS float* OP = VV + 512;
    LAS float* SS = OP + 2048;
    const int t_ = F.tid >> 7, d_ = F.tid & 127; const bf16* p_ = PROJ + (size_t)(m0 + t_) * INW + h * 128 + d_;
    const float lb_ = l == 0 ? 0.f : ((const float*)(F.ws + WS_TAB))[1024 + h * 128 + d_];
    const float xf_ = bf2f(p_[C_F]), xq_ = bf2f(p_[C_Q]), xi_ = bf2f(p_[C_I]), gg_ = bf2f(p_[C_G]), gn_ = A.in[18 + F.z][l * 128 + d_];
    __syncthreads();
    {
        const float e = __expf(-xf_), sg = __builtin_amdgcn_rcpf(1.f + e);
        FT[F.tid] = lb_ + (1.f - lb_) * sg; KT[F.tid] = (1.f - lb_) * e * sg; QT[F.tid] = xq_; VV[F.tid] = xi_;
    }
    __syncthreads();
    const int v = F.tid & 127, dq = F.tid >> 7;
#pragma unroll
    for (int t = 0; t < 4; ++t) {
        const float vt = VV[t * 128 + v]; float part = 0.f;
#pragma unroll
        for (int i = 0; i < 32; ++i) { const int d = dq * 32 + i; S[i] = FT[t * 128 + d] * S[i] + KT[t * 128 + d] * vt; part += QT[t * 128 + d] * S[i]; }
        OP[(dq * 4 + t) * 128 + v] = part;
    }
    float* So = F.out + O_HGS + (((size_t)l * 128 + bs) * 4 + h) * 16384 + (size_t)(dq * 32) * 128 + v;
#pragma unroll
    for (int i = 0; i < 32; ++i) So[i * 128] = S[i];
    __syncthreads();
    {
        const int t = F.tid >> 7, vv = F.tid & 127;
        const float o = (OP[(0 * 4 + t) * 128 + vv] + OP[(1 * 4 + t) * 128 + vv]) + (OP[(2 * 4 + t) * 128 + vv] + OP[(3 * 4 + t) * 128 + vv]);
        const float ss = wave_sum(o * o);
        if (F.lane == 0) SS[t * 2 + (F.wave & 1)] = ss;
        __syncthreads();
        const float rstd = __builtin_amdgcn_rsqf((SS[t * 2] + SS[t * 2 + 1]) * (1.f / 128.f) + EPS);
        ((bf16*)(F.ws + WS_MIX))[(size_t)(m0 + t) * D + 256 + h * 128 + vv] = (bf16)f2bf(o * rstd * gn_ * (gg_ * sigm(gg_)));
    }
}

constexpr int SHWLD = 4096;
template <int ACT> struct SEpiStore {
    bf16* O; int ldc; const float* rss; const float* shw;
    __device__ __forceinline__ void operator()(int row, int col, const f32x4 v, int lane) const {
        f32x4 w = v;
        if (rss) { const float rstd = __builtin_amdgcn_rsqf(rss[row] * (1.f / D) + EPS); w = v * rstd + *(const f32x4*)(shw + (size_t)modrow(row) * SHWLD + col); }
        if (ACT == 1) {
#pragma unroll
            for (int i = 0; i < 4; ++i) { const float r = w[i] > 0.f ? w[i] : 0.f; w[i] = r * r; } }
        v2u o; o.x = pk2(w[0], w[1]); o.y = pk2(w[2], w[3]);
        *(v2u*)(O + (size_t)row * ldc + col) = o;
    }
};
struct SEpiGateRes {
    const float* baseS; float* out; const float* gate; bf16* xs; float* rss; const float* gam; const float* sc;
    __device__ __forceinline__ void operator()(int row, int col, const f32x4 v, int lane) const {
        const int mr = modrow(row);
        const f32x4 g4 = *(const f32x4*)(gate + (size_t)mr * MODLD + col), b4 = *(const f32x4*)(baseS + (size_t)(row - NP) * D + col);
        const f32x4 x = b4 + g4 * v;
        *(f32x4*)(out + (size_t)row * D + col) = x;
        if (xs) {
            const f32x4 s4 = *(const f32x4*)(gam + col) * (*(const f32x4*)(sc + (size_t)mr * MODLD + col) + 1.f), y = x * s4;
            v2u o; o.x = pk2(y[0], y[1]); o.y = pk2(y[2], y[3]);
            *(v2u*)(xs + (size_t)row * D + col) = o;
        }
        if (rss) {
            float ss = (x[0] * x[0] + x[1] * x[1]) + (x[2] * x[2] + x[3] * x[3]);
            ss += __shfl_xor(ss, 16); ss += __shfl_xor(ss, 32);
            if ((lane >> 4) == 0) (void)__hip_atomic_fetch_add(rss + row, ss, __ATOMIC_RELAXED, __HIP_MEMORY_SCOPE_AGENT);
        }
    }
};
struct SEpiF32 {
    float* O; int ld;
    __device__ __forceinline__ void operator()(int row, int col, const f32x4 v, int lane) const { *(f32x4*)(O + (size_t)row * ld + col) = v; }
};
template <int NJ, class Epi>
__device__ __forceinline__ void sgemm_phase(Ctx& F, const bf16* Arow  , const bf16* Bt, int N, int K, const Epi& E, const int ntm = 8, const int row0 = NP) {
    static_assert(NJ <= 4, "wave-private image: 8 KiB of A + 2 NJ KiB of B");
    const int r16 = F.lane & 15, q4 = F.lane >> 4, lr = F.lane >> 3, lp = F.lane & 7;
    const int ntn = N / (16 * NJ), ksl = K / 8, nss = ksl / 64;
    LAS unsigned char* WL = F.lds + F.wave * 16384;
    LAS f32x4* RED = (LAS f32x4*)F.lds;
    TSEC_BEGIN(50);
    constexpr int SLOT = 4 * NJ * 64;
    const bool grp = ((F.G & 7) == 0) && ((ntn & 7) == 0);
    const int xg = F.bid & 7, wpx = grp ? (F.G >> 3) : F.G, cpx = ntn >> 3;
    for (int w = grp ? (F.bid >> 3) : F.bid; w < (grp ? ntm * cpx : ntm * ntn); w += wpx) {
        const int tm = w % ntm, tn = grp ? xg * cpx + w / ntm : w / ntm;
        const bf16* ap = Arow + (size_t)(64 * tm + lr) * K + F.wave * ksl + 8 * lp;
        const bf16* bp = Bt + (size_t)(16 * NJ * tn + lr) * K + F.wave * ksl + 8 * lp;
        f32x4 acc[4][NJ];
#pragma unroll
        for (int i = 0; i < 4; ++i)
#pragma unroll
            for (int j = 0; j < NJ; ++j) acc[i][j] = (f32x4){0.f, 0.f, 0.f, 0.f};
        v4u ra[8], rb[2 * NJ];
#define SG_LOAD(ss) do { _Pragma("unroll") for (int t = 0; t < 8; ++t) ra[t] = *(const v4u*)(ap + (size_t)(8 * t) * K + 64 * (ss)); \
                          _Pragma("unroll") for (int t = 0; t < 2 * NJ; ++t) rb[t] = *(const v4u*)(bp + (size_t)(8 * t) * K + 64 * (ss)); } while (0)
        SG_LOAD(0);
        __builtin_amdgcn_sched_barrier(0);
        __syncthreads();
        for (int ss = 0; ss < nss; ++ss) {
#pragma unroll
            for (int t = 0; t < 8; ++t) { const int r = 8 * t + lr; *(LAS v4u*)(WL + r * 128 + ((lp ^ (r & 7)) << 4)) = ra[t]; }
#pragma unroll
            for (int t = 0; t < 2 * NJ; ++t) { const int r = 8 * t + lr; *(LAS v4u*)(WL + 8192 + r * 128 + ((lp ^ (r & 7)) << 4)) = rb[t]; }
            __builtin_amdgcn_sched_barrier(0);
            if (ss + 1 < nss) SG_LOAD(ss + 1);
            __builtin_amdgcn_sched_barrier(0);
#pragma unroll
            for (int s = 0; s < 2; ++s) {
                bf16x8 fa[4], fb[NJ];
#pragma unroll
                for (int i = 0; i < 4; ++i) { const int r = 16 * i + r16; fa[i] = *(const LAS bf16x8*)(WL + r * 128 + (((4 * s + q4) ^ (r & 7)) << 4)); }
#pragma unroll
                for (int j = 0; j < NJ; ++j) { const int r = 16 * j + r16; fb[j] = *(const LAS bf16x8*)(WL + 8192 + r * 128 + (((4 * s + q4) ^ (r & 7)) << 4)); }
#pragma unroll
                for (int i = 0; i < 4; ++i)
#pragma unroll
                    for (int j = 0; j < NJ; ++j) acc[i][j] = MFMA16(fb[j], fa[i], acc[i][j]);
            }
            __builtin_amdgcn_sched_barrier(0);
        }
#undef SG_LOAD
        __syncthreads();
#pragma unroll
        for (int i = 0; i < 4; ++i)
#pragma unroll
            for (int j = 0; j < NJ; ++j) RED[(F.wave * 4 + i) * NJ * 64 + j * 64 + F.lane] = acc[i][j];
        __syncthreads();
#pragma unroll
        for (int q = 0; q < (SLOT + 511) / 512; ++q) {
            const int p = F.tid + 512 * q, ln = p & 63, ij = p >> 6, j = ij % NJ, mi = ij / NJ;
            if (p >= SLOT) break;
            f32x4 v = RED[p];
#pragma unroll
            for (int k4 = 1; k4 < 8; ++k4) v += RED[k4 * SLOT + p];
            E(row0 + 64 * tm + 16 * mi + (ln & 15), 16 * NJ * tn + 16 * j + 4 * (ln >> 4), v, ln);
        }
    }
    TSEC_END(50);
}

#ifndef MK_PER_PHASE
#define MK_PER_PHASE 0
#endif
#ifndef PH_MASK
#define PH_MASK 0xFFFF
#endif
#define PHON(k) ((PH_MASK >> (k)) & 1)
#ifndef PROBE_REP
#define PROBE_REP -1
#endif
#ifndef PROBE_SPIN
#define PROBE_SPIN -1
#endif
#define RELAUNDER() do { int tid_ = F.tid, bid_ = __builtin_amdgcn_readfirstlane(F.bid), g_ = __builtin_amdgcn_readfirstlane(F.G), z_ = __builtin_amdgcn_readfirstlane(F.z); asm volatile("" : "+s"(z_), "+s"(bid_), "+s"(g_)); asm volatile("" : "+v"(tid_)); \
    F.ws = args.ws + z_; F.out = args.out + z_; F.z = z_; F.tid = tid_; F.lane = tid_ & 63; F.wave = __builtin_amdgcn_readfirstlane(tid_ >> 6); F.bid = bid_; F.G = g_; } while (0)
#define SUBPROBE(k, ...) do { RELAUNDER(); const unsigned long long st0_ = PROBE_SPIN == (k) ? __builtin_amdgcn_s_memrealtime() : 0ull; __VA_ARGS__; if (PROBE_SPIN == (k)) { __syncthreads(); const unsigned long long st1_ = __builtin_amdgcn_s_memrealtime(), du_ = (st1_ - st0_) * PROBE_N; while (__builtin_amdgcn_s_memrealtime() - st1_ < du_) __builtin_amdgcn_s_sleep(8); } } while (0)
__global__ void __launch_bounds__(512, 2) mk_fwd(Args args) {
    extern __shared__ __attribute__((aligned(16))) unsigned char lds[];
    Ctx F;
    F.lds = (LAS unsigned char*)lds;
    F.tid = threadIdx.x; F.lane = F.tid & 63; F.wave = __builtin_amdgcn_readfirstlane(F.tid >> 6);
    F.G = gridDim.x; F.bid = blockIdx.x; F.z = 0;
    F.out = args.out; F.ws = args.ws;
    volatile LAS unsigned* MISC = (volatile LAS unsigned*)(F.lds + MISC_OFF);
    for (int u = F.tid; u < (LDS_BYTES - LDSCTL_OFF) / 4; u += 512) ((LAS unsigned*)(F.lds + LDSCTL_OFF))[u] = 0u;
    __syncthreads();
    const int lo = args.ph_lo, hi = args.ph_hi;
    const int wave0 = F.wave;
    XcdBarrier bar; bar.bar = (unsigned*)(F.ws + WS_CTL) + CW_BAR; bar.x = 0; bar.st = nullptr;
    if (hi - lo > 1) bar = xcd_barrier_post((unsigned*)(F.ws + WS_CTL) + CW_BAR, MISC + 8, F.tid);
    for (int p = lo; p < hi; ++p) {
        const int l = p < 2 ? 0 : (p - 2) / 9, s = (p < 2 || p == NPH - 1) ? -1 : (p - 2) % 9;
        const int which = p == NPH - 1 ? 2 : (s == 0 ? 0 : (s == 6 ? 1 : -1));
        const int kind = p == 0 ? 0 : p == 1 ? 12 : (which == 2 ? 10 : (which >= 0 ? 1 : (s == 1 ? 2 : (s == 2 ? 3 : (s == 3 ? 4 : (s == 4 ? 5 : (s == 5 ? (l == 0 ? 6 : 11) : (s == 7 ? 7 : 8))))))));
        if (s == 6 || (s == 0 && l == 1)) continue;
        const bool ffin = (int)gridDim.x >= (NP / 256) * (D / 256);
        if (p == NPH - 1 && ffin) continue;
        const int nrep = (kind == PROBE_REP) ? 1 + PROBE_N : 1;
        const unsigned long long pt0 = PROBE_SPIN >= 0 ? __builtin_amdgcn_s_memrealtime() : 0ull;
        for (int rep = 0; rep < nrep; ++rep) {
        { int z_ = 0, tid_ = wave0 * 64 + (int)__builtin_amdgcn_mbcnt_hi(~0u, __builtin_amdgcn_mbcnt_lo(~0u, 0u)), bid_ = blockIdx.x, g_ = gridDim.x;
          asm volatile("" : "+s"(z_), "+s"(bid_), "+s"(g_)); asm volatile("" : "+v"(tid_));
          F.ws = args.ws + z_; F.out = args.out + z_; F.z = z_; F.tid = tid_; F.lane = tid_ & 63; F.wave = __builtin_amdgcn_readfirstlane(tid_ >> 6); F.bid = bid_; F.G = g_; }
        if (PROBE_REP == 9 && hi - lo > 1) { for (int xb = 0; xb < PROBE_N; ++xb) xcd_barrier(bar, F.tid); }
        if (p == 0) { if (PHON(0)) p0_prologue(args, F); }
        else if (p == 1) { if (PHON(0)) mod_phase(args, F); }
        else if (which >= 0) { if (PHON(1)) norm_phase(args, F, p == NPH - 1 ? 0 : l, which); }
        else if (s == 1 && PHON(2)) {
            pg8::Gemm g{(const pg8::bf16_t*)(F.ws + WS_XN), (const pg8::bf16_t*)(F.ws + WS_WIN) + (size_t)l * INW * D, NP, INW, D};
            pg8::StaticOrder S; S.init(NP, INW, F.G, F.bid);
            const float* rss = l == 0 ? nullptr : (const float*)(F.ws + WS_CTL + CTL_RSS) + (size_t)1 * M;
            const float* shw = (const float*)(F.ws + WS_SHW) + (size_t)1 * 192 * SHWLD;
            pg8::EpiStore<0> E{(pg8::bf16_t*)(F.ws + WS_PROJ), INW, rss, shw};
            SEpiStore<0> SE{(bf16*)(F.ws + WS_PROJ), INW, rss, shw};
            if (l == 0) {
                const bf16* SHB = (const bf16*)(F.ws + WS_SHB); float* SHW = (float*)(F.ws + WS_SHW);
                { SEpiF32 HE{SHW + (size_t)0 * 192 * SHWLD, SHWLD}; sgemm_phase<4>(F, SHB + (size_t)0 * 192 * 1024, (const bf16*)(F.ws + WS_WUP), FF, D, HE, 3, 0); }
                { SEpiF32 HE{SHW + (size_t)2 * 192 * SHWLD, SHWLD}; sgemm_phase<4>(F, SHB + (size_t)2 * 192 * 1024, (const bf16*)(F.ws + WS_WUP) + (size_t)FF * D, FF, D, HE, 3, 0); }
                { SEpiF32 HE{SHW + (size_t)1 * 192 * SHWLD, SHWLD}; sgemm_phase<3>(F, SHB + (size_t)1 * 192 * 1024, (const bf16*)(F.ws + WS_WIN) + (size_t)INW * D, INW, D, HE, 3, 0); }
            }
            sgemm_phase<3>(F, (const bf16*)(F.ws + WS_XN) + (size_t)NP * D, (const bf16*)(F.ws + WS_WIN) + (size_t)l * INW * D, INW, D, SE);
            __syncthreads();
            pg8::gemm_phase<pg8::EpiStore<0>, pg8::StaticOrder, true, true>(F.lds, g, S, E, F.tid);
        } else if (s == 2) {
            for (int slot = 0; slot < 5; ++slot) {
                const int ty = __builtin_amdgcn_readfirstlane((slot + F.bid) % 5);
#if PHON(7)
                if (ty == 0) {
            SUBPROBE(20, for (int u = F.bid; u < 256; u += F.G) samp_b_unit(args, F, l, u));
                }
#endif
#if PHON(6)
                if (ty == 1) {
            SUBPROBE(21, { float S[32]; samp_hg_load(args, F, l, F.bid & 511, S); for (int u = F.bid; u < 512; u += F.G) { float Sn[32]; samp_hg_load(args, F, l, (u + F.G) & 511, Sn); samp_hg_unit(args, F, l, u, S); _Pragma("unroll") for (int i = 0; i < 32; ++i) S[i] = Sn[i]; } });
                }
#endif
#if PHON(3)
                if (ty == 2) {
            SUBPROBE(22, for (int u = F.bid; u < 256; u += F.G) attn_unit(args, F, l, u));
                }
#endif
#if PHON(4)
                if (ty == 3) {
            SUBPROBE(23, for (int u = F.bid; u < 256; u += F.G) conv_unit(args, F, l, u));
                }
#endif
#if PHON(5)
                if (ty == 4) {
                        SUBPROBE(24, {   const int nh1 = -1; auto h1idx = [&](int k) -> int { if (nh1 < 0) return F.bid + F.G * k; return k < 4 ? F.bid + 256 * k : F.bid + 640; }; const int cnt = nh1 < 0 ? (1024 - F.bid + F.G - 1) / F.G : nh1; v4u rf[2], rv[2]; h1_load(F, h1idx(0) & 1023, rf, rv); for (int k = 0; k < cnt; ++k) { v4u nf[2], nv[2]; h1_load(F, h1idx(k + 1 < cnt ? k + 1 : k) & 1023, nf, nv); h1_unit(args, F, l, h1idx(k), rf, rv); rf[0] = nf[0]; rf[1] = nf[1]; rv[0] = nv[0]; rv[1] = nv[1]; } });
                }
#endif
            }
        } else if (s == 3) { if (PHON(8)) h2_scan(args, F, l); }
        else if (s == 4 && PHON(9)) { v4u rf[2], rq[2], rv[2]; h3_load(F, F.bid & 1023, rf, rq, rv); for (int u = F.bid; u < 1024; u += F.G) { v4u nf[2], nq[2], nv[2]; h3_unit(args, F, l, u, rf, rq, rv, (u + F.G) & 1023, nf, nq, nv); rf[0] = nf[0]; rf[1] = nf[1]; rq[0] = nq[0]; rq[1] = nq[1]; rv[0] = nv[0]; rv[1] = nv[1]; } }
        else if ((s == 5 || s == 8) && PHON(10)) {
            const bool dn = s == 8;
            pg8::Gemm g{(const pg8::bf16_t*)(F.ws + (dn ? WS_HB : WS_MIX)), (const pg8::bf16_t*)(F.ws + (dn ? WS_WDN : WS_WOUT)) + (size_t)l * (dn ? D * FF : D * D), NP, D, dn ? FF : D};
            pg8::StaticOrder S; S.init(NP, D, F.G, F.bid);
            const bool from_in = (!dn && l == 0);
            const bool last = dn && l == 1, fin = last && ffin;
            const int f = last ? 3 : (dn ? 1 : 2 * l); const bool fold = !last;
            bf16* xs = fold ? (bf16*)(F.ws + WS_XN) : nullptr; float* rssw = (fold || fin) ? (float*)(F.ws + WS_CTL + CTL_RSS) + (size_t)f * M : nullptr;
            unsigned* fcnt = (unsigned*)(F.ws + WS_CTL) + CW_FIN;
            const float* gam = dn ? args.in[11 + F.z] + D : args.in[21 + F.z] + l * D;
            const float* scp = (const float*)(F.ws + WS_MOD) + (size_t)(dn ? 1 : l) * MODR * MODLD + (dn ? 1 * D : 4 * D);
            pg8::EpiGateRes E{from_in ? args.in[0 + F.z] : F.out, from_in ? args.in[1 + F.z] : F.out + (size_t)NP * D, F.out, (const float*)(F.ws + WS_MOD) + (size_t)l * MODR * MODLD + (dn ? 5 * D : 2 * D),
                              (pg8::bf16_t*)xs, rssw, gam, scp};
            SEpiGateRes SE{from_in ? args.in[1 + F.z] : F.out + (size_t)NP * D, F.out, (const float*)(F.ws + WS_MOD) + (size_t)l * MODR * MODLD + (dn ? 5 * D : 2 * D), xs, rssw, gam, scp};
            sgemm_phase<2>(F, (const bf16*)(F.ws + (dn ? WS_HB : WS_MIX)) + (size_t)NP * (dn ? FF : D), (const bf16*)(F.ws + (dn ? WS_WDN : WS_WOUT)) + (size_t)l * (dn ? D * FF : D * D), D, dn ? FF : D, SE);
            __syncthreads();
            if (fin && F.wave == 0) {
                __builtin_amdgcn_fence(__ATOMIC_RELEASE, "agent");
                if (F.lane == 0) (void)__hip_atomic_fetch_add(fcnt + 32 * 64, 1u, __ATOMIC_RELAXED, __HIP_MEMORY_SCOPE_AGENT);
            }
            if (fin) { pg8::EpiGateResFin EF{F.out, F.out, (const float*)(F.ws + WS_MOD) + (size_t)l * MODR * MODLD + 5 * D, rssw, args.in[24 + F.z], fcnt};
                pg8::gemm_phase<pg8::EpiGateResFin, pg8::StaticOrder, true, true>(F.lds, g, S, EF, F.tid); }
            else pg8::gemm_phase<pg8::EpiGateRes, pg8::StaticOrder, true, true>(F.lds, g, S, E, F.tid);
            if (fin) { RELAUNDER(); }
            if (fin && F.bid < NS / 8) {
                unsigned* scnt = (unsigned*)(F.ws + WS_CTL) + CW_FIN + 32 * 64; const float* rssr = (const float*)(F.ws + WS_CTL + CTL_RSS) + (size_t)3 * M;
                if (F.wave == 0) { while (__hip_atomic_load(scnt, __ATOMIC_RELAXED, __HIP_MEMORY_SCOPE_AGENT) < (unsigned)F.G) __builtin_amdgcn_s_sleep(2);
                    __builtin_amdgcn_fence(__ATOMIC_ACQUIRE, "agent"); }
                __syncthreads();
                const int m = NP + F.bid * 8 + F.wave; float* xr = F.out + (size_t)m * D; const float* gf = args.in[24 + F.z];
                f32x4 v[4], gm[4];
#pragma unroll
                for (int j = 0; j < 4; ++j) { v[j] = *(const f32x4*)(xr + 4 * F.lane + 256 * j); gm[j] = *(const f32x4*)(gf + 4 * F.lane + 256 * j); }
                const float rstd = __builtin_amdgcn_rsqf(rssr[m] * (1.f / D) + EPS);
#pragma unroll
                for (int j = 0; j < 4; ++j) *(f32x4*)(xr + 4 * F.lane + 256 * j) = v[j] * rstd * gm[j];
            }
        } else if (s == 7 && PHON(11)) {
            pg8::Gemm g{(const pg8::bf16_t*)(F.ws + WS_XN), (const pg8::bf16_t*)(F.ws + WS_WUP) + (size_t)l * FF * D, NP, FF, D};
            pg8::StaticOrder S; S.init(NP, FF, F.G, F.bid);
            const float* rss = (const float*)(F.ws + WS_CTL + CTL_RSS) + (size_t)(2 * l) * M;
            const float* shw = (const float*)(F.ws + WS_SHW) + (size_t)(2 * l) * 192 * SHWLD;
            pg8::EpiStore<1> E{(pg8::bf16_t*)(F.ws + WS_HB), FF, rss, shw};
            SEpiStore<1> SE{(bf16*)(F.ws + WS_HB), FF, rss, shw};
            sgemm_phase<4>(F, (const bf16*)(F.ws + WS_XN) + (size_t)NP * D, (const bf16*)(F.ws + WS_WUP) + (size_t)l * FF * D, FF, D, SE);
            __syncthreads();
            pg8::gemm_phase<pg8::EpiStore<1>, pg8::StaticOrder, true, true>(F.lds, g, S, E, F.tid);
        }
        }
        if (PROBE_SPIN >= 0 && kind == PROBE_SPIN) { const unsigned long long pt1 = __builtin_amdgcn_s_memrealtime(), dur = (pt1 - pt0) * PROBE_N; while (__builtin_amdgcn_s_memrealtime() - pt1 < dur) __builtin_amdgcn_s_sleep(8); }
        if (p + 1 < hi && !(ffin && p == NPH - 2)) xcd_barrier(bar, F.tid);
    }
}

extern "C" void kernel_launch(void* const* d_in, const int* in_sizes, int n_in, void* d_out, int out_size, void* d_ws, size_t ws_size, hipStream_t stream) {
    static int grid = 0;
    if (grid == 0) {
        if (n_in != 25 || in_sizes[0] != NP * D || (size_t)out_size != O_END || ws_size < WS_END) {
            fprintf(stderr, "kernel_launch: unexpected shapes (n_in %d, in0 %d, out %d, ws %zu)\n", n_in, n_in > 0 ? in_sizes[0] : -1, out_size, ws_size); grid = -1; return; }
        int dev = 0, cus = 0, per_cu = 0;
        if (hipGetDevice(&dev) != hipSuccess || hipDeviceGetAttribute(&cus, hipDeviceAttributeMultiprocessorCount, dev) != hipSuccess) { grid = -1; return; }
        if (hipFuncSetAttribute((const void*)mk_fwd, hipFuncAttributeMaxDynamicSharedMemorySize, LDS_BYTES) != hipSuccess) { fprintf(stderr, "kernel_launch: hipFuncSetAttribute failed\n"); grid = -1; return; }
        if (hipOccupancyMaxActiveBlocksPerMultiprocessor(&per_cu, (const void*)mk_fwd, 512, LDS_BYTES) != hipSuccess || per_cu < 1) {
            fprintf(stderr, "kernel_launch: occupancy query reports %d blocks per CU; nothing launched\n", per_cu); (void)hipGetLastError(); grid = -1; return; }
        grid = cus;
    }
    if (grid < 0) return;
    (void)hipMemsetAsync((char*)d_ws + WS_CTL, 0, CTL_ZERO_BYTES, stream);
    Args a{};
    for (int i = 0; i < 25; ++i) a.in[i] = (const float*)d_in[i];
    a.out = (float*)d_out; a.ws = (unsigned char*)d_ws;
#if MK_PER_PHASE
    for (int p = 0; p < NPH; ++p) { a.ph_lo = p; a.ph_hi = p + 1; hipLaunchKernelGGL(mk_fwd, dim3(grid), dim3(512), LDS_BYTES, stream, a); }
#else
    a.ph_lo = 0; a.ph_hi = NPH; hipLaunchKernelGGL(mk_fwd, dim3(grid), dim3(512), LDS_BYTES, stream, a);
#endif
}
```

```cpp
#define MK_PER_PHASE 0
#include <hip/hip_runtime.h>
#include <cstdio>
#include <cstdint>
namespace pg8 {
#define PG8_LAS __attribute__((address_space(3)))
typedef unsigned short bf16_t;
typedef short bf16x8 __attribute__((ext_vector_type(8)));
typedef float f32x4 __attribute__((ext_vector_type(4)));
typedef unsigned u32x4 __attribute__((ext_vector_type(4)));
constexpr int BM = 256, BK = 64, HALF = 128, HTB = HALF * BK * 2  , STAGE_BYTES = 8 * HTB, NXCD = 8, WGM = 8;

__host__ __device__ __forceinline__ int lds_byte(int r, int c) { const int st = (r >> 4) * 2 + (c >> 5), rr = r & 15, cc = c & 31, ob = rr * 64 + cc * 2; return st * 1024 + (ob ^ (((ob >> 9) & 1) << 5)); }
__host__ __device__ __forceinline__ void stage_rc(int b, int& R, int& C) { const int st = b / 1024, sb = b % 1024, swz = sb ^ (((sb >> 9) & 1) << 5); R = (st >> 1) * 16 + swz / 64; C = (st & 1) * 32 + (swz % 64) / 2; }
__host__ __device__ __forceinline__ int perm32(int rho) { const int n = rho >> 4, i = rho & 15; return 8 * (i >> 2) + 4 * n + (i & 3); }

struct Unit { int pm, pn; };
struct Gemm { const bf16_t* A; const bf16_t* Bt; int M, N, K; };

struct StaticOrder {
    int nM, nN, nwg, G, c;
    __host__ __device__ void init(int M, int N, int G_, int c_) { nM = M / BM; nN = N / BM; nwg = nM * nN; G = G_; c = c_; }
    __host__ __device__ bool next(int i, Unit& u) const {
        const long L = (long)i * G + c; if (L >= nwg) return false;
        int wgid = (int)L; { const int q = nwg / NXCD, r = nwg % NXCD, xcd = wgid % NXCD, off = wgid / NXCD; wgid = (xcd < r ? xcd * (q + 1) : r * (q + 1) + (xcd - r) * q) + off; }
        const int nig = WGM * nN, gid = wgid / nig, fm = gid * WGM, gsz = (nM - fm) < WGM ? (nM - fm) : WGM;
        u.pm = fm + ((wgid % nig) % gsz); u.pn = (wgid % nig) / gsz; return true;
    }
    __device__ __forceinline__ void a_ready(const Unit&) const {}
    __device__ __forceinline__ void done(const Unit&) const {}
};

__device__ __forceinline__ unsigned cvt_pk_bf16(float lo, float hi) { unsigned r; asm volatile("v_cvt_pk_bf16_f32 %0, %1, %2" : "=v"(r) : "v"(lo), "v"(hi)); return r; }
typedef float f32x2 __attribute__((ext_vector_type(2)));
constexpr int EP_NP = 16384, EP_D = 1024, EP_MODLD = 6144, EP_SHWLD = 4096;
constexpr float EP_EPS = 1e-6f;
#ifndef PROBE_SPIN
#define PROBE_SPIN -1
#endif
#ifndef PROBE_N
#define PROBE_N 0
#endif
#define EP_TSEC_BEGIN(k) const unsigned long long ets0_##k = PROBE_SPIN == (k) ? __builtin_amdgcn_s_memrealtime() : 0ull
#define EP_TSEC_END(k) do { if (PROBE_SPIN == (k)) { asm volatile("s_waitcnt vmcnt(0)" ::: "memory"); const unsigned long long ts1_ = __builtin_amdgcn_s_memrealtime(), du_ = (ts1_ - ets0_##k) * PROBE_N; while (__builtin_amdgcn_s_memrealtime() - ts1_ < du_) __builtin_amdgcn_s_sleep(4); } } while (0)
__device__ __forceinline__ int ep_modrow(int r) { return r < EP_NP ? (r >> 12) : 4 + ((r - EP_NP) >> 2); }
__device__ __forceinline__ float dpp_swap1(float v) { return __builtin_bit_cast(float, __builtin_amdgcn_mov_dpp(__builtin_bit_cast(int, v), 0xB1, 0xF, 0xF, true)); }
__device__ __forceinline__ void pair_rows(const f32x4 y0, const f32x4 y1, int odd, f32x4& d0, f32x4& d1) {
    f32x4 r;
#pragma unroll
    for (int e = 0; e < 4; ++e) r[e] = dpp_swap1(odd ? y0[e] : y1[e]);
#pragma unroll
    for (int e = 0; e < 4; ++e) { d0[e] = odd ? r[e] : y0[e]; d1[e] = odd ? y1[e] : r[e]; }
}
template <int ACT> struct EpiStore {
    static constexpr bool PERM = true, AFTER_DRAIN = false;
    bf16_t* O; int ldc; const float* rss; const float* shw;
    __device__ __forceinline__ void operator()(const f32x4 (&acc)[2][2][4][2], const Unit& u, int wr, int wc, int fr, int fq) const {
        const int row0 = u.pm * BM + wr * 64 + fr, col0 = u.pn * BM + wc * 64 + 8 * fq;
        f32x4 h4[2][2]; float rs[8];
#pragma unroll
        for (int bj = 0; bj < 2; ++bj)
#pragma unroll
            for (int n = 0; n < 2; ++n) h4[bj][n] = (f32x4){0.f, 0.f, 0.f, 0.f};
#pragma unroll
        for (int i = 0; i < 8; ++i) rs[i] = 1.f;
        if (rss) {
            const float* hp = shw + (size_t)ep_modrow(u.pm * BM) * EP_SHWLD + col0;
#pragma unroll
            for (int bj = 0; bj < 2; ++bj)
#pragma unroll
                for (int n = 0; n < 2; ++n) h4[bj][n] = *(const f32x4*)(hp + bj * 32 + 4 * n);
#pragma unroll
            for (int i = 0; i < 8; ++i) rs[i] = rss[row0 + (i >> 2) * HALF + (i & 3) * 16];
#pragma unroll
            for (int i = 0; i < 8; ++i) rs[i] = __builtin_amdgcn_rsqf(rs[i] * (1.f / EP_D) + EP_EPS);
        }
#pragma unroll
        for (int ai = 0; ai < 2; ++ai)
#pragma unroll
            for (int m = 0; m < 4; ++m) { const float rstd = rs[ai * 4 + m];
                bf16_t* rowp = O + (size_t)((row0 & ~1) + ai * HALF + m * 16) * ldc + u.pn * BM + wc * 64 + 8 * (fq + 4 * (fr & 1));
                f32x4 q[2];
#pragma unroll
                for (int bj = 0; bj < 2; ++bj) { f32x4 v0 = acc[ai][bj][m][0] * rstd + h4[bj][0], v1 = acc[ai][bj][m][1] * rstd + h4[bj][1];
                    if (ACT == 1) {
#pragma unroll
                        for (int e = 0; e < 4; ++e) { const float a = v0[e] > 0.f ? v0[e] : 0.f, b = v1[e] > 0.f ? v1[e] : 0.f; v0[e] = a * a; v1[e] = b * b; } }
                    u32x4 w; w.x = cvt_pk_bf16(v0[0], v0[1]); w.y = cvt_pk_bf16(v0[2], v0[3]); w.z = cvt_pk_bf16(v1[0], v1[1]); w.w = cvt_pk_bf16(v1[2], v1[3]);
                    q[bj] = __builtin_bit_cast(f32x4, w); }
                f32x4 d0, d1; pair_rows(q[0], q[1], fr & 1, d0, d1);
                *(f32x4*)rowp = d0; *(f32x4*)(rowp + ldc) = d1; }
    }
};
__device__ __forceinline__ f32x4 bf4_lo(const f32x4 q) { const u32x4 w = __builtin_bit_cast(u32x4, q); return (f32x4){__uint_as_float(w.x << 16), __uint_as_float(w.x & 0xffff0000u), __uint_as_float(w.y << 16), __uint_as_float(w.y & 0xffff0000u)}; }
__device__ __forceinline__ f32x4 bf4_hi(const f32x4 q) { const u32x4 w = __builtin_bit_cast(u32x4, q); return (f32x4){__uint_as_float(w.z << 16), __uint_as_float(w.z & 0xffff0000u), __uint_as_float(w.w << 16), __uint_as_float(w.w & 0xffff0000u)}; }
template <bool BF32, bool OF32> struct EpiGateRes {
    static constexpr bool PERM = true, AFTER_DRAIN = false;
    const void* baseP; void* out; const float* gate;
    bf16_t* xs; float* rss; const float* gam; const float* sc;
    __device__ __forceinline__ void operator()(const f32x4 (&acc)[2][2][4][2], const Unit& u, int wr, int wc, int fr_, int fq_) const {
        int fr = fr_, fq = fq_; asm volatile("" : "+v"(fr), "+v"(fq));
        const int col0 = u.pn * BM + wc * 64 + 8 * fq;
        const int mr = ep_modrow(u.pm * BM);
        f32x4 g4[2][2], s4[2][2];
#pragma unroll
        for (int bj = 0; bj < 2; ++bj)
#pragma unroll
            for (int n = 0; n < 2; ++n) { g4[bj][n] = *(const f32x4*)(gate + (size_t)mr * EP_MODLD + col0 + bj * 32 + 4 * n); s4[bj][n] = (f32x4){0.f, 0.f, 0.f, 0.f}; }
        if (xs) {
#pragma unroll
            for (int bj = 0; bj < 2; ++bj)
#pragma unroll
                for (int n = 0; n < 2; ++n) s4[bj][n] = *(const f32x4*)(gam + col0 + bj * 32 + 4 * n) * (*(const f32x4*)(sc + (size_t)mr * EP_MODLD + col0 + bj * 32 + 4 * n) + 1.f);
        }
        const int odd = fr & 1, cpair = u.pn * BM + wc * 64 + 4 * (2 * fq + odd);
        const int cp16 = u.pn * BM + wc * 64 + 8 * (fq + 4 * odd);
#pragma unroll
        for (int ai = 0; ai < 2; ++ai)
#pragma unroll
            for (int mp = 0; mp < 2; ++mp) {
                f32x4 b4[2][2][2];
#pragma unroll
                for (int mm = 0; mm < 2; ++mm) { const int re = (u.pm * BM + ai * HALF + wr * 64 + (2 * mp + mm) * 16 + fr) & ~1;
                    if (BF32) { const float* bp = (const float*)baseP + (size_t)re * EP_D + cpair;
#pragma unroll
                        for (int bj = 0; bj < 2; ++bj) { b4[mm][bj][0] = *(const f32x4*)(bp + bj * 32); b4[mm][bj][1] = *(const f32x4*)(bp + EP_D + bj * 32); } }
                    else { const bf16_t* bp = (const bf16_t*)baseP + (size_t)re * EP_D + cp16;
                        b4[mm][0][0] = *(const f32x4*)bp; b4[mm][0][1] = *(const f32x4*)(bp + EP_D); b4[mm][1][0] = b4[mm][0][0]; b4[mm][1][1] = b4[mm][0][1]; } }
                __builtin_amdgcn_sched_barrier(0);
#pragma unroll
                for (int mm = 0; mm < 2; ++mm) { const int m = 2 * mp + mm, r = u.pm * BM + ai * HALF + wr * 64 + m * 16 + fr;
                    float ss = 0.f; f32x4 wq[2] = {{0.f, 0.f, 0.f, 0.f}, {0.f, 0.f, 0.f, 0.f}}, wx[2];
                    f32x4 q0, q1; if (!BF32) pair_rows(b4[mm][0][0], b4[mm][0][1], odd, q0, q1);
#pragma unroll
                    for (int bj = 0; bj < 2; ++bj) {
                        f32x4 b0, b1;
                        if (BF32) pair_rows(b4[mm][bj][0], b4[mm][bj][1], odd, b0, b1);
                        else { const f32x4 q = bj == 0 ? q0 : q1; b0 = bf4_lo(q); b1 = bf4_hi(q); }
                        const f32x4 x0 = b0 + g4[bj][0] * acc[ai][bj][m][0], x1 = b1 + g4[bj][1] * acc[ai][bj][m][1];
                        if (OF32) { f32x4 d0, d1; pair_rows(x0, x1, odd, d0, d1); float* op = (float*)out + (size_t)(r & ~1) * EP_D + cpair;
                            *(f32x4*)(op + bj * 32) = d0; *(f32x4*)(op + EP_D + bj * 32) = d1; }
                        else { u32x4 w; w.x = cvt_pk_bf16(x0[0], x0[1]); w.y = cvt_pk_bf16(x0[2], x0[3]); w.z = cvt_pk_bf16(x1[0], x1[1]); w.w = cvt_pk_bf16(x1[2], x1[3]); wx[bj] = __builtin_bit_cast(f32x4, w); }
                        if (xs) {
                            ss += ((x0[0] * x0[0] + x0[1] * x0[1]) + (x0[2] * x0[2] + x0[3] * x0[3])) + ((x1[0] * x1[0] + x1[1] * x1[1]) + (x1[2] * x1[2] + x1[3] * x1[3]));
                            const f32x4 y0 = x0 * s4[bj][0], y1 = x1 * s4[bj][1];
                            u32x4 w; w.x = cvt_pk_bf16(y0[0], y0[1]); w.y = cvt_pk_bf16(y0[2], y0[3]); w.z = cvt_pk_bf16(y1[0], y1[1]); w.w = cvt_pk_bf16(y1[2], y1[3]);
                            wq[bj] = __builtin_bit_cast(f32x4, w); } }
                    if (!OF32) { f32x4 e0, e1; pair_rows(wx[0], wx[1], odd, e0, e1); bf16_t* xp = (bf16_t*)out + (size_t)(r & ~1) * EP_D + cp16; *(f32x4*)xp = e0; *(f32x4*)(xp + EP_D) = e1; }
                    if (xs) { f32x4 e0, e1; pair_rows(wq[0], wq[1], odd, e0, e1);
                        bf16_t* xp = xs + (size_t)(r & ~1) * EP_D + cp16;
                        *(f32x4*)xp = e0; *(f32x4*)(xp + EP_D) = e1;
                        ss += __shfl_xor(ss, 16); ss += __shfl_xor(ss, 32);
                        if (fq == 0) (void)__hip_atomic_fetch_add(rss + r, ss, __ATOMIC_RELAXED, __HIP_MEMORY_SCOPE_AGENT); } }
                __builtin_amdgcn_sched_barrier(0);
            }
    }
};
struct EpiGateResFin {
    static constexpr bool PERM = true, AFTER_DRAIN = false;
    const bf16_t* baseP; float* out; const float* gate; float* rss; const float* fing; unsigned* fcnt;
    __device__ __forceinline__ void operator()(const f32x4 (&acc)[2][2][4][2], const Unit& u, int wr, int wc, int fr_, int fq_) const {
        int fr = fr_, fq = fq_; asm volatile("" : "+v"(fr), "+v"(fq));
        const int col0 = u.pn * BM + wc * 64 + 8 * fq;
        const int mr = ep_modrow(u.pm * BM);
        f32x4 g4[2][2];
#pragma unroll
        for (int bj = 0; bj < 2; ++bj)
#pragma unroll
            for (int n = 0; n < 2; ++n) g4[bj][n] = *(const f32x4*)(gate + (size_t)mr * EP_MODLD + col0 + bj * 32 + 4 * n);
        EP_TSEC_BEGIN(60);
        f32x4 x[2][2][4][2];
#pragma unroll
        for (int ai = 0; ai < 2; ++ai)
#pragma unroll
            for (int mp = 0; mp < 2; ++mp) {
                f32x4 b4[2][2][2];
#pragma unroll
                for (int mm = 0; mm < 2; ++mm) { const int re = (u.pm * BM + ai * HALF + wr * 64 + (2 * mp + mm) * 16 + fr) & ~1;
                    const bf16_t* bp = baseP + (size_t)re * EP_D + u.pn * BM + wc * 64 + 8 * (fq + 4 * (fr & 1));
                    b4[mm][0][0] = *(const f32x4*)bp; b4[mm][0][1] = *(const f32x4*)(bp + EP_D); b4[mm][1][0] = b4[mm][0][0]; b4[mm][1][1] = b4[mm][0][1]; }
                __builtin_amdgcn_sched_barrier(0);
#pragma unroll
                for (int mm = 0; mm < 2; ++mm) { const int m = 2 * mp + mm, r = u.pm * BM + ai * HALF + wr * 64 + m * 16 + fr; float ss = 0.f;
                    f32x4 q0, q1; pair_rows(b4[mm][0][0], b4[mm][0][1], fr & 1, q0, q1);
#pragma unroll
                    for (int bj = 0; bj < 2; ++bj) {
                        const f32x4 q = bj == 0 ? q0 : q1, b0 = bf4_lo(q), b1 = bf4_hi(q);
                        const f32x4 x0 = b0 + g4[bj][0] * acc[ai][bj][m][0], x1 = b1 + g4[bj][1] * acc[ai][bj][m][1];
                        x[ai][bj][m][0] = x0; x[ai][bj][m][1] = x1;
                        ss += ((x0[0] * x0[0] + x0[1] * x0[1]) + (x0[2] * x0[2] + x0[3] * x0[3])) + ((x1[0] * x1[0] + x1[1] * x1[1]) + (x1[2] * x1[2] + x1[3] * x1[3])); }
                    ss += __shfl_xor(ss, 16); ss += __shfl_xor(ss, 32);
                    if (fq == 0) (void)__hip_atomic_fetch_add(rss + r, ss, __ATOMIC_RELAXED, __HIP_MEMORY_SCOPE_AGENT);
                    __builtin_amdgcn_sched_barrier(0); }
            }
        unsigned* cp = fcnt + 32 * u.pm;
        EP_TSEC_END(60);
        EP_TSEC_BEGIN(61);
        __syncthreads();
        if (wr == 0 && wc == 0) {
            __builtin_amdgcn_fence(__ATOMIC_RELEASE, "agent");
            if (fr == 0 && fq == 0) (void)__hip_atomic_fetch_add(cp, 1u, __ATOMIC_RELAXED, __HIP_MEMORY_SCOPE_AGENT);
            while (__hip_atomic_load(cp, __ATOMIC_RELAXED, __HIP_MEMORY_SCOPE_AGENT) < 4u) __builtin_amdgcn_s_sleep(2);
            __builtin_amdgcn_fence(__ATOMIC_ACQUIRE, "agent");
        }
        __syncthreads();
        EP_TSEC_END(61);
        EP_TSEC_BEGIN(62);
        asm volatile("" : "+v"(fr), "+v"(fq));
        const int col1 = u.pn * BM + wc * 64 + 8 * fq;
        f32x4 gm[2][2];
#pragma unroll
        for (int bj = 0; bj < 2; ++bj)
#pragma unroll
            for (int n = 0; n < 2; ++n) gm[bj][n] = *(const f32x4*)(fing + col1 + bj * 32 + 4 * n);
        const int row0 = u.pm * BM + wr * 64 + fr;
        float rs[8];
#pragma unroll
        for (int i = 0; i < 8; ++i) rs[i] = rss[row0 + (i >> 2) * HALF + (i & 3) * 16];
#pragma unroll
        for (int i = 0; i < 8; ++i) rs[i] = __builtin_amdgcn_rsqf(rs[i] * (1.f / EP_D) + EP_EPS);
#pragma unroll
        for (int ai = 0; ai < 2; ++ai)
#pragma unroll
            for (int m = 0; m < 4; ++m) { float* op = out + (size_t)((row0 & ~1) + ai * HALF + m * 16) * EP_D + u.pn * BM + wc * 64 + 4 * (2 * fq + (fr & 1)); const float rstd = rs[ai * 4 + m];
#pragma unroll
                for (int bj = 0; bj < 2; ++bj) { f32x4 d0, d1; pair_rows(x[ai][bj][m][0] * rstd * gm[bj][0], x[ai][bj][m][1] * rstd * gm[bj][1], fr & 1, d0, d1);
                    *(f32x4*)(op + bj * 32) = d0; *(f32x4*)(op + EP_D + bj * 32) = d1; } }
        EP_TSEC_END(62);
    }
};
template <class Epi, class Sched, bool ALIGN_EPI = false, bool SP2 = false>
__device__ __forceinline__ void gemm_phase(PG8_LAS unsigned char* lds, const Gemm g, const Sched& S, const Epi& E, const int tid) {
    const int wid = __builtin_amdgcn_readfirstlane(tid >> 6), lane = tid & 63, wr = wid >> 2, wc = wid & 3, fr = lane & 15, fq = lane >> 4;
    const int K = g.K, nt = K / BK;
    unsigned voffA[2], voffB[2];
#pragma unroll
    for (int i = 0; i < 2; ++i) { int R, C; stage_rc(tid * 16 + i * 8192, R, C); const int Rb = Epi::PERM ? ((R >> 5) * 64 + perm32(R & 31)) : R;
        voffA[i] = (unsigned)(R * K + C) * 2u; voffB[i] = (unsigned)(Rb * K + C) * 2u; }
    const size_t kstep = (size_t)(BK * 2);
    const size_t hstep = (size_t)HALF * K * 2;
    const size_t bhstep = Epi::PERM ? (size_t)32 * K * 2 : hstep;
    const size_t tstep = 2 * hstep;
    const unsigned ldsw = (unsigned)wid * 1024u;
    const int aoff = lds_byte(wr * 64 + fr, fq * 8), boff = lds_byte(wc * 32 + fr, fq * 8);
#define PG8_SA(b, h) (((b) * 2 + (h)) * HTB)
#define PG8_SB(b, h) ((4 + (b) * 2 + (h)) * HTB)
#define PG8_STAGE(bufoff, gbase, voff) do { _Pragma("unroll") for (int _i = 0; _i < 2; ++_i) \
        __builtin_amdgcn_global_load_lds((const unsigned*)((const char*)(gbase) + (voff)[_i]), (PG8_LAS unsigned*)(lds + (bufoff) + ldsw + _i * 8192), 16, 0, 0); } while (0)
#define PG8_LDA(dst, b, h) do { _Pragma("unroll") for (int m = 0; m < 4; ++m) _Pragma("unroll") for (int k = 0; k < 2; ++k) dst[m][k] = *(const PG8_LAS bf16x8*)(lds + PG8_SA(b, h) + aoff + m * 2048 + k * 1024); } while (0)
#define PG8_LDB(dst, b, h) do { _Pragma("unroll") for (int n = 0; n < 2; ++n) _Pragma("unroll") for (int k = 0; k < 2; ++k) dst[n][k] = *(const PG8_LAS bf16x8*)(lds + PG8_SB(b, h) + boff + n * 2048 + k * 1024); } while (0)
#define PG8_MMA(ai, bj, At, Bt) do { __builtin_amdgcn_s_setprio(1); _Pragma("unroll") for (int m = 0; m < 4; ++m) _Pragma("unroll") for (int n = 0; n < 2; ++n) _Pragma("unroll") for (int k = 0; k < 2; ++k) \
        acc[ai][bj][m][n] = __builtin_amdgcn_mfma_f32_16x16x32_bf16(Bt[n][k], At[m][k], acc[ai][bj][m][n], 0, 0, 0); __builtin_amdgcn_s_setprio(0); } while (0)
#define PG8_WAIT_V(n) asm volatile("s_waitcnt vmcnt(" #n ")" ::: "memory")
#define PG8_WAIT_L(n) asm volatile("s_waitcnt lgkmcnt(" #n ")" ::: "memory")
#define PG8_BAR __builtin_amdgcn_s_barrier()
#define PG8_SCHED __builtin_amdgcn_sched_barrier(0)
    Unit cur, nxt; int ui = 0;
    if (!S.next(0, cur)) return;
    f32x4 acc[2][2][4][2];
#pragma unroll
    for (int a = 0; a < 2; ++a)
#pragma unroll
        for (int b = 0; b < 2; ++b)
#pragma unroll
            for (int m = 0; m < 4; ++m)
#pragma unroll
                for (int n = 0; n < 2; ++n) acc[a][b][m][n] = (f32x4){0.f, 0.f, 0.f, 0.f};
    bf16x8 At[4][2], B0[2][2], B1[2][2];
    const char* cA = (const char*)g.A + (size_t)cur.pm * tstep; const char* cB = (const char*)g.Bt + (size_t)cur.pn * tstep;
    S.a_ready(cur);
    if constexpr (SP2) {
        PG8_STAGE(PG8_SB(0, 0), cB, voffB); PG8_STAGE(PG8_SB(0, 1), cB + bhstep, voffB); PG8_STAGE(PG8_SA(0, 0), cA, voffA); PG8_STAGE(PG8_SA(0, 1), cA + hstep, voffA);
        if (wr == 1) PG8_BAR;
        PG8_WAIT_V(2); PG8_BAR;
        PG8_STAGE(PG8_SB(1, 0), cB + kstep, voffB); PG8_STAGE(PG8_SA(1, 0), cA + kstep, voffA); PG8_STAGE(PG8_SB(1, 1), cB + bhstep + kstep, voffB);
        PG8_WAIT_V(6); PG8_BAR;
    } else {
        PG8_STAGE(PG8_SB(0, 0), cB, voffB); PG8_STAGE(PG8_SA(0, 0), cA, voffA); PG8_STAGE(PG8_SB(0, 1), cB + bhstep, voffB); PG8_STAGE(PG8_SA(0, 1), cA + hstep, voffA);
        if (wr == 1) PG8_BAR;
        PG8_WAIT_V(4); PG8_BAR;
        PG8_STAGE(PG8_SB(1, 0), cB + kstep, voffB); PG8_STAGE(PG8_SA(1, 0), cA + kstep, voffA); PG8_STAGE(PG8_SB(1, 1), cB + bhstep + kstep, voffB);
        PG8_WAIT_V(6); PG8_BAR;
    }
    for (;;) {
        const bool has_next = S.next(ui + 1, nxt);
        const char* nA = has_next ? (const char*)g.A + (size_t)nxt.pm * tstep : cA; const char* nB = has_next ? (const char*)g.Bt + (size_t)nxt.pn * tstep : cB;
        for (int t = 0; t < nt; t += 2) {
            const bool last = (t == nt - 2);
            const char* a1 = cA + (size_t)(t + 1) * kstep;
            const char* a2 = last ? nA : cA + (size_t)(t + 2) * kstep; const char* b2 = last ? nB : cB + (size_t)(t + 2) * kstep;
            const char* a3 = a2 + kstep; const char* b3 = b2 + kstep;
            if (last && has_next) S.a_ready(nxt);
            if constexpr (SP2) {
            PG8_LDB(B0, 0, 0); PG8_LDB(B1, 0, 1); PG8_SCHED; PG8_LDA(At, 0, 0); PG8_STAGE(PG8_SA(1, 1), a1 + hstep, voffA);
            PG8_WAIT_V(8); PG8_WAIT_L(0); PG8_BAR; PG8_MMA(0, 0, At, B0); PG8_MMA(0, 1, At, B1); PG8_BAR; PG8_SCHED;
            PG8_LDA(At, 0, 1); PG8_STAGE(PG8_SB(0, 0), b2, voffB); PG8_STAGE(PG8_SB(0, 1), b2 + bhstep, voffB); PG8_STAGE(PG8_SA(0, 0), a2, voffA);
            PG8_WAIT_V(8); PG8_WAIT_L(0); PG8_BAR; PG8_MMA(1, 0, At, B0); PG8_MMA(1, 1, At, B1); PG8_BAR; PG8_SCHED;
            PG8_LDB(B0, 1, 0); PG8_LDB(B1, 1, 1); PG8_SCHED; PG8_LDA(At, 1, 0); PG8_STAGE(PG8_SA(0, 1), a2 + hstep, voffA);
            PG8_WAIT_V(8); PG8_WAIT_L(0); PG8_BAR; PG8_MMA(0, 0, At, B0); PG8_MMA(0, 1, At, B1); PG8_BAR; PG8_SCHED;
            PG8_LDA(At, 1, 1); PG8_STAGE(PG8_SB(1, 0), b3, voffB); PG8_STAGE(PG8_SB(1, 1), b3 + bhstep, voffB); PG8_STAGE(PG8_SA(1, 0), a3, voffA);
            PG8_WAIT_V(8); PG8_WAIT_L(0); PG8_BAR; PG8_MMA(1, 0, At, B0); PG8_MMA(1, 1, At, B1); PG8_BAR; PG8_SCHED;
            } else {
            PG8_LDB(B0, 0, 0); PG8_SCHED; PG8_LDA(At, 0, 0); PG8_STAGE(PG8_SA(1, 1), a1 + hstep, voffA);
            PG8_WAIT_L(8); PG8_BAR; PG8_WAIT_L(0); PG8_MMA(0, 0, At, B0); PG8_BAR; PG8_SCHED;
            PG8_LDB(B1, 0, 1); PG8_STAGE(PG8_SB(0, 0), b2, voffB);
            PG8_BAR; PG8_WAIT_L(0); PG8_MMA(0, 1, At, B1); PG8_BAR;
            PG8_LDA(At, 0, 1); PG8_STAGE(PG8_SA(0, 0), a2, voffA);
            PG8_BAR; PG8_WAIT_L(0); PG8_MMA(1, 0, At, B0); PG8_BAR; PG8_SCHED;
            PG8_STAGE(PG8_SB(0, 1), b2 + bhstep, voffB);
            PG8_WAIT_V(6); PG8_BAR; PG8_MMA(1, 1, At, B1); PG8_BAR;
            PG8_LDB(B0, 1, 0); PG8_SCHED; PG8_LDA(At, 1, 0); PG8_STAGE(PG8_SA(0, 1), a2 + hstep, voffA);
            PG8_WAIT_L(8); PG8_BAR; PG8_WAIT_L(0); PG8_MMA(0, 0, At, B0); PG8_BAR; PG8_SCHED;
            PG8_LDB(B1, 1, 1); PG8_STAGE(PG8_SB(1, 0), b3, voffB);
            PG8_BAR; PG8_WAIT_L(0); PG8_MMA(0, 1, At, B1); PG8_BAR;
            PG8_LDA(At, 1, 1); PG8_STAGE(PG8_SA(1, 0), a3, voffA);
            PG8_BAR; PG8_WAIT_L(0); PG8_MMA(1, 0, At, B0); PG8_BAR; PG8_SCHED;
            PG8_STAGE(PG8_SB(1, 1), b3 + bhstep, voffB);
            PG8_WAIT_V(6); PG8_BAR; PG8_MMA(1, 1, At, B1); PG8_BAR;
            }
        }
        if constexpr (ALIGN_EPI) { if (wr == 0) PG8_BAR; }
        if constexpr (!Epi::AFTER_DRAIN) { E(acc, cur, wr, wc, fr, fq); S.done(cur); }
        if (!has_next) break;
#pragma unroll
        for (int a = 0; a < 2; ++a)
#pragma unroll
            for (int b = 0; b < 2; ++b)
#pragma unroll
                for (int m = 0; m < 4; ++m)
#pragma unroll
                    for (int n = 0; n < 2; ++n) acc[a][b][m][n] = (f32x4){0.f, 0.f, 0.f, 0.f};
        cur = nxt; cA = nA; cB = nB; ++ui;
        if constexpr (ALIGN_EPI) { if (wr == 1) PG8_BAR; }
    }
    PG8_WAIT_V(0);
    if constexpr (!ALIGN_EPI) { if (wr == 0) PG8_BAR; }
    PG8_BAR;
    if constexpr (Epi::AFTER_DRAIN) { E.fused(acc, cur, wr, wc, fr, fq, lds, wid, lane); S.done(cur); }
#undef PG8_SA
#undef PG8_SB
#undef PG8_STAGE
#undef PG8_LDA
#undef PG8_LDB
#undef PG8_MMA
#undef PG8_WAIT_V
#undef PG8_WAIT_L
#undef PG8_BAR
#undef PG8_SCHED
}
}
#define GAS __attribute__((address_space(1)))
#define LAS __attribute__((address_space(3)))
typedef unsigned short bf16;
typedef unsigned v4u __attribute__((ext_vector_type(4)));
typedef float f32x4 __attribute__((ext_vector_type(4)));
typedef short bf16x8 __attribute__((ext_vector_type(8)));
typedef GAS unsigned gu32;
typedef GAS unsigned long long gu64;
#define RLX_AGENT __ATOMIC_RELAXED, __HIP_MEMORY_SCOPE_AGENT
#define LDS_WAIT() asm volatile("s_waitcnt lgkmcnt(0)" ::: "memory")
#define VM_WAIT() asm volatile("s_waitcnt vmcnt(0)" ::: "memory")
__device__ __forceinline__ unsigned long long rt() { return __builtin_amdgcn_s_memrealtime(); }
typedef float f32x2_ __attribute__((ext_vector_type(2)));
typedef __bf16 bf16x2_ __attribute__((ext_vector_type(2)));
__device__ __forceinline__ unsigned pk2(float lo, float hi) { const f32x2_ v = {lo, hi}; const bf16x2_ b = __builtin_convertvector(v, bf16x2_); return __builtin_bit_cast(unsigned, b); }
__device__ __forceinline__ unsigned f2bf(float f) { return (unsigned)__builtin_bit_cast(unsigned short, (__bf16)f); }

#define XB_TMO      128
#define XB_XCNT(j)  (256  + 64 * (j))
#define XB_XSUB(j)  (1280 + 64 * (j))
#define XB_XGEN(j)  (2304 + 64 * (j))
#define XB_TOP      3328
#define XB_TOPGEN   3392
#define XCD_BAR_WORDS 3456
#define XB_SPIN_CAP (1u << 18)

__device__ __forceinline__ unsigned xb_ld(unsigned* p)              { return __hip_atomic_load(p, __ATOMIC_RELAXED, __HIP_MEMORY_SCOPE_AGENT); }
__device__ __forceinline__ unsigned xb_add(unsigned* p, unsigned v) { return __hip_atomic_fetch_add(p, v, __ATOMIC_RELAXED, __HIP_MEMORY_SCOPE_AGENT); }
__device__ __forceinline__ unsigned xb_xcc_id() { return (unsigned)__builtin_amdgcn_s_getreg((3 << 11) | 20) & 0xFu; }
#define XB_SPIN(cond, bar) do { unsigned _sp = 0; while (cond) { __builtin_amdgcn_s_sleep(1); \
    if ((++_sp & 255u) == 0u) { if (xb_ld(&(bar)[XB_TMO])) break; if (_sp > XB_SPIN_CAP) { atomicAdd(&(bar)[XB_TMO], 1u); break; } } } } while (0)

struct XcdBarrier {
    unsigned* bar; unsigned x;
    volatile LAS unsigned* st;
};

__device__ __forceinline__ XcdBarrier xcd_barrier_post(unsigned* bar, volatile LAS unsigned* st, const int tid_) {
    XcdBarrier b; b.bar = bar; b.x = xb_xcc_id(); b.st = st;
    if (tid_ == 0) (void)xb_add(&bar[XB_XCNT(b.x)], 1u);
    return b;
}
__device__ __forceinline__ void xcd_barrier_complete(unsigned* bar, unsigned x, unsigned& nloc, unsigned& nx) {
    const unsigned G = gridDim.x * gridDim.y * gridDim.z;
    unsigned sum, cnt, mine, sp = 0u;
    for (;;) {
        sum = 0u; cnt = 0u; mine = 0u;
#pragma unroll
        for (unsigned j = 0; j < 16; ++j) { const unsigned c = xb_ld(&bar[XB_XCNT(j)]); sum += c; cnt += (c > 0u) ? 1u : 0u; mine = (j == x) ? c : mine; }
        if (sum == G) break;
        __builtin_amdgcn_s_sleep(1);
        if ((++sp & 255u) == 0u) { if (xb_ld(&bar[XB_TMO])) break; if (sp > XB_SPIN_CAP) { atomicAdd(&bar[XB_TMO], 1u); break; } }
    }
    nloc = mine > 0u ? mine : 1u; nx = cnt > 0u ? cnt : 1u;
}

__device__ __forceinline__ void xcd_barrier(const XcdBarrier& b, const int tid_) {
    asm volatile("s_waitcnt vmcnt(0)" ::: "memory");
    __syncthreads();
    if (tid_ == 0) {
        unsigned* bar = b.bar;
        __builtin_amdgcn_s_waitcnt(0);
        unsigned nloc = b.st[0], nx = b.st[1];
        if (nloc == 0u) { xcd_barrier_complete(bar, b.x, nloc, nx); b.st[0] = nloc; b.st[1] = nx; }
        const unsigned old = xb_add(&bar[XB_XSUB(b.x)], 1u);
        const unsigned gen = old / nloc;
        if (old + 1u == (gen + 1u) * nloc) {
            __builtin_amdgcn_fence(__ATOMIC_RELEASE, "agent");
            asm volatile("s_waitcnt vmcnt(0)" ::: "memory");
            const unsigned og = xb_add(&bar[XB_TOP], 1u);
            const unsigned tg = og / nx;
            if (og + 1u == (tg + 1u) * nx) xb_add(&bar[XB_TOPGEN], 1u);
            else XB_SPIN(xb_ld(&bar[XB_TOPGEN]) == tg, bar);
            __builtin_amdgcn_fence(__ATOMIC_ACQUIRE, "agent");
            xb_add(&bar[XB_XGEN(b.x)], 1u);
            asm volatile("s_waitcnt vmcnt(0)" ::: "memory");
        } else {
            XB_SPIN(xb_ld(&bar[XB_XGEN(b.x)]) == gen, bar);
            __builtin_amdgcn_fence(__ATOMIC_ACQUIRE, "agent");
            asm volatile("s_waitcnt vmcnt(0)" ::: "memory");
        }
    }
    __syncthreads();
}

__device__ __forceinline__ void xcd_arrive(const XcdBarrier& b, const int tid_) {
    asm volatile("s_waitcnt vmcnt(0)" ::: "memory");
    __syncthreads();
    if (tid_ == 0) {
        unsigned* bar = b.bar;
        __builtin_amdgcn_s_waitcnt(0);
        unsigned nloc = b.st[0], nx = b.st[1];
        if (nloc == 0u) { xcd_barrier_complete(bar, b.x, nloc, nx); b.st[0] = nloc; b.st[1] = nx; }
        const unsigned old = xb_add(&bar[XB_XSUB(b.x)], 1u);
        const unsigned gen = old / nloc;
        b.st[2] = gen;
        if (old + 1u == (gen + 1u) * nloc) {
            __builtin_amdgcn_fence(__ATOMIC_RELEASE, "agent");
            asm volatile("s_waitcnt vmcnt(0)" ::: "memory");
            const unsigned og = xb_add(&bar[XB_TOP], 1u);
            const unsigned tg = og / nx;
            if (og + 1u == (tg + 1u) * nx) xb_add(&bar[XB_TOPGEN], 1u);
        }
    }
}
__device__ __forceinline__ void xcd_wait(const XcdBarrier& b, const int tid_) {
    if (tid_ == 0) {
        unsigned* bar = b.bar;
        const unsigned gen = b.st[2];
        XB_SPIN(xb_ld(&bar[XB_TOPGEN]) == gen, bar);
        __builtin_amdgcn_fence(__ATOMIC_ACQUIRE, "agent");
        asm volatile("s_waitcnt vmcnt(0)" ::: "memory");
    }
    __syncthreads();
}

constexpr int D = 1024, NP = 16384, NS = 512, M = NP + NS, INW = 3072, FF = 4096, TP = 4096;
constexpr int C_AV = 0, C_AG = 256, C_Q = 512, C_F = 1024, C_I = 1536, C_G = 2048, C_QA = 2560, C_KA = 2816, C_VA = 2944;
constexpr int MODR = 132, MODLD = 6144;
constexpr float EPS = 1e-6f;
constexpr size_t O_CONVP = (size_t)M * D, O_CONVS = O_CONVP + 2 * 4 * 30 * 256, O_HGP = O_CONVS + 2 * 128 * 30 * 256, O_HGS = O_HGP + 2 * 4 * 4 * 16384,
                 O_KP = O_HGS + (size_t)2 * 128 * 4 * 16384, O_KS = O_KP + 2 * 4 * 128 * 128, O_VP = O_KS + (size_t)2 * 128 * 128 * 128, O_VS = O_VP + 2 * 4 * 128 * 128,
                 O_END = O_VS + (size_t)2 * 128 * 128 * 128;
constexpr size_t MiB = 1u << 20;
constexpr size_t WS_CTL = 0, CTL_ZERO_BYTES = 1 * MiB, WS_TAB = 1 * MiB, WS_MOD = 2 * MiB, WS_DC = 9 * MiB, WS_WIN = 10 * MiB, WS_WOUT = 22 * MiB, WS_WUP = 26 * MiB, WS_WDN = 42 * MiB,
                 WS_XN = 58 * MiB, WS_HG = 58 * MiB, WS_PROJ = 91 * MiB, WS_MIX = 190 * MiB, WS_HB = 91 * MiB, WS_SHB = 224 * MiB, WS_SHW = 226 * MiB, WS_XB = 236 * MiB  , WS_HBS = 270 * MiB  ,
                 WS_PROJS = 274 * MiB  , WS_END = 277 * MiB;
constexpr size_t CTL_RSS = 65536;
constexpr size_t WS_SC = WS_TAB + 65536;
constexpr int CW_BAR = 4096;
constexpr int CW_FIN = 131072;
constexpr int RING_BYTES = 131072, LDSCTL_OFF = RING_BYTES, MISC_OFF = LDSCTL_OFF + 320, LDS_BYTES = 147456;
constexpr int NPH = 21;

typedef float f32x16 __attribute__((ext_vector_type(16)));
typedef unsigned v2u __attribute__((ext_vector_type(2)));
__device__ __forceinline__ float bf2f(unsigned h) { return __builtin_bit_cast(float, h << 16); }
__device__ __forceinline__ float wave_sum(float v) {
#pragma unroll
    for (int o = 1; o < 64; o <<= 1) v += __shfl_xor(v, o);
    return v;
}
__device__ __forceinline__ float wave_max(float v) {
#pragma unroll
    for (int o = 1; o < 64; o <<= 1) v = fmaxf(v, __shfl_xor(v, o));
    return v;
}
__device__ __forceinline__ int modrow(int r) { return r < NP ? (r >> 12) : 4 + ((r - NP) >> 2); }
__device__ __forceinline__ int crow(int r, int hi) { return (r & 3) + 8 * (r >> 2) + 4 * hi; }
__device__ __forceinline__ bf16x8 pk8(float a0, float a1, float a2, float a3, float a4, float a5, float a6, float a7) {
    v4u w; w.x = pk2(a0, a1); w.y = pk2(a2, a3); w.z = pk2(a4, a5); w.w = pk2(a6, a7); return __builtin_bit_cast(bf16x8, w);
}
__device__ __forceinline__ float sigm(float x) { return __builtin_amdgcn_rcpf(1.f + __expf(-x)); }
#define MFMA32(a, b, c) __builtin_amdgcn_mfma_f32_32x32x16_bf16((a), (b), (c), 0, 0, 0)
#define MFMA16(a, b, c) __builtin_amdgcn_mfma_f32_16x16x32_bf16((a), (b), (c), 0, 0, 0)

#ifndef PROBE_SPIN
#define PROBE_SPIN -1
#endif
#ifndef PROBE_N
#define PROBE_N 0
#endif
#define TSEC_BEGIN(k) const unsigned long long ts0_##k = PROBE_SPIN == (k) ? __builtin_amdgcn_s_memrealtime() : 0ull
#define TSEC_END(k) do { if (PROBE_SPIN == (k)) { const unsigned long long ts1_ = __builtin_amdgcn_s_memrealtime(), du_ = (ts1_ - ts0_##k) * PROBE_N; while (__builtin_amdgcn_s_memrealtime() - ts1_ < du_) __builtin_amdgcn_s_sleep(4); } } while (0)
struct Args { const float* in[25]; float* out; unsigned char* ws; int ph_lo, ph_hi; };
struct Ctx {
    LAS unsigned char* lds;
    int tid, lane, wave, G, bid, z;
    float* out; unsigned char* ws;
};

__device__ __forceinline__ void p0_transpose_item(const float* W, int K, int N, bf16* WT, LAS float* scr, int item, int lane) {
    const int nblk = N / 32, kb = item / nblk, nb = item % nblk, k0 = 64 * kb, n0 = 32 * nb;
    float tv[32];
#pragma unroll
    for (int i = 0; i < 32; ++i) { const int kk = 2 * i + (lane >> 5); tv[i] = __builtin_nontemporal_load(W + (size_t)(k0 + kk) * N + n0 + (lane & 31)); }
    __builtin_amdgcn_sched_barrier(0);
#pragma unroll
    for (int i = 0; i < 32; ++i) { const int kk = 2 * i + (lane >> 5); scr[kk * 33 + (lane & 31)] = tv[i]; }
    LDS_WAIT(); asm volatile("" ::: "memory");
    const int c = lane & 7;
#pragma unroll
    for (int j = 0; j < 4; ++j) { const int n = (lane >> 3) + 8 * j; const LAS float* s = scr + (8 * c) * 33 + n;
        v4u o; o.x = pk2(s[0 * 33], s[1 * 33]); o.y = pk2(s[2 * 33], s[3 * 33]); o.z = pk2(s[4 * 33], s[5 * 33]); o.w = pk2(s[6 * 33], s[7 * 33]);
        *(GAS v4u*)(WT + (size_t)(n0 + n) * K + k0 + 8 * c) = o; }
    LDS_WAIT(); asm volatile("" ::: "memory");
}
__device__ __forceinline__ void mod_unit(const Args& A, Ctx& F, int u) {
    const int l = u / 192, n0 = 32 * (u % 192), k0 = 128 * F.wave, c = F.lane & 31, h2 = F.lane >> 5;
    const float* W = A.in[9 + F.z] + (size_t)l * 1024 * 6144;
    f32x16 acc[5];
#pragma unroll
    for (int i = 0; i < 5; ++i)
#pragma unroll
        for (int e = 0; e < 16; ++e) acc[i][e] = 0.f;
    const bf16* SC = (const bf16*)(F.ws + WS_SC);
    LAS unsigned char* WL = F.lds + F.wave * 16384;
    const int lr = F.lane >> 3, lp = F.lane & 7;
    TSEC_BEGIN(42);
    __syncthreads();
#pragma unroll 1
    for (int jh = 0; jh < 2; ++jh) {
        const int kh = k0 + 64 * jh;
        float wv[4][8];
#pragma unroll
        for (int j = 0; j < 4; ++j)
#pragma unroll
            for (int e = 0; e < 8; ++e) wv[j][e] = __builtin_nontemporal_load(W + (size_t)(kh + 16 * j + 8 * h2 + e) * 6144 + n0 + c);
        v4u rs[16];
#pragma unroll
        for (int t = 0; t < 16; ++t) rs[t] = *(const v4u*)(SC + (size_t)(4 + 8 * t + lr) * 1024 + kh + 8 * lp);
        bf16x8 ap4[4];
#pragma unroll
        for (int j = 0; j < 4; ++j) { ap4[j] = (bf16x8){0, 0, 0, 0, 0, 0, 0, 0}; if (c < 4) ap4[j] = *(const bf16x8*)(SC + (size_t)c * 1024 + kh + 16 * j + 8 * h2); }
        __builtin_amdgcn_sched_barrier(0);
#pragma unroll
        for (int t = 0; t < 16; ++t) { const int r = 8 * t + lr; *(LAS v4u*)(WL + r * 128 + ((lp ^ (r & 7)) << 4)) = rs[t]; }
        __builtin_amdgcn_sched_barrier(0);
#pragma unroll
        for (int j = 0; j < 4; ++j) {
            const bf16x8 b = pk8(wv[j][0], wv[j][1], wv[j][2], wv[j][3], wv[j][4], wv[j][5], wv[j][6], wv[j][7]);
            acc[0] = MFMA32(ap4[j], b, acc[0]);
#pragma unroll
            for (int rt = 1; rt < 5; ++rt) { const int r = 32 * (rt - 1) + c; const bf16x8 af = *(const LAS bf16x8*)(WL + r * 128 + (((2 * j + h2) ^ (r & 7)) << 4)); acc[rt] = MFMA32(af, b, acc[rt]); }
        }
        __builtin_amdgcn_sched_barrier(0);
    }
    TSEC_END(42);
    TSEC_BEGIN(43);
    LAS float* RED = (LAS float*)F.lds;
#define RED_WR(slot) do { _Pragma("unroll") for (int rt = 0; rt < 5; ++rt) _Pragma("unroll") for (int e = 0; e < 16; ++e) RED[(slot) * 5120 + (rt * 16 + e) * 64 + F.lane] = acc[rt][e]; } while (0)
#define RED_ADD(slot) do { _Pragma("unroll") for (int rt = 0; rt < 5; ++rt) _Pragma("unroll") for (int e = 0; e < 16; ++e) acc[rt][e] += RED[(slot) * 5120 + (rt * 16 + e) * 64 + F.lane]; } while (0)
    __syncthreads();
    if (F.wave >= 4) RED_WR(F.wave - 4);
    __syncthreads();
    if (F.wave < 4) { RED_ADD(F.wave); RED_WR(F.wave); }
    __syncthreads();
    {
        float* mo = (float*)(F.ws + WS_MOD) + (size_t)l * MODR * MODLD;
        const float bias = A.in[10 + F.z][l * MODLD + n0 + c];
#pragma unroll
        for (int q = 0; q < 10; ++q) { const int p = F.tid + 512 * q, re = p >> 6, rt = re >> 4, e = re & 15;
            const float v = (RED[p] + RED[5120 + p]) + (RED[10240 + p] + RED[15360 + p]);
            const int cr = crow(e, h2), r = rt == 0 ? cr : 4 + 32 * (rt - 1) + cr;
            if (rt > 0 || cr < 4) mo[(size_t)r * MODLD + n0 + c] = v + bias; }
    }
#undef RED_WR
#undef RED_ADD
    TSEC_END(43);
}
__device__ __forceinline__ void p0_item(const Args& A, Ctx& F, LAS float* scr, int it) {
    const int l = it / 6144; int r = it % 6144;
    if (r < 1536) { p0_transpose_item(A.in[12 + F.z] + (size_t)l * 1024 * 3072, 1024, 3072, (bf16*)(F.ws + WS_WIN) + (size_t)l * 3072 * 1024, scr, r, F.lane); return; } r -= 1536;
    if (r < 512) { p0_transpose_item(A.in[20 + F.z] + (size_t)l * 1024 * 1024, 1024, 1024, (bf16*)(F.ws + WS_WOUT) + (size_t)l * 1024 * 1024, scr, r, F.lane); return; } r -= 512;
    if (r < 2048) { p0_transpose_item(A.in[22 + F.z] + (size_t)l * 1024 * 4096, 1024, 4096, (bf16*)(F.ws + WS_WUP) + (size_t)l * 4096 * 1024, scr, r, F.lane); return; } r -= 2048;
    p0_transpose_item(A.in[23 + F.z] + (size_t)l * 4096 * 1024, 4096, 1024, (bf16*)(F.ws + WS_WDN) + (size_t)l * 1024 * 4096, scr, r, F.lane);
}
__device__ __forceinline__ void mod_unit(const Args& A, Ctx& F, int u);
__device__ __forceinline__ void p0_gap_items(const Args& A, Ctx& F, int part) {
    if (F.G != 256) return;
    LAS float* scr = (LAS float*)(F.lds + F.wave * 16384);
    p0_item(A, F, scr, 2048 * part + F.bid * 8 + F.wave);
}
__device__ __forceinline__ void p0_prologue(const Args& A, Ctx& F) {
    LAS float* scr = (LAS float*)(F.lds + F.wave * 16384);
    const int gw = F.bid * 8 + F.wave, NGW = F.G * 8;
    unsigned* cnt = (unsigned*)(F.ws + WS_CTL) + CW_FIN + 32 * 66;
    for (int i = F.bid * 512 + F.tid; i < 160 * 128; i += F.G * 512) {
        const int r = i >> 7, k8 = 8 * (i & 127);
        v4u o = {0u, 0u, 0u, 0u};
        if (r < MODR) { const float* cp = (r < 4 ? A.in[6 + F.z] + r * 1024 : A.in[7 + F.z] + (r - 4) * 1024) + k8; const f32x4 c0 = *(const f32x4*)cp, c1 = *(const f32x4*)(cp + 4);
            o.x = pk2(c0.x * sigm(c0.x), c0.y * sigm(c0.y)); o.y = pk2(c0.z * sigm(c0.z), c0.w * sigm(c0.w)); o.z = pk2(c1.x * sigm(c1.x), c1.y * sigm(c1.y)); o.w = pk2(c1.z * sigm(c1.z), c1.w * sigm(c1.w)); }
        *(v4u*)((bf16*)(F.ws + WS_SC) + (size_t)r * 1024 + k8) = o;
    }
    asm volatile("s_waitcnt vmcnt(0)" ::: "memory");
    __syncthreads();
    if (F.tid == 0) { __builtin_amdgcn_fence(__ATOMIC_RELEASE, "agent"); (void)__hip_atomic_fetch_add(cnt, 1u, __ATOMIC_RELAXED, __HIP_MEMORY_SCOPE_AGENT); }
    if (F.bid == 0) {
        float* BT = (float*)(F.ws + WS_TAB); float* LB1 = BT + 1024;
        for (int i = F.tid; i < 129 * 4; i += 512) { const int rel = i >> 2, h = i & 3; int bk = rel;
            if (rel >= 16) { bk = 16 + (int)(logf((float)rel / 16.f) / logf(8.f) * 16.f); bk = bk > 31 ? 31 : bk; }
            BT[i] = A.in[8 + F.z][bk * 4 + h]; }
        { const int i = F.tid; const float a = A.in[17 + F.z][i], b = A.in[17 + F.z][512 + i], mx = fmaxf(a, b), ea = expf(a - mx), eb = expf(b - mx); LB1[i] = eb / (ea + eb); }
    }
    const bool split = F.G == 256;
    const int nit = split ? 1 : 0, ib = gw;
    TSEC_BEGIN(40);
    for (int j = 0; j < nit; ++j) p0_item(A, F, scr, ib + 2048 * j);
    TSEC_END(40);
    if (F.tid == 0) { while (__hip_atomic_load(cnt, __ATOMIC_RELAXED, __HIP_MEMORY_SCOPE_AGENT) < (unsigned)F.G) __builtin_amdgcn_s_sleep(2);
        __builtin_amdgcn_fence(__ATOMIC_ACQUIRE, "agent"); }
    __syncthreads();
    if (split) { const int i = (F.bid & 7) * 32 + (F.bid >> 3);
        mod_unit(A, F, i < 192 ? i : (i < 224 ? i : i + 64)); }
    else if ((F.G & 7) == 0) { const int xg = F.bid & 7, wpx = F.G >> 3; for (int w = F.bid >> 3; w < 48; w += wpx) mod_unit(A, F, xg * 48 + w); }
    else for (int u = F.bid; u < 384; u += F.G) mod_unit(A, F, u);
    __syncthreads();
    if (!split) for (int it = gw; it < 12288; it += NGW) p0_item(A, F, scr, it);
}
__device__ __forceinline__ void mod_deferred(const Args& A, Ctx& F) {
    if (F.G != 256 || (F.bid >> 3) >= 16) return;
    const int i = (F.bid & 7) * 16 + (F.bid >> 3);
    mod_unit(A, F, 192 + (i < 64 ? 32 + i : 64 + i));
    __syncthreads();
}
__device__ __forceinline__ void norm_phase(const Args& A, Ctx& F, int l, int which) {
    if (l == 0 && which == 0) mod_deferred(A, F);
    if (l == 0 && which == 0) {
        const float* MODp = (const float*)(F.ws + WS_MOD);
        for (int i = F.bid * 512 + F.tid; i < 3 * 192 * 128; i += F.G * 512) {
            const int f = i / (192 * 128), r = (i >> 7) % 192, k8 = 8 * (i & 127);
            v4u o = {0u, 0u, 0u, 0u};
            if (r < MODR) { const float* sp = MODp + (size_t)(f == 0 ? 0 : 1) * MODR * MODLD + (size_t)r * MODLD + (f == 1 ? 0 : 3 * D) + k8; const f32x4 c0 = *(const f32x4*)sp, c1 = *(const f32x4*)(sp + 4);
                o.x = pk2(c0.x, c0.y); o.y = pk2(c0.z, c0.w); o.z = pk2(c1.x, c1.y); o.w = pk2(c1.z, c1.w); }
            *(v4u*)((bf16*)(F.ws + WS_SHB) + (size_t)(f * 192 + r) * 1024 + k8) = o;
        }
    }
    const int gw = F.bid * 8 + F.wave, NGW = F.G * 8;
    const float* gamma = which == 0 ? A.in[11 + F.z] + l * D : (which == 1 ? A.in[21 + F.z] + l * D : A.in[24 + F.z]);
    const float* mod = (const float*)(F.ws + WS_MOD) + (size_t)l * MODR * MODLD;
    const int shc = which == 0 ? 0 : 3 * D, scc = shc + D;
    const bool from_in = (which == 0 && l == 0);
    bf16* XN = (bf16*)(F.ws + WS_XN);
    f32x4 gm[4];
#pragma unroll
    for (int j = 0; j < 4; ++j) gm[j] = *(const f32x4*)(gamma + 4 * F.lane + 256 * j);
    constexpr int NR = 4;
    for (int m0 = gw; m0 < M; m0 += NR * NGW) {
        f32x4 v[NR][4], msc[NR][4], msh[NR][4];
#pragma unroll
        for (int r = 0; r < NR; ++r) { const int mr_ = m0 + r * NGW, m = mr_ < M ? mr_ : m0;
            const float* xr = from_in ? (m < NP ? A.in[0 + F.z] + (size_t)m * D : A.in[1 + F.z] + (size_t)(m - NP) * D) : F.out + (size_t)m * D;
#pragma unroll
            for (int j = 0; j < 4; ++j) v[r][j] = *(const f32x4*)(xr + 4 * F.lane + 256 * j);
            if (which != 2) { const float* mr = mod + (size_t)modrow(m) * MODLD;
#pragma unroll
                for (int j = 0; j < 4; ++j) { msc[r][j] = *(const f32x4*)(mr + scc + 4 * F.lane + 256 * j); msh[r][j] = *(const f32x4*)(mr + shc + 4 * F.lane + 256 * j); } } }
        __builtin_amdgcn_sched_barrier(0);
        float ssq[NR];
#pragma unroll
        for (int r = 0; r < NR; ++r) { ssq[r] = 0.f;
#pragma unroll
            for (int j = 0; j < 4; ++j) ssq[r] += (v[r][j].x * v[r][j].x + v[r][j].y * v[r][j].y) + (v[r][j].z * v[r][j].z + v[r][j].w * v[r][j].w); }
#pragma unroll
        for (int o = 1; o < 64; o <<= 1) {
            float t_[NR];
#pragma unroll
            for (int r = 0; r < NR; ++r) t_[r] = __shfl_xor(ssq[r], o);
#pragma unroll
            for (int r = 0; r < NR; ++r) ssq[r] += t_[r];
        }
#pragma unroll
        for (int r = 0; r < NR; ++r) {
            const int m = m0 + r * NGW;
            if (m < M) {
                const float rstd = __builtin_amdgcn_rsqf(ssq[r] * (1.f / D) + EPS);
                if (which == 2) {
#pragma unroll
                    for (int j = 0; j < 4; ++j) *(f32x4*)(F.out + (size_t)m * D + 4 * F.lane + 256 * j) = v[r][j] * rstd * gm[j];
                } else {
#pragma unroll
                    for (int j = 0; j < 4; ++j) { const f32x4 y = v[r][j] * rstd * gm[j] * (msc[r][j] + 1.f) + msh[r][j]; v2u w; w.x = pk2(y.x, y.y); w.y = pk2(y.z, y.w);
                        *(v2u*)(XN + (size_t)m * D + 4 * F.lane + 256 * j) = w; }
                }
            }
        }
    }
}

constexpr int RS = 272;
constexpr int RS64 = 144;
struct HgGate { float cl[16], kf[16]; };
__device__ __forceinline__ void hg_gates(const float lb, const LAS unsigned short* rawf  , int d, HgGate& g) {
    float run = 0.f;
#pragma unroll
    for (int j = 0; j < 16; ++j) {
        const float x = bf2f(rawf[j * (RS / 2) + d]);
        const float e = __expf(-x), sg = __builtin_amdgcn_rcpf(1.f + e);
        const float f = lb + (1.f - lb) * sg;
        g.kf[j] = (1.f - lb) * e * sg;
        run += __logf(f); g.cl[j] = run;
    }
}
__device__ __forceinline__ void tile_load(const bf16* g0  , int tid, v4u (&r)[2]) {
#pragma unroll
    for (int i = 0; i < 2; ++i) { const int it = tid + 512 * i; r[i] = *(const v4u*)(g0 + (size_t)(it >> 4) * INW + 8 * (it & 15)); }
    __builtin_amdgcn_sched_barrier(0);
}
__device__ __forceinline__ void tile_store(LAS unsigned char* dst, int tid, const v4u (&r)[2]) {
#pragma unroll
    for (int i = 0; i < 2; ++i) { const int it = tid + 512 * i; *(LAS v4u*)(dst + (it >> 4) * RS + 16 * (it & 15)) = r[i]; }
}
__device__ __forceinline__ void h1_load(Ctx& F, int u, v4u (&rf)[2], v4u (&rv)[2]) {
    const int bh = u >> 6, b = bh >> 2, h = bh & 3, ch = u & 63, m0 = b * TP + ch * 64;
    const bf16* PROJ = (const bf16*)(F.ws + WS_PROJ);
    tile_load(PROJ + (size_t)m0 * INW + C_F + h * 128, F.tid, rf); tile_load(PROJ + (size_t)m0 * INW + C_I + h * 128, F.tid, rv);
}
__device__ __forceinline__ void h1_unit(const Args& A, Ctx& F, int l, int u, const v4u (&rf)[2], const v4u (&rv)[2]) {
    const int bh = u >> 6, b = bh >> 2, h = bh & 3, ch = u & 63, m0 = b * TP + ch * 64;
    const int d = F.tid & 127, sc = F.tid >> 7, c = F.lane & 31, h2 = F.lane >> 5;
    const bf16* PROJ = (const bf16*)(F.ws + WS_PROJ);
    LAS unsigned char* L = F.lds;
    constexpr int OKDT = 0, OVT = 128 * RS64, OTOT = 2 * 128 * RS64, ORF = OTOT + 2048, ORV = ORF + 64 * RS;
    LAS unsigned short* KDT = (LAS unsigned short*)(L + OKDT);
    LAS unsigned short* VT = (LAS unsigned short*)(L + OVT);
    LAS float* TOT = (LAS float*)(L + OTOT);
    const float lb = l == 0 ? 0.f : ((const float*)(F.ws + WS_TAB))[1024 + h * 128 + d];
    __syncthreads();
    tile_store(L + ORF, F.tid, rf); tile_store(L + ORV, F.tid, rv);
    __syncthreads();
    HgGate g; hg_gates(lb, (const LAS unsigned short*)(L + ORF + sc * 16 * RS), d, g);
    TOT[sc * 128 + d] = g.cl[15];
#pragma unroll
    for (int j = 0; j < 16; ++j) VT[d * (RS64 / 2) + sc * 16 + j] = ((const LAS unsigned short*)(L + ORV))[(sc * 16 + j) * (RS / 2) + d];
    __syncthreads();
    float after = 0.f;
#pragma unroll
    for (int i = 1; i < 4; ++i) if (i > sc) after += TOT[i * 128 + d];
    const float tot = g.cl[15];
#pragma unroll
    for (int j = 0; j < 16; ++j) KDT[d * (RS64 / 2) + sc * 16 + j] = (unsigned short)f2bf(g.kf[j] * __expf(after + tot - g.cl[j]));
    if (sc == 0) ((float*)(F.ws + WS_DC))[u * 128 + d] = __expf(after + tot);
    __syncthreads();
    const int vt = F.wave >> 1, dt0 = 2 * (F.wave & 1);
    f32x16 acc0, acc1;
#pragma unroll
    for (int e = 0; e < 16; ++e) { acc0[e] = 0.f; acc1[e] = 0.f; }
#pragma unroll
    for (int ks = 0; ks < 4; ++ks) {
        const bf16x8 a = *(const LAS bf16x8*)(L + OVT + (32 * vt + c) * RS64 + (16 * ks + 8 * h2) * 2);
        const bf16x8 b0 = *(const LAS bf16x8*)(L + OKDT + (32 * dt0 + c) * RS64 + (16 * ks + 8 * h2) * 2);
        const bf16x8 b1 = *(const LAS bf16x8*)(L + OKDT + (32 * dt0 + 32 + c) * RS64 + (16 * ks + 8 * h2) * 2);
        acc0 = MFMA32(a, b0, acc0); acc1 = MFMA32(a, b1, acc1);
    }
    LAS unsigned short* OT = (LAS unsigned short*)(L + ORF);
#pragma unroll
    for (int e = 0; e < 16; ++e) { const int v = 32 * vt + crow(e, h2);
        OT[v * (RS / 2) + 32 * dt0 + c] = (unsigned short)f2bf(acc0[e]); OT[v * (RS / 2) + 32 * dt0 + 32 + c] = (unsigned short)f2bf(acc1[e]); }
    __syncthreads();
    bf16* HG = (bf16*)(F.ws + WS_HG) + (size_t)u * 16384;
#pragma unroll
    for (int i = 0; i < 4; ++i) { const int it = F.tid + 512 * i, v = it >> 4, ch16 = it & 15;
        *(v4u*)(HG + v * 128 + 8 * ch16) = *(const LAS v4u*)(L + ORF + v * RS + 16 * ch16); }
}
__device__ __forceinline__ void h2_scan(const Args& A, Ctx& F, int l) {
    unsigned* HG32 = (unsigned*)(F.ws + WS_HG); const float* DC = (const float*)(F.ws + WS_DC);
    for (int gid = F.bid * 512 + F.tid; gid < 16 * 8192; gid += F.G * 512) {
        const int bh = gid >> 13, e2 = gid & 8191, v = e2 >> 6, d = 2 * (e2 & 63);
        float s0 = 0.f, s1 = 0.f;
        for (int c0 = 0; c0 < 64; c0 += 16) {
            unsigned kc[16]; float d0[16], d1[16];
#pragma unroll
            for (int i = 0; i < 16; ++i) { const int u = bh * 64 + c0 + i; kc[i] = HG32[(size_t)u * 8192 + e2]; d0[i] = DC[u * 128 + d]; d1[i] = DC[u * 128 + d + 1]; }
            __builtin_amdgcn_sched_barrier(0);
#pragma unroll
            for (int i = 0; i < 16; ++i) { const int u = bh * 64 + c0 + i;
                HG32[(size_t)u * 8192 + e2] = pk2(s0, s1);
                s0 = d0[i] * s0 + bf2f(kc[i] & 0xffffu); s1 = d1[i] * s1 + bf2f(kc[i] >> 16); }
        }
        float* o = F.out + O_HGP + ((size_t)l * 16 + bh) * 16384;
        o[d * 128 + v] = s0; o[(d + 1) * 128 + v] = s1;
    }
}
__device__ __forceinline__ void h3_load(Ctx& F, int u, v4u (&rf)[2], v4u (&rq)[2], v4u (&rv)[2]) {
    const int bh = u >> 6, b = bh >> 2, h = bh & 3, ch = u & 63, m0 = b * TP + ch * 64;
    const bf16* PROJ = (const bf16*)(F.ws + WS_PROJ);
    tile_load(PROJ + (size_t)m0 * INW + C_F + h * 128, F.tid, rf); tile_load(PROJ + (size_t)m0 * INW + C_Q + h * 128, F.tid, rq); tile_load(PROJ + (size_t)m0 * INW + C_I + h * 128, F.tid, rv);
}
__device__ __forceinline__ void h3_unit(const Args& A, Ctx& F, int l, int u, const v4u (&rf)[2], const v4u (&rq)[2], const v4u (&rv)[2], int un, v4u (&nf)[2], v4u (&nq)[2], v4u (&nv)[2]) {
    const int bh = u >> 6, b = bh >> 2, h = bh & 3, ch = u & 63, m0 = b * TP + ch * 64;
    const int d = F.tid & 127, sc = F.tid >> 7, c = F.lane & 31, h2 = F.lane >> 5;
    const bf16* PROJ = (const bf16*)(F.ws + WS_PROJ);
    LAS unsigned char* L = F.lds;
    constexpr int OQH = 0, OKH = 64 * RS, OKC = 2 * 64 * RS, OQG = 3 * 64 * RS, OQT = OQG + 48 * RS, OAM = OQT + 64 * RS, OVT = OAM + 64 * RS64, OTOT = OVT + 128 * RS64, OEND = OTOT + 2048;
    static_assert(OEND <= RING_BYTES, "h3 LDS map");
    LAS unsigned short* QH = (LAS unsigned short*)(L + OQH); LAS unsigned short* KH = (LAS unsigned short*)(L + OKH); LAS unsigned short* KC = (LAS unsigned short*)(L + OKC);
    LAS unsigned short* QG = (LAS unsigned short*)(L + OQG); LAS unsigned short* QT = (LAS unsigned short*)(L + OQT); LAS unsigned short* AM = (LAS unsigned short*)(L + OAM);
    LAS unsigned short* VT = (LAS unsigned short*)(L + OVT); LAS float* TOT = (LAS float*)(L + OTOT); LAS float* O32 = (LAS float*)(L + OQH);
    TSEC_BEGIN(30);
    const float lb = l == 0 ? 0.f : ((const float*)(F.ws + WS_TAB))[1024 + h * 128 + d];
    f32x4 gnv[4];
#pragma unroll
    for (int i = 0; i < 4; ++i) gnv[i] = *(const f32x4*)(A.in[18 + F.z] + l * 128 + (F.tid & 7) * 16 + 4 * i);
    __syncthreads();
    tile_store(L + OQH, F.tid, rf); tile_store(L + OKH, F.tid, rq); tile_store(L + OKC, F.tid, rv);
    const bf16* gp = PROJ + (size_t)(m0 + (F.tid >> 3)) * INW + C_G + h * 128 + (F.tid & 7) * 16;
    const v4u g0 = *(const v4u*)gp, g1 = *(const v4u*)(gp + 8);
    const bf16* Srow = (const bf16*)(F.ws + WS_HG) + (size_t)u * 16384 + (size_t)(32 * (F.wave & 3) + c) * 128 + 8 * h2;
    bf16x8 sb[8];
#pragma unroll
    for (int ks = 0; ks < 8; ++ks) sb[ks] = *(const bf16x8*)(Srow + 16 * ks);
    __builtin_amdgcn_sched_barrier(0);
    for (int i = F.tid; i < 64 * RS64 / 4; i += 512) ((LAS unsigned*)AM)[i] = 0u;
    __syncthreads();
    TSEC_END(30);
    TSEC_BEGIN(31);
    HgGate g; hg_gates(lb, (const LAS unsigned short*)(L + OQH + sc * 16 * RS), d, g);
    float q[16];
#pragma unroll
    for (int j = 0; j < 16; ++j) q[j] = bf2f(((const LAS unsigned short*)(L + OKH))[(sc * 16 + j) * (RS / 2) + d]);
    TOT[sc * 128 + d] = g.cl[15];
#pragma unroll
    for (int j = 0; j < 16; ++j) VT[d * (RS64 / 2) + sc * 16 + j] = ((const LAS unsigned short*)(L + OKC))[(sc * 16 + j) * (RS / 2) + d];
    __syncthreads();
    TSEC_END(31);
    TSEC_BEGIN(32);
    const float t0 = TOT[d], t1 = TOT[128 + d], t2 = TOT[256 + d];
    const float rsc = sc == 0 ? 0.f : (sc == 1 ? t0 : (sc == 2 ? t0 + t1 : t0 + t1 + t2));
    const float ers = __expf(rsc), tot = g.cl[15];
    const float ga = sc == 2 ? __expf(t1) : __expf(t1 + t2), gb = __expf(t2);
#pragma unroll
    for (int j = 0; j < 16; ++j) {
        const int row = sc * 16 + j;
        const float qh = q[j] * __expf(g.cl[j]);
        QH[row * (RS / 2) + d] = (unsigned short)f2bf(qh);
        QT[row * (RS / 2) + d] = (unsigned short)f2bf(qh * ers);
        if (sc == 2) QG[j * (RS / 2) + d] = (unsigned short)f2bf(qh * ga);
        if (sc == 3) { QG[(16 + j) * (RS / 2) + d] = (unsigned short)f2bf(qh * ga); QG[(32 + j) * (RS / 2) + d] = (unsigned short)f2bf(qh * gb); }
        KH[row * (RS / 2) + d] = (unsigned short)f2bf(g.kf[j] * __expf(tot - g.cl[j]));
        KC[row * (RS / 2) + d] = (unsigned short)f2bf(g.kf[j] * __expf(-g.cl[j]));
    }
    h3_load(F, un, nf, nq, nv);
    __syncthreads();
    TSEC_END(32);
    TSEC_BEGIN(33);
    {
        const int r16 = F.lane & 15, kq = F.lane >> 4;
        for (int blk = F.wave; blk < 10; blk += 8) {
            int bi, bj, qoff, koff;
            if (blk < 4) { bi = blk; bj = blk; qoff = OQH + 16 * bi * RS; koff = OKC + 16 * bj * RS; }
            else if (blk < 7) { bi = blk - 3; bj = bi - 1; qoff = OQH + 16 * bi * RS; koff = OKH + 16 * bj * RS; }
            else if (blk == 7) { bi = 2; bj = 0; qoff = OQG; koff = OKH; }
            else if (blk == 8) { bi = 3; bj = 0; qoff = OQG + 16 * RS; koff = OKH; }
            else { bi = 3; bj = 1; qoff = OQG + 32 * RS; koff = OKH + 16 * RS; }
            f32x4 a4 = {0.f, 0.f, 0.f, 0.f};
#pragma unroll
            for (int ks = 0; ks < 4; ++ks) {
                const bf16x8 qa = *(const LAS bf16x8*)(L + qoff + r16 * RS + (32 * ks + 8 * kq) * 2);
                const bf16x8 kb = *(const LAS bf16x8*)(L + koff + r16 * RS + (32 * ks + 8 * kq) * 2);
                a4 = MFMA16(qa, kb, a4);
            }
#pragma unroll
            for (int e = 0; e < 4; ++e) { const int t = 4 * kq + e; float val = a4[e]; if (bi == bj && r16 > t) val = 0.f;
                AM[(16 * bi + t) * (RS64 / 2) + 16 * bj + r16] = (unsigned short)f2bf(val); }
        }
    }
    __syncthreads();
    TSEC_END(33);
    TSEC_BEGIN(34);
    const int tt = F.wave >> 2, vt = F.wave & 3;
    f32x16 acc;
#pragma unroll
    for (int e = 0; e < 16; ++e) acc[e] = 0.f;
#pragma unroll
    for (int ks = 0; ks < 4; ++ks) {
        const bf16x8 a = *(const LAS bf16x8*)(L + OAM + (32 * tt + c) * RS64 + (16 * ks + 8 * h2) * 2);
        const bf16x8 bv = *(const LAS bf16x8*)(L + OVT + (32 * vt + c) * RS64 + (16 * ks + 8 * h2) * 2);
        acc = MFMA32(a, bv, acc);
    }
#pragma unroll
    for (int ks = 0; ks < 8; ++ks) {
        const bf16x8 a = *(const LAS bf16x8*)(L + OQT + (32 * tt + c) * RS + (16 * ks + 8 * h2) * 2);
        acc = MFMA32(a, sb[ks], acc);
    }
#pragma unroll
    for (int e = 0; e < 16; ++e) O32[(32 * tt + crow(e, h2)) * 132 + 32 * vt + c] = acc[e];
    __syncthreads();
    TSEC_END(34);
    TSEC_BEGIN(35);
    {
        const int t = F.tid >> 3, vq = F.tid & 7;
        float o[16]; float ss = 0.f;
#pragma unroll
        for (int i = 0; i < 4; ++i) { const f32x4 x = *(const LAS f32x4*)(O32 + t * 132 + vq * 16 + 4 * i); o[4 * i] = x.x; o[4 * i + 1] = x.y; o[4 * i + 2] = x.z; o[4 * i + 3] = x.w;
            ss += (x.x * x.x + x.y * x.y) + (x.z * x.z + x.w * x.w); }
        ss += __shfl_xor(ss, 1); ss += __shfl_xor(ss, 2); ss += __shfl_xor(ss, 4);
        const float rstd = __builtin_amdgcn_rsqf(ss * (1.f / 128.f) + EPS);
        const float gn[16] = {gnv[0].x, gnv[0].y, gnv[0].z, gnv[0].w, gnv[1].x, gnv[1].y, gnv[1].z, gnv[1].w, gnv[2].x, gnv[2].y, gnv[2].z, gnv[2].w, gnv[3].x, gnv[3].y, gnv[3].z, gnv[3].w};
        unsigned gw_[8] = {g0.x, g0.y, g0.z, g0.w, g1.x, g1.y, g1.z, g1.w};
        unsigned ow[8];
#pragma unroll
        for (int i = 0; i < 8; ++i) {
            const float ga0 = bf2f(gw_[i] & 0xffffu), ga1 = bf2f(gw_[i] >> 16);
            const float y0 = o[2 * i] * rstd * gn[2 * i] * (ga0 * sigm(ga0)), y1 = o[2 * i + 1] * rstd * gn[2 * i + 1] * (ga1 * sigm(ga1));
            ow[i] = pk2(y0, y1);
        }
        bf16* op = (bf16*)(F.ws + WS_MIX) + (size_t)(m0 + t) * D + 256 + h * 128 + vq * 16;
        v4u w0 = {ow[0], ow[1], ow[2], ow[3]}, w1 = {ow[4], ow[5], ow[6], ow[7]};
        *(v4u*)op = w0; *(v4u*)(op + 8) = w1;
    }
    TSEC_END(35);
}

__device__ __forceinline__ void conv_tail(const Args& A, Ctx& F, int l, f32x4 acc, bf16* orow) {
    const float mean = wave_sum((acc.x + acc.y) + (acc.z + acc.w)) * (1.f / 256.f);
    const f32x4 dv = acc - mean;
    const float rstd = __builtin_amdgcn_rsqf(wave_sum((dv.x * dv.x + dv.y * dv.y) + (dv.z * dv.z + dv.w * dv.w)) * (1.f / 256.f) + EPS);
    const f32x4 lg = *(const f32x4*)(A.in[15 + F.z] + l * 256 + 4 * F.lane), lb = *(const f32x4*)(A.in[16 + F.z] + l * 256 + 4 * F.lane);
    const f32x4 y = dv * rstd * lg + lb;
    v2u w; w.x = pk2(y.x * sigm(y.x), y.y * sigm(y.y)); w.y = pk2(y.z * sigm(y.z), y.w * sigm(y.w));
    *(v2u*)(orow + 4 * F.lane) = w;
}
__device__ __forceinline__ void conv_unit(const Args& A, Ctx& F, int l, int u) {
    const int b = u >> 6, tile = u & 63, t0 = tile * 64;
    const bf16* PROJ = (const bf16*)(F.ws + WS_PROJ);
    LAS float* AL = (LAS float*)F.lds;
    v4u sv[6], sg[6];
#pragma unroll
    for (int i = 0; i < 6; ++i) { const int it = F.tid + 512 * i, row = it >> 5, cg = it & 31, t = t0 - 30 + row;
        sv[i] = (v4u){0u, 0u, 0u, 0u}; sg[i] = sv[i];
        if (it < 94 * 32 && t >= 0) { const bf16* p = PROJ + (size_t)(b * TP + t) * INW + 8 * cg; sv[i] = *(const v4u*)(p + C_AV); sg[i] = *(const v4u*)(p + C_AG); } }
    __builtin_amdgcn_sched_barrier(0);
    __syncthreads();
#pragma unroll
    for (int i = 0; i < 6; ++i) { const int it = F.tid + 512 * i, row = it >> 5, cg = it & 31;
        if (it < 94 * 32) {
            const v4u vv = sv[i], gg = sg[i]; f32x4 a0, a1;
            a0.x = bf2f(vv.x & 0xffffu) * sigm(bf2f(gg.x & 0xffffu)); a0.y = bf2f(vv.x >> 16) * sigm(bf2f(gg.x >> 16));
            a0.z = bf2f(vv.y & 0xffffu) * sigm(bf2f(gg.y & 0xffffu)); a0.w = bf2f(vv.y >> 16) * sigm(bf2f(gg.y >> 16));
            a1.x = bf2f(vv.z & 0xffffu) * sigm(bf2f(gg.z & 0xffffu)); a1.y = bf2f(vv.z >> 16) * sigm(bf2f(gg.z >> 16));
            a1.z = bf2f(vv.w & 0xffffu) * sigm(bf2f(gg.w & 0xffffu)); a1.w = bf2f(vv.w >> 16) * sigm(bf2f(gg.w >> 16));
            *(LAS f32x4*)(AL + row * 256 + 8 * cg) = a0; *(LAS f32x4*)(AL + row * 256 + 8 * cg + 4) = a1; } }
    const f32x4 cb = *(const f32x4*)(A.in[14 + F.z] + l * 256 + 4 * F.lane);
    __syncthreads();
    typedef float f32x2c __attribute__((ext_vector_type(2)));
    f32x4 acc[8];
#pragma unroll
    for (int hc = 0; hc < 2; ++hc) {
        __builtin_amdgcn_sched_barrier(0);
        f32x2c cw[31], a2[8];
#pragma unroll
        for (int j = 0; j < 31; ++j) cw[j] = *(const f32x2c*)(A.in[13 + F.z] + (size_t)(l * 31 + j) * 256 + 4 * F.lane + 2 * hc);
#pragma unroll
        for (int i = 0; i < 8; ++i) a2[i] = (f32x2c){hc ? cb.z : cb.x, hc ? cb.w : cb.y};
        __builtin_amdgcn_sched_barrier(0);
#pragma unroll
        for (int r = 0; r < 38; ++r) {
            const f32x2c row = *(const LAS f32x2c*)(AL + (8 * F.wave + r) * 256 + 4 * F.lane + 2 * hc);
#pragma unroll
            for (int i = 0; i < 8; ++i) if (r - i >= 0 && r - i <= 30) a2[i] += cw[r - i] * row;
            if ((r & 7) == 7) __builtin_amdgcn_sched_barrier(0);
        }
#pragma unroll
        for (int i = 0; i < 8; ++i) { if (hc) { acc[i].z = a2[i].x; acc[i].w = a2[i].y; } else { acc[i].x = a2[i].x; acc[i].y = a2[i].y; } }
    }
    {
        float s1[8], s2[8];
#pragma unroll
        for (int i = 0; i < 8; ++i) { s1[i] = (acc[i].x + acc[i].y) + (acc[i].z + acc[i].w); s2[i] = (acc[i].x * acc[i].x + acc[i].y * acc[i].y) + (acc[i].z * acc[i].z + acc[i].w * acc[i].w); }
#pragma unroll
        for (int o = 1; o < 64; o <<= 1) {
            float t1[8], t2[8];
#pragma unroll
            for (int i = 0; i < 8; ++i) { t1[i] = __shfl_xor(s1[i], o); t2[i] = __shfl_xor(s2[i], o); }
#pragma unroll
            for (int i = 0; i < 8; ++i) { s1[i] += t1[i]; s2[i] += t2[i]; }
        }
        const f32x4 lg = *(const f32x4*)(A.in[15 + F.z] + l * 256 + 4 * F.lane), lb = *(const f32x4*)(A.in[16 + F.z] + l * 256 + 4 * F.lane);
#pragma unroll
        for (int i = 0; i < 8; ++i) {
            const float mean = s1[i] * (1.f / 256.f), var = fmaxf(s2[i] * (1.f / 256.f) - mean * mean, 0.f);
            const float rstd = __builtin_amdgcn_rsqf(var + EPS);
            const f32x4 y = (acc[i] - mean) * rstd * lg + lb;
            v2u w; w.x = pk2(y.x * sigm(y.x), y.y * sigm(y.y)); w.y = pk2(y.z * sigm(y.z), y.w * sigm(y.w));
            *(v2u*)((bf16*)(F.ws + WS_MIX) + (size_t)(b * TP + t0 + 8 * F.wave + i) * D + 4 * F.lane) = w;
        }
    }
    if (tile == 63) {
        float* o = F.out + O_CONVP + (size_t)(l * 4 + b) * 30 * 256;
        for (int i = F.tid; i < 30 * 256; i += 512) o[i] = AL[64 * 256 + i];
    }
}
constexpr int VS = 528;
__device__ __forceinline__ void attn_unit(const Args& A, Ctx& F, int l, int u) {
    const int b = u >> 6, blk = (u >> 1) & 31, kvh = u & 1;
    const int c = F.lane & 31, h2 = F.lane >> 5;
    const bf16* PROJ = (const bf16*)(F.ws + WS_PROJ);
    LAS unsigned char* L = F.lds;
    LAS unsigned short* VTt = (LAS unsigned short*)L;
    LAS float* BTl = (LAS float*)(L + 64 * VS);
    const int tok0 = b * TP + (blk - 1) * 128;
    const int g = F.wave >> 2, qs = F.wave & 3, hq = 2 * kvh + g;
    const int mq = b * TP + blk * 128 + 32 * qs + c;
    bf16x8 bq[4];
#pragma unroll
    for (int ks = 0; ks < 4; ++ks) bq[ks] = *(const bf16x8*)(PROJ + (size_t)mq * INW + C_QA + hq * 64 + 16 * ks + 8 * h2);
#define ATTN_LOADK(dst, j) do { const int kidx_ = 32 * (qs + (j)) + c; const bool ex_ = (blk > 0 || kidx_ >= 128); \
        _Pragma("unroll") for (int ks = 0; ks < 4; ++ks) { dst[ks] = (bf16x8){0, 0, 0, 0, 0, 0, 0, 0}; \
            if (ex_) dst[ks] = *(const bf16x8*)(PROJ + (size_t)(tok0 + kidx_) * INW + C_KA + kvh * 64 + 16 * ks + 8 * h2); } } while (0)
    bf16x8 ak0[4], ak1[4];
    ATTN_LOADK(ak0, 0); ATTN_LOADK(ak1, 1);
    const float sink = A.in[19 + F.z][l * 4 + hq];
    float btv = 0.f; { const int gg = F.tid / 224, ix = F.tid % 224 - 32; if (F.tid < 448 && ix >= 0 && ix <= 128) btv = ((const float*)(F.ws + WS_TAB))[(128 - ix) * 4 + 2 * kvh + gg]; }
    __builtin_amdgcn_sched_barrier(0);
    __syncthreads();
    if (F.tid < 448) BTl[F.tid] = btv;
    f32x16 S[5];
#pragma unroll
    for (int j = 0; j < 5; ++j)
#pragma unroll
        for (int e = 0; e < 16; ++e) S[j][e] = 0.f;
    bf16x8 ak2[4], ak3[4];
    ATTN_LOADK(ak2, 2); ATTN_LOADK(ak3, 3);
    __builtin_amdgcn_sched_barrier(0);
#pragma unroll
    for (int ks = 0; ks < 4; ++ks) { S[0] = MFMA32(ak0[ks], bq[ks], S[0]); S[1] = MFMA32(ak1[ks], bq[ks], S[1]); }
    ATTN_LOADK(ak0, 4);
#pragma unroll
    for (int ks = 0; ks < 4; ++ks) { S[2] = MFMA32(ak2[ks], bq[ks], S[2]); S[3] = MFMA32(ak3[ks], bq[ks], S[3]); }
#pragma unroll
    for (int ks = 0; ks < 4; ++ks) S[4] = MFMA32(ak0[ks], bq[ks], S[4]);
#undef ATTN_LOADK
    v4u vst[4];
#pragma unroll
    for (int i = 0; i < 4; ++i) { const int it = F.tid + 512 * i, pos = it >> 3, pl = pos & 31, kidx = (pos & ~31) | (pl & 0x13) | ((pl & 4) << 1) | ((pl & 8) >> 1), chn = it & 7; vst[i] = (v4u){0u, 0u, 0u, 0u};
        if (blk > 0 || kidx >= 128) vst[i] = *(const v4u*)(PROJ + (size_t)(tok0 + kidx) * INW + C_VA + kvh * 64 + 8 * chn); }
    __builtin_amdgcn_sched_barrier(0);
    __syncthreads();
    float mx = -INFINITY;
    const LAS float* trp = BTl + g * 224 + 32 + 4 * h2 - c;
#pragma unroll
    for (int j = 0; j < 5; ++j) {
        float bia[16];
#pragma unroll
        for (int e = 0; e < 16; ++e) bia[e] = trp[32 * j + 8 * (e >> 2) + (e & 3)];
#pragma unroll
        for (int e = 0; e < 16; e += 4) asm volatile("" : "+v"(bia[e]), "+v"(bia[e + 1]), "+v"(bia[e + 2]), "+v"(bia[e + 3]));
#pragma unroll
        for (int e = 0; e < 16; ++e) {
            const int cr = crow(e, h2), rel = 128 + c - 32 * j - cr, kidx = 32 * (qs + j) + cr;
            const bool ok = rel >= 0 && rel <= 128 && (blk > 0 || kidx >= 128);
            const float s = ok ? S[j][e] * 0.125f + bia[e] : -INFINITY;
            S[j][e] = s; mx = fmaxf(mx, s);
        }
        __builtin_amdgcn_sched_barrier(0);
    }
    mx = fmaxf(mx, __shfl_xor(mx, 32)); mx = fmaxf(mx, sink);
    float sum = 0.f;
#pragma unroll
    for (int j = 0; j < 5; ++j)
#pragma unroll
        for (int e = 0; e < 16; ++e) { const float p = __expf(S[j][e] - mx); S[j][e] = p; sum += p; if (e == 15) __builtin_amdgcn_sched_barrier(0); }
    sum += __shfl_xor(sum, 32);
    const float inv = 1.f / (sum + __expf(sink - mx));
#pragma unroll
    for (int i = 0; i < 4; ++i) { const int it = F.tid + 512 * i, pos = it >> 3, chn = it & 7;
        unsigned w0 = vst[i].x, w1 = vst[i].y, w2 = vst[i].z, w3 = vst[i].w;
        if (chn & 1) { const unsigned t0 = __builtin_amdgcn_alignbit(w1, w0, 16), t1 = __builtin_amdgcn_alignbit(w2, w1, 16), t2 = __builtin_amdgcn_alignbit(w3, w2, 16), t3 = __builtin_amdgcn_alignbit(w0, w3, 16); w0 = t0; w1 = t1; w2 = t2; w3 = t3; }
        if (chn & 2) { const unsigned t0 = w1, t1 = w2, t2 = w3, t3 = w0; w0 = t0; w1 = t1; w2 = t2; w3 = t3; }
        if (chn & 4) { const unsigned t0 = w2, t1 = w3, t2 = w0, t3 = w1; w0 = t0; w1 = t1; w2 = t2; w3 = t3; }
        const unsigned w[4] = {w0, w1, w2, w3};
#pragma unroll
        for (int e = 0; e < 8; ++e) VTt[(8 * chn + ((e + chn) & 7)) * (VS / 2) + pos] = (unsigned short)((e & 1) ? (w[e >> 1] >> 16) : (w[e >> 1] & 0xffffu)); }
    __syncthreads();
    f32x16 O0, O1;
#pragma unroll
    for (int e = 0; e < 16; ++e) { O0[e] = 0.f; O1[e] = 0.f; }
#pragma unroll
    for (int j = 0; j < 5; ++j)
#pragma unroll
        for (int s2 = 0; s2 < 2; ++s2) {
            const bf16x8 pb = pk8(S[j][8 * s2], S[j][8 * s2 + 1], S[j][8 * s2 + 2], S[j][8 * s2 + 3], S[j][8 * s2 + 4], S[j][8 * s2 + 5], S[j][8 * s2 + 6], S[j][8 * s2 + 7]);
            const int slot = 32 * (qs + j) + 16 * s2 + 8 * h2;
            const bf16x8 av0 = *(const LAS bf16x8*)(L + c * VS + slot * 2), av1 = *(const LAS bf16x8*)(L + (32 + c) * VS + slot * 2);
            O0 = MFMA32(av0, pb, O0); O1 = MFMA32(av1, pb, O1);
            __builtin_amdgcn_sched_barrier(0);
        }
    bf16* op = (bf16*)(F.ws + WS_MIX) + (size_t)mq * D + 768 + hq * 64;
#pragma unroll
    for (int gq = 0; gq < 4; ++gq) {
        v2u w0, w1;
        w0.x = pk2(O0[4 * gq] * inv, O0[4 * gq + 1] * inv); w0.y = pk2(O0[4 * gq + 2] * inv, O0[4 * gq + 3] * inv);
        w1.x = pk2(O1[4 * gq] * inv, O1[4 * gq + 1] * inv); w1.y = pk2(O1[4 * gq + 2] * inv, O1[4 * gq + 3] * inv);
        *(v2u*)(op + 8 * gq + 4 * h2) = w0; *(v2u*)(op + 32 + 8 * gq + 4 * h2) = w1;
    }
    if (blk == 31) {
        v4u kk[2], vv[2];
#pragma unroll
        for (int i = 0; i < 2; ++i) { const int it = F.tid + 512 * i, j = it >> 3, c8 = 8 * (it & 7);
            const bf16* p = PROJ + (size_t)(b * TP + 3968 + j) * INW + kvh * 64 + c8; kk[i] = *(const v4u*)(p + C_KA); vv[i] = *(const v4u*)(p + C_VA); }
        __builtin_amdgcn_sched_barrier(0);
#pragma unroll
        for (int i = 0; i < 2; ++i) { const int it = F.tid + 512 * i, j = it >> 3, c8 = 8 * (it & 7);
            const size_t oi = (((size_t)(l * 4 + b) * 128 + j) * 2 + kvh) * 64 + c8;
            const unsigned kw[4] = {kk[i].x, kk[i].y, kk[i].z, kk[i].w}, vw[4] = {vv[i].x, vv[i].y, vv[i].z, vv[i].w};
#pragma unroll
            for (int h4 = 0; h4 < 2; ++h4) {
                f32x4 ko, vo;
                ko.x = bf2f(kw[2 * h4] & 0xffffu); ko.y = bf2f(kw[2 * h4] >> 16); ko.z = bf2f(kw[2 * h4 + 1] & 0xffffu); ko.w = bf2f(kw[2 * h4 + 1] >> 16);
                vo.x = bf2f(vw[2 * h4] & 0xffffu); vo.y = bf2f(vw[2 * h4] >> 16); vo.z = bf2f(vw[2 * h4 + 1] & 0xffffu); vo.w = bf2f(vw[2 * h4 + 1] >> 16);
                *(f32x4*)(F.out + O_KP + oi + 4 * h4) = ko; *(f32x4*)(F.out + O_VP + oi + 4 * h4) = vo; } }
    }
}

__device__ __forceinline__ void samp_b_unit(const Args& A, Ctx& F, int l, int u) {
    const bf16* PROJ = (const bf16*)(F.ws + WS_PROJS) - (size_t)NP * INW;
    const int bs = u >> 1, hf = u & 1, m0 = NP + 4 * bs;
    LAS unsigned char* L = F.lds;
    constexpr int OFL = 0, OCV = 34 * 1024, OKL = OCV + 4096, OVTL = OKL + 144 * RS64, OQL = OVTL + 64 * 336, OSL = 0, OPL = 16 * 592, OENDB = OQL + 16 * RS64;
    static_assert(OENDB <= RING_BYTES && OPL + 16 * 336 <= OCV, "samp_b LDS map");
    LAS float* FL = (LAS float*)(L + OFL); LAS float* CV = (LAS float*)(L + OCV);
    const float* ck = A.in[4 + F.z] + ((size_t)l * 128 + bs) * 128 * 128 + hf * 64;
    const float* cv = A.in[5 + F.z] + ((size_t)l * 128 + bs) * 128 * 128 + hf * 64;
    float* okp = F.out + O_KS + ((size_t)l * 128 + bs) * 128 * 128 + hf * 64; float* ovp = F.out + O_VS + ((size_t)l * 128 + bs) * 128 * 128 + hf * 64;
    const float* cc = A.in[2 + F.z] + ((size_t)l * 128 + bs) * 30 * 256;
    f32x4 fr4[4];
#pragma unroll
    for (int i = 0; i < 4; ++i) { const int it = F.tid + 512 * i; fr4[i] = it < 30 * 64 ? *(const f32x4*)(cc + 4 * it) : (f32x4){0.f, 0.f, 0.f, 0.f}; }
    f32x4 kr[2][2], vr[2][2];
#pragma unroll
    for (int i = 0; i < 2; ++i) { const int it = F.tid + 512 * i, j = it >> 3, c8 = 8 * (it & 7);
        kr[i][0] = *(const f32x4*)(ck + j * 128 + c8); kr[i][1] = *(const f32x4*)(ck + j * 128 + c8 + 4); vr[i][0] = *(const f32x4*)(cv + j * 128 + c8); vr[i][1] = *(const f32x4*)(cv + j * 128 + c8 + 4); }
    const int nt_ = F.tid >> 8, nch = F.tid & 255;
    const bf16* pa0 = PROJ + (size_t)(m0 + nt_) * INW + nch; const bf16* pa1 = PROJ + (size_t)(m0 + 2 + nt_) * INW + nch;
    const unsigned short av0 = pa0[C_AV], ag0 = pa0[C_AG], av1 = pa1[C_AV], ag1 = pa1[C_AG];
    unsigned short kb = 0, vb = 0;
    if (F.tid < 256) { const int t = F.tid >> 6, r = F.tid & 63; const bf16* p = PROJ + (size_t)(m0 + t) * INW + hf * 64 + r; kb = p[C_KA]; vb = p[C_VA]; }
    unsigned short qv[2];
#pragma unroll
    for (int i = 0; i < 2; ++i) { const int ix = F.tid + 512 * i, row = ix >> 6, dd = ix & 63; qv[i] = PROJ[(size_t)(m0 + (row >> 2)) * INW + C_QA + (row & 3) * 64 + dd]; }
    const float sinkv = A.in[19 + F.z][l * 4 + 2 * hf + (F.wave & 1)];
    const float cbias = A.in[14 + F.z][l * 256 + nch];
    __builtin_amdgcn_sched_barrier(0);
    __syncthreads();
#pragma unroll
    for (int i = 0; i < 4; ++i) { const int it = F.tid + 512 * i; if (it < 30 * 64) *(LAS f32x4*)(FL + 4 * it) = fr4[i]; }
    FL[(30 + nt_) * 256 + nch] = bf2f(av0) * sigm(bf2f(ag0)); FL[(32 + nt_) * 256 + nch] = bf2f(av1) * sigm(bf2f(ag1));
#pragma unroll
    for (int i = 0; i < 2; ++i) { const int it = F.tid + 512 * i, j = it >> 3, c8 = 8 * (it & 7);
        const f32x4 k0 = kr[i][0], k1 = kr[i][1], v0 = vr[i][0], v1 = vr[i][1];
        if (j >= 4) { __builtin_nontemporal_store(k0, (f32x4*)(okp + (j - 4) * 128 + c8)); __builtin_nontemporal_store(k1, (f32x4*)(okp + (j - 4) * 128 + c8 + 4)); __builtin_nontemporal_store(v0, (f32x4*)(ovp + (j - 4) * 128 + c8)); __builtin_nontemporal_store(v1, (f32x4*)(ovp + (j - 4) * 128 + c8 + 4)); }
        v4u kw; kw.x = pk2(k0.x, k0.y); kw.y = pk2(k0.z, k0.w); kw.z = pk2(k1.x, k1.y); kw.w = pk2(k1.z, k1.w);
        *(LAS v4u*)(L + OKL + j * RS64 + 2 * c8) = kw;
        const float vv[8] = {v0.x, v0.y, v0.z, v0.w, v1.x, v1.y, v1.z, v1.w};
#pragma unroll
        for (int e = 0; e < 8; ++e) *(LAS unsigned short*)(L + OVTL + (c8 + e) * 336 + 2 * j) = (unsigned short)f2bf(vv[e]); }
    if (F.tid < 256) { const int t = F.tid >> 6, r = F.tid & 63;
        *(LAS unsigned short*)(L + OKL + (128 + t) * RS64 + 2 * r) = kb; *(LAS unsigned short*)(L + OVTL + r * 336 + 2 * (128 + t)) = vb;
        okp[(124 + t) * 128 + r] = bf2f(kb); ovp[(124 + t) * 128 + r] = bf2f(vb); }
    for (int i = F.tid; i < 12 * 64; i += 512) *(LAS unsigned short*)(L + OKL + (132 + (i >> 6)) * RS64 + 2 * (i & 63)) = 0;
    for (int i = F.tid; i < 64 * 28; i += 512) *(LAS unsigned short*)(L + OVTL + (i / 28) * 336 + 2 * (132 + i % 28)) = 0;
#pragma unroll
    for (int i = 0; i < 2; ++i) { const int ix = F.tid + 512 * i, row = ix >> 6, dd = ix & 63; *(LAS unsigned short*)(L + OQL + row * RS64 + 2 * dd) = qv[i]; }
    __syncthreads();
    {
        const int ch = nch, tok = 2 * hf + nt_;
        float a0 = cbias;
#pragma unroll
        for (int j = 0; j < 31; ++j) a0 += A.in[13 + F.z][(size_t)(l * 31 + j) * 256 + ch] * FL[(tok + j) * 256 + ch];
        CV[tok * 256 + ch] = a0;
    }
    { float* o = F.out + O_CONVS + ((size_t)l * 128 + bs) * 30 * 256 + hf * 15 * 256; for (int i = F.tid; i < 15 * 64; i += 512) *(f32x4*)(o + 4 * i) = *(const LAS f32x4*)(FL + (4 + 15 * hf) * 256 + 4 * i); }
    __syncthreads();
    if (F.wave < 2) { const int tok = 2 * hf + F.wave; const f32x4 acc = *(const LAS f32x4*)(CV + tok * 256 + 4 * F.lane); conv_tail(A, F, l, acc, (bf16*)(F.ws + WS_MIX) + (size_t)(m0 + tok) * D); }
    const int r16 = F.lane & 15, q4 = F.lane >> 4;
    const float* BT = (const float*)(F.ws + WS_TAB);
    for (int kt = F.wave; kt < 9; kt += 8) {
        f32x4 s0 = {0.f, 0.f, 0.f, 0.f};
#pragma unroll
        for (int ks = 0; ks < 2; ++ks) {
            const bf16x8 qa = *(const LAS bf16x8*)(L + OQL + r16 * RS64 + (32 * ks + 8 * q4) * 2);
            const bf16x8 k0 = *(const LAS bf16x8*)(L + OKL + (16 * kt + r16) * RS64 + (32 * ks + 8 * q4) * 2);
            s0 = MFMA16(qa, k0, s0);
        }
        const int key = 16 * kt + r16, t = q4; const bool ok = key >= t && key <= 128 + t;
#pragma unroll
        for (int g = 0; g < 2; ++g) { const int e = 2 * hf + g; const float sv = (hf ? (g ? s0[3] : s0[2]) : (g ? s0[1] : s0[0])) * 0.125f;
            const int rel_ = 128 + t - key; float bia = BT[(rel_ < 0 ? 0 : (rel_ > 128 ? 128 : rel_)) * 4 + e]; asm volatile("" : "+v"(bia));
            ((LAS float*)(L + OSL))[(4 * t + e) * 148 + key] = ok ? sv + bia : -INFINITY; }
    }
    __syncthreads();
    {
        const int row = 4 * (F.wave >> 1) + 2 * hf + (F.wave & 1);
        const LAS float* sl = (const LAS float*)(L + OSL) + row * 148;
        float sc[3];
#pragma unroll
        for (int i = 0; i < 3; ++i) { const int j = F.lane + 64 * i; sc[i] = j < 144 ? sl[j] : -INFINITY; }
        const float mx = fmaxf(wave_max(fmaxf(fmaxf(sc[0], sc[1]), sc[2])), sinkv);
        float p[3], ps = 0.f;
#pragma unroll
        for (int i = 0; i < 3; ++i) { p[i] = __expf(sc[i] - mx); ps += p[i]; }
        const float inv = __builtin_amdgcn_rcpf(wave_sum(ps) + __expf(sinkv - mx));
#pragma unroll
        for (int i = 0; i < 3; ++i) { const int j = F.lane + 64 * i; if (j < 160) *(LAS unsigned short*)(L + OPL + row * 336 + 2 * j) = (unsigned short)f2bf(p[i] * inv); }
    }
    __syncthreads();
    if (F.wave < 4) {
        const int dt = F.wave;
        f32x4 o4 = {0.f, 0.f, 0.f, 0.f};
#pragma unroll
        for (int ks = 0; ks < 5; ++ks) {
            const bf16x8 pa = *(const LAS bf16x8*)(L + OPL + r16 * 336 + (32 * ks + 8 * q4) * 2);
            const bf16x8 vb8 = *(const LAS bf16x8*)(L + OVTL + (16 * dt + r16) * 336 + (32 * ks + 8 * q4) * 2);
            o4 = MFMA16(pa, vb8, o4);
        }
#pragma unroll
        for (int g = 0; g < 2; ++g) { const int e = 2 * hf + g; const float ov = hf ? (g ? o4[3] : o4[2]) : (g ? o4[1] : o4[0]);
            ((bf16*)(F.ws + WS_MIX))[(size_t)(m0 + q4) * D + 768 + e * 64 + 16 * dt + r16] = (bf16)f2bf(ov); }
    }
}
__device__ __forceinline__ void samp_hg_load(const Args& A, Ctx& F, int l, int u, float (&S)[32]) {
    const int bs = u >> 2, h = u & 3, v = F.tid & 127, dq = F.tid >> 7;
    const float* S0 = A.in[3 + F.z] + (((size_t)l * 128 + bs) * 4 + h) * 16384 + (size_t)(dq * 32) * 128 + v;
#pragma unroll
    for (int i = 0; i < 32; ++i) S[i] = S0[i * 128];
    __builtin_amdgcn_sched_barrier(0);
}
__device__ __forceinline__ void samp_hg_unit(const Args& A, Ctx& F, int l, int u, float (&S)[32]) {
    const int bs = u >> 2, h = u & 3, m0 = NP + 4 * bs;
    const bf16* PROJ = (const bf16*)(F.ws + WS_PROJS) - (size_t)NP * INW;
    LAS float* FT = (LAS float*)F.lds;
    LAS float* KT = FT + 512;
    LAS float* QT = KT + 512;
    LAS float* VV = QT + 512;
    LAS float* OP = VV + 512;
    LAS float* SS = OP + 2048;
    const int t_ = F.tid >> 7, d_ = F.tid & 127; const bf16* p_ = PROJ + (size_t)(m0 + t_) * INW + h * 128 + d_;
    const float lb_ = l == 0 ? 0.f : ((const float*)(F.ws + WS_TAB))[1024 + h * 128 + d_];
    const float xf_ = bf2f(p_[C_F]), xq_ = bf2f(p_[C_Q]), xi_ = bf2f(p_[C_I]), gg_ = bf2f(p_[C_G]), gn_ = A.in[18 + F.z][l * 128 + d_];
    __syncthreads();
    {
        const float e = __expf(-xf_), sg = __builtin_amdgcn_rcpf(1.f + e);
        FT[F.tid] = lb_ + (1.f - lb_) * sg; KT[F.tid] = (1.f - lb_) * e * sg; QT[F.tid] = xq_; VV[F.tid] = xi_;
    }
    __syncthreads();
    const int v = F.tid & 127, dq = F.tid >> 7;
#pragma unroll
    for (int t = 0; t < 4; ++t) {
        const float vt = VV[t * 128 + v]; float part = 0.f;
#pragma unroll
        for (int i = 0; i < 32; ++i) { const int d = dq * 32 + i; S[i] = FT[t * 128 + d] * S[i] + KT[t * 128 + d] * vt; part += QT[t * 128 + d] * S[i]; }
        OP[(dq * 4 + t) * 128 + v] = part;
    }
    float* So = F.out + O_HGS + (((size_t)l * 128 + bs) * 4 + h) * 16384 + (size_t)(dq * 32) * 128 + v;
#pragma unroll
    for (int i = 0; i < 32; ++i) __builtin_nontemporal_store(S[i], So + i * 128);
    __syncthreads();
    {
        const int t = F.tid >> 7, vv = F.tid & 127;
        const float o = (OP[(0 * 4 + t) * 128 + vv] + OP[(1 * 4 + t) * 128 + vv]) + (OP[(2 * 4 + t) * 128 + vv] + OP[(3 * 4 + t) * 128 + vv]);
        const float ss = wave_sum(o * o);
        if (F.lane == 0) SS[t * 2 + (F.wave & 1)] = ss;
        __syncthreads();
        const float rstd = __builtin_amdgcn_rsqf((SS[t * 2] + SS[t * 2 + 1]) * (1.f / 128.f) + EPS);
        ((bf16*)(F.ws + WS_MIX))[(size_t)(m0 + t) * D + 256 + h * 128 + vv] = (bf16)f2bf(o * rstd * gn_ * (gg_ * sigm(gg_)));
    }
}

constexpr int SHWLD = 4096;
template <int ACT> struct SEpiStore {
    bf16* O; int ldc; const float* rss; const float* shw;
    __device__ __forceinline__ void operator()(int row, int col, const f32x4 v, int lane) const {
        f32x4 w = v;
        if (rss) { const float rstd = __builtin_amdgcn_rsqf(rss[row] * (1.f / D) + EPS); w = v * rstd + *(const f32x4*)(shw + (size_t)modrow(row) * SHWLD + col); }
        if (ACT == 1) {
#pragma unroll
            for (int i = 0; i < 4; ++i) { const float r = w[i] > 0.f ? w[i] : 0.f; w[i] = r * r; } }
        v2u o; o.x = pk2(w[0], w[1]); o.y = pk2(w[2], w[3]);
        *(v2u*)(O + (size_t)row * ldc + col) = o;
    }
};
template <bool BF32, bool OF32> struct SEpiGateRes {
    const void* base; void* out; const float* gate; bf16* xs; float* rss; const float* gam; const float* sc;
    __device__ __forceinline__ void operator()(int row, int col, const f32x4 v, int lane) const {
        const int mr = modrow(row);
        const f32x4 g4 = *(const f32x4*)(gate + (size_t)mr * MODLD + col);
        f32x4 b4;
        if (BF32) b4 = *(const f32x4*)((const float*)base + (size_t)(row - NP) * D + col);
        else { const v2u w = *(const v2u*)((const bf16*)base + (size_t)row * D + col); b4 = (f32x4){bf2f(w.x & 0xffffu), bf2f(w.x >> 16), bf2f(w.y & 0xffffu), bf2f(w.y >> 16)}; }
        const f32x4 x = b4 + g4 * v;
        if (OF32) *(f32x4*)((float*)out + (size_t)row * D + col) = x;
        else { v2u o; o.x = pk2(x[0], x[1]); o.y = pk2(x[2], x[3]); *(v2u*)((bf16*)out + (size_t)row * D + col) = o; }
        if (xs) {
            const f32x4 s4 = *(const f32x4*)(gam + col) * (*(const f32x4*)(sc + (size_t)mr * MODLD + col) + 1.f), y = x * s4;
            v2u o; o.x = pk2(y[0], y[1]); o.y = pk2(y[2], y[3]);
            *(v2u*)(xs + (size_t)row * D + col) = o;
        }
        if (rss) {
            float ss = (x[0] * x[0] + x[1] * x[1]) + (x[2] * x[2] + x[3] * x[3]);
            ss += __shfl_xor(ss, 16); ss += __shfl_xor(ss, 32);
            if ((lane >> 4) == 0) (void)__hip_atomic_fetch_add(rss + row, ss, __ATOMIC_RELAXED, __HIP_MEMORY_SCOPE_AGENT);
        }
    }
};
struct SEpiF32 {
    float* O; int ld;
    __device__ __forceinline__ void operator()(int row, int col, const f32x4 v, int lane) const { *(f32x4*)(O + (size_t)row * ld + col) = v; }
};
template <int NJ, class Epi>
__device__ __forceinline__ void sgemm_phase(Ctx& F, const bf16* Arow  , const bf16* Bt, int N, int K, const Epi& E, const int ntm = 8, const int row0 = NP) {
    static_assert(NJ <= 4, "wave-private image: 8 KiB of A + 2 NJ KiB of B");
    const int r16 = F.lane & 15, q4 = F.lane >> 4, lr = F.lane >> 3, lp = F.lane & 7;
    const int ntn = N / (16 * NJ), ksl = K / 8, nss = ksl / 64;
    LAS unsigned char* WL = F.lds + F.wave * 16384;
    LAS f32x4* RED = (LAS f32x4*)F.lds;
    TSEC_BEGIN(50);
    constexpr int SLOT = 4 * NJ * 64;
    const bool grp = ((F.G & 7) == 0) && ((ntn & 7) == 0);
    const int xg = F.bid & 7, wpx = grp ? (F.G >> 3) : F.G, cpx = ntn >> 3;
    for (int w = grp ? (F.bid >> 3) : F.bid; w < (grp ? ntm * cpx : ntm * ntn); w += wpx) {
        const int tm = w % ntm, tn = grp ? xg * cpx + w / ntm : w / ntm;
        const bf16* ap = Arow + (size_t)(64 * tm + lr) * K + F.wave * ksl + 8 * lp;
        const bf16* bp = Bt + (size_t)(16 * NJ * tn + lr) * K + F.wave * ksl + 8 * lp;
        f32x4 acc[4][NJ];
#pragma unroll
        for (int i = 0; i < 4; ++i)
#pragma unroll
            for (int j = 0; j < NJ; ++j) acc[i][j] = (f32x4){0.f, 0.f, 0.f, 0.f};
        v4u ra[8], rb[2 * NJ];
#define SG_LOAD(ss) do { _Pragma("unroll") for (int t = 0; t < 8; ++t) ra[t] = *(const v4u*)(ap + (size_t)(8 * t) * K + 64 * (ss)); \
                          _Pragma("unroll") for (int t = 0; t < 2 * NJ; ++t) rb[t] = *(const v4u*)(bp + (size_t)(8 * t) * K + 64 * (ss)); } while (0)
        SG_LOAD(0);
        __builtin_amdgcn_sched_barrier(0);
        __syncthreads();
        for (int ss = 0; ss < nss; ++ss) {
#pragma unroll
            for (int t = 0; t < 8; ++t) { const int r = 8 * t + lr; *(LAS v4u*)(WL + r * 128 + ((lp ^ (r & 7)) << 4)) = ra[t]; }
#pragma unroll
            for (int t = 0; t < 2 * NJ; ++t) { const int r = 8 * t + lr; *(LAS v4u*)(WL + 8192 + r * 128 + ((lp ^ (r & 7)) << 4)) = rb[t]; }
            __builtin_amdgcn_sched_barrier(0);
            if (ss + 1 < nss) SG_LOAD(ss + 1);
            __builtin_amdgcn_sched_barrier(0);
#pragma unroll
            for (int s = 0; s < 2; ++s) {
                bf16x8 fa[4], fb[NJ];
#pragma unroll
                for (int i = 0; i < 4; ++i) { const int r = 16 * i + r16; fa[i] = *(const LAS bf16x8*)(WL + r * 128 + (((4 * s + q4) ^ (r & 7)) << 4)); }
#pragma unroll
                for (int j = 0; j < NJ; ++j) { const int r = 16 * j + r16; fb[j] = *(const LAS bf16x8*)(WL + 8192 + r * 128 + (((4 * s + q4) ^ (r & 7)) << 4)); }
#pragma unroll
                for (int i = 0; i < 4; ++i)
#pragma unroll
                    for (int j = 0; j < NJ; ++j) acc[i][j] = MFMA16(fb[j], fa[i], acc[i][j]);
            }
            __builtin_amdgcn_sched_barrier(0);
        }
#undef SG_LOAD
        __syncthreads();
#pragma unroll
        for (int i = 0; i < 4; ++i)
#pragma unroll
            for (int j = 0; j < NJ; ++j) RED[(F.wave * 4 + i) * NJ * 64 + j * 64 + F.lane] = acc[i][j];
        __syncthreads();
#pragma unroll
        for (int q = 0; q < (SLOT + 511) / 512; ++q) {
            const int p = F.tid + 512 * q, ln = p & 63, ij = p >> 6, j = ij % NJ, mi = ij / NJ;
            if (p >= SLOT) break;
            f32x4 v = RED[p];
#pragma unroll
            for (int k4 = 1; k4 < 8; ++k4) v += RED[k4 * SLOT + p];
            E(row0 + 64 * tm + 16 * mi + (ln & 15), 16 * NJ * tn + 16 * j + 4 * (ln >> 4), v, ln);
        }
    }
    TSEC_END(50);
}

#ifndef MK_PER_PHASE
#define MK_PER_PHASE 0
#endif
#ifndef PH_MASK
#define PH_MASK 0xFFFF
#endif
#define PHON(k) ((PH_MASK >> (k)) & 1)
#ifndef PROBE_REP
#define PROBE_REP -1
#endif
#ifndef PROBE_SPIN
#define PROBE_SPIN -1
#endif
#define RELAUNDER() do { int tid_ = F.tid, bid_ = __builtin_amdgcn_readfirstlane(F.bid), g_ = __builtin_amdgcn_readfirstlane(F.G), z_ = __builtin_amdgcn_readfirstlane(F.z); asm volatile("" : "+s"(z_), "+s"(bid_), "+s"(g_)); asm volatile("" : "+v"(tid_)); \
    F.ws = args.ws + z_; F.out = args.out + z_; F.z = z_; F.tid = tid_; F.lane = tid_ & 63; F.wave = __builtin_amdgcn_readfirstlane(tid_ >> 6); F.bid = bid_; F.G = g_; } while (0)
#define SUBPROBE(k, ...) do { RELAUNDER(); const unsigned long long st0_ = PROBE_SPIN == (k) ? __builtin_amdgcn_s_memrealtime() : 0ull; __VA_ARGS__; if (PROBE_SPIN == (k)) { __syncthreads(); const unsigned long long st1_ = __builtin_amdgcn_s_memrealtime(), du_ = (st1_ - st0_) * PROBE_N; while (__builtin_amdgcn_s_memrealtime() - st1_ < du_) __builtin_amdgcn_s_sleep(8); } } while (0)
__device__ __forceinline__ void sample_gate_gemm(const Args& args, Ctx& F, int l, bool dn, bool ffin) {
    const bool from_in = (!dn && l == 0), last = dn && l == 1, fin = last && ffin;
    const int f = last ? 3 : (dn ? 1 : 2 * l); const bool fold = !last;
    bf16* xs = fold ? (bf16*)(F.ws + WS_XN) : nullptr; float* rssw = (fold || fin) ? (float*)(F.ws + WS_CTL + CTL_RSS) + (size_t)f * M : nullptr;
    const float* gam = dn ? args.in[11 + F.z] + D : args.in[21 + F.z] + l * D;
    const float* scp = (const float*)(F.ws + WS_MOD) + (size_t)(dn ? 1 : l) * MODR * MODLD + (dn ? 1 * D : 4 * D);
    const float* gate = (const float*)(F.ws + WS_MOD) + (size_t)l * MODR * MODLD + (dn ? 5 * D : 2 * D);
    const bf16* Ap = dn ? (const bf16*)(F.ws + WS_HBS) : (const bf16*)(F.ws + WS_MIX) + (size_t)NP * D; const bf16* Bp = (const bf16*)(F.ws + (dn ? WS_WDN : WS_WOUT)) + (size_t)l * (dn ? D * FF : D * D);
    bf16* XB = (bf16*)(F.ws + WS_XB);
    if (from_in) { SEpiGateRes<true, false> SE{args.in[1 + F.z], XB, gate, xs, rssw, gam, scp}; sgemm_phase<2>(F, Ap, Bp, D, dn ? FF : D, SE); }
    else if (last) { SEpiGateRes<false, true> SE{XB, F.out, gate, xs, rssw, gam, scp}; sgemm_phase<2>(F, Ap, Bp, D, dn ? FF : D, SE); }
    else { SEpiGateRes<false, false> SE{XB, XB, gate, xs, rssw, gam, scp}; sgemm_phase<2>(F, Ap, Bp, D, dn ? FF : D, SE); }
}
__device__ __forceinline__ void sample_up_gemm(const Args& args, Ctx& F, int l) {
    SEpiStore<1> SE{(bf16*)(F.ws + WS_HBS) - (size_t)NP * FF, FF, (const float*)(F.ws + WS_CTL + CTL_RSS) + (size_t)(2 * l) * M, (const float*)(F.ws + WS_SHW) + (size_t)(2 * l) * 192 * SHWLD};
    sgemm_phase<4>(F, (const bf16*)(F.ws + WS_XN) + (size_t)NP * D, (const bf16*)(F.ws + WS_WUP) + (size_t)l * FF * D, FF, D, SE);
}
__device__ __forceinline__ void sample_in_gemm(const Args& args, Ctx& F, int l) {
    const float* rss = l == 0 ? nullptr : (const float*)(F.ws + WS_CTL + CTL_RSS) + (size_t)1 * M;
    SEpiStore<0> SE{(bf16*)(F.ws + WS_PROJS) - (size_t)NP * INW, INW, rss, (const float*)(F.ws + WS_SHW) + (size_t)1 * 192 * SHWLD};
    sgemm_phase<3>(F, (const bf16*)(F.ws + WS_XN) + (size_t)NP * D, (const bf16*)(F.ws + WS_WIN) + (size_t)l * INW * D, INW, D, SE);
}
__device__ __forceinline__ unsigned* sample_words(Ctx& F, int k) { return (unsigned*)(F.ws + WS_CTL) + CW_FIN + 8192 + 2048 * k; }
__device__ __forceinline__ void sample_publish(const XcdBarrier& b, Ctx& F, int k) {
    asm volatile("s_waitcnt vmcnt(0)" ::: "memory");
    __syncthreads();
    if (F.tid == 0) {
        unsigned* w = sample_words(F, k);
        const unsigned nloc = b.st[0];
        const unsigned old = xb_add(&w[64 * b.x], 1u);
        if (old + 1u == nloc) { __builtin_amdgcn_fence(__ATOMIC_RELEASE, "agent"); asm volatile("s_waitcnt vmcnt(0)" ::: "memory"); (void)xb_add(&w[1024], 1u); }
    }
}
__device__ __forceinline__ void sample_consume(const XcdBarrier& b, Ctx& F, int k) {
    if (F.tid == 0) {
        unsigned* w = sample_words(F, k);
        const unsigned nx = b.st[1];
        while (xb_ld(&w[1024]) < nx) __builtin_amdgcn_s_sleep(2);
        __builtin_amdgcn_fence(__ATOMIC_ACQUIRE, "agent");
        asm volatile("s_waitcnt vmcnt(0)" ::: "memory");
    }
    __syncthreads();
}
__global__ void __launch_bounds__(512, 2) mk_fwd(Args args) {
    extern __shared__ __attribute__((aligned(16))) unsigned char lds[];
    Ctx F;
    F.lds = (LAS unsigned char*)lds;
    F.tid = threadIdx.x; F.lane = F.tid & 63; F.wave = __builtin_amdgcn_readfirstlane(F.tid >> 6);
    F.G = gridDim.x; F.bid = blockIdx.x; F.z = 0;
    F.out = args.out; F.ws = args.ws;
    volatile LAS unsigned* MISC = (volatile LAS unsigned*)(F.lds + MISC_OFF);
    for (int u = F.tid; u < (LDS_BYTES - LDSCTL_OFF) / 4; u += 512) ((LAS unsigned*)(F.lds + LDSCTL_OFF))[u] = 0u;
    __syncthreads();
    const int lo = args.ph_lo, hi = args.ph_hi;
    const int wave0 = F.wave;
    XcdBarrier bar; bar.bar = (unsigned*)(F.ws + WS_CTL) + CW_BAR; bar.x = 0; bar.st = nullptr;
    if (hi - lo > 1) bar = xcd_barrier_post((unsigned*)(F.ws + WS_CTL) + CW_BAR, MISC + 8, F.tid);
    for (int p = lo; p < hi; ++p) {
        const int l = p < 2 ? 0 : (p - 2) / 9, s = (p < 2 || p == NPH - 1) ? -1 : (p - 2) % 9;
        const int which = p == NPH - 1 ? 2 : (s == 0 ? 0 : (s == 6 ? 1 : -1));
        const int kind = p == 0 ? 0 : p == 1 ? 12 : (which == 2 ? 10 : (which >= 0 ? 1 : (s == 1 ? 2 : (s == 2 ? 3 : (s == 3 ? 4 : (s == 4 ? 5 : (s == 5 ? (l == 0 ? 6 : 11) : (s == 7 ? 7 : 8))))))));
        if (p == 1) continue;
        if (s == 6 || (s == 0 && l == 1)) continue;
        const bool ffin = (int)gridDim.x >= (NP / 256) * (D / 256);
        if (p == NPH - 1 && ffin) continue;
        const int nrep = (kind == PROBE_REP) ? 1 + PROBE_N : 1;
        const unsigned long long pt0 = PROBE_SPIN >= 0 ? __builtin_amdgcn_s_memrealtime() : 0ull;
        for (int rep = 0; rep < nrep; ++rep) {
        { int z_ = 0, tid_ = wave0 * 64 + (int)__builtin_amdgcn_mbcnt_hi(~0u, __builtin_amdgcn_mbcnt_lo(~0u, 0u)), bid_ = blockIdx.x, g_ = gridDim.x;
          asm volatile("" : "+s"(z_), "+s"(bid_), "+s"(g_)); asm volatile("" : "+v"(tid_));
          F.ws = args.ws + z_; F.out = args.out + z_; F.z = z_; F.tid = tid_; F.lane = tid_ & 63; F.wave = __builtin_amdgcn_readfirstlane(tid_ >> 6); F.bid = bid_; F.G = g_; }
        if (PROBE_REP == 9 && hi - lo > 1) { for (int xb = 0; xb < PROBE_N; ++xb) { xcd_arrive(bar, F.tid); xcd_wait(bar, F.tid); } }
        if (p == 0) { if (PHON(0)) p0_prologue(args, F); }
        else if (which >= 0) { if (PHON(1)) norm_phase(args, F, p == NPH - 1 ? 0 : l, which); }
        else if (s == 1 && PHON(2)) {
            pg8::Gemm g{(const pg8::bf16_t*)(F.ws + WS_XN), (const pg8::bf16_t*)(F.ws + WS_WIN) + (size_t)l * INW * D, NP, INW, D};
            pg8::StaticOrder S; S.init(NP, INW, F.G, F.bid);
            const float* rss = l == 0 ? nullptr : (const float*)(F.ws + WS_CTL + CTL_RSS) + (size_t)1 * M;
            const float* shw = (const float*)(F.ws + WS_SHW) + (size_t)1 * 192 * SHWLD;
            pg8::EpiStore<0> E{(pg8::bf16_t*)(F.ws + WS_PROJ), INW, rss, shw};
            if (l == 0) { sample_in_gemm(args, F, 0); __syncthreads(); }
            pg8::gemm_phase<pg8::EpiStore<0>, pg8::StaticOrder, true, true>(F.lds, g, S, E, F.tid);
        } else if (s == 2) {
            for (int slot = 0; slot < 5; ++slot) {
                const int ty = __builtin_amdgcn_readfirstlane((slot + F.bid) % 5);
#if PHON(7)
                if (ty == 0) {
            SUBPROBE(20, for (int u = F.bid; u < 256; u += F.G) samp_b_unit(args, F, l, u));
                }
#endif
#if PHON(6)
                if (ty == 1) {
            SUBPROBE(21, { float S[32]; samp_hg_load(args, F, l, F.bid & 511, S); for (int u = F.bid; u < 512; u += F.G) { float Sn[32]; samp_hg_load(args, F, l, (u + F.G) & 511, Sn); samp_hg_unit(args, F, l, u, S); _Pragma("unroll") for (int i = 0; i < 32; ++i) S[i] = Sn[i]; } });
                }
#endif
#if PHON(3)
                if (ty == 2) {
            SUBPROBE(22, for (int u = F.bid; u < 256; u += F.G) attn_unit(args, F, l, u));
                }
#endif
#if PHON(4)
                if (ty == 3) {
            SUBPROBE(23, for (int u = F.bid; u < 256; u += F.G) conv_unit(args, F, l, u));
                }
#endif
#if PHON(5)
                if (ty == 4) {
                        SUBPROBE(24, {   const int nh1 = -1; auto h1idx = [&](int k) -> int { if (nh1 < 0) return F.bid + F.G * k; return k < 4 ? F.bid + 256 * k : F.bid + 640; }; const int cnt = nh1 < 0 ? (1024 - F.bid + F.G - 1) / F.G : nh1; v4u rf[2], rv[2]; h1_load(F, h1idx(0) & 1023, rf, rv); for (int k = 0; k < cnt; ++k) { v4u nf[2], nv[2]; h1_load(F, h1idx(k + 1 < cnt ? k + 1 : k) & 1023, nf, nv); h1_unit(args, F, l, h1idx(k), rf, rv); rf[0] = nf[0]; rf[1] = nf[1]; rv[0] = nv[0]; rv[1] = nv[1]; } });
                }
#endif
            }
        } else if (s == 3) { if (PHON(8)) h2_scan(args, F, l); }
        else if (s == 4 && PHON(9)) { v4u rf[2], rq[2], rv[2]; h3_load(F, F.bid & 1023, rf, rq, rv); for (int u = F.bid; u < 1024; u += F.G) { v4u nf[2], nq[2], nv[2]; h3_unit(args, F, l, u, rf, rq, rv, (u + F.G) & 1023, nf, nq, nv); rf[0] = nf[0]; rf[1] = nf[1]; rq[0] = nq[0]; rq[1] = nq[1]; rv[0] = nv[0]; rv[1] = nv[1]; } }
        else if ((s == 5 || s == 8) && PHON(10)) {
            const bool dn = s == 8;
            pg8::Gemm g{(const pg8::bf16_t*)(F.ws + (dn ? WS_HB : WS_MIX)), (const pg8::bf16_t*)(F.ws + (dn ? WS_WDN : WS_WOUT)) + (size_t)l * (dn ? D * FF : D * D), NP, D, dn ? FF : D};
            pg8::StaticOrder S; S.init(NP, D, F.G, F.bid);
            const bool from_in = (!dn && l == 0);
            const bool last = dn && l == 1, fin = last && ffin;
            const int f = last ? 3 : (dn ? 1 : 2 * l); const bool fold = !last;
            bf16* xs = fold ? (bf16*)(F.ws + WS_XN) : nullptr; float* rssw = (fold || fin) ? (float*)(F.ws + WS_CTL + CTL_RSS) + (size_t)f * M : nullptr;
            unsigned* fcnt = (unsigned*)(F.ws + WS_CTL) + CW_FIN;
            const float* gam = dn ? args.in[11 + F.z] + D : args.in[21 + F.z] + l * D;
            const float* scp = (const float*)(F.ws + WS_MOD) + (size_t)(dn ? 1 : l) * MODR * MODLD + (dn ? 1 * D : 4 * D);
            const float* gatep = (const float*)(F.ws + WS_MOD) + (size_t)l * MODR * MODLD + (dn ? 5 * D : 2 * D); pg8::bf16_t* XB = (pg8::bf16_t*)(F.ws + WS_XB);
            if (fin) { pg8::EpiGateResFin EF{XB, F.out, gatep, rssw, args.in[24 + F.z], fcnt};
                pg8::gemm_phase<pg8::EpiGateResFin, pg8::StaticOrder, true, true>(F.lds, g, S, EF, F.tid); }
            else if (from_in) { pg8::EpiGateRes<true, false> E{args.in[0 + F.z], XB, gatep, (pg8::bf16_t*)xs, rssw, gam, scp};
                pg8::gemm_phase<pg8::EpiGateRes<true, false>, pg8::StaticOrder, true, true>(F.lds, g, S, E, F.tid); }
            else if (last) { pg8::EpiGateRes<false, true> E{XB, F.out, gatep, (pg8::bf16_t*)xs, rssw, gam, scp};
                pg8::gemm_phase<pg8::EpiGateRes<false, true>, pg8::StaticOrder, true, true>(F.lds, g, S, E, F.tid); }
            else { pg8::EpiGateRes<false, false> E{XB, XB, gatep, (pg8::bf16_t*)xs, rssw, gam, scp};
                pg8::gemm_phase<pg8::EpiGateRes<false, false>, pg8::StaticOrder, true, true>(F.lds, g, S, E, F.tid); }
            if (fin) { RELAUNDER(); }
            if (fin && F.bid < NS / 8) {
                const float* rssr = (const float*)(F.ws + WS_CTL + CTL_RSS) + (size_t)3 * M;
                sample_consume(bar, F, 5);
                const int m = NP + F.bid * 8 + F.wave; float* xr = F.out + (size_t)m * D; const float* gf = args.in[24 + F.z];
                f32x4 v[4], gm[4];
#pragma unroll
                for (int j = 0; j < 4; ++j) { v[j] = *(const f32x4*)(xr + 4 * F.lane + 256 * j); gm[j] = *(const f32x4*)(gf + 4 * F.lane + 256 * j); }
                const float rstd = __builtin_amdgcn_rsqf(rssr[m] * (1.f / D) + EPS);
#pragma unroll
                for (int j = 0; j < 4; ++j) *(f32x4*)(xr + 4 * F.lane + 256 * j) = v[j] * rstd * gm[j];
            }
        } else if (s == 7 && PHON(11)) {
            pg8::Gemm g{(const pg8::bf16_t*)(F.ws + WS_XN), (const pg8::bf16_t*)(F.ws + WS_WUP) + (size_t)l * FF * D, NP, FF, D};
            pg8::StaticOrder S; S.init(NP, FF, F.G, F.bid);
            const float* rss = (const float*)(F.ws + WS_CTL + CTL_RSS) + (size_t)(2 * l) * M;
            const float* shw = (const float*)(F.ws + WS_SHW) + (size_t)(2 * l) * 192 * SHWLD;
            pg8::EpiStore<1> E{(pg8::bf16_t*)(F.ws + WS_HB), FF, rss, shw};
            pg8::gemm_phase<pg8::EpiStore<1>, pg8::StaticOrder, true, true>(F.lds, g, S, E, F.tid);
        }
        }
        if (PROBE_SPIN >= 0 && kind == PROBE_SPIN) { const unsigned long long pt1 = __builtin_amdgcn_s_memrealtime(), dur = (pt1 - pt0) * PROBE_N; while (__builtin_amdgcn_s_memrealtime() - pt1 < dur) __builtin_amdgcn_s_sleep(8); }
        if (p + 1 < hi && !(ffin && p == NPH - 2)) {
            xcd_arrive(bar, F.tid);
            {
                RELAUNDER();
                const bf16* SHB = (const bf16*)(F.ws + WS_SHB); float* SHW = (float*)(F.ws + WS_SHW);
                if (p == 0) p0_gap_items(args, F, 1);
                else if (l == 0 && s == 0) p0_gap_items(args, F, 3);
                else if (l == 0 && s == 1) { SEpiF32 HE{SHW + (size_t)0 * 192 * SHWLD, SHWLD}; sgemm_phase<4>(F, SHB + (size_t)0 * 192 * 1024, (const bf16*)(F.ws + WS_WUP), FF, D, HE, 3, 0); }
                else if (l == 0 && s == 2) { SEpiF32 HE{SHW + (size_t)1 * 192 * SHWLD, SHWLD}; sgemm_phase<3>(F, SHB + (size_t)1 * 192 * 1024, (const bf16*)(F.ws + WS_WIN) + (size_t)INW * D, INW, D, HE, 3, 0); }
                else if (l == 0 && s == 3) p0_gap_items(args, F, 2);
                else if (s == 4) { sample_gate_gemm(args, F, l, false, ffin); sample_publish(bar, F, l == 0 ? 0 : 3); }
                else if (s == 5) { sample_consume(bar, F, l == 0 ? 0 : 3); sample_up_gemm(args, F, l); sample_publish(bar, F, l == 0 ? 1 : 4); }
                else if (s == 7) { sample_consume(bar, F, l == 0 ? 1 : 4); sample_gate_gemm(args, F, l, true, ffin); sample_publish(bar, F, l == 0 ? 2 : 5); }
                else if (l == 0 && s == 8) { sample_consume(bar, F, 2); sample_in_gemm(args, F, 1); }
                else if (l == 1 && s == 1) p0_gap_items(args, F, 4);
                else if (l == 1 && s == 2) p0_gap_items(args, F, 5);
                else if (l == 1 && s == 3) { SEpiF32 HE{SHW + (size_t)2 * 192 * SHWLD, SHWLD}; sgemm_phase<4>(F, SHB + (size_t)2 * 192 * 1024, (const bf16*)(F.ws + WS_WUP) + (size_t)FF * D, FF, D, HE, 3, 0); }
            }
            xcd_wait(bar, F.tid);
        }
    }
}

extern "C" void kernel_launch(void* const* d_in, const int* in_sizes, int n_in, void* d_out, int out_size, void* d_ws, size_t ws_size, hipStream_t stream) {
    static int grid = 0;
    if (grid == 0) {
        if (n_in != 25 || in_sizes[0] != NP * D || (size_t)out_size != O_END || ws_size < WS_END) {
            fprintf(stderr, "kernel_launch: unexpected shapes (n_in %d, in0 %d, out %d, ws %zu)\n", n_in, n_in > 0 ? in_sizes[0] : -1, out_size, ws_size); grid = -1; return; }
        int dev = 0, cus = 0, per_cu = 0;
        if (hipGetDevice(&dev) != hipSuccess || hipDeviceGetAttribute(&cus, hipDeviceAttributeMultiprocessorCount, dev) != hipSuccess) { grid = -1; return; }
        if (hipFuncSetAttribute((const void*)mk_fwd, hipFuncAttributeMaxDynamicSharedMemorySize, LDS_BYTES) != hipSuccess) { fprintf(stderr, "kernel_launch: hipFuncSetAttribute failed\n"); grid = -1; return; }
        if (hipOccupancyMaxActiveBlocksPerMultiprocessor(&per_cu, (const void*)mk_fwd, 512, LDS_BYTES) != hipSuccess || per_cu < 1) {
            fprintf(stderr, "kernel_launch: occupancy query reports %d blocks per CU; nothing launched\n", per_cu); (void)hipGetLastError(); grid = -1; return; }
        grid = cus;
    }
    if (grid < 0) return;
    (void)hipMemsetAsync((char*)d_ws + WS_CTL, 0, CTL_ZERO_BYTES, stream);
    Args a{};
    for (int i = 0; i < 25; ++i) a.in[i] = (const float*)d_in[i];
    a.out = (float*)d_out; a.ws = (unsigned char*)d_ws;
#if MK_PER_PHASE
    for (int p = 0; p < NPH; ++p) { a.ph_lo = p; a.ph_hi = p + 1; hipLaunchKernelGGL(mk_fwd, dim3(grid), dim3(512), LDS_BYTES, stream, a); }
#else
    a.ph_lo = 0; a.ph_hi = NPH; hipLaunchKernelGGL(mk_fwd, dim3(grid), dim3(512), LDS_BYTES, stream, a);
#endif
}
```
